# Optimizing an MI355X kernel written in HIP

```python
import math
import jax, jax.numpy as jnp
from jax import lax
import numpy as np

D_MODEL = 2048
BATCH = 2
SEQ = 16384
DEPTH = 1
DEC_BATCH = 4
DEC_SEQ = 4096
PAST_LEN = 128

GRID_W = 64
NA_HEADS = 8
NA_HD = 128
NA_WIN_ROWS = 8
NA_WIN_COLS = 16
DIFF_HEADS = 8
DIFF_DK = 64
DIFF_DV = 2 * DIFF_DK
Q_BLOCK = 128
ROPE_THETA = 10000.0
MEM_TOKENS = 256
MEM_HEADS = 4
MEM_HD = D_MODEL // MEM_HEADS
D_FF = ((8 * D_MODEL // 3 + 255) // 256) * 256
NA_W = NA_HEADS * NA_HD
DIFF_QK_W = DIFF_HEADS * 2 * DIFF_DK
DIFF_V_W = DIFF_HEADS * DIFF_DV
MIX_W = NA_W + DIFF_V_W
IN_W = 3 * NA_W + 2 * DIFF_QK_W + DIFF_V_W
RMS_EPS = 1e-6
SUBLN_EPS = 1e-5

kernel_name = "hymba_na_diffattn_encoder"


def rms_norm(x, g, eps=RMS_EPS):
    xf = x.astype(jnp.float32)
    y = xf * lax.rsqrt(jnp.mean(xf * xf, axis=-1, keepdims=True) + eps)
    return (y * g.astype(jnp.float32)).astype(x.dtype)


def rotary_tables(T):
    inv = 1.0 / (ROPE_THETA ** (jnp.arange(0, DIFF_DK, 2, dtype=jnp.float32) / DIFF_DK))
    ang = jnp.arange(T, dtype=jnp.float32)[:, None] * inv[None, :]
    ang = jnp.concatenate([ang, ang], axis=-1)
    return jnp.cos(ang), jnp.sin(ang)


def apply_rope(x, cos, sin):
    c = cos[None, :, None, None, :]
    s = sin[None, :, None, None, :]
    xf = x.astype(jnp.float32)
    x1, x2 = jnp.split(xf, 2, axis=-1)
    rot = jnp.concatenate([-x2, x1], axis=-1)
    return (xf * c + rot * s).astype(x.dtype)


def neighbourhood_attention(q, k, v, rpb):
    B, T = q.shape[0], q.shape[1]
    rows = T // GRID_W
    wr = min(NA_WIN_ROWS, rows)
    q4 = q.reshape(B, rows, GRID_W, NA_HEADS, NA_HD)
    k4 = k.reshape(B, rows, GRID_W, NA_HEADS, NA_HD)
    v4 = v.reshape(B, rows, GRID_W, NA_HEADS, NA_HD)
    col_start = np.clip(np.arange(GRID_W) - NA_WIN_COLS // 2, 0, GRID_W - NA_WIN_COLS)
    col_idx = col_start[:, None] + np.arange(NA_WIN_COLS)[None, :]
    dc_idx = col_idx - np.arange(GRID_W)[:, None] + (NA_WIN_COLS - 1)
    scale = NA_HD ** -0.5

    def row_block(r):
        rs = jnp.clip(r - wr // 2, 0, rows - wr)
        q_r = lax.dynamic_index_in_dim(q4, r, axis=1, keepdims=False)
        k_rows = lax.dynamic_slice_in_dim(k4, rs, wr, axis=1)
        v_rows = lax.dynamic_slice_in_dim(v4, rs, wr, axis=1)
        k_win = k_rows[:, :, col_idx]
        v_win = v_rows[:, :, col_idx]
        dr_idx = rs + jnp.arange(wr) - r + (NA_WIN_ROWS - 1)
        bias = rpb[:, dr_idx[None, :, None], dc_idx[:, None, :]]
        s = jnp.einsum('bchd,bicjhd->bhcij', q_r, k_win).astype(jnp.float32) * scale
        s = s + bias.astype(jnp.float32)[None]
        p = jax.nn.softmax(s.reshape(B, NA_HEADS, GRID_W, wr * NA_WIN_COLS), axis=-1)
        p = p.reshape(B, NA_HEADS, GRID_W, wr, NA_WIN_COLS).astype(v.dtype)
        return jnp.einsum('bhcij,bicjhd->bchd', p, v_win)

    out = lax.map(row_block, jnp.arange(rows, dtype=jnp.int32))
    return out.transpose(1, 0, 2, 3, 4).reshape(B, T, NA_W)


def differential_attention(q, k, v, lam, g_subln, lam_init):
    B, T = q.shape[0], q.shape[1]
    nblk = T // Q_BLOCK
    scale = DIFF_DK ** -0.5
    qb = q.reshape(B, nblk, Q_BLOCK, DIFF_HEADS, 2, DIFF_DK).transpose(1, 0, 2, 3, 4, 5)

    def q_block(qi):
        s = jnp.einsum('bqhsd,bkhsd->bhsqk', qi, k).astype(jnp.float32) * scale
        p = jax.nn.softmax(s, axis=-1)
        a = (p[:, :, 0] - lam * p[:, :, 1]).astype(v.dtype)
        return jnp.einsum('bhqk,bkhd->bqhd', a, v)

    o = lax.map(q_block, qb).transpose(1, 0, 2, 3, 4).reshape(B, T, DIFF_HEADS, DIFF_DV)
    o = rms_norm(o, g_subln, eps=SUBLN_EPS) * (1.0 - lam_init)
    return o.reshape(B, T, DIFF_V_W)


def memory_cross_attention(h, mem, g_x, g_mem, w_mq, w_mkv, w_mo):
    B, T = h.shape[0], h.shape[1]
    M = mem.shape[1]
    hn = rms_norm(h, g_x)
    mn = rms_norm(mem, g_mem)
    q = (hn @ w_mq).reshape(B, T, MEM_HEADS, MEM_HD)
    kv = mn @ w_mkv
    k = kv[..., :D_MODEL].reshape(B, M, MEM_HEADS, MEM_HD)
    v = kv[..., D_MODEL:].reshape(B, M, MEM_HEADS, MEM_HD)
    s = jnp.einsum('bqhd,bkhd->bhqk', q, k).astype(jnp.float32) * (MEM_HD ** -0.5)
    p = jax.nn.softmax(s, axis=-1).astype(v.dtype)
    o = jnp.einsum('bhqk,bkhd->bqhd', p, v).reshape(B, T, D_MODEL)
    return o @ w_mo


def swiglu_ffn(h, g_ffn, w_gate_up, w_down):
    hn = rms_norm(h, g_ffn)
    gu = hn @ w_gate_up
    gate, up = gu[..., :D_FF], gu[..., D_FF:]
    return (jax.nn.silu(gate) * up) @ w_down


def encoder_trunk(x, mem, g_mix, w_in, rpb, lam_q1, lam_k1, lam_q2, lam_k2, g_subln, w_out,
                  g_xattn, g_mem, w_mq, w_mkv, w_mo, g_ffn, w_gate_up, w_down, g_final):
    B, T = x.shape[0], x.shape[1]
    cos, sin = rotary_tables(T)
    splits = [NA_W, 2 * NA_W, 3 * NA_W, 3 * NA_W + DIFF_QK_W, 3 * NA_W + 2 * DIFF_QK_W]
    for l in range(DEPTH):
        lam_init = 0.8 - 0.6 * math.exp(-0.3 * l)
        xn = rms_norm(x, g_mix[l])
        proj = xn @ w_in[l]
        na_q, na_k, na_v, df_q, df_k, df_v = jnp.split(proj, splits, axis=-1)
        na_o = neighbourhood_attention(
            na_q.reshape(B, T, NA_HEADS, NA_HD),
            na_k.reshape(B, T, NA_HEADS, NA_HD),
            na_v.reshape(B, T, NA_HEADS, NA_HD), rpb[l])
        df_q = apply_rope(df_q.reshape(B, T, DIFF_HEADS, 2, DIFF_DK), cos, sin)
        df_k = apply_rope(df_k.reshape(B, T, DIFF_HEADS, 2, DIFF_DK), cos, sin)
        lam = (jnp.exp(jnp.sum(lam_q1[l].astype(jnp.float32) * lam_k1[l].astype(jnp.float32)))
               - jnp.exp(jnp.sum(lam_q2[l].astype(jnp.float32) * lam_k2[l].astype(jnp.float32)))
               + lam_init)
        df_o = differential_attention(df_q, df_k, df_v.reshape(B, T, DIFF_HEADS, DIFF_DV),
                                      lam, g_subln[l], lam_init)
        x = x + jnp.concatenate([na_o, df_o], axis=-1) @ w_out[l]
        x = x + memory_cross_attention(x, mem, g_xattn[l], g_mem[l], w_mq[l], w_mkv[l], w_mo[l])
        x = x + swiglu_ffn(x, g_ffn[l], w_gate_up[l], w_down[l])
    return rms_norm(x, g_final)


def setup_inputs(seed: int = 0) -> dict:
    key = jax.random.key(seed)
    ks = jax.random.split(key, 24)
    f32 = jnp.float32

    def w(k, shape, fan_in):
        return jax.random.normal(k, shape, f32) * (fan_in ** -0.5)

    def gain(k, shape):
        return 1.0 + 0.01 * jax.random.normal(k, shape, f32)

    return {
        "x_prompt": jax.random.normal(ks[0], (BATCH, SEQ, D_MODEL), f32),
        "x_sample": jax.random.normal(ks[1], (DEC_BATCH, DEC_SEQ, D_MODEL), f32),
        "mem_prompt": jax.random.normal(ks[2], (BATCH, MEM_TOKENS, D_MODEL), f32),
        "mem_sample": jax.random.normal(ks[3], (DEC_BATCH, MEM_TOKENS, D_MODEL), f32),
        "g_mix": gain(ks[4], (DEPTH, D_MODEL)),
        "w_in": w(ks[5], (DEPTH, D_MODEL, IN_W), D_MODEL),
        "rpb": 0.1 * jax.random.normal(ks[6], (DEPTH, NA_HEADS, 2 * NA_WIN_ROWS - 1, 2 * NA_WIN_COLS - 1), f32),
        "lam_q1": 0.1 * jax.random.normal(ks[7], (DEPTH, DIFF_DK), f32),
        "lam_k1": 0.1 * jax.random.normal(ks[8], (DEPTH, DIFF_DK), f32),
        "lam_q2": 0.1 * jax.random.normal(ks[9], (DEPTH, DIFF_DK), f32),
        "lam_k2": 0.1 * jax.random.normal(ks[10], (DEPTH, DIFF_DK), f32),
        "g_subln": gain(ks[11], (DEPTH, DIFF_DV)),
        "w_out": w(ks[12], (DEPTH, MIX_W, D_MODEL), MIX_W),
        "g_xattn": gain(ks[13], (DEPTH, D_MODEL)),
        "g_mem": gain(ks[14], (DEPTH, D_MODEL)),
        "w_mq": w(ks[15], (DEPTH, D_MODEL, D_MODEL), D_MODEL),
        "w_mkv": w(ks[16], (DEPTH, D_MODEL, 2 * D_MODEL), D_MODEL),
        "w_mo": w(ks[17], (DEPTH, D_MODEL, D_MODEL), D_MODEL),
        "g_ffn": gain(ks[18], (DEPTH, D_MODEL)),
        "w_gate_up": w(ks[19], (DEPTH, D_MODEL, 2 * D_FF), D_MODEL),
        "w_down": w(ks[20], (DEPTH, D_FF, D_MODEL), D_FF),
        "g_final": gain(ks[21], (D_MODEL,)),
    }


def reference(x_prompt, x_sample, mem_prompt, mem_sample, g_mix, w_in, rpb, lam_q1, lam_k1,
              lam_q2, lam_k2, g_subln, w_out, g_xattn, g_mem, w_mq, w_mkv, w_mo, g_ffn,
              w_gate_up, w_down, g_final):
    y_prompt = encoder_trunk(x_prompt, mem_prompt, g_mix, w_in, rpb, lam_q1, lam_k1, lam_q2, lam_k2,
                             g_subln, w_out, g_xattn, g_mem, w_mq, w_mkv, w_mo, g_ffn,
                             w_gate_up, w_down, g_final)
    y_sample = encoder_trunk(x_sample, mem_sample, g_mix, w_in, rpb, lam_q1, lam_k1, lam_q2, lam_k2,
                             g_subln, w_out, g_xattn, g_mem, w_mq, w_mkv, w_mo, g_ffn,
                             w_gate_up, w_down, g_final)
    return (y_prompt, y_sample)
```

```cpp
#include <hip/hip_runtime.h>
#include <hip/hip_cooperative_groups.h>
#include <cstdio>
#include <cstdint>
namespace cg = cooperative_groups;

#ifndef MK_MULTI
#define MK_MULTI 0
#endif

#define LAS __attribute__((address_space(3)))
typedef unsigned short bf16_t;
typedef short bf16x8 __attribute__((ext_vector_type(8)));
typedef short s16x4 __attribute__((ext_vector_type(4)));
typedef float f32x2 __attribute__((ext_vector_type(2)));
typedef float f32x4 __attribute__((ext_vector_type(4)));
typedef float f32x16 __attribute__((ext_vector_type(16)));
typedef unsigned u32x2 __attribute__((ext_vector_type(2)));
typedef unsigned u32x4 __attribute__((ext_vector_type(4)));

constexpr int DM = 2048, TP = 16384, TS = 4096, NP = 2 * TP, NS = 4 * TS, MT = NP + NS;
constexpr int INW = 6144, DFF = 5632, NGU = 2 * DFF, MEMT = 256, NMEM = 6 * MEMT, NSW = 1024;
constexpr float RMS_EPS = 1e-6f, SUBLN_EPS = 1e-5f, LOG2E = 1.4426950408889634f;
constexpr float NA_QS = 0.08838834764831845f * LOG2E, DF_QS = 0.125f * LOG2E, MEM_QS = 0.04419417382415922f * LOG2E;
constexpr float LAM_INIT = 0.2f;

constexpr size_t MiB = 1u << 20;
constexpr size_t WS_SS = 0, WS_RS0 = 6 * MiB, WS_ROPE = 7 * MiB, WS_WIN = 11 * MiB, WS_WOUT = 35 * MiB, WS_WMQ = 43 * MiB, WS_WMO = 51 * MiB,
                 WS_WMKV = 59 * MiB, WS_WGU = 75 * MiB, WS_WDN = 119 * MiB, WS_MN = 141 * MiB, WS_KB = 147 * MiB, WS_VB = 153 * MiB,
                 WS_WQK = 159 * MiB, WS_WVO = 183 * MiB, WS_O1 = 207 * MiB, WS_XB = 239 * MiB, WS_BIG = 431 * MiB, WS_END = 1007 * MiB;
constexpr size_t WS_H1B = WS_BIG, WS_S = WS_BIG + 192 * MiB, WS_P = WS_BIG + 384 * MiB, WS_ACT = WS_BIG;

constexpr int LDS_BYTES = 147456, NTHREADS = 512;

__device__ __forceinline__ unsigned cvt_pk_bf16(float lo, float hi) { unsigned r; asm volatile("v_cvt_pk_bf16_f32 %0, %1, %2" : "=v"(r) : "v"(lo), "v"(hi)); return r; }
__device__ __forceinline__ unsigned f2bf(float f) { unsigned u = __builtin_bit_cast(unsigned, f); return (u + 0x7fffu + ((u >> 16) & 1u)) >> 16; }
__device__ __forceinline__ unsigned pk2(float lo, float hi) { return f2bf(lo) | (f2bf(hi) << 16); }
__device__ __forceinline__ float wave_sum(float v) {
#pragma unroll
    for (int o = 1; o < 64; o <<= 1) v += __shfl_xor(v, o);
    return v;
}
__device__ __forceinline__ float wave_max(float v) {
#pragma unroll
    for (int o = 1; o < 64; o <<= 1) v = fmaxf(v, __shfl_xor(v, o));
    return v;
}
__device__ __forceinline__ int tid_l() { int t = threadIdx.x; asm volatile("" : "+v"(t)); return t; }
__device__ __forceinline__ int batch_of_pm(int pm) { return pm < 128 ? (pm >> 6) : 2 + ((pm - 128) >> 4); }

namespace pg8 {
constexpr int BM = 256, BK = 64, HALF = 128, HTB = HALF * BK * 2, STAGE_BYTES = 8 * HTB, NXCD = 8, WGM = 8;
__host__ __device__ __forceinline__ int lds_byte(int r, int c) { const int st = (r >> 4) * 2 + (c >> 5), rr = r & 15, cc = c & 31, ob = rr * 64 + cc * 2; return st * 1024 + (ob ^ (((ob >> 9) & 1) << 5)); }
__host__ __device__ __forceinline__ void stage_rc(int b, int& R, int& C) { const int st = b / 1024, sb = b % 1024, swz = sb ^ (((sb >> 9) & 1) << 5); R = (st >> 1) * 16 + swz / 64; C = (st & 1) * 32 + (swz % 64) / 2; }
__host__ __device__ __forceinline__ int perm32(int rho) { const int n = rho >> 4, i = rho & 15; return 8 * (i >> 2) + 4 * n + (i & 3); }

struct Unit { int pm, pn, z; };

__device__ __forceinline__ void tile_decode(int wgid, int nM, int nN, int& pm, int& pn) {
    const int nwg = nM * nN;
    { const int q = nwg / NXCD, r = nwg % NXCD, xcd = wgid % NXCD, off = wgid / NXCD; wgid = (xcd < r ? xcd * (q + 1) : r * (q + 1) + (xcd - r) * q) + off; }
    const int nig = WGM * nN, gid = wgid / nig, fm = gid * WGM, gsz = (nM - fm) < WGM ? (nM - fm) : WGM;
    pm = fm + ((wgid % nig) % gsz); pn = (wgid % nig) / gsz;
}
struct Sched {
    const char *A0, *B0, *A1, *B1; int nM0, nN0, n0, nM1, n1; size_t tA, tB, bstride; int G, c;
    __device__ __forceinline__ bool next(int i, Unit& u) const {
        int L = i * G + c;
        if (L < n0) { tile_decode(L, nM0, nN0, u.pm, u.pn); u.z = 0; return true; }
        L -= n0; if (L < n1) { u.pm = L % nM1; u.pn = L / nM1; u.z = 1; return true; }
        return false;
    }
    __device__ __forceinline__ const char* abase(const Unit& u) const { return (u.z ? A1 : A0) + (size_t)u.pm * tA; }
    __device__ __forceinline__ const char* bbase(const Unit& u) const { return (u.z ? B1 : B0) + (size_t)u.pn * tB + (bstride ? (size_t)batch_of_pm(u.pm) * bstride : (size_t)0); }
};
struct PreSched {
    const char *Kb, *Vb, *Wmq, *Wmo; int G, c;
    __device__ __forceinline__ bool next(int i, Unit& u) const { const int L = i * G + c; if (L >= 384) return false; u.z = L / 8; const int t = L & 7; if (u.z < 24) { u.pm = 0; u.pn = t; } else { u.pm = t; u.pn = 0; } return true; }
    __device__ __forceinline__ const char* abase(const Unit& u) const { const int zz = u.z % 24, b = zz >> 2, h = zz & 3;
        return u.z < 24 ? Kb + ((size_t)(b * 256) * DM + h * 512) * 2 : Wmo + ((size_t)(u.pm * 256) * DM + h * 512) * 2; }
    __device__ __forceinline__ const char* bbase(const Unit& u) const { const int zz = u.z % 24, b = zz >> 2, h = zz & 3;
        return u.z < 24 ? Wmq + ((size_t)(u.pn * 256) * DM + h * 512) * 2 : Vb + ((size_t)(b * 256) * DM + h * 512) * 2; }
};

template <class Epi, class SchedT, bool ALIGN_EPI, bool SP2>
__device__ __forceinline__ void gemm_phase(LAS unsigned char* lds, const int K, const int ld, const SchedT& S, const Epi& E) {
    const int tid = tid_l(), wid = __builtin_amdgcn_readfirstlane(tid >> 6), lane = tid & 63, wr = wid >> 2, wc = wid & 3, fr = lane & 15, fq = lane >> 4;
    const int nt = K / BK;
    unsigned voffA[2], voffB[2];
#pragma unroll
    for (int i = 0; i < 2; ++i) { int R, C; stage_rc(tid * 16 + i * 8192, R, C); const int Rb = Epi::PERM ? ((R & ~31) + perm32(R & 31)) : R;
        voffA[i] = (unsigned)(R * ld + C) * 2u; voffB[i] = (unsigned)(Rb * ld + C) * 2u; }
    const size_t kstep = (size_t)(BK * 2);
    const size_t hstep = (size_t)HALF * ld * 2;
    const unsigned ldsw = (unsigned)wid * 1024u;
    const int aoff = lds_byte(wr * 64 + fr, fq * 8), boff = lds_byte(wc * 32 + fr, fq * 8);
#define PG8_SA(b, h) (((b) * 2 + (h)) * HTB)
#define PG8_SB(b, h) ((4 + (b) * 2 + (h)) * HTB)
#define PG8_STAGE(bufoff, gbase, voff) do { _Pragma("unroll") for (int _i = 0; _i < 2; ++_i) \
        __builtin_amdgcn_global_load_lds((const unsigned*)((const char*)(gbase) + (voff)[_i]), (LAS unsigned*)(lds + (bufoff) + ldsw + _i * 8192), 16, 0, 0); } while (0)
#define PG8_LDA(dst, b, h) do { _Pragma("unroll") for (int m = 0; m < 4; ++m) _Pragma("unroll") for (int k = 0; k < 2; ++k) dst[m][k] = *(const LAS bf16x8*)(lds + PG8_SA(b, h) + aoff + m * 2048 + k * 1024); } while (0)
#define PG8_LDB(dst, b, h) do { _Pragma("unroll") for (int n = 0; n < 2; ++n) _Pragma("unroll") for (int k = 0; k < 2; ++k) dst[n][k] = *(const LAS bf16x8*)(lds + PG8_SB(b, h) + boff + n * 2048 + k * 1024); } while (0)
#define PG8_MMA(ai, bj, At, Bt) do { __builtin_amdgcn_s_setprio(1); _Pragma("unroll") for (int m = 0; m < 4; ++m) _Pragma("unroll") for (int n = 0; n < 2; ++n) _Pragma("unroll") for (int k = 0; k < 2; ++k) \
        acc[ai][bj][m][n] = __builtin_amdgcn_mfma_f32_16x16x32_bf16(Bt[n][k], At[m][k], acc[ai][bj][m][n], 0, 0, 0); __builtin_amdgcn_s_setprio(0); } while (0)
#define PG8_WAIT_V(n) asm volatile("s_waitcnt vmcnt(" #n ")" ::: "memory")
#define PG8_WAIT_L(n) asm volatile("s_waitcnt lgkmcnt(" #n ")" ::: "memory")
#define PG8_BAR __builtin_amdgcn_s_barrier()
#define PG8_SCHED __builtin_amdgcn_sched_barrier(0)
    Unit cur, nxt; int ui = 0;
    if (!S.next(0, cur)) return;
    f32x4 acc[2][2][4][2];
#pragma unroll
    for (int a = 0; a < 2; ++a)
#pragma unroll
        for (int b = 0; b < 2; ++b)
#pragma unroll
            for (int m = 0; m < 4; ++m)
#pragma unroll
                for (int n = 0; n < 2; ++n) acc[a][b][m][n] = (f32x4){0.f, 0.f, 0.f, 0.f};
    bf16x8 At[4][2], B0[2][2], B1[2][2];
    const char* cA = S.abase(cur); const char* cB = S.bbase(cur);
    if constexpr (SP2) {
        PG8_STAGE(PG8_SB(0, 0), cB, voffB); PG8_STAGE(PG8_SB(0, 1), cB + hstep, voffB); PG8_STAGE(PG8_SA(0, 0), cA, voffA); PG8_STAGE(PG8_SA(0, 1), cA + hstep, voffA);
        if (wr == 1) PG8_BAR;
        PG8_WAIT_V(2); PG8_BAR;
        PG8_STAGE(PG8_SB(1, 0), cB + kstep, voffB); PG8_STAGE(PG8_SA(1, 0), cA + kstep, voffA); PG8_STAGE(PG8_SB(1, 1), cB + hstep + kstep, voffB);
        PG8_WAIT_V(6); PG8_BAR;
    } else {
        PG8_STAGE(PG8_SB(0, 0), cB, voffB); PG8_STAGE(PG8_SA(0, 0), cA, voffA); PG8_STAGE(PG8_SB(0, 1), cB + hstep, voffB); PG8_STAGE(PG8_SA(0, 1), cA + hstep, voffA);
        if (wr == 1) PG8_BAR;
        PG8_WAIT_V(4); PG8_BAR;
        PG8_STAGE(PG8_SB(1, 0), cB + kstep, voffB); PG8_STAGE(PG8_SA(1, 0), cA + kstep, voffA); PG8_STAGE(PG8_SB(1, 1), cB + hstep + kstep, voffB);
        PG8_WAIT_V(6); PG8_BAR;
    }
    for (;;) {
        const bool has_next = S.next(ui + 1, nxt);
        const char* nA = has_next ? S.abase(nxt) : cA; const char* nB = has_next ? S.bbase(nxt) : cB;
        for (int t = 0; t < nt; t += 2) {
            const bool last = (t == nt - 2);
            const char* a1 = cA + (size_t)(t + 1) * kstep;
            const char* a2 = last ? nA : cA + (size_t)(t + 2) * kstep; const char* b2 = last ? nB : cB + (size_t)(t + 2) * kstep;
            const char* a3 = a2 + kstep; const char* b3 = b2 + kstep;
            if constexpr (SP2) {
            PG8_LDB(B0, 0, 0); PG8_LDB(B1, 0, 1); PG8_SCHED; PG8_LDA(At, 0, 0); PG8_STAGE(PG8_SA(1, 1), a1 + hstep, voffA);
            PG8_WAIT_V(8); PG8_WAIT_L(0); PG8_BAR; PG8_MMA(0, 0, At, B0); PG8_MMA(0, 1, At, B1); PG8_BAR; PG8_SCHED;
            PG8_LDA(At, 0, 1); PG8_STAGE(PG8_SB(0, 0), b2, voffB); PG8_STAGE(PG8_SB(0, 1), b2 + hstep, voffB); PG8_STAGE(PG8_SA(0, 0), a2, voffA);
            PG8_WAIT_V(8); PG8_WAIT_L(0); PG8_BAR; PG8_MMA(1, 0, At, B0); PG8_MMA(1, 1, At, B1); PG8_BAR; PG8_SCHED;
            PG8_LDB(B0, 1, 0); PG8_LDB(B1, 1, 1); PG8_SCHED; PG8_LDA(At, 1, 0); PG8_STAGE(PG8_SA(0, 1), a2 + hstep, voffA);
            PG8_WAIT_V(8); PG8_WAIT_L(0); PG8_BAR; PG8_MMA(0, 0, At, B0); PG8_MMA(0, 1, At, B1); PG8_BAR; PG8_SCHED;
            PG8_LDA(At, 1, 1); PG8_STAGE(PG8_SB(1, 0), b3, voffB); PG8_STAGE(PG8_SB(1, 1), b3 + hstep, voffB); PG8_STAGE(PG8_SA(1, 0), a3, voffA);
            PG8_WAIT_V(8); PG8_WAIT_L(0); PG8_BAR; PG8_MMA(1, 0, At, B0); PG8_MMA(1, 1, At, B1); PG8_BAR; PG8_SCHED;
            } else {
            PG8_LDB(B0, 0, 0); PG8_SCHED; PG8_LDA(At, 0, 0); PG8_STAGE(PG8_SA(1, 1), a1 + hstep, voffA);
            PG8_WAIT_L(8); PG8_BAR; PG8_WAIT_L(0); PG8_MMA(0, 0, At, B0); PG8_BAR; PG8_SCHED;
            PG8_LDB(B1, 0, 1); PG8_STAGE(PG8_SB(0, 0), b2, voffB);
            PG8_BAR; PG8_WAIT_L(0); PG8_MMA(0, 1, At, B1); PG8_BAR;
            PG8_LDA(At, 0, 1); PG8_STAGE(PG8_SA(0, 0), a2, voffA);
            PG8_BAR; PG8_WAIT_L(0); PG8_MMA(1, 0, At, B0); PG8_BAR; PG8_SCHED;
            PG8_STAGE(PG8_SB(0, 1), b2 + hstep, voffB);
            PG8_WAIT_V(6); PG8_BAR; PG8_MMA(1, 1, At, B1); PG8_BAR;
            PG8_LDB(B0, 1, 0); PG8_SCHED; PG8_LDA(At, 1, 0); PG8_STAGE(PG8_SA(0, 1), a2 + hstep, voffA);
            PG8_WAIT_L(8); PG8_BAR; PG8_WAIT_L(0); PG8_MMA(0, 0, At, B0); PG8_BAR; PG8_SCHED;
            PG8_LDB(B1, 1, 1); PG8_STAGE(PG8_SB(1, 0), b3, voffB);
            PG8_BAR; PG8_WAIT_L(0); PG8_MMA(0, 1, At, B1); PG8_BAR;
            PG8_LDA(At, 1, 1); PG8_STAGE(PG8_SA(1, 0), a3, voffA);
            PG8_BAR; PG8_WAIT_L(0); PG8_MMA(1, 0, At, B0); PG8_BAR; PG8_SCHED;
            PG8_STAGE(PG8_SB(1, 1), b3 + hstep, voffB);
            PG8_WAIT_V(6); PG8_BAR; PG8_MMA(1, 1, At, B1); PG8_BAR;
            }
        }
        if constexpr (ALIGN_EPI) { if (wr == 0) PG8_BAR; }
        E(acc, cur, wr, wc, fr, fq);
        if (!has_next) break;
#pragma unroll
        for (int a = 0; a < 2; ++a)
#pragma unroll
            for (int b = 0; b < 2; ++b)
#pragma unroll
                for (int m = 0; m < 4; ++m)
#pragma unroll
                    for (int n = 0; n < 2; ++n) acc[a][b][m][n] = (f32x4){0.f, 0.f, 0.f, 0.f};
        cur = nxt; cA = nA; cB = nB; ++ui;
        if constexpr (ALIGN_EPI) { if (wr == 1) PG8_BAR; }
    }
    PG8_WAIT_V(0);
    if constexpr (!ALIGN_EPI) { if (wr == 0) PG8_BAR; }
    PG8_BAR;
#undef PG8_SA
#undef PG8_SB
#undef PG8_STAGE
#undef PG8_LDA
#undef PG8_LDB
#undef PG8_MMA
#undef PG8_WAIT_V
#undef PG8_WAIT_L
#undef PG8_BAR
#undef PG8_SCHED
}

typedef const f32x4 (&AccRef)[2][2][4][2];

__device__ __forceinline__ float row_rs(const float* ss, int row) {
    const f32x4* p = (const f32x4*)(ss + (size_t)row * 32); float s = 0.f;
#pragma unroll
    for (int i = 0; i < 8; ++i) { const f32x4 v = p[i]; s += (v[0] + v[1]) + (v[2] + v[3]); }
    return __builtin_amdgcn_rsqf(s * (1.0f / DM) + RMS_EPS);
}

struct EpiInProj {
    static constexpr bool PERM = true;
    bf16_t* proj; bf16_t* kb; bf16_t* vb; const float* rs0; const f32x2* rope;
    __device__ __forceinline__ void operator()(AccRef acc, const Unit& u, int wr, int wc, int fr, int fq) const {
        const int row0 = u.pm * BM + wr * 64 + fr;
        if (u.z == 1) {
            bf16_t* base = (u.pn < 8 ? kb : vb) + (u.pn & 7) * BM + wc * 32 + 8 * fq;
#pragma unroll
            for (int ai = 0; ai < 2; ++ai)
#pragma unroll
                for (int m = 0; m < 4; ++m) { bf16_t* rowp = base + (size_t)(row0 + ai * HALF + m * 16) * DM;
#pragma unroll
                    for (int bj = 0; bj < 2; ++bj) { const f32x4 v0 = acc[ai][bj][m][0], v1 = acc[ai][bj][m][1]; u32x4 w;
                        w.x = cvt_pk_bf16(v0[0], v0[1]); w.y = cvt_pk_bf16(v0[2], v0[3]); w.z = cvt_pk_bf16(v1[0], v1[1]); w.w = cvt_pk_bf16(v1[2], v1[3]);
                        *(u32x4*)(rowp + bj * HALF) = w; } }
            return;
        }
        const int pn = u.pn; const bool rp = (pn >= 12 && pn < 20);
        const float sc = pn < 4 ? NA_QS : ((pn >= 12 && pn < 16) ? DF_QS : 1.0f);
        if (!rp) {
            bf16_t* base = proj + pn * BM + wc * 32 + 8 * fq;
#pragma unroll
            for (int ai = 0; ai < 2; ++ai)
#pragma unroll
                for (int m = 0; m < 4; ++m) { const int row = row0 + ai * HALF + m * 16; const float rr = rs0[row] * sc; bf16_t* rowp = base + (size_t)row * INW;
#pragma unroll
                    for (int bj = 0; bj < 2; ++bj) { const f32x4 v0 = acc[ai][bj][m][0] * rr, v1 = acc[ai][bj][m][1] * rr; u32x4 w;
                        w.x = cvt_pk_bf16(v0[0], v0[1]); w.y = cvt_pk_bf16(v0[2], v0[3]); w.z = cvt_pk_bf16(v1[0], v1[1]); w.w = cvt_pk_bf16(v1[2], v1[3]);
                        *(u32x4*)(rowp + bj * HALF) = w; } }
        } else {
            const int dd0 = 16 * (wc & 1) + 4 * fq;
            bf16_t* base = proj + pn * BM + (wc >> 1) * 64 + dd0;
#pragma unroll
            for (int ai = 0; ai < 2; ++ai)
#pragma unroll
                for (int m = 0; m < 4; ++m) { const int row = row0 + ai * HALF + m * 16; const float rr = rs0[row] * sc; bf16_t* rowp = base + (size_t)row * INW;
                    const int t = row < NP ? (row & (TP - 1)) : (row & (TS - 1));
                    const f32x4 cs0 = *(const f32x4*)(rope + (size_t)t * 32 + dd0), cs1 = *(const f32x4*)(rope + (size_t)t * 32 + dd0 + 2);
#pragma unroll
                    for (int bj = 0; bj < 2; ++bj) { const f32x4 x1 = acc[ai][bj][m][0] * rr, x2 = acc[ai][bj][m][1] * rr;
                        const float a0 = x1[0] * cs0[0] - x2[0] * cs0[1], a1 = x1[1] * cs0[2] - x2[1] * cs0[3], a2 = x1[2] * cs1[0] - x2[2] * cs1[1], a3 = x1[3] * cs1[2] - x2[3] * cs1[3];
                        const float b0 = x2[0] * cs0[0] + x1[0] * cs0[1], b1 = x2[1] * cs0[2] + x1[1] * cs0[3], b2 = x2[2] * cs1[0] + x1[2] * cs1[1], b3 = x2[3] * cs1[2] + x1[3] * cs1[3];
                        u32x2 wa, wb; wa.x = cvt_pk_bf16(a0, a1); wa.y = cvt_pk_bf16(a2, a3); wb.x = cvt_pk_bf16(b0, b1); wb.y = cvt_pk_bf16(b2, b3);
                        *(u32x2*)(rowp + bj * HALF) = wa; *(u32x2*)(rowp + bj * HALF + 32) = wb; } }
        }
    }
};
struct EpiPre {
    static constexpr bool PERM = true;
    bf16_t* wqk; bf16_t* wvo;
    __device__ __forceinline__ void operator()(AccRef acc, const Unit& u, int wr, int wc, int fr, int fq) const {
        const int zz = u.z % 24, b = zz >> 2, h = zz & 3; bf16_t* base; int ldc; float sc;
        if (u.z < 24) { base = wqk + ((size_t)(b * 1024 + h * 256)) * DM + u.pn * BM; ldc = DM; sc = MEM_QS; }
        else { base = wvo + ((size_t)(b * 2048 + u.pm * BM)) * NSW + h * 256; ldc = NSW; sc = 1.0f; }
        base += wc * 32 + 8 * fq;
#pragma unroll
        for (int ai = 0; ai < 2; ++ai)
#pragma unroll
            for (int m = 0; m < 4; ++m) { bf16_t* rowp = base + (size_t)(wr * 64 + fr + ai * HALF + m * 16) * ldc;
#pragma unroll
                for (int bj = 0; bj < 2; ++bj) { const f32x4 v0 = acc[ai][bj][m][0] * sc, v1 = acc[ai][bj][m][1] * sc; u32x4 w;
                    w.x = cvt_pk_bf16(v0[0], v0[1]); w.y = cvt_pk_bf16(v0[2], v0[3]); w.z = cvt_pk_bf16(v1[0], v1[1]); w.w = cvt_pk_bf16(v1[2], v1[3]);
                    *(u32x4*)(rowp + bj * HALF) = w; } }
    }
};
struct EpiResid {
    static constexpr bool PERM = false;
    const float* base; float* out; bf16_t* ob; float* ss;
    __device__ __forceinline__ void operator()(AccRef acc, const Unit& u, int wr, int wc, int fr, int fq) const {
        const int col0 = u.pn * BM + wc * 32 + 4 * fq;
#pragma unroll
        for (int ai = 0; ai < 2; ++ai)
#pragma unroll
            for (int m = 0; m < 4; ++m) { const int row = u.pm * BM + ai * HALF + wr * 64 + m * 16 + fr; const size_t off = (size_t)row * DM + col0; float q = 0.f;
#pragma unroll
                for (int bj = 0; bj < 2; ++bj)
#pragma unroll
                    for (int n = 0; n < 2; ++n) { const size_t o2 = off + bj * HALF + n * 16; const f32x4 o = *(const f32x4*)(base + o2) + acc[ai][bj][m][n];
                        *(f32x4*)(out + o2) = o; q += (o[0] * o[0] + o[1] * o[1]) + (o[2] * o[2] + o[3] * o[3]);
                        if (ob) { u32x2 w; w.x = cvt_pk_bf16(o[0], o[1]); w.y = cvt_pk_bf16(o[2], o[3]); *(u32x2*)(ob + o2) = w; } }
                q += __shfl_xor(q, 16); q += __shfl_xor(q, 32);
                if (fq == 0) ss[(size_t)row * 32 + u.pn * 4 + wc] = q; }
    }
};
struct EpiX { static constexpr bool PERM = false; const float* xp; const float* xs; float* out; bf16_t* ob; float* ss;
    __device__ __forceinline__ void operator()(AccRef acc, const Unit& u, int wr, int wc, int fr, int fq) const {
        const float* base = (u.pm < NP / 256) ? xp : xs - (size_t)NP * DM; EpiResid E{base, out, ob, ss}; E(acc, u, wr, wc, fr, fq); } };
struct EpiS {
    static constexpr bool PERM = false;
    float* S; const float* ss;
    __device__ __forceinline__ void operator()(AccRef acc, const Unit& u, int wr, int wc, int fr, int fq) const {
        const int col0 = u.pn * BM + wc * 32 + 4 * fq;
#pragma unroll
        for (int ai = 0; ai < 2; ++ai)
#pragma unroll
            for (int m = 0; m < 4; ++m) { const int row = u.pm * BM + ai * HALF + wr * 64 + m * 16 + fr; const float rr = row_rs(ss, row); float* rowp = S + (size_t)row * NSW + col0;
#pragma unroll
                for (int bj = 0; bj < 2; ++bj)
#pragma unroll
                    for (int n = 0; n < 2; ++n) *(f32x4*)(rowp + bj * HALF + n * 16) = acc[ai][bj][m][n] * rr; }
    }
};
struct EpiGU {
    static constexpr bool PERM = true;
    bf16_t* act; const float* ss;
    __device__ __forceinline__ void operator()(AccRef acc, const Unit& u, int wr, int wc, int fr, int fq) const {
        bf16_t* base = act + u.pn * HALF + wc * 32 + 8 * fq;
#pragma unroll
        for (int ai = 0; ai < 2; ++ai)
#pragma unroll
            for (int m = 0; m < 4; ++m) { const int row = u.pm * BM + ai * HALF + wr * 64 + m * 16 + fr; const float rr = row_rs(ss, row); float o[8];
#pragma unroll
                for (int n = 0; n < 2; ++n)
#pragma unroll
                    for (int e = 0; e < 4; ++e) { const float g = acc[ai][0][m][n][e] * rr, up = acc[ai][1][m][n][e] * rr;
                        o[n * 4 + e] = g * __builtin_amdgcn_rcpf(1.0f + __builtin_amdgcn_exp2f(-g * LOG2E)) * up; }
                u32x4 w; w.x = cvt_pk_bf16(o[0], o[1]); w.y = cvt_pk_bf16(o[2], o[3]); w.z = cvt_pk_bf16(o[4], o[5]); w.w = cvt_pk_bf16(o[6], o[7]);
                *(u32x4*)(base + (size_t)row * DFF) = w; }
    }
};
}

namespace att {
#define SBAR() __builtin_amdgcn_sched_barrier(0)
constexpr float THR = 8.0f;
constexpr int SHM_V = 16384, SHM_K = 16384, OFF_K = 2 * SHM_V, OFF_WS = OFF_K + 2 * SHM_K, OFF_RPB = OFF_WS + 8 * 256, OFF_STG = OFF_RPB + 2048, OFF_END = OFF_STG + 8 * 8192;
__device__ __forceinline__ int crow(int r, int hi) { return (r & 3) + 8 * (r >> 2) + 4 * hi; }
#define KSWZ128(row, colB) ((row) * 256 + ((colB) ^ (((row) & 7) << 4)))
#define KSWZ64(row, colB) ((row) * 128 + ((colB) ^ ((((row) >> 1) & 7) << 4)))
__device__ __forceinline__ int v_st(int k, int c) { const int kk = (k & ~0xC) | ((k & 4) << 1) | ((k & 8) >> 1); return ((kk >> 3) * 4 + (c >> 5)) * 512 + ((kk & 7) * 32 + (c & 31)) * 2; }
__device__ __forceinline__ int v_rd_base(int lane) { return ((lane & 3) << 3) | (((lane >> 2) & 3) << 6) | (((lane >> 4) & 1) << 5) | (((lane >> 5) & 1) << 8); }
constexpr int v_rd_off(int d0, int ks, int half) { return d0 * 512 + ks * 4096 + half * 2048; }
template <int OFF> __device__ __forceinline__ s16x4 tr_read(int vb) { s16x4 r; asm volatile("ds_read_b64_tr_b16 %0, %1 offset:%2" : "=&v"(r) : "v"(vb), "i"(OFF) : "memory"); return r; }
template <int D0> __device__ __forceinline__ void pv_one(f32x16& od, int vb, bf16x8 pa0, bf16x8 pa1, bf16x8 pa2, bf16x8 pa3) {
    const s16x4 l0 = tr_read<v_rd_off(D0, 0, 0)>(vb), h0 = tr_read<v_rd_off(D0, 0, 1)>(vb), l1 = tr_read<v_rd_off(D0, 1, 0)>(vb), h1 = tr_read<v_rd_off(D0, 1, 1)>(vb);
    const s16x4 l2 = tr_read<v_rd_off(D0, 2, 0)>(vb), h2 = tr_read<v_rd_off(D0, 2, 1)>(vb), l3 = tr_read<v_rd_off(D0, 3, 0)>(vb), h3 = tr_read<v_rd_off(D0, 3, 1)>(vb);
    asm volatile("s_waitcnt lgkmcnt(0)" ::: "memory"); SBAR();
#define PK(L, H) (bf16x8){L[0], L[1], L[2], L[3], H[0], H[1], H[2], H[3]}
    od = __builtin_amdgcn_mfma_f32_32x32x16_bf16(pa0, PK(l0, h0), od, 0, 0, 0);
    od = __builtin_amdgcn_mfma_f32_32x32x16_bf16(pa1, PK(l1, h1), od, 0, 0, 0);
    od = __builtin_amdgcn_mfma_f32_32x32x16_bf16(pa2, PK(l2, h2), od, 0, 0, 0);
    od = __builtin_amdgcn_mfma_f32_32x32x16_bf16(pa3, PK(l3, h3), od, 0, 0, 0);
#undef PK
}
__device__ __forceinline__ void pv_all(f32x16* o, int vb, bf16x8 pa0, bf16x8 pa1, bf16x8 pa2, bf16x8 pa3) {
    pv_one<0>(o[0], vb, pa0, pa1, pa2, pa3); pv_one<1>(o[1], vb, pa0, pa1, pa2, pa3); pv_one<2>(o[2], vb, pa0, pa1, pa2, pa3); pv_one<3>(o[3], vb, pa0, pa1, pa2, pa3);
}
__device__ __forceinline__ void softmax_tile(f32x16& p0, f32x16& p1, float& m_reg, float& l_reg, float& alpha, bf16x8& pa0, bf16x8& pa1, bf16x8& pa2, bf16x8& pa3) {
    float pmax = p0[0];
#pragma unroll
    for (int r = 1; r < 16; ++r) pmax = fmaxf(pmax, p0[r]);
#pragma unroll
    for (int r = 0; r < 16; ++r) pmax = fmaxf(pmax, p1[r]);
    { auto rr = __builtin_amdgcn_permlane32_swap(__float_as_uint(pmax), __float_as_uint(pmax), false, false); pmax = fmaxf(__uint_as_float(rr[0]), __uint_as_float(rr[1])); }
    float mn;
    if (__builtin_expect(__all(pmax - m_reg <= THR), 1)) { mn = m_reg; alpha = 1.f; }
    else { mn = fmaxf(m_reg, pmax); alpha = __builtin_amdgcn_exp2f(m_reg - mn); m_reg = mn; }
#pragma unroll
    for (int r = 0; r < 16; ++r) { p0[r] = __builtin_amdgcn_exp2f(p0[r] - mn); p1[r] = __builtin_amdgcn_exp2f(p1[r] - mn); }
    float ps = 0.f;
#pragma unroll
    for (int r = 0; r < 16; ++r) ps += p0[r];
#pragma unroll
    for (int r = 0; r < 16; ++r) ps += p1[r];
    { auto rr = __builtin_amdgcn_permlane32_swap(__float_as_uint(ps), __float_as_uint(ps), false, false); ps = __uint_as_float(rr[0]) + __uint_as_float(rr[1]); }
    l_reg = l_reg * alpha + ps;
#define PK4(P, BASE, OUT) do { unsigned a0 = cvt_pk_bf16(P[BASE + 0], P[BASE + 1]), a1 = cvt_pk_bf16(P[BASE + 2], P[BASE + 3]);   \
    unsigned b0 = cvt_pk_bf16(P[BASE + 4], P[BASE + 5]), b1 = cvt_pk_bf16(P[BASE + 6], P[BASE + 7]);                              \
    auto r0 = __builtin_amdgcn_permlane32_swap(a0, b0, false, false); auto r1 = __builtin_amdgcn_permlane32_swap(a1, b1, false, false); \
    u32x4 w = {r0[0], r1[0], r0[1], r1[1]}; OUT = __builtin_bit_cast(bf16x8, w); } while (0)
    PK4(p0, 0, pa0); PK4(p0, 8, pa1); PK4(p1, 0, pa2); PK4(p1, 8, pa3);
#undef PK4
}
#define ATT_RESC(a) do { if (__any((a) < 1.f)) { if (hi == 0) al_l[r32] = (a); asm volatile("s_waitcnt lgkmcnt(0)" ::: "memory"); \
    _Pragma("unroll") for (int d = 0; d < 4; ++d) _Pragma("unroll") for (int r = 0; r < 16; ++r) o[d][r] *= al_l[crow(r, hi)]; } } while (0)

__device__ __forceinline__ void diff_unit(const bf16_t* __restrict__ proj, bf16_t* __restrict__ mix, float* __restrict__ o1s, const float* __restrict__ g_sub, float lam,
                                          int rowbase, int T, int h, int qb, char* lds) {
    const int tid = tid_l(), wid = tid >> 6, lane = tid & 63, r32 = lane & 31, hi = lane >> 5;
    char* V_lds = lds; char* K_lds = lds + OFF_K;
    float* wsf = (float*)(lds + OFF_WS) + wid * 64; float* li_l = wsf; float* al_l = wsf + 32;
    LAS unsigned char* ldsl = (LAS unsigned char*)lds; const int widu = __builtin_amdgcn_readfirstlane(wid);
    unsigned kgo, vgo[2];
    { const int X = wid * 1024 + lane * 16, krow = X >> 7, kcolB = (X & 127) ^ (((krow >> 1) & 7) << 4); kgo = (unsigned)(krow * INW * 2 + kcolB); }
#pragma unroll
    for (int i = 0; i < 2; ++i) { const int X = wid * 1024 + lane * 16 + i * 8192, sub = X >> 9, e = (X & 511) >> 1, kk = (sub >> 2) * 8 + (e >> 5), cc = (sub & 3) * 32 + (e & 31);
        const int k = (kk & ~0xC) | ((kk & 4) << 1) | ((kk & 8) >> 1); vgo[i] = (unsigned)((k * INW + cc) * 2); }
    const int vb0 = (int)(uintptr_t)V_lds + v_rd_base(lane);
    const int NT = T / 64; const int q0 = qb * 256;
    const bf16_t* Vh = proj + (size_t)rowbase * INW + 5120 + h * 128;
#pragma unroll 1
    for (int s = 0; s < 2; ++s) {
        const bf16_t* Kh = proj + (size_t)rowbase * INW + 4096 + h * 128 + s * 64;
        const bf16_t* Qw = proj + (size_t)(rowbase + q0 + wid * 32 + r32) * INW + 3072 + h * 128 + s * 64 + hi * 8;
        bf16x8 qr[4];
#pragma unroll
        for (int d0 = 0; d0 < 4; ++d0) qr[d0] = *(const bf16x8*)(Qw + d0 * 16);
        float m_reg = -1e30f, l_reg = 0.f; f32x16 o[4];
#pragma unroll
        for (int d = 0; d < 4; ++d) o[d] = f32x16{};
#define DDMA(j, b) do { const char* kt = (const char*)Kh + (size_t)(j) * (64 * INW * 2); const char* vt = (const char*)Vh + (size_t)(j) * (64 * INW * 2); \
        __builtin_amdgcn_global_load_lds((const unsigned*)(kt + kgo), (LAS unsigned*)(ldsl + OFF_K + (b) * SHM_K + widu * 1024), 16, 0, 0); \
        __builtin_amdgcn_global_load_lds((const unsigned*)(vt + vgo[0]), (LAS unsigned*)(ldsl + (b) * SHM_V + widu * 1024), 16, 0, 0); \
        __builtin_amdgcn_global_load_lds((const unsigned*)(vt + vgo[1]), (LAS unsigned*)(ldsl + (b) * SHM_V + widu * 1024 + 8192), 16, 0, 0); } while (0)
        DDMA(0, 0); asm volatile("s_waitcnt vmcnt(0)" ::: "memory"); __syncthreads();
#pragma unroll 1
        for (int j = 0; j < NT; ++j) {
            const int b = j & 1;
            if (j + 1 < NT) DDMA(j + 1, b ^ 1);
            f32x16 p0 = f32x16{}, p1 = f32x16{};
            const char* Ks = K_lds + b * SHM_K;
#pragma unroll
            for (int d0 = 0; d0 < 4; ++d0) { const int cb = (d0 * 16 + hi * 8) * 2;
                const bf16x8 b0 = *(const bf16x8*)(Ks + KSWZ64(r32, cb)); const bf16x8 b1 = *(const bf16x8*)(Ks + KSWZ64(32 + r32, cb));
                p0 = __builtin_amdgcn_mfma_f32_32x32x16_bf16(b0, qr[d0], p0, 0, 0, 0); p1 = __builtin_amdgcn_mfma_f32_32x32x16_bf16(b1, qr[d0], p1, 0, 0, 0); }
            float alpha; bf16x8 pa0, pa1, pa2, pa3;
            softmax_tile(p0, p1, m_reg, l_reg, alpha, pa0, pa1, pa2, pa3);
            ATT_RESC(alpha);
            pv_all(o, vb0 + b * SHM_V, pa0, pa1, pa2, pa3);
            asm volatile("s_waitcnt vmcnt(0)" ::: "memory");
            __syncthreads();
        }
#undef DDMA
        if (hi == 0) li_l[r32] = l_reg;
        asm volatile("s_waitcnt lgkmcnt(0)" ::: "memory");
        float rli[16];
#pragma unroll
        for (int r = 0; r < 16; ++r) rli[r] = __builtin_amdgcn_rcpf(li_l[crow(r, hi)]);
        f32x4* o1v = (f32x4*)o1s + tid * 16;
        if (s == 0) {
#pragma unroll
            for (int d = 0; d < 4; ++d)
#pragma unroll
                for (int r = 0; r < 16; r += 4) o1v[d * 4 + (r >> 2)] = (f32x4){o[d][r] * rli[r], o[d][r + 1] * rli[r + 1], o[d][r + 2] * rli[r + 2], o[d][r + 3] * rli[r + 3]};
        } else {
#pragma unroll
            for (int d = 0; d < 4; ++d)
#pragma unroll
                for (int r = 0; r < 16; r += 4) { const f32x4 t = o1v[d * 4 + (r >> 2)];
#pragma unroll
                    for (int e = 0; e < 4; ++e) o[d][r + e] = t[e] - lam * (o[d][r + e] * rli[r + e]); }
            float gs[4];
#pragma unroll
            for (int d = 0; d < 4; ++d) gs[d] = g_sub[d * 32 + r32] * (1.0f - LAM_INIT);
            bf16_t* stg = (bf16_t*)(lds + OFF_STG) + wid * 4096;
#pragma unroll
            for (int r = 0; r < 16; ++r) {
                float q = (o[0][r] * o[0][r] + o[1][r] * o[1][r]) + (o[2][r] * o[2][r] + o[3][r] * o[3][r]);
                q += __shfl_xor(q, 1); q += __shfl_xor(q, 2); q += __shfl_xor(q, 4); q += __shfl_xor(q, 8); q += __shfl_xor(q, 16);
                const float rn = __builtin_amdgcn_rsqf(q * (1.0f / 128.0f) + SUBLN_EPS);
#pragma unroll
                for (int d = 0; d < 4; ++d) stg[crow(r, hi) * 128 + d * 32 + r32] = (bf16_t)f2bf(o[d][r] * rn * gs[d]);
            }
            asm volatile("s_waitcnt lgkmcnt(0)" ::: "memory");
            bf16_t* gp = mix + (size_t)(rowbase + q0 + wid * 32 + (lane >> 4)) * DM + 1024 + h * 128 + (lane & 15) * 8;
#pragma unroll
            for (int i = 0; i < 8; ++i) { const u32x4 v = *(const u32x4*)(stg + (i * 4 + (lane >> 4)) * 128 + (lane & 15) * 8); *(u32x4*)gp = v; gp += 4 * DM; }
        }
    }
}

__device__ __forceinline__ void na_unit(const bf16_t* __restrict__ proj, bf16_t* __restrict__ mix, const float* __restrict__ rpb,
                                        int rowbase, int ROWS, int h, int rg, char* lds) {
    const int tid = tid_l(), wid = tid >> 6, lane = tid & 63, r32 = lane & 31, hi = lane >> 5;
    char* V_lds = lds; char* K_lds = lds + OFF_K;
    float* wsf = (float*)(lds + OFF_WS) + wid * 64; float* li_l = wsf; float* al_l = wsf + 32;
    float* rpbL = (float*)(lds + OFF_RPB);
    LAS unsigned char* ldsl = (LAS unsigned char*)lds; const int widu = __builtin_amdgcn_readfirstlane(wid);
    unsigned kgo[2], vgo[2];
#pragma unroll
    for (int i = 0; i < 2; ++i) { const int X = wid * 1024 + lane * 16 + i * 8192;
        { const int krow = X >> 8, kcolB = (X & 255) ^ ((krow & 7) << 4); kgo[i] = (unsigned)(krow * INW * 2 + kcolB); }
        { const int sub = X >> 9, e = (X & 511) >> 1, kk = (sub >> 2) * 8 + (e >> 5), cc = (sub & 3) * 32 + (e & 31); const int k = (kk & ~0xC) | ((kk & 4) << 1) | ((kk & 8) >> 1); vgo[i] = (unsigned)((k * INW + cc) * 2); } }
    const int vb0 = (int)(uintptr_t)V_lds + v_rd_base(lane);
    const int r0 = rg * 4, rq = r0 + (wid >> 1), c = 32 * (wid & 1) + r32;
    const int rsw = min(max(rq - 4, 0), ROWS - 8), cs = min(max(c - 8, 0), 48);
    const int klo = min(max(r0 - 4, 0), ROWS - 8), khi = min(max(r0 + 3 - 4, 0), ROWS - 8) + 8;
    for (int i = tid; i < 465; i += NTHREADS) rpbL[i] = rpb[h * 465 + i] * LOG2E;
    const bf16_t* Kh = proj + (size_t)rowbase * INW + 1024 + h * 128;
    const bf16_t* Vh = proj + (size_t)rowbase * INW + 2048 + h * 128;
    const bf16_t* Qw = proj + (size_t)(rowbase + rq * 64 + c) * INW + h * 128 + hi * 8;
    bf16x8 qr[8];
#pragma unroll
    for (int d0 = 0; d0 < 8; ++d0) qr[d0] = *(const bf16x8*)(Qw + d0 * 16);
    float m_reg = -1e30f, l_reg = 0.f; f32x16 o[4];
#pragma unroll
    for (int d = 0; d < 4; ++d) o[d] = f32x16{};
#define NDMA(kr, b) do { const char* kt = (const char*)Kh + (size_t)(kr) * (64 * INW * 2); const char* vt = (const char*)Vh + (size_t)(kr) * (64 * INW * 2); \
        __builtin_amdgcn_global_load_lds((const unsigned*)(kt + kgo[0]), (LAS unsigned*)(ldsl + OFF_K + (b) * SHM_K + widu * 1024), 16, 0, 0); \
        __builtin_amdgcn_global_load_lds((const unsigned*)(kt + kgo[1]), (LAS unsigned*)(ldsl + OFF_K + (b) * SHM_K + widu * 1024 + 8192), 16, 0, 0); \
        __builtin_amdgcn_global_load_lds((const unsigned*)(vt + vgo[0]), (LAS unsigned*)(ldsl + (b) * SHM_V + widu * 1024), 16, 0, 0); \
        __builtin_amdgcn_global_load_lds((const unsigned*)(vt + vgo[1]), (LAS unsigned*)(ldsl + (b) * SHM_V + widu * 1024 + 8192), 16, 0, 0); } while (0)
    NDMA(klo, 0); asm volatile("s_waitcnt vmcnt(0)" ::: "memory"); __syncthreads();
#pragma unroll 1
    for (int kr = klo; kr < khi; ++kr) {
        const int b = (kr - klo) & 1;
        if (kr + 1 < khi) NDMA(kr + 1, b ^ 1);
        if (kr >= rsw && kr < rsw + 8) {
            f32x16 p0 = f32x16{}, p1 = f32x16{};
            const char* Ks = K_lds + b * SHM_K;
#pragma unroll
            for (int d0 = 0; d0 < 8; ++d0) { const int cb = (d0 * 16 + hi * 8) * 2;
                const bf16x8 b0 = *(const bf16x8*)(Ks + KSWZ128(r32, cb)); const bf16x8 b1 = *(const bf16x8*)(Ks + KSWZ128(32 + r32, cb));
                p0 = __builtin_amdgcn_mfma_f32_32x32x16_bf16(b0, qr[d0], p0, 0, 0, 0); p1 = __builtin_amdgcn_mfma_f32_32x32x16_bf16(b1, qr[d0], p1, 0, 0, 0); }
            const float* brow = rpbL + (kr - rq + 7) * 31;
#pragma unroll
            for (int r = 0; r < 16; ++r) {
                const int kc = crow(r, hi), kc2 = kc + 32;
                const int i0 = min(max(kc - c + 15, 0), 30), i1 = min(max(kc2 - c + 15, 0), 30);
                const float b0 = brow[i0], b1 = brow[i1];
                p0[r] = ((unsigned)(kc - cs) < 16u) ? p0[r] + b0 : -1e30f;
                p1[r] = ((unsigned)(kc2 - cs) < 16u) ? p1[r] + b1 : -1e30f;
            }
            float alpha; bf16x8 pa0, pa1, pa2, pa3;
            softmax_tile(p0, p1, m_reg, l_reg, alpha, pa0, pa1, pa2, pa3);
            ATT_RESC(alpha);
            pv_all(o, vb0 + b * SHM_V, pa0, pa1, pa2, pa3);
        }
        asm volatile("s_waitcnt vmcnt(0)" ::: "memory");
        __syncthreads();
    }
#undef NDMA
    if (hi == 0) li_l[r32] = l_reg;
    asm volatile("s_waitcnt lgkmcnt(0)" ::: "memory");
    bf16_t* stg = (bf16_t*)(lds + OFF_STG) + wid * 4096;
#pragma unroll
    for (int r = 0; r < 16; ++r) { const float rl = __builtin_amdgcn_rcpf(li_l[crow(r, hi)]);
#pragma unroll
        for (int d = 0; d < 4; ++d) stg[crow(r, hi) * 128 + d * 32 + r32] = (bf16_t)f2bf(o[d][r] * rl); }
    asm volatile("s_waitcnt lgkmcnt(0)" ::: "memory");
    bf16_t* gp = mix + (size_t)(rowbase + rq * 64 + 32 * (wid & 1) + (lane >> 4)) * DM + h * 128 + (lane & 15) * 8;
#pragma unroll
    for (int i = 0; i < 8; ++i) { const u32x4 v = *(const u32x4*)(stg + (i * 4 + (lane >> 4)) * 128 + (lane & 15) * 8); *(u32x4*)gp = v; gp += 4 * DM; }
    __syncthreads();
}
#undef SBAR
}

template <int MODE> __device__ __forceinline__ int dest_row(int n) {
    if (MODE == 1) { if (n < 3072 || n >= 5120) return n; const int d = n & 63, blk = n & ~63, nn = d >> 5, dd = d & 31; return blk + 32 * (dd >> 4) + 8 * ((dd >> 2) & 3) + 4 * nn + (dd & 3); }
    if (MODE == 2) { if (n < DFF) return 256 * (n >> 7) + (n & 127); const int n2 = n - DFF; return 256 * (n2 >> 7) + 128 + (n2 & 127); }
    return n;
}
template <int MODE> __device__ __forceinline__ void p0_transpose_item(const float* __restrict__ W, int K, int N, bf16_t* __restrict__ WT, const float* __restrict__ gain, LAS float* scr, int item, int lane) {
    const int nblk = N / 32, kb = item / nblk, nb = item % nblk, k0 = 64 * kb, n0 = 32 * nb;
#pragma unroll 8
    for (int i = 0; i < 32; ++i) { const int kk = 2 * i + (lane >> 5); const float g = gain ? gain[k0 + kk] : 1.0f; scr[kk * 33 + (lane & 31)] = W[(size_t)(k0 + kk) * N + n0 + (lane & 31)] * g; }
    asm volatile("s_waitcnt lgkmcnt(0)" ::: "memory");
    const int c = lane & 7;
#pragma unroll
    for (int j = 0; j < 4; ++j) { const int n = (lane >> 3) + 8 * j; const LAS float* s = scr + (8 * c) * 33 + n;
        u32x4 o; o.x = pk2(s[0 * 33], s[1 * 33]); o.y = pk2(s[2 * 33], s[3 * 33]); o.z = pk2(s[4 * 33], s[5 * 33]); o.w = pk2(s[6 * 33], s[7 * 33]);
        *(u32x4*)(WT + (size_t)dest_row<MODE>(n0 + n) * K + k0 + 8 * c) = o; }
    asm volatile("s_waitcnt lgkmcnt(0)" ::: "memory");
}
__device__ __forceinline__ float row_ssq(const float* xrow, int lane, f32x4 (&v)[8]) {
    const f32x4* xr = (const f32x4*)xrow + lane; float s = 0.f;
#pragma unroll
    for (int j = 0; j < 8; ++j) { v[j] = xr[64 * j]; s += (v[j][0] * v[j][0] + v[j][1] * v[j][1]) + (v[j][2] * v[j][2] + v[j][3] * v[j][3]); }
    return wave_sum(s);
}
__device__ __forceinline__ void sincos_d(double x, double& sn, double& cs) {
    const double k = __builtin_rint(x * 0.6366197723675814); const double r0 = __builtin_fma(-k, 1.5707963267948966, x); const double r = __builtin_fma(-k, 6.123233995736766e-17, r0);
    const double r2 = r * r;
    double s = -1.0 / 1307674368000.0; s = s * r2 + 1.0 / 6227020800.0; s = s * r2 - 1.0 / 39916800.0; s = s * r2 + 1.0 / 362880.0; s = s * r2 - 1.0 / 5040.0; s = s * r2 + 1.0 / 120.0; s = s * r2 - 1.0 / 6.0; s = s * r2 * r + r;
    double c = 1.0 / 20922789888000.0; c = c * r2 - 1.0 / 87178291200.0; c = c * r2 + 1.0 / 479001600.0; c = c * r2 - 1.0 / 3628800.0; c = c * r2 + 1.0 / 40320.0; c = c * r2 - 1.0 / 720.0; c = c * r2 + 1.0 / 24.0; c = c * r2 - 0.5; c = c * r2 + 1.0;
    const int q = ((int)k) & 3;
    sn = (q == 0) ? s : (q == 1) ? c : (q == 2) ? -s : -c;
    cs = (q == 0) ? c : (q == 1) ? -s : (q == 2) ? -c : s;
}

struct Args { const float* in[22]; float* out; unsigned char* ws; int ph_lo, ph_hi; };
constexpr int NPHASE = 10;

__global__ void __launch_bounds__(NTHREADS, 2) fwd_kernel(Args a) {
    extern __shared__ __attribute__((aligned(16))) unsigned char lds[];
    LAS unsigned char* ldsl = (LAS unsigned char*)lds;
    const int G = gridDim.x, bx = blockIdx.x, vcu = (G % 8 == 0) ? (bx % 8) * (G / 8) + bx / 8 : bx;
#define x_p (ap->in[0])
#define x_s (ap->in[1])
#define mem_p (ap->in[2])
#define mem_s (ap->in[3])
#define g_mix (ap->in[4])
#define w_in (ap->in[5])
#define rpb (ap->in[6])
#define lam_q1 (ap->in[7])
#define lam_k1 (ap->in[8])
#define lam_q2 (ap->in[9])
#define lam_k2 (ap->in[10])
#define g_subln (ap->in[11])
#define w_out (ap->in[12])
#define g_xattn (ap->in[13])
#define g_mem (ap->in[14])
#define w_mq (ap->in[15])
#define w_mkv (ap->in[16])
#define w_mo (ap->in[17])
#define g_ffn (ap->in[18])
#define w_gu (ap->in[19])
#define w_dn (ap->in[20])
#define g_final (ap->in[21])
#define out (ap->out)
#define WSP() const __attribute__((address_space(4))) Args* ap = (const __attribute__((address_space(4))) Args*)__builtin_amdgcn_kernarg_segment_ptr(); asm volatile("" : "+s"(ap)); unsigned char* ws = ap->ws
#define SS ((float*)(ws + WS_SS))
#define RS0 ((float*)(ws + WS_RS0))
#define ROPE ((f32x2*)(ws + WS_ROPE))
#define WIN ((bf16_t*)(ws + WS_WIN))
#define WOUT ((bf16_t*)(ws + WS_WOUT))
#define WMQ ((bf16_t*)(ws + WS_WMQ))
#define WMO ((bf16_t*)(ws + WS_WMO))
#define WMKV ((bf16_t*)(ws + WS_WMKV))
#define WGU ((bf16_t*)(ws + WS_WGU))
#define WDN ((bf16_t*)(ws + WS_WDN))
#define MN ((bf16_t*)(ws + WS_MN))
#define KB ((bf16_t*)(ws + WS_KB))
#define VB ((bf16_t*)(ws + WS_VB))
#define WQK ((bf16_t*)(ws + WS_WQK))
#define WVO ((bf16_t*)(ws + WS_WVO))
#define O1S ((float*)(ws + WS_O1))
#define XB ((bf16_t*)(ws + WS_XB))
#define PROJ ((bf16_t*)(ws + WS_BIG))
#define H1B ((bf16_t*)(ws + WS_H1B))
#define SB ((float*)(ws + WS_S))
#define PB ((bf16_t*)(ws + WS_P))
#define ACT ((bf16_t*)(ws + WS_ACT))
#define MIX XB
#define H2B XB
    const int lo = a.ph_lo, hi_ph = a.ph_hi;
#ifdef ONLY_PHASE
#define IN(k) ((k) == ONLY_PHASE && lo <= (k) && (k) < hi_ph)
#else
#define IN(k) (lo <= (k) && (k) < hi_ph)
#endif
#define SEAM(k) do { if (IN(k) && IN((k) + 1)) cg::this_grid().sync(); } while (0)
    const int NGW = G * 8;
#define TIDS() const int tid = tid_l(), lane = tid & 63, wave = __builtin_amdgcn_readfirstlane(tid >> 6), gw = vcu * 8 + wave; (void)lane; (void)gw

    if (IN(0)) { WSP(); TIDS();
        LAS float* scr = (LAS float*)(ldsl + wave * 16384);
        constexpr int I0 = (DM / 64) * (INW / 32), I1 = (DM / 64) * (DM / 32), I2 = I1, I3 = (DM / 64) * (4096 / 32), I4 = (DM / 64) * (NGU / 32), I5 = (DFF / 64) * (DM / 32);
        constexpr int NIT = I0 + I1 + I2 + I3 + I4 + I5;
        for (int it = gw; it < NIT; it += NGW) {
            int r = it;
            if (r < I0) { p0_transpose_item<1>(w_in, DM, INW, WIN, g_mix, scr, r, lane); continue; } r -= I0;
            if (r < I1) { p0_transpose_item<0>(w_out, DM, DM, WOUT, nullptr, scr, r, lane); continue; } r -= I1;
            if (r < I2) { p0_transpose_item<0>(w_mo, DM, DM, WMO, nullptr, scr, r, lane); continue; } r -= I2;
            if (r < I3) { p0_transpose_item<0>(w_mkv, DM, 4096, WMKV, nullptr, scr, r, lane); continue; } r -= I3;
            if (r < I4) { p0_transpose_item<2>(w_gu, DM, NGU, WGU, g_ffn, scr, r, lane); continue; } r -= I4;
            p0_transpose_item<0>(w_dn, DFF, DM, WDN, nullptr, scr, r, lane);
        }
        for (int k = gw; k < DM; k += NGW) { const float g = g_xattn[k]; const f32x4* src = (const f32x4*)(w_mq + (size_t)k * DM) + lane; u32x2* dst = (u32x2*)(WMQ + (size_t)k * DM) + lane;
#pragma unroll
            for (int j = 0; j < 8; ++j) { const f32x4 v = src[64 * j] * g; u32x2 w; w.x = pk2(v[0], v[1]); w.y = pk2(v[2], v[3]); dst[64 * j] = w; } }
        for (int m = gw; m < MT; m += NGW) { const float* xr = m < NP ? x_p + (size_t)m * DM : x_s + (size_t)(m - NP) * DM; f32x4 v[8];
            const float s = row_ssq(xr, lane, v); if (lane == 0) RS0[m] = 1.0f / sqrtf(s * (1.0f / DM) + RMS_EPS);
            u32x2* dst = (u32x2*)(XB + (size_t)m * DM) + lane;
#pragma unroll
            for (int j = 0; j < 8; ++j) { u32x2 w; w.x = pk2(v[j][0], v[j][1]); w.y = pk2(v[j][2], v[j][3]); dst[64 * j] = w; } }
        for (int m = gw; m < NMEM; m += NGW) { const float* xr = m < 512 ? mem_p + (size_t)m * DM : mem_s + (size_t)(m - 512) * DM; f32x4 v[8];
            const float s = row_ssq(xr, lane, v); const float rr = 1.0f / sqrtf(s * (1.0f / DM) + RMS_EPS);
            u32x2* dst = (u32x2*)(MN + (size_t)m * DM) + lane; const f32x4* gp = (const f32x4*)g_mem + lane;
#pragma unroll
            for (int j = 0; j < 8; ++j) { const f32x4 g = gp[64 * j]; u32x2 w; w.x = pk2(v[j][0] * rr * g[0], v[j][1] * rr * g[1]); w.y = pk2(v[j][2] * rr * g[2], v[j][3] * rr * g[3]); dst[64 * j] = w; } }
        for (int e = vcu * NTHREADS + tid; e < TP * 32; e += G * NTHREADS) { const int t = e >> 5, dd = e & 31;
            double pw = 1.0; for (int i = 0; i < dd; ++i) pw *= 1.333521432163324;
            const float inv = 1.0f / (float)pw; const float ang = (float)t * inv; double sn, cs; sincos_d((double)ang, sn, cs);
            ROPE[e] = (f32x2){(float)cs, (float)sn}; }
    }
    SEAM(0);

    if (IN(1)) { WSP();
        pg8::Sched S{(const char*)XB, (const char*)WIN, (const char*)MN, (const char*)WMKV, MT / 256, INW / 256, (MT / 256) * (INW / 256), NMEM / 256, (NMEM / 256) * 16,
                     (size_t)256 * DM * 2, (size_t)256 * DM * 2, 0, G, bx};
        pg8::EpiInProj E{PROJ, KB, VB, RS0, ROPE};
        pg8::gemm_phase<pg8::EpiInProj, pg8::Sched, true, true>(ldsl, DM, DM, S, E);
    }
    SEAM(1);

    if (IN(2)) { WSP(); TIDS();
#if !defined(P2_PART) || P2_PART == 1
        { pg8::PreSched S{(const char*)KB, (const char*)VB, (const char*)WMQ, (const char*)WMO, G, bx}; pg8::EpiPre E{WQK, WVO};
          pg8::gemm_phase<pg8::EpiPre, pg8::PreSched, true, true>(ldsl, 512, DM, S, E); }
#endif
        __syncthreads();
#if !defined(P2_PART) || P2_PART == 2
        for (int id = vcu; id < 1024 + 512; id += G) {
            const bool pr = id < 1024; const int i2 = pr ? id : id - 1024;
            const int rg = pr ? (i2 & 63) : (i2 & 15), h = pr ? ((i2 >> 6) & 7) : ((i2 >> 4) & 7), b = pr ? (i2 >> 9) : (i2 >> 7);
            att::na_unit(PROJ, MIX, rpb, pr ? b * TP : NP + b * TS, pr ? TP / 64 : TS / 64, h, rg, (char*)lds);
        }
#endif
#if !defined(P2_PART) || P2_PART == 3
        float lam;
        { const float a1 = wave_sum(lam_q1[lane] * lam_k1[lane]), a2 = wave_sum(lam_q2[lane] * lam_k2[lane]); lam = __expf(a1) - __expf(a2) + LAM_INIT; }
        float* o1s = O1S + (size_t)bx * 64 * NTHREADS;
        for (int id = vcu; id < 1024 + 512; id += G) {
            const bool pr = id < 1024; const int i2 = pr ? id : id - 1024;
            const int qb = pr ? (i2 & 63) : (i2 & 15), bh = pr ? (i2 >> 6) : (i2 >> 4);
            att::diff_unit(PROJ, MIX, o1s, g_subln, lam, pr ? (bh >> 3) * TP : NP + (bh >> 3) * TS, pr ? TP : TS, bh & 7, qb, (char*)lds);
        }
#endif
    }
    SEAM(2);

    if (IN(3)) { WSP();
        pg8::Sched S{(const char*)MIX, (const char*)WOUT, nullptr, nullptr, MT / 256, DM / 256, (MT / 256) * (DM / 256), 1, 0, (size_t)256 * DM * 2, (size_t)256 * DM * 2, 0, G, bx};
        pg8::EpiX E{x_p, x_s, out, H1B, SS};
        pg8::gemm_phase<pg8::EpiX, pg8::Sched, true, true>(ldsl, DM, DM, S, E);
    }
    SEAM(3);

    if (IN(4)) { WSP();
        pg8::Sched S{(const char*)H1B, (const char*)WQK, nullptr, nullptr, MT / 256, NSW / 256, (MT / 256) * (NSW / 256), 1, 0, (size_t)256 * DM * 2, (size_t)256 * DM * 2, (size_t)NSW * DM * 2, G, bx};
        pg8::EpiS E{SB, SS};
        pg8::gemm_phase<pg8::EpiS, pg8::Sched, true, true>(ldsl, DM, DM, S, E);
    }
    SEAM(4);

    if (IN(5)) { WSP(); TIDS();
        for (int m = gw; m < MT; m += NGW) {
            const f32x4* sp = (const f32x4*)(SB + (size_t)m * NSW) + lane; u32x2* pp = (u32x2*)(PB + (size_t)m * NSW) + lane;
#pragma unroll
            for (int hh = 0; hh < 4; ++hh) { f32x4 v = sp[64 * hh]; const float mx = wave_max(fmaxf(fmaxf(v[0], v[1]), fmaxf(v[2], v[3])));
                v[0] = __builtin_amdgcn_exp2f(v[0] - mx); v[1] = __builtin_amdgcn_exp2f(v[1] - mx); v[2] = __builtin_amdgcn_exp2f(v[2] - mx); v[3] = __builtin_amdgcn_exp2f(v[3] - mx);
                const float rl = 1.0f / wave_sum((v[0] + v[1]) + (v[2] + v[3]));
                u32x2 w; w.x = pk2(v[0] * rl, v[1] * rl); w.y = pk2(v[2] * rl, v[3] * rl); pp[64 * hh] = w; }
        }
    }
    SEAM(5);

    if (IN(6)) { WSP();
        pg8::Sched S{(const char*)PB, (const char*)WVO, nullptr, nullptr, MT / 256, DM / 256, (MT / 256) * (DM / 256), 1, 0, (size_t)256 * NSW * 2, (size_t)256 * NSW * 2, (size_t)DM * NSW * 2, G, bx};
        pg8::EpiResid E{out, out, H2B, SS};
        pg8::gemm_phase<pg8::EpiResid, pg8::Sched, true, true>(ldsl, NSW, NSW, S, E);
    }
    SEAM(6);

    if (IN(7)) { WSP();
        pg8::Sched S{(const char*)H2B, (const char*)WGU, nullptr, nullptr, MT / 256, NGU / 256, (MT / 256) * (NGU / 256), 1, 0, (size_t)256 * DM * 2, (size_t)256 * DM * 2, 0, G, bx};
        pg8::EpiGU E{ACT, SS};
        pg8::gemm_phase<pg8::EpiGU, pg8::Sched, true, true>(ldsl, DM, DM, S, E);
    }
    SEAM(7);

    if (IN(8)) { WSP();
        pg8::Sched S{(const char*)ACT, (const char*)WDN, nullptr, nullptr, MT / 256, DM / 256, (MT / 256) * (DM / 256), 1, 0, (size_t)256 * DFF * 2, (size_t)256 * DFF * 2, 0, G, bx};
        pg8::EpiResid E{out, out, nullptr, SS};
        pg8::gemm_phase<pg8::EpiResid, pg8::Sched, true, true>(ldsl, DFF, DFF, S, E);
    }
    SEAM(8);

    if (IN(9)) { WSP(); TIDS();
        for (int m = gw; m < MT; m += NGW) {
            const float rr = pg8::row_rs(SS, m); f32x4* op = (f32x4*)(out + (size_t)m * DM) + lane; const f32x4* gp = (const f32x4*)g_final + lane;
#pragma unroll
            for (int j = 0; j < 8; ++j) { const f32x4 v = op[64 * j], g = gp[64 * j]; op[64 * j] = v * rr * g; }
        }
    }
#undef IN
#undef SEAM
#undef TIDS
}
#undef x_p
#undef x_s
#undef mem_p
#undef mem_s
#undef g_mix
#undef w_in
#undef rpb
#undef lam_q1
#undef lam_k1
#undef lam_q2
#undef lam_k2
#undef g_subln
#undef w_out
#undef g_xattn
#undef g_mem
#undef w_mq
#undef w_mkv
#undef w_mo
#undef g_ffn
#undef w_gu
#undef w_dn
#undef g_final
#undef out
#undef WSP
#undef SS
#undef RS0
#undef ROPE
#undef WIN
#undef WOUT
#undef WMQ
#undef WMO
#undef WMKV
#undef WGU
#undef WDN
#undef MN
#undef KB
#undef VB
#undef WQK
#undef WVO
#undef O1S
#undef XB
#undef PROJ
#undef H1B
#undef SB
#undef PB
#undef ACT
#undef MIX
#undef H2B


extern "C" void kernel_launch(void* const* d_in, const int* in_sizes, int n_in, void* d_out, int out_size, void* d_ws, size_t ws_size, hipStream_t stream) {
    static int grid = 0;
    if (grid == 0) {
        if (n_in != 22 || out_size != MT * DM || ws_size < WS_END) { fprintf(stderr, "kernel_launch: unexpected shapes (n_in %d, out %d, ws %zu); nothing launched\n", n_in, out_size, ws_size); grid = -1; return; }
        int dev = 0, cus = 0, per_cu = 0;
        (void)hipGetDevice(&dev); (void)hipDeviceGetAttribute(&cus, hipDeviceAttributeMultiprocessorCount, dev);
        if (hipFuncSetAttribute((const void*)fwd_kernel, hipFuncAttributeMaxDynamicSharedMemorySize, LDS_BYTES) != hipSuccess) { fprintf(stderr, "kernel_launch: hipFuncSetAttribute failed\n"); grid = -1; return; }
        if (hipOccupancyMaxActiveBlocksPerMultiprocessor(&per_cu, (const void*)fwd_kernel, NTHREADS, LDS_BYTES) != hipSuccess || per_cu < 1) per_cu = 1;
        (void)hipGetLastError();
        grid = cus * per_cu;
    }
    if (grid < 0) return;
    Args a{};
    for (int i = 0; i < 22; ++i) a.in[i] = (const float*)d_in[i];
    a.out = (float*)d_out; a.ws = (unsigned char*)d_ws;
#if MK_MULTI
    for (int p = 0; p < NPHASE; ++p) { a.ph_lo = p; a.ph_hi = p + 1; hipLaunchKernelGGL(fwd_kernel, dim3(grid), dim3(NTHREADS), LDS_BYTES, stream, a); }
#else
    a.ph_lo = 0; a.ph_hi = NPHASE;
    void* args[] = {&a};
    hipError_t e = hipLaunchCooperativeKernel((const void*)fwd_kernel, dim3(grid), dim3(NTHREADS), args, LDS_BYTES, stream);
    if (e != hipSuccess) fprintf(stderr, "cooperative launch failed: %s (grid %d)\n", hipGetErrorString(e), grid);
#endif
}
```

```cpp
#include <hip/hip_runtime.h>
#include <hip/hip_cooperative_groups.h>
#include <cstdio>
#include <cstdint>
namespace cg = cooperative_groups;

#ifndef MK_MULTI
#define MK_MULTI 0
#endif

#define LAS __attribute__((address_space(3)))
typedef unsigned short bf16_t;
typedef short bf16x8 __attribute__((ext_vector_type(8)));
typedef short s16x4 __attribute__((ext_vector_type(4)));
typedef float f32x2 __attribute__((ext_vector_type(2)));
typedef float f32x4 __attribute__((ext_vector_type(4)));
typedef float f32x16 __attribute__((ext_vector_type(16)));
typedef unsigned u32x2 __attribute__((ext_vector_type(2)));
typedef unsigned u32x4 __attribute__((ext_vector_type(4)));

constexpr int DM = 2048, TP = 16384, TS = 4096, NP = 2 * TP, NS = 4 * TS, MT = NP + NS;
constexpr int INW = 6144, DFF = 5632, NGU = 2 * DFF, MEMT = 256, NMEM = 6 * MEMT, NSW = 1024;
constexpr float RMS_EPS = 1e-6f, SUBLN_EPS = 1e-5f, LOG2E = 1.4426950408889634f;
constexpr float NA_QS = 0.08838834764831845f * LOG2E, DF_QS = 0.125f * LOG2E, MEM_QS = 0.04419417382415922f * LOG2E;
constexpr float LAM_INIT = 0.2f;

constexpr size_t MiB = 1u << 20;
constexpr size_t WS_SS = 0, WS_RS0 = 6 * MiB, WS_ROPE = 7 * MiB, WS_WIN = 11 * MiB, WS_WOUT = 35 * MiB, WS_WMQ = 43 * MiB, WS_WMO = 51 * MiB,
                 WS_WMKV = 59 * MiB, WS_WGU = 75 * MiB, WS_WDN = 119 * MiB, WS_MN = 141 * MiB, WS_KB = 147 * MiB, WS_VB = 153 * MiB,
                 WS_WQK = 159 * MiB, WS_WVO = 183 * MiB, WS_O1 = 207 * MiB, WS_XB = 239 * MiB, WS_BIG = 431 * MiB, WS_END = 1007 * MiB;
constexpr size_t WS_BAR = 6 * MiB + 512 * 1024;
constexpr size_t WS_H1B = WS_BIG, WS_S = WS_BIG + 192 * MiB, WS_P = WS_BIG + 384 * MiB, WS_ACT = WS_BIG;

constexpr int LDS_BYTES = 147456, NTHREADS = 512;

__device__ __forceinline__ unsigned cvt_pk_bf16(float lo, float hi) { unsigned r; asm volatile("v_cvt_pk_bf16_f32 %0, %1, %2" : "=v"(r) : "v"(lo), "v"(hi)); return r; }
__device__ __forceinline__ unsigned f2bf(float f) { unsigned u = __builtin_bit_cast(unsigned, f); return (u + 0x7fffu + ((u >> 16) & 1u)) >> 16; }
__device__ __forceinline__ unsigned pk2(float lo, float hi) { return f2bf(lo) | (f2bf(hi) << 16); }
__device__ __forceinline__ float wave_sum(float v) {
#pragma unroll
    for (int o = 1; o < 64; o <<= 1) v += __shfl_xor(v, o);
    return v;
}
__device__ __forceinline__ float wave_max(float v) {
#pragma unroll
    for (int o = 1; o < 64; o <<= 1) v = fmaxf(v, __shfl_xor(v, o));
    return v;
}
__device__ __forceinline__ int tid_l(int widk) { int t; asm volatile("v_mbcnt_lo_u32_b32 %0, -1, 0\n\tv_mbcnt_hi_u32_b32 %0, -1, %0\n\tv_or_b32 %0, %1, %0" : "=&v"(t) : "s"(widk << 6)); return t; }
__device__ __forceinline__ void grid_barrier(unsigned* ctr, unsigned target, int tid) {
    asm volatile("s_waitcnt vmcnt(0) lgkmcnt(0)" ::: "memory");
    __syncthreads();
    if (tid == 0) {
        __builtin_amdgcn_fence(__ATOMIC_RELEASE, "agent");
        asm volatile("s_waitcnt vmcnt(0)" ::: "memory");
        (void)__hip_atomic_fetch_add(ctr, 1u, __ATOMIC_RELAXED, __HIP_MEMORY_SCOPE_AGENT);
        unsigned spins = 0;
        while (__hip_atomic_load(ctr, __ATOMIC_RELAXED, __HIP_MEMORY_SCOPE_AGENT) < target && ++spins < (1u << 22)) __builtin_amdgcn_s_sleep(2);
        __builtin_amdgcn_fence(__ATOMIC_ACQUIRE, "agent");
        asm volatile("s_waitcnt vmcnt(0)" ::: "memory");
    }
    __syncthreads();
}
__device__ __forceinline__ int batch_of_pm(int pm) { return pm < 128 ? (pm >> 6) : 2 + ((pm - 128) >> 4); }

namespace pg8 {
constexpr int BM = 256, BK = 64, HALF = 128, HTB = HALF * BK * 2, STAGE_BYTES = 8 * HTB, NXCD = 8, WGM = 8;
__host__ __device__ __forceinline__ int lds_byte(int r, int c) { const int st = (r >> 4) * 2 + (c >> 5), rr = r & 15, cc = c & 31, ob = rr * 64 + cc * 2; return st * 1024 + (ob ^ (((ob >> 9) & 1) << 5)); }
__host__ __device__ __forceinline__ void stage_rc(int b, int& R, int& C) { const int st = b / 1024, sb = b % 1024, swz = sb ^ (((sb >> 9) & 1) << 5); R = (st >> 1) * 16 + swz / 64; C = (st & 1) * 32 + (swz % 64) / 2; }
__host__ __device__ __forceinline__ int perm32(int rho) { const int n = rho >> 4, i = rho & 15; return 8 * (i >> 2) + 4 * n + (i & 3); }

struct Unit { int pm, pn, z; };

__device__ __forceinline__ void tile_decode(int wgid, int nM, int nN, int& pm, int& pn) {
    const int nwg = nM * nN;
    { const int q = nwg / NXCD, r = nwg % NXCD, xcd = wgid % NXCD, off = wgid / NXCD; wgid = (xcd < r ? xcd * (q + 1) : r * (q + 1) + (xcd - r) * q) + off; }
    const int nig = WGM * nN, gid = wgid / nig, fm = gid * WGM, gsz = (nM - fm) < WGM ? (nM - fm) : WGM;
    pm = fm + ((wgid % nig) % gsz); pn = (wgid % nig) / gsz;
}
struct Sched {
    const char *A0, *B0, *A1, *B1; int nM0, nN0, n0, nM1, n1; size_t tA, tB, bstride; int G, c;
    __device__ __forceinline__ bool next(int i, Unit& u) const {
        int L = i * G + c;
        if (L < n0) { tile_decode(L, nM0, nN0, u.pm, u.pn); u.z = 0; return true; }
        L -= n0; if (L < n1) { u.pm = L % nM1; u.pn = L / nM1; u.z = 1; return true; }
        return false;
    }
    __device__ __forceinline__ const char* abase(const Unit& u) const { return (u.z ? A1 : A0) + (size_t)u.pm * tA; }
    __device__ __forceinline__ const char* bbase(const Unit& u) const { return (u.z ? B1 : B0) + (size_t)u.pn * tB + (bstride ? (size_t)batch_of_pm(u.pm) * bstride : (size_t)0); }
};
struct PreSched {
    const char *Kb, *Vb, *Wmq, *Wmo; int G, c;
    __device__ __forceinline__ bool next(int i, Unit& u) const { const int L = i * G + c; if (L >= 384) return false; u.z = L / 8; const int t = L & 7; if (u.z < 24) { u.pm = 0; u.pn = t; } else { u.pm = t; u.pn = 0; } return true; }
    __device__ __forceinline__ const char* abase(const Unit& u) const { const int zz = u.z % 24, b = zz >> 2, h = zz & 3;
        return u.z < 24 ? Kb + ((size_t)(b * 256) * DM + h * 512) * 2 : Wmo + ((size_t)(u.pm * 256) * DM + h * 512) * 2; }
    __device__ __forceinline__ const char* bbase(const Unit& u) const { const int zz = u.z % 24, b = zz >> 2, h = zz & 3;
        return u.z < 24 ? Wmq + ((size_t)(u.pn * 256) * DM + h * 512) * 2 : Vb + ((size_t)(b * 256) * DM + h * 512) * 2; }
};

template <class Epi, class SchedT, bool ALIGN_EPI, bool SP2>
__device__ __forceinline__ void gemm_phase(LAS unsigned char* lds, const int widk, const int K, const int ld, const SchedT& S, const Epi& E) {
    const int tid = tid_l(widk), wid = __builtin_amdgcn_readfirstlane(tid >> 6), lane = tid & 63, wr = wid >> 2, wc = wid & 3, fr = lane & 15, fq = lane >> 4;
    const int nt = K / BK;
    unsigned voffA[2], voffB[2];
#pragma unroll
    for (int i = 0; i < 2; ++i) { int R, C; stage_rc(tid * 16 + i * 8192, R, C); const int Rb = Epi::PERM ? ((R & ~31) + perm32(R & 31)) : R;
        voffA[i] = (unsigned)(R * ld + C) * 2u; voffB[i] = (unsigned)(Rb * ld + C) * 2u; }
    const size_t kstep = (size_t)(BK * 2);
    const size_t hstep = (size_t)HALF * ld * 2;
    const unsigned ldsw = (unsigned)wid * 1024u;
    const int aoff = lds_byte(wr * 64 + fr, fq * 8), boff = lds_byte(wc * 32 + fr, fq * 8);
#define PG8_SA(b, h) (((b) * 2 + (h)) * HTB)
#define PG8_SB(b, h) ((4 + (b) * 2 + (h)) * HTB)
#define PG8_STAGE(bufoff, gbase, voff) do { _Pragma("unroll") for (int _i = 0; _i < 2; ++_i) \
        __builtin_amdgcn_global_load_lds((const unsigned*)((const char*)(gbase) + (voff)[_i]), (LAS unsigned*)(lds + (bufoff) + ldsw + _i * 8192), 16, 0, 0); } while (0)
#define PG8_LDA(dst, b, h) do { _Pragma("unroll") for (int m = 0; m < 4; ++m) _Pragma("unroll") for (int k = 0; k < 2; ++k) dst[m][k] = *(const LAS bf16x8*)(lds + PG8_SA(b, h) + aoff + m * 2048 + k * 1024); } while (0)
#define PG8_LDB(dst, b, h) do { _Pragma("unroll") for (int n = 0; n < 2; ++n) _Pragma("unroll") for (int k = 0; k < 2; ++k) dst[n][k] = *(const LAS bf16x8*)(lds + PG8_SB(b, h) + boff + n * 2048 + k * 1024); } while (0)
#define PG8_MMA(ai, bj, At, Bt) do { __builtin_amdgcn_s_setprio(1); _Pragma("unroll") for (int m = 0; m < 4; ++m) _Pragma("unroll") for (int n = 0; n < 2; ++n) _Pragma("unroll") for (int k = 0; k < 2; ++k) \
        acc[ai][bj][m][n] = __builtin_amdgcn_mfma_f32_16x16x32_bf16(Bt[n][k], At[m][k], acc[ai][bj][m][n], 0, 0, 0); __builtin_amdgcn_s_setprio(0); } while (0)
#define PG8_WAIT_V(n) asm volatile("s_waitcnt vmcnt(" #n ")" ::: "memory")
#define PG8_WAIT_L(n) asm volatile("s_waitcnt lgkmcnt(" #n ")" ::: "memory")
#define PG8_BAR __builtin_amdgcn_s_barrier()
#define PG8_SCHED __builtin_amdgcn_sched_barrier(0)
    Unit cur, nxt; int ui = 0;
    if (!S.next(0, cur)) return;
    f32x4 acc[2][2][4][2];
#pragma unroll
    for (int a = 0; a < 2; ++a)
#pragma unroll
        for (int b = 0; b < 2; ++b)
#pragma unroll
            for (int m = 0; m < 4; ++m)
#pragma unroll
                for (int n = 0; n < 2; ++n) acc[a][b][m][n] = (f32x4){0.f, 0.f, 0.f, 0.f};
    bf16x8 At[4][2], B0[2][2], B1[2][2];
    const char* cA = S.abase(cur); const char* cB = S.bbase(cur);
    if constexpr (SP2) {
        PG8_STAGE(PG8_SB(0, 0), cB, voffB); PG8_STAGE(PG8_SB(0, 1), cB + hstep, voffB); PG8_STAGE(PG8_SA(0, 0), cA, voffA); PG8_STAGE(PG8_SA(0, 1), cA + hstep, voffA);
        if (wr == 1) PG8_BAR;
        PG8_WAIT_V(2); PG8_BAR;
        PG8_STAGE(PG8_SB(1, 0), cB + kstep, voffB); PG8_STAGE(PG8_SA(1, 0), cA + kstep, voffA); PG8_STAGE(PG8_SB(1, 1), cB + hstep + kstep, voffB);
        PG8_WAIT_V(6); PG8_BAR;
    } else {
        PG8_STAGE(PG8_SB(0, 0), cB, voffB); PG8_STAGE(PG8_SA(0, 0), cA, voffA); PG8_STAGE(PG8_SB(0, 1), cB + hstep, voffB); PG8_STAGE(PG8_SA(0, 1), cA + hstep, voffA);
        if (wr == 1) PG8_BAR;
        PG8_WAIT_V(4); PG8_BAR;
        PG8_STAGE(PG8_SB(1, 0), cB + kstep, voffB); PG8_STAGE(PG8_SA(1, 0), cA + kstep, voffA); PG8_STAGE(PG8_SB(1, 1), cB + hstep + kstep, voffB);
        PG8_WAIT_V(6); PG8_BAR;
    }
    for (;;) {
        const bool has_next = S.next(ui + 1, nxt);
        const char* nA = has_next ? S.abase(nxt) : cA; const char* nB = has_next ? S.bbase(nxt) : cB;
        for (int t = 0; t < nt; t += 2) {
            const bool last = (t == nt - 2);
            const char* a1 = cA + (size_t)(t + 1) * kstep;
            const char* a2 = last ? nA : cA + (size_t)(t + 2) * kstep; const char* b2 = last ? nB : cB + (size_t)(t + 2) * kstep;
            const char* a3 = a2 + kstep; const char* b3 = b2 + kstep;
            if constexpr (SP2) {
            PG8_LDB(B0, 0, 0); PG8_LDB(B1, 0, 1); PG8_SCHED; PG8_LDA(At, 0, 0); PG8_STAGE(PG8_SA(1, 1), a1 + hstep, voffA);
            PG8_WAIT_V(8); PG8_WAIT_L(0); PG8_BAR; PG8_MMA(0, 0, At, B0); PG8_MMA(0, 1, At, B1); PG8_BAR; PG8_SCHED;
            PG8_LDA(At, 0, 1); PG8_STAGE(PG8_SB(0, 0), b2, voffB); PG8_STAGE(PG8_SB(0, 1), b2 + hstep, voffB); PG8_STAGE(PG8_SA(0, 0), a2, voffA);
            PG8_WAIT_V(8); PG8_WAIT_L(0); PG8_BAR; PG8_MMA(1, 0, At, B0); PG8_MMA(1, 1, At, B1); PG8_BAR; PG8_SCHED;
            PG8_LDB(B0, 1, 0); PG8_LDB(B1, 1, 1); PG8_SCHED; PG8_LDA(At, 1, 0); PG8_STAGE(PG8_SA(0, 1), a2 + hstep, voffA);
            PG8_WAIT_V(8); PG8_WAIT_L(0); PG8_BAR; PG8_MMA(0, 0, At, B0); PG8_MMA(0, 1, At, B1); PG8_BAR; PG8_SCHED;
            PG8_LDA(At, 1, 1); PG8_STAGE(PG8_SB(1, 0), b3, voffB); PG8_STAGE(PG8_SB(1, 1), b3 + hstep, voffB); PG8_STAGE(PG8_SA(1, 0), a3, voffA);
            PG8_WAIT_V(8); PG8_WAIT_L(0); PG8_BAR; PG8_MMA(1, 0, At, B0); PG8_MMA(1, 1, At, B1); PG8_BAR; PG8_SCHED;
            } else {
            PG8_LDB(B0, 0, 0); PG8_SCHED; PG8_LDA(At, 0, 0); PG8_STAGE(PG8_SA(1, 1), a1 + hstep, voffA);
            PG8_WAIT_L(8); PG8_BAR; PG8_WAIT_L(0); PG8_MMA(0, 0, At, B0); PG8_BAR; PG8_SCHED;
            PG8_LDB(B1, 0, 1); PG8_STAGE(PG8_SB(0, 0), b2, voffB);
            PG8_BAR; PG8_WAIT_L(0); PG8_MMA(0, 1, At, B1); PG8_BAR;
            PG8_LDA(At, 0, 1); PG8_STAGE(PG8_SA(0, 0), a2, voffA);
            PG8_BAR; PG8_WAIT_L(0); PG8_MMA(1, 0, At, B0); PG8_BAR; PG8_SCHED;
            PG8_STAGE(PG8_SB(0, 1), b2 + hstep, voffB);
            PG8_WAIT_V(6); PG8_BAR; PG8_MMA(1, 1, At, B1); PG8_BAR;
            PG8_LDB(B0, 1, 0); PG8_SCHED; PG8_LDA(At, 1, 0); PG8_STAGE(PG8_SA(0, 1), a2 + hstep, voffA);
            PG8_WAIT_L(8); PG8_BAR; PG8_WAIT_L(0); PG8_MMA(0, 0, At, B0); PG8_BAR; PG8_SCHED;
            PG8_LDB(B1, 1, 1); PG8_STAGE(PG8_SB(1, 0), b3, voffB);
            PG8_BAR; PG8_WAIT_L(0); PG8_MMA(0, 1, At, B1); PG8_BAR;
            PG8_LDA(At, 1, 1); PG8_STAGE(PG8_SA(1, 0), a3, voffA);
            PG8_BAR; PG8_WAIT_L(0); PG8_MMA(1, 0, At, B0); PG8_BAR; PG8_SCHED;
            PG8_STAGE(PG8_SB(1, 1), b3 + hstep, voffB);
            PG8_WAIT_V(6); PG8_BAR; PG8_MMA(1, 1, At, B1); PG8_BAR;
            }
        }
        if constexpr (ALIGN_EPI) { if (wr == 0) PG8_BAR; }
        E(acc, cur, wr, wc, fr, fq);
        if (!has_next) break;
#pragma unroll
        for (int a = 0; a < 2; ++a)
#pragma unroll
            for (int b = 0; b < 2; ++b)
#pragma unroll
                for (int m = 0; m < 4; ++m)
#pragma unroll
                    for (int n = 0; n < 2; ++n) acc[a][b][m][n] = (f32x4){0.f, 0.f, 0.f, 0.f};
        cur = nxt; cA = nA; cB = nB; ++ui;
        if constexpr (ALIGN_EPI) { if (wr == 1) PG8_BAR; }
    }
    PG8_WAIT_V(0);
    if constexpr (!ALIGN_EPI) { if (wr == 0) PG8_BAR; }
    PG8_BAR;
#undef PG8_SA
#undef PG8_SB
#undef PG8_STAGE
#undef PG8_LDA
#undef PG8_LDB
#undef PG8_MMA
#undef PG8_WAIT_V
#undef PG8_WAIT_L
#undef PG8_BAR
#undef PG8_SCHED
}

typedef const f32x4 (&AccRef)[2][2][4][2];

__device__ __forceinline__ float row_rs(const float* ss, int row) {
    const f32x4* p = (const f32x4*)(ss + (size_t)row * 32); float s = 0.f;
#pragma unroll
    for (int i = 0; i < 8; ++i) { const f32x4 v = p[i]; s += (v[0] + v[1]) + (v[2] + v[3]); }
    return __builtin_amdgcn_rsqf(s * (1.0f / DM) + RMS_EPS);
}

struct EpiInProj {
    static constexpr bool PERM = true;
    bf16_t* proj; bf16_t* kb; bf16_t* vb; const float* rs0; const f32x2* rope;
    __device__ __forceinline__ void operator()(AccRef acc, const Unit& u, int wr, int wc, int fr, int fq) const {
        const int row0 = u.pm * BM + wr * 64 + fr;
        if (u.z == 1) {
            bf16_t* base = (u.pn < 8 ? kb : vb) + (u.pn & 7) * BM + wc * 32 + 8 * fq;
#pragma unroll
            for (int ai = 0; ai < 2; ++ai)
#pragma unroll
                for (int m = 0; m < 4; ++m) { bf16_t* rowp = base + (size_t)(row0 + ai * HALF + m * 16) * DM;
#pragma unroll
                    for (int bj = 0; bj < 2; ++bj) { const f32x4 v0 = acc[ai][bj][m][0], v1 = acc[ai][bj][m][1]; u32x4 w;
                        w.x = cvt_pk_bf16(v0[0], v0[1]); w.y = cvt_pk_bf16(v0[2], v0[3]); w.z = cvt_pk_bf16(v1[0], v1[1]); w.w = cvt_pk_bf16(v1[2], v1[3]);
                        *(u32x4*)(rowp + bj * HALF) = w; } }
            return;
        }
        const int pn = u.pn; const bool rp = (pn >= 12 && pn < 20);
        const float sc = pn < 4 ? NA_QS : ((pn >= 12 && pn < 16) ? DF_QS : 1.0f);
        if (!rp) {
            bf16_t* base = proj + pn * BM + wc * 32 + 8 * fq;
#pragma unroll
            for (int ai = 0; ai < 2; ++ai)
#pragma unroll
                for (int m = 0; m < 4; ++m) { const int row = row0 + ai * HALF + m * 16; const float rr = rs0[row] * sc; bf16_t* rowp = base + (size_t)row * INW;
#pragma unroll
                    for (int bj = 0; bj < 2; ++bj) { const f32x4 v0 = acc[ai][bj][m][0] * rr, v1 = acc[ai][bj][m][1] * rr; u32x4 w;
                        w.x = cvt_pk_bf16(v0[0], v0[1]); w.y = cvt_pk_bf16(v0[2], v0[3]); w.z = cvt_pk_bf16(v1[0], v1[1]); w.w = cvt_pk_bf16(v1[2], v1[3]);
                        *(u32x4*)(rowp + bj * HALF) = w; } }
        } else {
            const int dd0 = 16 * (wc & 1) + 4 * fq;
            bf16_t* base = proj + pn * BM + (wc >> 1) * 64 + dd0;
#pragma unroll
            for (int ai = 0; ai < 2; ++ai)
#pragma unroll
                for (int m = 0; m < 4; ++m) { const int row = row0 + ai * HALF + m * 16; const float rr = rs0[row] * sc; bf16_t* rowp = base + (size_t)row * INW;
                    const int t = row < NP ? (row & (TP - 1)) : (row & (TS - 1));
                    const f32x4 cs0 = *(const f32x4*)(rope + (size_t)t * 32 + dd0), cs1 = *(const f32x4*)(rope + (size_t)t * 32 + dd0 + 2);
#pragma unroll
                    for (int bj = 0; bj < 2; ++bj) { const f32x4 x1 = acc[ai][bj][m][0] * rr, x2 = acc[ai][bj][m][1] * rr;
                        const float a0 = x1[0] * cs0[0] - x2[0] * cs0[1], a1 = x1[1] * cs0[2] - x2[1] * cs0[3], a2 = x1[2] * cs1[0] - x2[2] * cs1[1], a3 = x1[3] * cs1[2] - x2[3] * cs1[3];
                        const float b0 = x2[0] * cs0[0] + x1[0] * cs0[1], b1 = x2[1] * cs0[2] + x1[1] * cs0[3], b2 = x2[2] * cs1[0] + x1[2] * cs1[1], b3 = x2[3] * cs1[2] + x1[3] * cs1[3];
                        u32x2 wa, wb; wa.x = cvt_pk_bf16(a0, a1); wa.y = cvt_pk_bf16(a2, a3); wb.x = cvt_pk_bf16(b0, b1); wb.y = cvt_pk_bf16(b2, b3);
                        *(u32x2*)(rowp + bj * HALF) = wa; *(u32x2*)(rowp + bj * HALF + 32) = wb; } }
        }
    }
};
struct EpiPre {
    static constexpr bool PERM = true;
    bf16_t* wqk; bf16_t* wvo;
    __device__ __forceinline__ void operator()(AccRef acc, const Unit& u, int wr, int wc, int fr, int fq) const {
        const int zz = u.z % 24, b = zz >> 2, h = zz & 3; bf16_t* base; int ldc; float sc;
        if (u.z < 24) { base = wqk + ((size_t)(b * 1024 + h * 256)) * DM + u.pn * BM; ldc = DM; sc = MEM_QS; }
        else { base = wvo + ((size_t)(b * 2048 + u.pm * BM)) * NSW + h * 256; ldc = NSW; sc = 1.0f; }
        base += wc * 32 + 8 * fq;
#pragma unroll
        for (int ai = 0; ai < 2; ++ai)
#pragma unroll
            for (int m = 0; m < 4; ++m) { bf16_t* rowp = base + (size_t)(wr * 64 + fr + ai * HALF + m * 16) * ldc;
#pragma unroll
                for (int bj = 0; bj < 2; ++bj) { const f32x4 v0 = acc[ai][bj][m][0] * sc, v1 = acc[ai][bj][m][1] * sc; u32x4 w;
                    w.x = cvt_pk_bf16(v0[0], v0[1]); w.y = cvt_pk_bf16(v0[2], v0[3]); w.z = cvt_pk_bf16(v1[0], v1[1]); w.w = cvt_pk_bf16(v1[2], v1[3]);
                    *(u32x4*)(rowp + bj * HALF) = w; } }
    }
};
__device__ __forceinline__ float row_rs4(const float* ss, int row, int fq) {
    const f32x4* p = (const f32x4*)(ss + (size_t)row * 32 + fq * 8); const f32x4 a = p[0], b = p[1];
    float s = ((a[0] + a[1]) + (a[2] + a[3])) + ((b[0] + b[1]) + (b[2] + b[3]));
    s += __shfl_xor(s, 16); s += __shfl_xor(s, 32);
    return __builtin_amdgcn_rsqf(s * (1.0f / DM) + RMS_EPS);
}
struct EpiResid {
    static constexpr bool PERM = false;
    const float* basef; const bf16_t* baseb; bf16_t* ob; int ldo; float* ss;
    __device__ __forceinline__ void operator()(AccRef acc, const Unit& u, int wr, int wc, int fr, int fq) const {
        const int col0 = u.pn * BM + wc * 32 + 4 * fq;
#pragma unroll
        for (int ai = 0; ai < 2; ++ai)
#pragma unroll
            for (int m = 0; m < 4; ++m) { const int row = u.pm * BM + ai * HALF + wr * 64 + m * 16 + fr; const size_t off = (size_t)row * DM + col0; bf16_t* orow = ob + (size_t)row * ldo + col0; float q = 0.f;
#pragma unroll
                for (int bj = 0; bj < 2; ++bj)
#pragma unroll
                    for (int n = 0; n < 2; ++n) { const int o2 = bj * HALF + n * 16; f32x4 bv;
                        if (baseb) { const u32x2 w = *(const u32x2*)(baseb + off + o2); bv = (f32x4){__uint_as_float(w.x << 16), __uint_as_float(w.x & 0xffff0000u), __uint_as_float(w.y << 16), __uint_as_float(w.y & 0xffff0000u)}; }
                        else bv = *(const f32x4*)(basef + off + o2);
                        const f32x4 o = bv + acc[ai][bj][m][n]; q += (o[0] * o[0] + o[1] * o[1]) + (o[2] * o[2] + o[3] * o[3]);
                        u32x2 w2; w2.x = cvt_pk_bf16(o[0], o[1]); w2.y = cvt_pk_bf16(o[2], o[3]); *(u32x2*)(orow + o2) = w2; }
                q += __shfl_xor(q, 16); q += __shfl_xor(q, 32);
                if (fq == 0) ss[(size_t)row * 32 + u.pn * 4 + wc] = q; }
    }
};
struct EpiX { static constexpr bool PERM = false; const float* xp; const float* xs; bf16_t* ob; float* ss;
    __device__ __forceinline__ void operator()(AccRef acc, const Unit& u, int wr, int wc, int fr, int fq) const {
        const float* base = (u.pm < NP / 256) ? xp : xs - (size_t)NP * DM; EpiResid E{base, nullptr, ob, DM, ss}; E(acc, u, wr, wc, fr, fq); } };
struct EpiS {
    static constexpr bool PERM = false;
    float* S; const float* ss;
    __device__ __forceinline__ void operator()(AccRef acc, const Unit& u, int wr, int wc, int fr, int fq) const {
        const int col0 = u.pn * BM + wc * 32 + 4 * fq;
#pragma unroll
        for (int ai = 0; ai < 2; ++ai)
#pragma unroll
            for (int m = 0; m < 4; ++m) { const int row = u.pm * BM + ai * HALF + wr * 64 + m * 16 + fr; const float rr = row_rs4(ss, row, fq); float* rowp = S + (size_t)row * NSW + col0;
#pragma unroll
                for (int bj = 0; bj < 2; ++bj)
#pragma unroll
                    for (int n = 0; n < 2; ++n) *(f32x4*)(rowp + bj * HALF + n * 16) = acc[ai][bj][m][n] * rr; }
    }
};
struct EpiGU {
    static constexpr bool PERM = true;
    bf16_t* act; const float* ss;
    __device__ __forceinline__ void operator()(AccRef acc, const Unit& u, int wr, int wc, int fr, int fq) const {
        bf16_t* base = act + u.pn * HALF + wc * 32 + 8 * fq;
#pragma unroll
        for (int ai = 0; ai < 2; ++ai)
#pragma unroll
            for (int m = 0; m < 4; ++m) { const int row = u.pm * BM + ai * HALF + wr * 64 + m * 16 + fr; const float rr = row_rs4(ss, row, fq); float o[8];
#pragma unroll
                for (int n = 0; n < 2; ++n)
#pragma unroll
                    for (int e = 0; e < 4; ++e) { const float g = acc[ai][0][m][n][e] * rr, up = acc[ai][1][m][n][e] * rr;
                        o[n * 4 + e] = g * __builtin_amdgcn_rcpf(1.0f + __builtin_amdgcn_exp2f(-g * LOG2E)) * up; }
                u32x4 w; w.x = cvt_pk_bf16(o[0], o[1]); w.y = cvt_pk_bf16(o[2], o[3]); w.z = cvt_pk_bf16(o[4], o[5]); w.w = cvt_pk_bf16(o[6], o[7]);
                *(u32x4*)(base + (size_t)row * DFF) = w; }
    }
};
}

namespace att {
#define SBAR() __builtin_amdgcn_sched_barrier(0)
constexpr float THR = 8.0f;
constexpr int SHM_V = 16384, SHM_K = 16384, OFF_K = 2 * SHM_V, OFF_WS = OFF_K + 2 * SHM_K, OFF_RPB = OFF_WS + 8 * 256, OFF_STG = OFF_RPB + 2048, OFF_END = OFF_STG + 8 * 8192;
constexpr int DF_R = 5, DF_D = 4;
constexpr int DF_K = DF_R * SHM_V, DF_KSZ = 8192, DF_WS = DF_K + DF_R * DF_KSZ, DF_STG = 0  , DF_END = DF_WS + 8 * 256;
static_assert(8 * 8192 <= DF_K, "output stage fits inside the V ring");
static_assert(DF_END <= 147456 && OFF_END <= 147456, "attention LDS maps fit the dynamic LDS allocation");
__device__ __forceinline__ int crow(int r, int hi) { return (r & 3) + 8 * (r >> 2) + 4 * hi; }
#define KSWZ128(row, colB) ((row) * 256 + ((colB) ^ (((row) & 7) << 4)))
#define KSWZ64(row, colB) ((row) * 128 + ((colB) ^ ((((row) >> 1) & 7) << 4)))
__device__ __forceinline__ int v_st(int k, int c) { const int kk = (k & ~0xC) | ((k & 4) << 1) | ((k & 8) >> 1); return ((kk >> 3) * 4 + (c >> 5)) * 512 + ((kk & 7) * 32 + (c & 31)) * 2; }
__device__ __forceinline__ int v_rd_base(int lane) { return ((lane & 3) << 3) | (((lane >> 2) & 3) << 6) | (((lane >> 4) & 1) << 5) | (((lane >> 5) & 1) << 8); }
constexpr int v_rd_off(int d0, int ks, int half) { return d0 * 512 + ks * 4096 + half * 2048; }
template <int OFF> __device__ __forceinline__ s16x4 tr_read(int vb) { s16x4 r; asm volatile("ds_read_b64_tr_b16 %0, %1 offset:%2" : "=&v"(r) : "v"(vb), "i"(OFF) : "memory"); return r; }
template <int D0> __device__ __forceinline__ void pv_one(f32x16& od, int vb, bf16x8 pa0, bf16x8 pa1, bf16x8 pa2, bf16x8 pa3) {
    const s16x4 l0 = tr_read<v_rd_off(D0, 0, 0)>(vb), h0 = tr_read<v_rd_off(D0, 0, 1)>(vb), l1 = tr_read<v_rd_off(D0, 1, 0)>(vb), h1 = tr_read<v_rd_off(D0, 1, 1)>(vb);
    const s16x4 l2 = tr_read<v_rd_off(D0, 2, 0)>(vb), h2 = tr_read<v_rd_off(D0, 2, 1)>(vb), l3 = tr_read<v_rd_off(D0, 3, 0)>(vb), h3 = tr_read<v_rd_off(D0, 3, 1)>(vb);
    asm volatile("s_waitcnt lgkmcnt(0)" ::: "memory"); SBAR();
#define PK(L, H) (bf16x8){L[0], L[1], L[2], L[3], H[0], H[1], H[2], H[3]}
    od = __builtin_amdgcn_mfma_f32_32x32x16_bf16(pa0, PK(l0, h0), od, 0, 0, 0);
    od = __builtin_amdgcn_mfma_f32_32x32x16_bf16(pa1, PK(l1, h1), od, 0, 0, 0);
    od = __builtin_amdgcn_mfma_f32_32x32x16_bf16(pa2, PK(l2, h2), od, 0, 0, 0);
    od = __builtin_amdgcn_mfma_f32_32x32x16_bf16(pa3, PK(l3, h3), od, 0, 0, 0);
#undef PK
}
template <int D0> __device__ __forceinline__ void pv_rd(s16x4 (&L)[4], s16x4 (&H)[4], int vb) {
    L[0] = tr_read<v_rd_off(D0, 0, 0)>(vb); H[0] = tr_read<v_rd_off(D0, 0, 1)>(vb); L[1] = tr_read<v_rd_off(D0, 1, 0)>(vb); H[1] = tr_read<v_rd_off(D0, 1, 1)>(vb);
    L[2] = tr_read<v_rd_off(D0, 2, 0)>(vb); H[2] = tr_read<v_rd_off(D0, 2, 1)>(vb); L[3] = tr_read<v_rd_off(D0, 3, 0)>(vb); H[3] = tr_read<v_rd_off(D0, 3, 1)>(vb);
}
#define PV_PK(L, H) (bf16x8){L[0], L[1], L[2], L[3], H[0], H[1], H[2], H[3]}
#define PV_MMA(od, L, H) do { od = __builtin_amdgcn_mfma_f32_32x32x16_bf16(pa0, PV_PK(L[0], H[0]), od, 0, 0, 0); od = __builtin_amdgcn_mfma_f32_32x32x16_bf16(pa1, PV_PK(L[1], H[1]), od, 0, 0, 0); \
    od = __builtin_amdgcn_mfma_f32_32x32x16_bf16(pa2, PV_PK(L[2], H[2]), od, 0, 0, 0); od = __builtin_amdgcn_mfma_f32_32x32x16_bf16(pa3, PV_PK(L[3], H[3]), od, 0, 0, 0); } while (0)
__device__ __forceinline__ void pv_all_pre(f32x16* o, f32x16& lsum, int vb, bf16x8 pa0, bf16x8 pa1, bf16x8 pa2, bf16x8 pa3) {
    const bf16x8 ones = (bf16x8){16256, 16256, 16256, 16256, 16256, 16256, 16256, 16256};
    s16x4 L0[4], H0[4], L1[4], H1[4], L2[4], H2[4], L3[4], H3[4];
    pv_rd<0>(L0, H0, vb); pv_rd<1>(L1, H1, vb);
    asm volatile("s_waitcnt lgkmcnt(8)" ::: "memory"); SBAR(); PV_MMA(o[0], L0, H0); lsum = __builtin_amdgcn_mfma_f32_32x32x16_bf16(pa0, ones, lsum, 0, 0, 0); SBAR();
    pv_rd<2>(L2, H2, vb);
    asm volatile("s_waitcnt lgkmcnt(8)" ::: "memory"); SBAR(); PV_MMA(o[1], L1, H1); lsum = __builtin_amdgcn_mfma_f32_32x32x16_bf16(pa1, ones, lsum, 0, 0, 0); SBAR();
    pv_rd<3>(L3, H3, vb);
    asm volatile("s_waitcnt lgkmcnt(8)" ::: "memory"); SBAR(); PV_MMA(o[2], L2, H2); lsum = __builtin_amdgcn_mfma_f32_32x32x16_bf16(pa2, ones, lsum, 0, 0, 0); SBAR();
    asm volatile("s_waitcnt lgkmcnt(0)" ::: "memory"); SBAR(); PV_MMA(o[3], L3, H3); lsum = __builtin_amdgcn_mfma_f32_32x32x16_bf16(pa3, ones, lsum, 0, 0, 0); SBAR();
}
__device__ __forceinline__ void pv_all(f32x16* o, int vb, bf16x8 pa0, bf16x8 pa1, bf16x8 pa2, bf16x8 pa3) {
    pv_one<0>(o[0], vb, pa0, pa1, pa2, pa3); pv_one<1>(o[1], vb, pa0, pa1, pa2, pa3); pv_one<2>(o[2], vb, pa0, pa1, pa2, pa3); pv_one<3>(o[3], vb, pa0, pa1, pa2, pa3);
}
__device__ __forceinline__ void softmax_tile(f32x16& p0, f32x16& p1, float& m_reg, float& l_reg, float& alpha, bf16x8& pa0, bf16x8& pa1, bf16x8& pa2, bf16x8& pa3) {
    float pmax = p0[0];
#pragma unroll
    for (int r = 1; r < 16; ++r) pmax = fmaxf(pmax, p0[r]);
#pragma unroll
    for (int r = 0; r < 16; ++r) pmax = fmaxf(pmax, p1[r]);
    { auto rr = __builtin_amdgcn_permlane32_swap(__float_as_uint(pmax), __float_as_uint(pmax), false, false); pmax = fmaxf(__uint_as_float(rr[0]), __uint_as_float(rr[1])); }
    float mn;
    if (__builtin_expect(__all(pmax - m_reg <= THR), 1)) { mn = m_reg; alpha = 1.f; }
    else { mn = fmaxf(m_reg, pmax); alpha = __builtin_amdgcn_exp2f(m_reg - mn); m_reg = mn; }
#pragma unroll
    for (int r = 0; r < 16; ++r) { p0[r] = __builtin_amdgcn_exp2f(p0[r] - mn); p1[r] = __builtin_amdgcn_exp2f(p1[r] - mn); }
    float ps = 0.f;
#pragma unroll
    for (int r = 0; r < 16; ++r) ps += p0[r];
#pragma unroll
    for (int r = 0; r < 16; ++r) ps += p1[r];
    { auto rr = __builtin_amdgcn_permlane32_swap(__float_as_uint(ps), __float_as_uint(ps), false, false); ps = __uint_as_float(rr[0]) + __uint_as_float(rr[1]); }
    l_reg = l_reg * alpha + ps;
#define PK4(P, BASE, OUT) do { unsigned a0 = cvt_pk_bf16(P[BASE + 0], P[BASE + 1]), a1 = cvt_pk_bf16(P[BASE + 2], P[BASE + 3]);   \
    unsigned b0 = cvt_pk_bf16(P[BASE + 4], P[BASE + 5]), b1 = cvt_pk_bf16(P[BASE + 6], P[BASE + 7]);                              \
    auto r0 = __builtin_amdgcn_permlane32_swap(a0, b0, false, false); auto r1 = __builtin_amdgcn_permlane32_swap(a1, b1, false, false); \
    u32x4 w = {r0[0], r1[0], r0[1], r1[1]}; OUT = __builtin_bit_cast(bf16x8, w); } while (0)
    PK4(p0, 0, pa0); PK4(p0, 8, pa1); PK4(p1, 0, pa2); PK4(p1, 8, pa3);
#undef PK4
}
__device__ __forceinline__ void softmax_rel(f32x16& p0, f32x16& p1, float& m_reg, f32x16& negm, float& alpha, bool first, bf16x8& pa0, bf16x8& pa1, bf16x8& pa2, bf16x8& pa3) {
    float pmax = p0[0];
#pragma unroll
    for (int r = 1; r < 16; ++r) pmax = fmaxf(pmax, p0[r]);
#pragma unroll
    for (int r = 0; r < 16; ++r) pmax = fmaxf(pmax, p1[r]);
    { auto rr = __builtin_amdgcn_permlane32_swap(__float_as_uint(pmax), __float_as_uint(pmax), false, false); pmax = fmaxf(__uint_as_float(rr[0]), __uint_as_float(rr[1])); }
    alpha = 1.f;
    if (__builtin_expect(first || !__all(pmax <= THR), 0)) {
        const float dl = first ? pmax : fmaxf(pmax, 0.f);
        m_reg += dl; alpha = first ? 1.f : __builtin_amdgcn_exp2f(-dl);
#pragma unroll
        for (int r = 0; r < 16; ++r) { p0[r] -= dl; p1[r] -= dl; negm[r] = -m_reg; }
    }
#pragma unroll
    for (int r = 0; r < 16; ++r) { p0[r] = __builtin_amdgcn_exp2f(p0[r]); p1[r] = __builtin_amdgcn_exp2f(p1[r]); }
#define PK4(P, BASE, OUT) do { unsigned a0 = cvt_pk_bf16(P[BASE + 0], P[BASE + 1]), a1 = cvt_pk_bf16(P[BASE + 2], P[BASE + 3]);   \
    unsigned b0 = cvt_pk_bf16(P[BASE + 4], P[BASE + 5]), b1 = cvt_pk_bf16(P[BASE + 6], P[BASE + 7]);                              \
    auto r0 = __builtin_amdgcn_permlane32_swap(a0, b0, false, false); auto r1 = __builtin_amdgcn_permlane32_swap(a1, b1, false, false); \
    u32x4 w = {r0[0], r1[0], r0[1], r1[1]}; OUT = __builtin_bit_cast(bf16x8, w); } while (0)
    PK4(p0, 0, pa0); PK4(p0, 8, pa1); PK4(p1, 0, pa2); PK4(p1, 8, pa3);
#undef PK4
}
#define ATT_RESC2(a) do { if (__any((a) < 1.f)) { if (hi == 0) al_l[r32] = (a); asm volatile("s_waitcnt lgkmcnt(0)" ::: "memory"); \
    _Pragma("unroll") for (int r = 0; r < 16; ++r) { const float f_ = al_l[crow(r, hi)]; o[0][r] *= f_; o[1][r] *= f_; o[2][r] *= f_; o[3][r] *= f_; lsum[r] *= f_; } } } while (0)
#define ATT_RESC(a) do { if (__any((a) < 1.f)) { if (hi == 0) al_l[r32] = (a); asm volatile("s_waitcnt lgkmcnt(0)" ::: "memory"); \
    _Pragma("unroll") for (int d = 0; d < 4; ++d) _Pragma("unroll") for (int r = 0; r < 16; ++r) o[d][r] *= al_l[crow(r, hi)]; } } while (0)

__device__ __forceinline__ void diff_unit(const bf16_t* __restrict__ proj, bf16_t* __restrict__ mix, float* __restrict__ o1s, const float* __restrict__ g_sub, float lam,
                                          int rowbase, int T, int h, int qb, char* lds, int widk) {
    const int tid = tid_l(widk), wid = tid >> 6, lane = tid & 63, r32 = lane & 31, hi = lane >> 5;
    char* V_lds = lds; char* K_lds = lds + DF_K;
    float* wsf = (float*)(lds + DF_WS) + wid * 64; float* li_l = wsf; float* al_l = wsf + 32;
    LAS unsigned char* ldsl = (LAS unsigned char*)lds; const int widu = __builtin_amdgcn_readfirstlane(wid);
    unsigned kgo, vgo[2];
    { const int X = wid * 1024 + lane * 16, krow = X >> 7, kcolB = (X & 127) ^ (((krow >> 1) & 7) << 4); kgo = (unsigned)(krow * INW * 2 + kcolB); }
#pragma unroll
    for (int i = 0; i < 2; ++i) { const int X = wid * 1024 + lane * 16 + i * 8192, sub = X >> 9, e = (X & 511) >> 1, kk = (sub >> 2) * 8 + (e >> 5), cc = (sub & 3) * 32 + (e & 31);
        const int k = (kk & ~0xC) | ((kk & 4) << 1) | ((kk & 8) >> 1); vgo[i] = (unsigned)((k * INW + cc) * 2); }
    const int vb0 = (int)(uintptr_t)V_lds + v_rd_base(lane);
    const int NT = T / 64; const int q0 = qb * 256;
    const bf16_t* Vh = proj + (size_t)rowbase * INW + 5120 + h * 128;
#define BAR() do { asm volatile("" ::: "memory"); __builtin_amdgcn_s_barrier(); asm volatile("" ::: "memory"); } while (0)
#pragma unroll 1
    for (int s = 0; s < 2; ++s) {
        const bf16_t* Kh = proj + (size_t)rowbase * INW + 4096 + h * 128 + s * 64;
        const unsigned qoff = ((unsigned)(rowbase + q0 + wid * 32 + r32) * INW + 3072 + h * 128 + s * 64 + hi * 8) * 2u;
        bf16x8 qr[4];
#pragma unroll
        for (int d0 = 0; d0 < 4; ++d0) qr[d0] = *(const bf16x8*)((const char*)proj + qoff + d0 * 32);
        float m_reg = 0.f; f32x16 o[4], lsum = f32x16{}, negm = f32x16{};
#pragma unroll
        for (int d = 0; d < 4; ++d) o[d] = f32x16{};
#define DDMA(j, b) do { const char* kt = (const char*)Kh + (size_t)(j) * (64 * INW * 2); const char* vt = (const char*)Vh + (size_t)(j) * (64 * INW * 2); \
        __builtin_amdgcn_global_load_lds((const unsigned*)(kt + kgo), (LAS unsigned*)(ldsl + DF_K + (b) * DF_KSZ + widu * 1024), 16, 0, 0); \
        __builtin_amdgcn_global_load_lds((const unsigned*)(vt + vgo[0]), (LAS unsigned*)(ldsl + (b) * SHM_V + widu * 1024), 16, 0, 0); \
        __builtin_amdgcn_global_load_lds((const unsigned*)(vt + vgo[1]), (LAS unsigned*)(ldsl + (b) * SHM_V + widu * 1024 + 8192), 16, 0, 0); } while (0)
#pragma unroll
        for (int t = 0; t < DF_D; ++t) DDMA(t, t);
        asm volatile("s_waitcnt vmcnt(%0)" :: "n"(3 * (DF_D - 1)) : "memory"); BAR();
        bf16x8 kf[8];
#define KLOAD(slot) do { const char* Ks_ = K_lds + (slot) * DF_KSZ; _Pragma("unroll") for (int d0 = 0; d0 < 4; ++d0) { const int cb = (d0 * 16 + hi * 8) * 2; \
            kf[2 * d0] = *(const bf16x8*)(Ks_ + KSWZ64(r32, cb)); kf[2 * d0 + 1] = *(const bf16x8*)(Ks_ + KSWZ64(32 + r32, cb)); } } while (0)
        int bsl = 0;
#pragma unroll 1
        for (int j = 0; j < NT; ++j) {
            f32x16 p0, p1;
            KLOAD(bsl);
            p0 = __builtin_amdgcn_mfma_f32_32x32x16_bf16(kf[0], qr[0], negm, 0, 0, 0); p1 = __builtin_amdgcn_mfma_f32_32x32x16_bf16(kf[1], qr[0], negm, 0, 0, 0);
#pragma unroll
            for (int d0 = 1; d0 < 4; ++d0) { p0 = __builtin_amdgcn_mfma_f32_32x32x16_bf16(kf[2 * d0], qr[d0], p0, 0, 0, 0); p1 = __builtin_amdgcn_mfma_f32_32x32x16_bf16(kf[2 * d0 + 1], qr[d0], p1, 0, 0, 0); }
            float alpha; bf16x8 pa0, pa1, pa2, pa3;
            softmax_rel(p0, p1, m_reg, negm, alpha, j == 0, pa0, pa1, pa2, pa3);
            ATT_RESC2(alpha);
            if (j + DF_D <= NT) asm volatile("s_waitcnt vmcnt(%0) lgkmcnt(0)" :: "n"(3 * (DF_D - 2)) : "memory"); else asm volatile("s_waitcnt vmcnt(0) lgkmcnt(0)" ::: "memory");
            BAR();
            if (j + DF_D < NT) { const int b2 = bsl >= 1 ? bsl - 1 : DF_R - 1; DDMA(j + DF_D, b2); }
            const int bn = bsl == DF_R - 1 ? 0 : bsl + 1;
            pv_all_pre(o, lsum, vb0 + bsl * SHM_V, pa0, pa1, pa2, pa3);
            bsl = bn;
        }
#undef KLOAD
        asm volatile("s_waitcnt lgkmcnt(0)" ::: "memory");
        BAR();
#undef DDMA
        float rli[16];
#pragma unroll
        for (int r = 0; r < 16; ++r) rli[r] = __builtin_amdgcn_rcpf(lsum[r]);
        f32x4* o1v = (f32x4*)((char*)o1s + (unsigned)tid * 256u);
        if (s == 0) {
#pragma unroll
            for (int d = 0; d < 4; ++d)
#pragma unroll
                for (int r = 0; r < 16; r += 4) o1v[d * 4 + (r >> 2)] = (f32x4){o[d][r] * rli[r], o[d][r + 1] * rli[r + 1], o[d][r + 2] * rli[r + 2], o[d][r + 3] * rli[r + 3]};
        } else {
#pragma unroll
            for (int d = 0; d < 4; ++d)
#pragma unroll
                for (int r = 0; r < 16; r += 4) { const f32x4 t = o1v[d * 4 + (r >> 2)];
#pragma unroll
                    for (int e = 0; e < 4; ++e) o[d][r + e] = t[e] - lam * (o[d][r + e] * rli[r + e]); }
            float gs[4];
#pragma unroll
            for (int d = 0; d < 4; ++d) gs[d] = g_sub[d * 32 + r32] * (1.0f - LAM_INIT);
            bf16_t* stg = (bf16_t*)(lds + DF_STG) + wid * 4096;
#pragma unroll
            for (int r = 0; r < 16; ++r) {
                float q = (o[0][r] * o[0][r] + o[1][r] * o[1][r]) + (o[2][r] * o[2][r] + o[3][r] * o[3][r]);
                q += __shfl_xor(q, 1); q += __shfl_xor(q, 2); q += __shfl_xor(q, 4); q += __shfl_xor(q, 8); q += __shfl_xor(q, 16);
                const float rn = __builtin_amdgcn_rsqf(q * (1.0f / 128.0f) + SUBLN_EPS);
#pragma unroll
                for (int d = 0; d < 4; ++d) stg[crow(r, hi) * 128 + d * 32 + r32] = (bf16_t)f2bf(o[d][r] * rn * gs[d]);
            }
            asm volatile("s_waitcnt lgkmcnt(0)" ::: "memory");
            const unsigned goff = ((unsigned)(rowbase + q0 + wid * 32 + (lane >> 4)) * DM + 1024 + h * 128 + (lane & 15) * 8) * 2u;
#pragma unroll
            for (int i = 0; i < 8; ++i) { const u32x4 v = *(const u32x4*)(stg + (i * 4 + (lane >> 4)) * 128 + (lane & 15) * 8); *(u32x4*)((char*)mix + goff + (unsigned)(i * 4 * DM * 2)) = v; }
            asm volatile("s_waitcnt lgkmcnt(0)" ::: "memory"); BAR();
        }
    }
#undef BAR
}

__device__ __forceinline__ void na_unit(const bf16_t* __restrict__ proj, bf16_t* __restrict__ mix, const float* __restrict__ rpb,
                                        int rowbase, int ROWS, int h, int rg, char* lds, int widk) {
    const int tid = tid_l(widk), wid = tid >> 6, lane = tid & 63, r32 = lane & 31, hi = lane >> 5;
    char* V_lds = lds; char* K_lds = lds + OFF_K;
    float* wsf = (float*)(lds + OFF_WS) + wid * 64; float* li_l = wsf; float* al_l = wsf + 32;
    float* rpbL = (float*)(lds + OFF_RPB);
    LAS unsigned char* ldsl = (LAS unsigned char*)lds; const int widu = __builtin_amdgcn_readfirstlane(wid);
    unsigned kgo[2], vgo[2];
#pragma unroll
    for (int i = 0; i < 2; ++i) { const int X = wid * 1024 + lane * 16 + i * 8192;
        { const int krow = X >> 8, kcolB = (X & 255) ^ ((krow & 7) << 4); kgo[i] = (unsigned)(krow * INW * 2 + kcolB); }
        { const int sub = X >> 9, e = (X & 511) >> 1, kk = (sub >> 2) * 8 + (e >> 5), cc = (sub & 3) * 32 + (e & 31); const int k = (kk & ~0xC) | ((kk & 4) << 1) | ((kk & 8) >> 1); vgo[i] = (unsigned)((k * INW + cc) * 2); } }
    const int vb0 = (int)(uintptr_t)V_lds + v_rd_base(lane);
    const int r0 = rg * 4, rq = r0 + (wid >> 1), c = 32 * (wid & 1) + r32;
    const int rsw = min(max(rq - 4, 0), ROWS - 8), cs = min(max(c - 8, 0), 48);
    const int klo = min(max(r0 - 4, 0), ROWS - 8), khi = min(max(r0 + 3 - 4, 0), ROWS - 8) + 8;
    for (int i = tid; i < 465; i += NTHREADS) rpbL[i] = rpb[h * 465 + i] * LOG2E;
    const bf16_t* Kh = proj + (size_t)rowbase * INW + 1024 + h * 128;
    const bf16_t* Vh = proj + (size_t)rowbase * INW + 2048 + h * 128;
    const bf16_t* Qw = proj + (size_t)(rowbase + rq * 64 + c) * INW + h * 128 + hi * 8;
    bf16x8 qr[8];
#pragma unroll
    for (int d0 = 0; d0 < 8; ++d0) qr[d0] = *(const bf16x8*)(Qw + d0 * 16);
    float m_reg = -1e30f, l_reg = 0.f; f32x16 o[4];
#pragma unroll
    for (int d = 0; d < 4; ++d) o[d] = f32x16{};
#define NDMA(kr, b) do { const char* kt = (const char*)Kh + (size_t)(kr) * (64 * INW * 2); const char* vt = (const char*)Vh + (size_t)(kr) * (64 * INW * 2); \
        __builtin_amdgcn_global_load_lds((const unsigned*)(kt + kgo[0]), (LAS unsigned*)(ldsl + OFF_K + (b) * SHM_K + widu * 1024), 16, 0, 0); \
        __builtin_amdgcn_global_load_lds((const unsigned*)(kt + kgo[1]), (LAS unsigned*)(ldsl + OFF_K + (b) * SHM_K + widu * 1024 + 8192), 16, 0, 0); \
        __builtin_amdgcn_global_load_lds((const unsigned*)(vt + vgo[0]), (LAS unsigned*)(ldsl + (b) * SHM_V + widu * 1024), 16, 0, 0); \
        __builtin_amdgcn_global_load_lds((const unsigned*)(vt + vgo[1]), (LAS unsigned*)(ldsl + (b) * SHM_V + widu * 1024 + 8192), 16, 0, 0); } while (0)
    NDMA(klo, 0); asm volatile("s_waitcnt vmcnt(0)" ::: "memory"); __syncthreads();
#pragma unroll 1
    for (int kr = klo; kr < khi; ++kr) {
        const int b = (kr - klo) & 1;
        if (kr + 1 < khi) NDMA(kr + 1, b ^ 1);
        if (kr >= rsw && kr < rsw + 8) {
            f32x16 p0 = f32x16{}, p1 = f32x16{};
            const char* Ks = K_lds + b * SHM_K;
#pragma unroll
            for (int d0 = 0; d0 < 8; ++d0) { const int cb = (d0 * 16 + hi * 8) * 2;
                const bf16x8 b0 = *(const bf16x8*)(Ks + KSWZ128(r32, cb)); const bf16x8 b1 = *(const bf16x8*)(Ks + KSWZ128(32 + r32, cb));
                p0 = __builtin_amdgcn_mfma_f32_32x32x16_bf16(b0, qr[d0], p0, 0, 0, 0); p1 = __builtin_amdgcn_mfma_f32_32x32x16_bf16(b1, qr[d0], p1, 0, 0, 0); }
            const float* brow = rpbL + (kr - rq + 7) * 31;
#pragma unroll
            for (int r = 0; r < 16; ++r) {
                const int kc = crow(r, hi), kc2 = kc + 32;
                const int i0 = min(max(kc - c + 15, 0), 30), i1 = min(max(kc2 - c + 15, 0), 30);
                const float b0 = brow[i0], b1 = brow[i1];
                p0[r] = ((unsigned)(kc - cs) < 16u) ? p0[r] + b0 : -1e30f;
                p1[r] = ((unsigned)(kc2 - cs) < 16u) ? p1[r] + b1 : -1e30f;
            }
            float alpha; bf16x8 pa0, pa1, pa2, pa3;
            softmax_tile(p0, p1, m_reg, l_reg, alpha, pa0, pa1, pa2, pa3);
            ATT_RESC(alpha);
            pv_all(o, vb0 + b * SHM_V, pa0, pa1, pa2, pa3);
        }
        asm volatile("s_waitcnt vmcnt(0)" ::: "memory");
        __syncthreads();
    }
#undef NDMA
    if (hi == 0) li_l[r32] = l_reg;
    asm volatile("s_waitcnt lgkmcnt(0)" ::: "memory");
    bf16_t* stg = (bf16_t*)(lds + OFF_STG) + wid * 4096;
#pragma unroll
    for (int r = 0; r < 16; ++r) { const float rl = __builtin_amdgcn_rcpf(li_l[crow(r, hi)]);
#pragma unroll
        for (int d = 0; d < 4; ++d) stg[crow(r, hi) * 128 + d * 32 + r32] = (bf16_t)f2bf(o[d][r] * rl); }
    asm volatile("s_waitcnt lgkmcnt(0)" ::: "memory");
    bf16_t* gp = mix + (size_t)(rowbase + rq * 64 + 32 * (wid & 1) + (lane >> 4)) * DM + h * 128 + (lane & 15) * 8;
#pragma unroll
    for (int i = 0; i < 8; ++i) { const u32x4 v = *(const u32x4*)(stg + (i * 4 + (lane >> 4)) * 128 + (lane & 15) * 8); *(u32x4*)gp = v; gp += 4 * DM; }
    __syncthreads();
}
#undef SBAR
}

template <int MODE> __device__ __forceinline__ int dest_row(int n) {
    if (MODE == 1) { if (n < 3072 || n >= 5120) return n; const int d = n & 63, blk = n & ~63, nn = d >> 5, dd = d & 31; return blk + 32 * (dd >> 4) + 8 * ((dd >> 2) & 3) + 4 * nn + (dd & 3); }
    if (MODE == 2) { if (n < DFF) return 256 * (n >> 7) + (n & 127); const int n2 = n - DFF; return 256 * (n2 >> 7) + 128 + (n2 & 127); }
    return n;
}
template <int MODE> __device__ __forceinline__ void p0_transpose_item(const float* __restrict__ W, int K, int N, bf16_t* __restrict__ WT, const float* __restrict__ gain, LAS float* scr, int item, int lane) {
    const int nblk = N / 32, kb = item / nblk, nb = item % nblk, k0 = 64 * kb, n0 = 32 * nb;
#pragma unroll 8
    for (int i = 0; i < 32; ++i) { const int kk = 2 * i + (lane >> 5); const float g = gain ? gain[k0 + kk] : 1.0f; scr[kk * 33 + (lane & 31)] = W[(size_t)(k0 + kk) * N + n0 + (lane & 31)] * g; }
    asm volatile("s_waitcnt lgkmcnt(0)" ::: "memory");
    const int c = lane & 7;
#pragma unroll
    for (int j = 0; j < 4; ++j) { const int n = (lane >> 3) + 8 * j; const LAS float* s = scr + (8 * c) * 33 + n;
        u32x4 o; o.x = pk2(s[0 * 33], s[1 * 33]); o.y = pk2(s[2 * 33], s[3 * 33]); o.z = pk2(s[4 * 33], s[5 * 33]); o.w = pk2(s[6 * 33], s[7 * 33]);
        *(u32x4*)(WT + (size_t)dest_row<MODE>(n0 + n) * K + k0 + 8 * c) = o; }
    asm volatile("s_waitcnt lgkmcnt(0)" ::: "memory");
}
__device__ __forceinline__ float row_ssq(const float* xrow, int lane, f32x4 (&v)[8]) {
    const f32x4* xr = (const f32x4*)xrow + lane; float s = 0.f;
#pragma unroll
    for (int j = 0; j < 8; ++j) { v[j] = xr[64 * j]; s += (v[j][0] * v[j][0] + v[j][1] * v[j][1]) + (v[j][2] * v[j][2] + v[j][3] * v[j][3]); }
    return wave_sum(s);
}
__device__ __forceinline__ void sincos_d(double x, double& sn, double& cs) {
    const double k = __builtin_rint(x * 0.6366197723675814); const double r0 = __builtin_fma(-k, 1.5707963267948966, x); const double r = __builtin_fma(-k, 6.123233995736766e-17, r0);
    const double r2 = r * r;
    double s = -1.0 / 1307674368000.0; s = s * r2 + 1.0 / 6227020800.0; s = s * r2 - 1.0 / 39916800.0; s = s * r2 + 1.0 / 362880.0; s = s * r2 - 1.0 / 5040.0; s = s * r2 + 1.0 / 120.0; s = s * r2 - 1.0 / 6.0; s = s * r2 * r + r;
    double c = 1.0 / 20922789888000.0; c = c * r2 - 1.0 / 87178291200.0; c = c * r2 + 1.0 / 479001600.0; c = c * r2 - 1.0 / 3628800.0; c = c * r2 + 1.0 / 40320.0; c = c * r2 - 1.0 / 720.0; c = c * r2 + 1.0 / 24.0; c = c * r2 - 0.5; c = c * r2 + 1.0;
    const int q = ((int)k) & 3;
    sn = (q == 0) ? s : (q == 1) ? c : (q == 2) ? -s : -c;
    cs = (q == 0) ? c : (q == 1) ? -s : (q == 2) ? -c : s;
}

struct Args { const float* in[22]; float* out; unsigned char* ws; int ph_lo, ph_hi; };
constexpr int NPHASE = 10;

__global__ void __launch_bounds__(NTHREADS, 2) fwd_kernel(Args a) {
    extern __shared__ __attribute__((aligned(16))) unsigned char lds[];
    LAS unsigned char* ldsl = (LAS unsigned char*)lds;
    const int widk = __builtin_amdgcn_readfirstlane((int)(threadIdx.x >> 6));
    const int G = gridDim.x, bx = blockIdx.x, vcu = (G % 8 == 0) ? (bx % 8) * (G / 8) + bx / 8 : bx;
#define x_p (ap->in[0])
#define x_s (ap->in[1])
#define mem_p (ap->in[2])
#define mem_s (ap->in[3])
#define g_mix (ap->in[4])
#define w_in (ap->in[5])
#define rpb (ap->in[6])
#define lam_q1 (ap->in[7])
#define lam_k1 (ap->in[8])
#define lam_q2 (ap->in[9])
#define lam_k2 (ap->in[10])
#define g_subln (ap->in[11])
#define w_out (ap->in[12])
#define g_xattn (ap->in[13])
#define g_mem (ap->in[14])
#define w_mq (ap->in[15])
#define w_mkv (ap->in[16])
#define w_mo (ap->in[17])
#define g_ffn (ap->in[18])
#define w_gu (ap->in[19])
#define w_dn (ap->in[20])
#define g_final (ap->in[21])
#define out (ap->out)
#define WSP() const __attribute__((address_space(4))) Args* ap = (const __attribute__((address_space(4))) Args*)__builtin_amdgcn_kernarg_segment_ptr(); asm volatile("" : "+s"(ap)); unsigned char* ws = ap->ws
#define SS ((float*)(ws + WS_SS))
#define RS0 ((float*)(ws + WS_RS0))
#define ROPE ((f32x2*)(ws + WS_ROPE))
#define WIN ((bf16_t*)(ws + WS_WIN))
#define WOUT ((bf16_t*)(ws + WS_WOUT))
#define WMQ ((bf16_t*)(ws + WS_WMQ))
#define WMO ((bf16_t*)(ws + WS_WMO))
#define WMKV ((bf16_t*)(ws + WS_WMKV))
#define WGU ((bf16_t*)(ws + WS_WGU))
#define WDN ((bf16_t*)(ws + WS_WDN))
#define MN ((bf16_t*)(ws + WS_MN))
#define KB ((bf16_t*)(ws + WS_KB))
#define VB ((bf16_t*)(ws + WS_VB))
#define WQK ((bf16_t*)(ws + WS_WQK))
#define WVO ((bf16_t*)(ws + WS_WVO))
#define O1S ((float*)(ws + WS_O1))
#define XB ((bf16_t*)(ws + WS_XB))
#define PROJ ((bf16_t*)(ws + WS_BIG))
#define H1B ((bf16_t*)(ws + WS_H1B))
#define SB ((float*)(ws + WS_S))
#define PB ((bf16_t*)(ws + WS_P))
#define ACT ((bf16_t*)(ws + WS_ACT))
#define MIX XB
#define H2B XB
    const int lo = a.ph_lo, hi_ph = a.ph_hi;
    if (lo < 0) cg::this_grid().sync();
#ifdef ONLY_PHASE
#define IN(k) ((k) == ONLY_PHASE && lo <= (k) && (k) < hi_ph)
#else
#define IN(k) (lo <= (k) && (k) < hi_ph)
#endif
#define SEAM(k) do { if (IN(k) && IN((k) + 1)) { WSP(); grid_barrier((unsigned*)(ws + WS_BAR), (unsigned)((k) + 1 - lo) * (unsigned)G, tid_l(widk)); } } while (0)
    const int NGW = G * 8;
#define TIDS() const int tid = tid_l(widk), lane = tid & 63, wave = __builtin_amdgcn_readfirstlane(tid >> 6), gw = vcu * 8 + wave; (void)lane; (void)gw

    if (IN(0)) { WSP(); TIDS();
        LAS float* scr = (LAS float*)(ldsl + wave * 16384);
        constexpr int I0 = (DM / 64) * (INW / 32), I1 = (DM / 64) * (DM / 32), I2 = I1, I3 = (DM / 64) * (4096 / 32), I4 = (DM / 64) * (NGU / 32), I5 = (DFF / 64) * (DM / 32);
        constexpr int NIT = I0 + I1 + I2 + I3 + I4 + I5;
        for (int it = gw; it < NIT; it += NGW) {
            int r = it;
            if (r < I0) { p0_transpose_item<1>(w_in, DM, INW, WIN, g_mix, scr, r, lane); continue; } r -= I0;
            if (r < I1) { p0_transpose_item<0>(w_out, DM, DM, WOUT, nullptr, scr, r, lane); continue; } r -= I1;
            if (r < I2) { p0_transpose_item<0>(w_mo, DM, DM, WMO, nullptr, scr, r, lane); continue; } r -= I2;
            if (r < I3) { p0_transpose_item<0>(w_mkv, DM, 4096, WMKV, nullptr, scr, r, lane); continue; } r -= I3;
            if (r < I4) { p0_transpose_item<2>(w_gu, DM, NGU, WGU, g_ffn, scr, r, lane); continue; } r -= I4;
            p0_transpose_item<0>(w_dn, DFF, DM, WDN, nullptr, scr, r, lane);
        }
        for (int k = gw; k < DM; k += NGW) { const float g = g_xattn[k]; const f32x4* src = (const f32x4*)(w_mq + (size_t)k * DM) + lane; u32x2* dst = (u32x2*)(WMQ + (size_t)k * DM) + lane;
#pragma unroll
            for (int j = 0; j < 8; ++j) { const f32x4 v = src[64 * j] * g; u32x2 w; w.x = pk2(v[0], v[1]); w.y = pk2(v[2], v[3]); dst[64 * j] = w; } }
        for (int m = gw; m < MT; m += NGW) { const float* xr = m < NP ? x_p + (size_t)m * DM : x_s + (size_t)(m - NP) * DM; f32x4 v[8];
            const float s = row_ssq(xr, lane, v); if (lane == 0) RS0[m] = 1.0f / sqrtf(s * (1.0f / DM) + RMS_EPS);
            u32x2* dst = (u32x2*)(XB + (size_t)m * DM) + lane;
#pragma unroll
            for (int j = 0; j < 8; ++j) { u32x2 w; w.x = pk2(v[j][0], v[j][1]); w.y = pk2(v[j][2], v[j][3]); dst[64 * j] = w; } }
        for (int m = gw; m < NMEM; m += NGW) { const float* xr = m < 512 ? mem_p + (size_t)m * DM : mem_s + (size_t)(m - 512) * DM; f32x4 v[8];
            const float s = row_ssq(xr, lane, v); const float rr = 1.0f / sqrtf(s * (1.0f / DM) + RMS_EPS);
            u32x2* dst = (u32x2*)(MN + (size_t)m * DM) + lane; const f32x4* gp = (const f32x4*)g_mem + lane;
#pragma unroll
            for (int j = 0; j < 8; ++j) { const f32x4 g = gp[64 * j]; u32x2 w; w.x = pk2(v[j][0] * rr * g[0], v[j][1] * rr * g[1]); w.y = pk2(v[j][2] * rr * g[2], v[j][3] * rr * g[3]); dst[64 * j] = w; } }
        for (int e = vcu * NTHREADS + tid; e < TP * 32; e += G * NTHREADS) { const int t = e >> 5, dd = e & 31;
            double pw = 1.0; for (int i = 0; i < dd; ++i) pw *= 1.333521432163324;
            const float inv = 1.0f / (float)pw; const float ang = (float)t * inv; double sn, cs; sincos_d((double)ang, sn, cs);
            ROPE[e] = (f32x2){(float)cs, (float)sn}; }
    }
    SEAM(0);

    if (IN(1)) { WSP();
        pg8::Sched S{(const char*)XB, (const char*)WIN, (const char*)MN, (const char*)WMKV, MT / 256, INW / 256, (MT / 256) * (INW / 256), NMEM / 256, (NMEM / 256) * 16,
                     (size_t)256 * DM * 2, (size_t)256 * DM * 2, 0, G, bx};
        pg8::EpiInProj E{PROJ, KB, VB, RS0, ROPE};
        pg8::gemm_phase<pg8::EpiInProj, pg8::Sched, true, true>(ldsl, widk, DM, DM, S, E);
    }
    SEAM(1);

    if (IN(2)) { WSP(); TIDS();
#if !defined(P2_PART) || P2_PART == 1
        { pg8::PreSched S{(const char*)KB, (const char*)VB, (const char*)WMQ, (const char*)WMO, G, bx}; pg8::EpiPre E{WQK, WVO};
          pg8::gemm_phase<pg8::EpiPre, pg8::PreSched, true, true>(ldsl, widk, 512, DM, S, E); }
#endif
        __syncthreads();
#if !defined(P2_PART) || P2_PART == 2
        for (int id = vcu; id < 1024 + 512; id += G) {
            const bool pr = id < 1024; const int i2 = pr ? id : id - 1024;
            const int rg = pr ? (i2 & 63) : (i2 & 15), h = pr ? ((i2 >> 6) & 7) : ((i2 >> 4) & 7), b = pr ? (i2 >> 9) : (i2 >> 7);
            att::na_unit(PROJ, MIX, rpb, pr ? b * TP : NP + b * TS, pr ? TP / 64 : TS / 64, h, rg, (char*)lds, widk);
        }
#endif
#if !defined(P2_PART) || P2_PART == 3
        float lam;
        { const float a1 = wave_sum(lam_q1[lane] * lam_k1[lane]), a2 = wave_sum(lam_q2[lane] * lam_k2[lane]); lam = __expf(a1) - __expf(a2) + LAM_INIT; lam = __builtin_bit_cast(float, __builtin_amdgcn_readfirstlane(__builtin_bit_cast(int, lam))); }
        float* o1s = O1S + (size_t)bx * 64 * NTHREADS;
#ifndef DIFF_REPS
#define DIFF_REPS 1
#endif
        for (int rep = 0; rep < DIFF_REPS; ++rep)
        for (int id = vcu; id < 1024 + 512; id += G) {
            const bool pr = id < 1024; const int i2 = pr ? id : id - 1024;
            const int qb = pr ? (i2 & 63) : (i2 & 15), bh = pr ? (i2 >> 6) : (i2 >> 4);
            att::diff_unit(PROJ, MIX, o1s, g_subln, lam, pr ? (bh >> 3) * TP : NP + (bh >> 3) * TS, pr ? TP : TS, bh & 7, qb, (char*)lds, widk);
        }
#endif
    }
    SEAM(2);

    if (IN(3)) { WSP();
        pg8::Sched S{(const char*)MIX, (const char*)WOUT, nullptr, nullptr, MT / 256, DM / 256, (MT / 256) * (DM / 256), 1, 0, (size_t)256 * DM * 2, (size_t)256 * DM * 2, 0, G, bx};
        pg8::EpiX E{x_p, x_s, H1B, SS};
        pg8::gemm_phase<pg8::EpiX, pg8::Sched, true, true>(ldsl, widk, DM, DM, S, E);
    }
    SEAM(3);

    if (IN(4)) { WSP();
        pg8::Sched S{(const char*)H1B, (const char*)WQK, nullptr, nullptr, MT / 256, NSW / 256, (MT / 256) * (NSW / 256), 1, 0, (size_t)256 * DM * 2, (size_t)256 * DM * 2, (size_t)NSW * DM * 2, G, bx};
        pg8::EpiS E{SB, SS};
        pg8::gemm_phase<pg8::EpiS, pg8::Sched, true, true>(ldsl, widk, DM, DM, S, E);
    }
    SEAM(4);

    if (IN(5)) { WSP(); TIDS();
        for (int m = gw; m < MT; m += NGW) {
            const f32x4* sp = (const f32x4*)(SB + (size_t)m * NSW) + lane; u32x2* pp = (u32x2*)(PB + (size_t)m * NSW) + lane;
#pragma unroll
            for (int hh = 0; hh < 4; ++hh) { f32x4 v = sp[64 * hh]; const float mx = wave_max(fmaxf(fmaxf(v[0], v[1]), fmaxf(v[2], v[3])));
                v[0] = __builtin_amdgcn_exp2f(v[0] - mx); v[1] = __builtin_amdgcn_exp2f(v[1] - mx); v[2] = __builtin_amdgcn_exp2f(v[2] - mx); v[3] = __builtin_amdgcn_exp2f(v[3] - mx);
                const float rl = 1.0f / wave_sum((v[0] + v[1]) + (v[2] + v[3]));
                u32x2 w; w.x = pk2(v[0] * rl, v[1] * rl); w.y = pk2(v[2] * rl, v[3] * rl); pp[64 * hh] = w; }
        }
    }
    SEAM(5);

    if (IN(6)) { WSP();
        pg8::Sched S{(const char*)PB, (const char*)WVO, nullptr, nullptr, MT / 256, DM / 256, (MT / 256) * (DM / 256), 1, 0, (size_t)256 * NSW * 2, (size_t)256 * NSW * 2, (size_t)DM * NSW * 2, G, bx};
        pg8::EpiResid E{nullptr, H1B, H2B, DM, SS};
        pg8::gemm_phase<pg8::EpiResid, pg8::Sched, true, true>(ldsl, widk, NSW, NSW, S, E);
    }
    SEAM(6);

    if (IN(7)) { WSP();
        pg8::Sched S{(const char*)H2B, (const char*)WGU, nullptr, nullptr, MT / 256, NGU / 256, (MT / 256) * (NGU / 256), 1, 0, (size_t)256 * DM * 2, (size_t)256 * DM * 2, 0, G, bx};
        pg8::EpiGU E{ACT, SS};
        pg8::gemm_phase<pg8::EpiGU, pg8::Sched, true, true>(ldsl, widk, DM, DM, S, E);
    }
    SEAM(7);

    if (IN(8)) { WSP();
        pg8::Sched S{(const char*)ACT, (const char*)WDN, nullptr, nullptr, MT / 256, DM / 256, (MT / 256) * (DM / 256), 1, 0, (size_t)256 * DFF * 2, (size_t)256 * DFF * 2, 0, G, bx};
        pg8::EpiResid E{nullptr, H2B, (bf16_t*)out + DM, 2 * DM, SS};
        pg8::gemm_phase<pg8::EpiResid, pg8::Sched, true, true>(ldsl, widk, DFF, DFF, S, E);
    }
    SEAM(8);

    if (IN(9)) { WSP(); TIDS();
        for (int m = gw; m < MT; m += NGW) {
            float sq = lane < 32 ? SS[(size_t)m * 32 + lane] : 0.f; sq = wave_sum(sq); const float rr = __builtin_amdgcn_rsqf(sq * (1.0f / DM) + RMS_EPS);
            const u32x2* hp = (const u32x2*)((const bf16_t*)out + (size_t)m * (2 * DM) + DM) + lane;
            u32x2 hv[8];
#pragma unroll
            for (int j = 0; j < 8; ++j) hv[j] = hp[64 * j];
            asm volatile("s_waitcnt vmcnt(0)" ::: "memory");
            f32x4* op = (f32x4*)(out + (size_t)m * DM) + lane; const f32x4* gp = (const f32x4*)g_final + lane;
#pragma unroll
            for (int j = 0; j < 8; ++j) { const f32x4 g = gp[64 * j];
                const f32x4 v = (f32x4){__uint_as_float(hv[j].x << 16), __uint_as_float(hv[j].x & 0xffff0000u), __uint_as_float(hv[j].y << 16), __uint_as_float(hv[j].y & 0xffff0000u)};
                op[64 * j] = v * rr * g; }
        }
    }
#undef IN
#undef SEAM
#undef TIDS
}
#undef x_p
#undef x_s
#undef mem_p
#undef mem_s
#undef g_mix
#undef w_in
#undef rpb
#undef lam_q1
#undef lam_k1
#undef lam_q2
#undef lam_k2
#undef g_subln
#undef w_out
#undef g_xattn
#undef g_mem
#undef w_mq
#undef w_mkv
#undef w_mo
#undef g_ffn
#undef w_gu
#undef w_dn
#undef g_final
#undef out
#undef WSP
#undef SS
#undef RS0
#undef ROPE
#undef WIN
#undef WOUT
#undef WMQ
#undef WMO
#undef WMKV
#undef WGU
#undef WDN
#undef MN
#undef KB
#undef VB
#undef WQK
#undef WVO
#undef O1S
#undef XB
#undef PROJ
#undef H1B
#undef SB
#undef PB
#undef ACT
#undef MIX
#undef H2B


extern "C" void kernel_launch(void* const* d_in, const int* in_sizes, int n_in, void* d_out, int out_size, void* d_ws, size_t ws_size, hipStream_t stream) {
    static int grid = 0;
    if (grid == 0) {
        if (n_in != 22 || out_size != MT * DM || ws_size < WS_END) { fprintf(stderr, "kernel_launch: unexpected shapes (n_in %d, out %d, ws %zu); nothing launched\n", n_in, out_size, ws_size); grid = -1; return; }
        int dev = 0, cus = 0, per_cu = 0;
        (void)hipGetDevice(&dev); (void)hipDeviceGetAttribute(&cus, hipDeviceAttributeMultiprocessorCount, dev);
        if (hipFuncSetAttribute((const void*)fwd_kernel, hipFuncAttributeMaxDynamicSharedMemorySize, LDS_BYTES) != hipSuccess) { fprintf(stderr, "kernel_launch: hipFuncSetAttribute failed\n"); grid = -1; return; }
        if (hipOccupancyMaxActiveBlocksPerMultiprocessor(&per_cu, (const void*)fwd_kernel, NTHREADS, LDS_BYTES) != hipSuccess || per_cu < 1) per_cu = 1;
        (void)hipGetLastError();
        grid = cus * per_cu;
    }
    if (grid < 0) return;
    Args a{};
    for (int i = 0; i < 22; ++i) a.in[i] = (const float*)d_in[i];
    a.out = (float*)d_out; a.ws = (unsigned char*)d_ws;
#if MK_MULTI
    for (int p = 0; p < NPHASE; ++p) { a.ph_lo = p; a.ph_hi = p + 1; hipLaunchKernelGGL(fwd_kernel, dim3(grid), dim3(NTHREADS), LDS_BYTES, stream, a); }
#else
    a.ph_lo = 0; a.ph_hi = NPHASE;
    (void)hipMemsetAsync((char*)d_ws + WS_BAR, 0, 256, stream);
    void* args[] = {&a};
    hipError_t e = hipLaunchCooperativeKernel((const void*)fwd_kernel, dim3(grid), dim3(NTHREADS), args, LDS_BYTES, stream);
    if (e != hipSuccess) fprintf(stderr, "cooperative launch failed: %s (grid %d)\n", hipGetErrorString(e), grid);
#endif
}
```

```cpp
#include <hip/hip_runtime.h>
#include <hip/hip_cooperative_groups.h>
#include <cstdio>
#include <cstdint>
namespace cg = cooperative_groups;

#ifndef MK_MULTI
#define MK_MULTI 0
#endif

#define LAS __attribute__((address_space(3)))
typedef unsigned short bf16_t;
typedef short bf16x8 __attribute__((ext_vector_type(8)));
typedef short s16x4 __attribute__((ext_vector_type(4)));
typedef float f32x2 __attribute__((ext_vector_type(2)));
typedef float f32x4 __attribute__((ext_vector_type(4)));
typedef float f32x16 __attribute__((ext_vector_type(16)));
typedef unsigned u32x2 __attribute__((ext_vector_type(2)));
typedef unsigned u32x4 __attribute__((ext_vector_type(4)));

constexpr int DM = 2048, TP = 16384, TS = 4096, NP = 2 * TP, NS = 4 * TS, MT = NP + NS;
constexpr int INW = 6144, DFF = 5632, NGU = 2 * DFF, MEMT = 256, NMEM = 6 * MEMT, NSW = 1024;
constexpr float RMS_EPS = 1e-6f, SUBLN_EPS = 1e-5f, LOG2E = 1.4426950408889634f;
constexpr float NA_QS = 0.08838834764831845f * LOG2E, DF_QS = 0.125f * LOG2E, MEM_QS = 0.04419417382415922f * LOG2E;
constexpr float LAM_INIT = 0.2f;

constexpr size_t MiB = 1u << 20;
constexpr size_t WS_SS = 0, WS_RS0 = 6 * MiB, WS_ROPE = 7 * MiB, WS_WIN = 11 * MiB, WS_WOUT = 35 * MiB, WS_WMQ = 43 * MiB, WS_WMO = 51 * MiB,
                 WS_WMKV = 59 * MiB, WS_WGU = 75 * MiB, WS_WDN = 119 * MiB, WS_MN = 141 * MiB, WS_KB = 147 * MiB, WS_VB = 153 * MiB,
                 WS_WQK = 159 * MiB, WS_WVO = 183 * MiB, WS_O1 = 207 * MiB, WS_XB = 239 * MiB, WS_BIG = 431 * MiB, WS_END = 1007 * MiB;
constexpr size_t WS_BAR = 6 * MiB + 512 * 1024;
constexpr size_t WS_H1B = WS_BIG, WS_S = WS_BIG + 192 * MiB, WS_P = WS_BIG + 384 * MiB, WS_ACT = WS_BIG;

constexpr int LDS_BYTES = 147456, NTHREADS = 512;

__device__ __forceinline__ unsigned cvt_pk_bf16(float lo, float hi) { unsigned r; asm volatile("v_cvt_pk_bf16_f32 %0, %1, %2" : "=v"(r) : "v"(lo), "v"(hi)); return r; }
__device__ __forceinline__ unsigned f2bf(float f) { unsigned u = __builtin_bit_cast(unsigned, f); return (u + 0x7fffu + ((u >> 16) & 1u)) >> 16; }
__device__ __forceinline__ unsigned pk2(float lo, float hi) { return f2bf(lo) | (f2bf(hi) << 16); }
__device__ __forceinline__ float wave_sum(float v) {
#pragma unroll
    for (int o = 1; o < 64; o <<= 1) v += __shfl_xor(v, o);
    return v;
}
__device__ __forceinline__ float wave_max(float v) {
#pragma unroll
    for (int o = 1; o < 64; o <<= 1) v = fmaxf(v, __shfl_xor(v, o));
    return v;
}
__device__ __forceinline__ int tid_l(int widk) { int t; asm volatile("v_mbcnt_lo_u32_b32 %0, -1, 0\n\tv_mbcnt_hi_u32_b32 %0, -1, %0\n\tv_or_b32 %0, %1, %0" : "=&v"(t) : "s"(widk << 6)); return t; }
__device__ __forceinline__ void grid_barrier(unsigned* ctr, unsigned target, int tid) {
    asm volatile("s_waitcnt vmcnt(0) lgkmcnt(0)" ::: "memory");
    __syncthreads();
    if (tid == 0) {
        __builtin_amdgcn_fence(__ATOMIC_RELEASE, "agent");
        asm volatile("s_waitcnt vmcnt(0)" ::: "memory");
        (void)__hip_atomic_fetch_add(ctr, 1u, __ATOMIC_RELAXED, __HIP_MEMORY_SCOPE_AGENT);
        unsigned spins = 0;
        while (__hip_atomic_load(ctr, __ATOMIC_RELAXED, __HIP_MEMORY_SCOPE_AGENT) < target && ++spins < (1u << 22)) __builtin_amdgcn_s_sleep(2);
        __builtin_amdgcn_fence(__ATOMIC_ACQUIRE, "agent");
        asm volatile("s_waitcnt vmcnt(0)" ::: "memory");
    }
    __syncthreads();
}
__device__ __forceinline__ int batch_of_pm(int pm) { return pm < 128 ? (pm >> 6) : 2 + ((pm - 128) >> 4); }

namespace pg8 {
constexpr int BM = 256, BK = 64, HALF = 128, HTB = HALF * BK * 2, STAGE_BYTES = 8 * HTB, NXCD = 8, WGM = 8;
__host__ __device__ __forceinline__ int lds_byte(int r, int c) { const int st = (r >> 4) * 2 + (c >> 5), rr = r & 15, cc = c & 31, ob = rr * 64 + cc * 2; return st * 1024 + (ob ^ (((ob >> 9) & 1) << 5)); }
__host__ __device__ __forceinline__ void stage_rc(int b, int& R, int& C) { const int st = b / 1024, sb = b % 1024, swz = sb ^ (((sb >> 9) & 1) << 5); R = (st >> 1) * 16 + swz / 64; C = (st & 1) * 32 + (swz % 64) / 2; }
__host__ __device__ __forceinline__ int perm32(int rho) { const int n = rho >> 4, i = rho & 15; return 8 * (i >> 2) + 4 * n + (i & 3); }

struct Unit { int pm, pn, z; };

__device__ __forceinline__ void tile_decode(int wgid, int nM, int nN, int& pm, int& pn) {
    const int nwg = nM * nN;
    { const int q = nwg / NXCD, r = nwg % NXCD, xcd = wgid % NXCD, off = wgid / NXCD; wgid = (xcd < r ? xcd * (q + 1) : r * (q + 1) + (xcd - r) * q) + off; }
    const int nig = WGM * nN, gid = wgid / nig, fm = gid * WGM, gsz = (nM - fm) < WGM ? (nM - fm) : WGM;
    pm = fm + ((wgid % nig) % gsz); pn = (wgid % nig) / gsz;
}
struct Sched {
    const char *A0, *B0, *A1, *B1; int nM0, nN0, n0, nM1, n1; size_t tA, tB, bstride; int G, c;
    __device__ __forceinline__ bool next(int i, Unit& u) const {
        int L = i * G + c;
        if (L < n0) { tile_decode(L, nM0, nN0, u.pm, u.pn); u.z = 0; return true; }
        L -= n0; if (L < n1) { u.pm = L % nM1; u.pn = L / nM1; u.z = 1; return true; }
        return false;
    }
    __device__ __forceinline__ const char* abase(const Unit& u) const { return (u.z ? A1 : A0) + (size_t)u.pm * tA; }
    __device__ __forceinline__ const char* bbase(const Unit& u) const { return (u.z ? B1 : B0) + (size_t)u.pn * tB + (bstride ? (size_t)batch_of_pm(u.pm) * bstride : (size_t)0); }
};
struct PreSched {
    const char *Kb, *Vb, *Wmq, *Wmo; int G, c;
    __device__ __forceinline__ bool next(int i, Unit& u) const { const int L = i * G + c; if (L >= 384) return false; u.z = L / 8; const int t = L & 7; if (u.z < 24) { u.pm = 0; u.pn = t; } else { u.pm = t; u.pn = 0; } return true; }
    __device__ __forceinline__ const char* abase(const Unit& u) const { const int zz = u.z % 24, b = zz >> 2, h = zz & 3;
        return u.z < 24 ? Kb + ((size_t)(b * 256) * DM + h * 512) * 2 : Wmo + ((size_t)(u.pm * 256) * DM + h * 512) * 2; }
    __device__ __forceinline__ const char* bbase(const Unit& u) const { const int zz = u.z % 24, b = zz >> 2, h = zz & 3;
        return u.z < 24 ? Wmq + ((size_t)(u.pn * 256) * DM + h * 512) * 2 : Vb + ((size_t)(b * 256) * DM + h * 512) * 2; }
};

template <class Epi, class SchedT, bool ALIGN_EPI, bool SP2>
__device__ __forceinline__ void gemm_phase(LAS unsigned char* lds, const int widk, const int K, const int ld, const SchedT& S, const Epi& E) {
    const int tid = tid_l(widk), wid = __builtin_amdgcn_readfirstlane(tid >> 6), lane = tid & 63, wr = wid >> 2, wc = wid & 3, fr = lane & 15, fq = lane >> 4;
    const int nt = K / BK;
    unsigned voffA[2], voffB[2];
#pragma unroll
    for (int i = 0; i < 2; ++i) { int R, C; stage_rc(tid * 16 + i * 8192, R, C); const int Rb = Epi::PERM ? ((R & ~31) + perm32(R & 31)) : R;
        voffA[i] = (unsigned)(R * ld + C) * 2u; voffB[i] = (unsigned)(Rb * ld + C) * 2u; }
    const size_t kstep = (size_t)(BK * 2);
    const size_t hstep = (size_t)HALF * ld * 2;
    const unsigned ldsw = (unsigned)wid * 1024u;
    const int aoff = lds_byte(wr * 64 + fr, fq * 8), boff = lds_byte(wc * 32 + fr, fq * 8);
#define PG8_SA(b, h) (((b) * 2 + (h)) * HTB)
#define PG8_SB(b, h) ((4 + (b) * 2 + (h)) * HTB)
#define PG8_STAGE(bufoff, gbase, voff) do { _Pragma("unroll") for (int _i = 0; _i < 2; ++_i) \
        __builtin_amdgcn_global_load_lds((const unsigned*)((const char*)(gbase) + (voff)[_i]), (LAS unsigned*)(lds + (bufoff) + ldsw + _i * 8192), 16, 0, 0); } while (0)
#define PG8_LDA(dst, b, h) do { _Pragma("unroll") for (int m = 0; m < 4; ++m) _Pragma("unroll") for (int k = 0; k < 2; ++k) dst[m][k] = *(const LAS bf16x8*)(lds + PG8_SA(b, h) + aoff + m * 2048 + k * 1024); } while (0)
#define PG8_LDB(dst, b, h) do { _Pragma("unroll") for (int n = 0; n < 2; ++n) _Pragma("unroll") for (int k = 0; k < 2; ++k) dst[n][k] = *(const LAS bf16x8*)(lds + PG8_SB(b, h) + boff + n * 2048 + k * 1024); } while (0)
#define PG8_MMA(ai, bj, At, Bt) do { __builtin_amdgcn_s_setprio(1); _Pragma("unroll") for (int m = 0; m < 4; ++m) _Pragma("unroll") for (int n = 0; n < 2; ++n) _Pragma("unroll") for (int k = 0; k < 2; ++k) \
        acc[ai][bj][m][n] = __builtin_amdgcn_mfma_f32_16x16x32_bf16(Bt[n][k], At[m][k], acc[ai][bj][m][n], 0, 0, 0); __builtin_amdgcn_s_setprio(0); } while (0)
#define PG8_WAIT_V(n) asm volatile("s_waitcnt vmcnt(" #n ")" ::: "memory")
#define PG8_WAIT_L(n) asm volatile("s_waitcnt lgkmcnt(" #n ")" ::: "memory")
#define PG8_BAR __builtin_amdgcn_s_barrier()
#define PG8_SCHED __builtin_amdgcn_sched_barrier(0)
    Unit cur, nxt; int ui = 0;
    if (!S.next(0, cur)) return;
    f32x4 acc[2][2][4][2];
#pragma unroll
    for (int a = 0; a < 2; ++a)
#pragma unroll
        for (int b = 0; b < 2; ++b)
#pragma unroll
            for (int m = 0; m < 4; ++m)
#pragma unroll
                for (int n = 0; n < 2; ++n) acc[a][b][m][n] = (f32x4){0.f, 0.f, 0.f, 0.f};
    bf16x8 At[4][2], B0[2][2], B1[2][2];
    const char* cA = S.abase(cur); const char* cB = S.bbase(cur);
    if constexpr (SP2) {
        PG8_STAGE(PG8_SB(0, 0), cB, voffB); PG8_STAGE(PG8_SB(0, 1), cB + hstep, voffB); PG8_STAGE(PG8_SA(0, 0), cA, voffA); PG8_STAGE(PG8_SA(0, 1), cA + hstep, voffA);
        if (wr == 1) PG8_BAR;
        PG8_WAIT_V(2); PG8_BAR;
        PG8_STAGE(PG8_SB(1, 0), cB + kstep, voffB); PG8_STAGE(PG8_SA(1, 0), cA + kstep, voffA); PG8_STAGE(PG8_SB(1, 1), cB + hstep + kstep, voffB);
        PG8_WAIT_V(6); PG8_BAR;
    } else {
        PG8_STAGE(PG8_SB(0, 0), cB, voffB); PG8_STAGE(PG8_SA(0, 0), cA, voffA); PG8_STAGE(PG8_SB(0, 1), cB + hstep, voffB); PG8_STAGE(PG8_SA(0, 1), cA + hstep, voffA);
        if (wr == 1) PG8_BAR;
        PG8_WAIT_V(4); PG8_BAR;
        PG8_STAGE(PG8_SB(1, 0), cB + kstep, voffB); PG8_STAGE(PG8_SA(1, 0), cA + kstep, voffA); PG8_STAGE(PG8_SB(1, 1), cB + hstep + kstep, voffB);
        PG8_WAIT_V(6); PG8_BAR;
    }
    for (;;) {
        const bool has_next = S.next(ui + 1, nxt);
        const char* nA = has_next ? S.abase(nxt) : cA; const char* nB = has_next ? S.bbase(nxt) : cB;
        for (int t = 0; t < nt; t += 2) {
            const bool last = (t == nt - 2);
            const char* a1 = cA + (size_t)(t + 1) * kstep;
            const char* a2 = last ? nA : cA + (size_t)(t + 2) * kstep; const char* b2 = last ? nB : cB + (size_t)(t + 2) * kstep;
            const char* a3 = a2 + kstep; const char* b3 = b2 + kstep;
            if constexpr (SP2) {
            PG8_LDB(B0, 0, 0); PG8_LDB(B1, 0, 1); PG8_SCHED; PG8_LDA(At, 0, 0); PG8_STAGE(PG8_SA(1, 1), a1 + hstep, voffA);
            PG8_WAIT_V(8); PG8_WAIT_L(0); PG8_BAR; PG8_MMA(0, 0, At, B0); PG8_MMA(0, 1, At, B1); PG8_BAR; PG8_SCHED;
            PG8_LDA(At, 0, 1); PG8_STAGE(PG8_SB(0, 0), b2, voffB); PG8_STAGE(PG8_SB(0, 1), b2 + hstep, voffB); PG8_STAGE(PG8_SA(0, 0), a2, voffA);
            PG8_WAIT_V(8); PG8_WAIT_L(0); PG8_BAR; PG8_MMA(1, 0, At, B0); PG8_MMA(1, 1, At, B1); PG8_BAR; PG8_SCHED;
            PG8_LDB(B0, 1, 0); PG8_LDB(B1, 1, 1); PG8_SCHED; PG8_LDA(At, 1, 0); PG8_STAGE(PG8_SA(0, 1), a2 + hstep, voffA);
            PG8_WAIT_V(8); PG8_WAIT_L(0); PG8_BAR; PG8_MMA(0, 0, At, B0); PG8_MMA(0, 1, At, B1); PG8_BAR; PG8_SCHED;
            PG8_LDA(At, 1, 1); PG8_STAGE(PG8_SB(1, 0), b3, voffB); PG8_STAGE(PG8_SB(1, 1), b3 + hstep, voffB); PG8_STAGE(PG8_SA(1, 0), a3, voffA);
            PG8_WAIT_V(8); PG8_WAIT_L(0); PG8_BAR; PG8_MMA(1, 0, At, B0); PG8_MMA(1, 1, At, B1); PG8_BAR; PG8_SCHED;
            } else {
            PG8_LDB(B0, 0, 0); PG8_SCHED; PG8_LDA(At, 0, 0); PG8_STAGE(PG8_SA(1, 1), a1 + hstep, voffA);
            PG8_WAIT_L(8); PG8_BAR; PG8_WAIT_L(0); PG8_MMA(0, 0, At, B0); PG8_BAR; PG8_SCHED;
            PG8_LDB(B1, 0, 1); PG8_STAGE(PG8_SB(0, 0), b2, voffB);
            PG8_BAR; PG8_WAIT_L(0); PG8_MMA(0, 1, At, B1); PG8_BAR;
            PG8_LDA(At, 0, 1); PG8_STAGE(PG8_SA(0, 0), a2, voffA);
            PG8_BAR; PG8_WAIT_L(0); PG8_MMA(1, 0, At, B0); PG8_BAR; PG8_SCHED;
            PG8_STAGE(PG8_SB(0, 1), b2 + hstep, voffB);
            PG8_WAIT_V(6); PG8_BAR; PG8_MMA(1, 1, At, B1); PG8_BAR;
            PG8_LDB(B0, 1, 0); PG8_SCHED; PG8_LDA(At, 1, 0); PG8_STAGE(PG8_SA(0, 1), a2 + hstep, voffA);
            PG8_WAIT_L(8); PG8_BAR; PG8_WAIT_L(0); PG8_MMA(0, 0, At, B0); PG8_BAR; PG8_SCHED;
            PG8_LDB(B1, 1, 1); PG8_STAGE(PG8_SB(1, 0), b3, voffB);
            PG8_BAR; PG8_WAIT_L(0); PG8_MMA(0, 1, At, B1); PG8_BAR;
            PG8_LDA(At, 1, 1); PG8_STAGE(PG8_SA(1, 0), a3, voffA);
            PG8_BAR; PG8_WAIT_L(0); PG8_MMA(1, 0, At, B0); PG8_BAR; PG8_SCHED;
            PG8_STAGE(PG8_SB(1, 1), b3 + hstep, voffB);
            PG8_WAIT_V(6); PG8_BAR; PG8_MMA(1, 1, At, B1); PG8_BAR;
            }
        }
        if constexpr (ALIGN_EPI) { if (wr == 0) PG8_BAR; }
        E(acc, cur, wr, wc, fr, fq);
        if (!has_next) break;
#pragma unroll
        for (int a = 0; a < 2; ++a)
#pragma unroll
            for (int b = 0; b < 2; ++b)
#pragma unroll
                for (int m = 0; m < 4; ++m)
#pragma unroll
                    for (int n = 0; n < 2; ++n) acc[a][b][m][n] = (f32x4){0.f, 0.f, 0.f, 0.f};
        cur = nxt; cA = nA; cB = nB; ++ui;
        if constexpr (ALIGN_EPI) { if (wr == 1) PG8_BAR; }
    }
    PG8_WAIT_V(0);
    if constexpr (!ALIGN_EPI) { if (wr == 0) PG8_BAR; }
    PG8_BAR;
#undef PG8_SA
#undef PG8_SB
#undef PG8_STAGE
#undef PG8_LDA
#undef PG8_LDB
#undef PG8_MMA
#undef PG8_WAIT_V
#undef PG8_WAIT_L
#undef PG8_BAR
#undef PG8_SCHED
}

typedef const f32x4 (&AccRef)[2][2][4][2];

__device__ __forceinline__ float row_rs(const float* ss, int row) {
    const f32x4* p = (const f32x4*)(ss + (size_t)row * 32); float s = 0.f;
#pragma unroll
    for (int i = 0; i < 8; ++i) { const f32x4 v = p[i]; s += (v[0] + v[1]) + (v[2] + v[3]); }
    return __builtin_amdgcn_rsqf(s * (1.0f / DM) + RMS_EPS);
}

struct EpiInProj {
    static constexpr bool PERM = true;
    bf16_t* proj; bf16_t* kb; bf16_t* vb; const float* rs0; const f32x2* rope;
    __device__ __forceinline__ void operator()(AccRef acc, const Unit& u, int wr, int wc, int fr, int fq) const {
        const int row0 = u.pm * BM + wr * 64 + fr;
        if (u.z == 1) {
            bf16_t* base = (u.pn < 8 ? kb : vb) + (u.pn & 7) * BM + wc * 32 + 8 * fq;
#pragma unroll
            for (int ai = 0; ai < 2; ++ai)
#pragma unroll
                for (int m = 0; m < 4; ++m) { bf16_t* rowp = base + (size_t)(row0 + ai * HALF + m * 16) * DM;
#pragma unroll
                    for (int bj = 0; bj < 2; ++bj) { const f32x4 v0 = acc[ai][bj][m][0], v1 = acc[ai][bj][m][1]; u32x4 w;
                        w.x = cvt_pk_bf16(v0[0], v0[1]); w.y = cvt_pk_bf16(v0[2], v0[3]); w.z = cvt_pk_bf16(v1[0], v1[1]); w.w = cvt_pk_bf16(v1[2], v1[3]);
                        *(u32x4*)(rowp + bj * HALF) = w; } }
            return;
        }
        const int pn = u.pn; const bool rp = (pn >= 12 && pn < 20);
        const float sc = pn < 4 ? NA_QS : ((pn >= 12 && pn < 16) ? DF_QS : 1.0f);
        if (!rp) {
            bf16_t* base = proj + pn * BM + wc * 32 + 8 * fq;
#pragma unroll
            for (int ai = 0; ai < 2; ++ai)
#pragma unroll
                for (int m = 0; m < 4; ++m) { const int row = row0 + ai * HALF + m * 16; const float rr = rs0[row] * sc; bf16_t* rowp = base + (size_t)row * INW;
#pragma unroll
                    for (int bj = 0; bj < 2; ++bj) { const f32x4 v0 = acc[ai][bj][m][0] * rr, v1 = acc[ai][bj][m][1] * rr; u32x4 w;
                        w.x = cvt_pk_bf16(v0[0], v0[1]); w.y = cvt_pk_bf16(v0[2], v0[3]); w.z = cvt_pk_bf16(v1[0], v1[1]); w.w = cvt_pk_bf16(v1[2], v1[3]);
                        *(u32x4*)(rowp + bj * HALF) = w; } }
        } else {
            const int dd0 = 16 * (wc & 1) + 4 * fq;
            bf16_t* base = proj + pn * BM + (wc >> 1) * 64 + dd0;
#pragma unroll
            for (int ai = 0; ai < 2; ++ai)
#pragma unroll
                for (int m = 0; m < 4; ++m) { const int row = row0 + ai * HALF + m * 16; const float rr = rs0[row] * sc; bf16_t* rowp = base + (size_t)row * INW;
                    const int t = row < NP ? (row & (TP - 1)) : (row & (TS - 1));
                    const f32x4 cs0 = *(const f32x4*)(rope + (size_t)t * 32 + dd0), cs1 = *(const f32x4*)(rope + (size_t)t * 32 + dd0 + 2);
#pragma unroll
                    for (int bj = 0; bj < 2; ++bj) { const f32x4 x1 = acc[ai][bj][m][0] * rr, x2 = acc[ai][bj][m][1] * rr;
                        const float a0 = x1[0] * cs0[0] - x2[0] * cs0[1], a1 = x1[1] * cs0[2] - x2[1] * cs0[3], a2 = x1[2] * cs1[0] - x2[2] * cs1[1], a3 = x1[3] * cs1[2] - x2[3] * cs1[3];
                        const float b0 = x2[0] * cs0[0] + x1[0] * cs0[1], b1 = x2[1] * cs0[2] + x1[1] * cs0[3], b2 = x2[2] * cs1[0] + x1[2] * cs1[1], b3 = x2[3] * cs1[2] + x1[3] * cs1[3];
                        u32x2 wa, wb; wa.x = cvt_pk_bf16(a0, a1); wa.y = cvt_pk_bf16(a2, a3); wb.x = cvt_pk_bf16(b0, b1); wb.y = cvt_pk_bf16(b2, b3);
                        *(u32x2*)(rowp + bj * HALF) = wa; *(u32x2*)(rowp + bj * HALF + 32) = wb; } }
        }
    }
};
struct EpiPre {
    static constexpr bool PERM = true;
    bf16_t* wqk; bf16_t* wvo;
    __device__ __forceinline__ void operator()(AccRef acc, const Unit& u, int wr, int wc, int fr, int fq) const {
        const int zz = u.z % 24, b = zz >> 2, h = zz & 3; bf16_t* base; int ldc; float sc;
        if (u.z < 24) { base = wqk + ((size_t)(b * 1024 + h * 256)) * DM + u.pn * BM; ldc = DM; sc = MEM_QS; }
        else { base = wvo + ((size_t)(b * 2048 + u.pm * BM)) * NSW + h * 256; ldc = NSW; sc = 1.0f; }
        base += wc * 32 + 8 * fq;
#pragma unroll
        for (int ai = 0; ai < 2; ++ai)
#pragma unroll
            for (int m = 0; m < 4; ++m) { bf16_t* rowp = base + (size_t)(wr * 64 + fr + ai * HALF + m * 16) * ldc;
#pragma unroll
                for (int bj = 0; bj < 2; ++bj) { const f32x4 v0 = acc[ai][bj][m][0] * sc, v1 = acc[ai][bj][m][1] * sc; u32x4 w;
                    w.x = cvt_pk_bf16(v0[0], v0[1]); w.y = cvt_pk_bf16(v0[2], v0[3]); w.z = cvt_pk_bf16(v1[0], v1[1]); w.w = cvt_pk_bf16(v1[2], v1[3]);
                    *(u32x4*)(rowp + bj * HALF) = w; } }
    }
};
__device__ __forceinline__ float row_rs4(const float* ss, int row, int fq) {
    const f32x4* p = (const f32x4*)(ss + (size_t)row * 32 + fq * 8); const f32x4 a = p[0], b = p[1];
    float s = ((a[0] + a[1]) + (a[2] + a[3])) + ((b[0] + b[1]) + (b[2] + b[3]));
    s += __shfl_xor(s, 16); s += __shfl_xor(s, 32);
    return __builtin_amdgcn_rsqf(s * (1.0f / DM) + RMS_EPS);
}
struct EpiResid {
    static constexpr bool PERM = false;
    const float* basef; const bf16_t* baseb; bf16_t* ob; int ldo; float* ss;
    __device__ __forceinline__ void operator()(AccRef acc, const Unit& u, int wr, int wc, int fr, int fq) const {
        const int col0 = u.pn * BM + wc * 32 + 4 * fq;
#pragma unroll
        for (int ai = 0; ai < 2; ++ai)
#pragma unroll
            for (int m = 0; m < 4; ++m) { const int row = u.pm * BM + ai * HALF + wr * 64 + m * 16 + fr; const size_t off = (size_t)row * DM + col0; bf16_t* orow = ob + (size_t)row * ldo + col0; float q = 0.f;
#pragma unroll
                for (int bj = 0; bj < 2; ++bj)
#pragma unroll
                    for (int n = 0; n < 2; ++n) { const int o2 = bj * HALF + n * 16; f32x4 bv;
                        if (baseb) { const u32x2 w = *(const u32x2*)(baseb + off + o2); bv = (f32x4){__uint_as_float(w.x << 16), __uint_as_float(w.x & 0xffff0000u), __uint_as_float(w.y << 16), __uint_as_float(w.y & 0xffff0000u)}; }
                        else bv = *(const f32x4*)(basef + off + o2);
                        const f32x4 o = bv + acc[ai][bj][m][n]; q += (o[0] * o[0] + o[1] * o[1]) + (o[2] * o[2] + o[3] * o[3]);
                        u32x2 w2; w2.x = cvt_pk_bf16(o[0], o[1]); w2.y = cvt_pk_bf16(o[2], o[3]); *(u32x2*)(orow + o2) = w2; }
                q += __shfl_xor(q, 16); q += __shfl_xor(q, 32);
                if (fq == 0) ss[(size_t)row * 32 + u.pn * 4 + wc] = q; }
    }
};
struct EpiX { static constexpr bool PERM = false; const float* xp; const float* xs; bf16_t* ob; float* ss;
    __device__ __forceinline__ void operator()(AccRef acc, const Unit& u, int wr, int wc, int fr, int fq) const {
        const float* base = (u.pm < NP / 256) ? xp : xs - (size_t)NP * DM; EpiResid E{base, nullptr, ob, DM, ss}; E(acc, u, wr, wc, fr, fq); } };
struct EpiS {
    static constexpr bool PERM = false;
    float* S; const float* ss;
    __device__ __forceinline__ void operator()(AccRef acc, const Unit& u, int wr, int wc, int fr, int fq) const {
        const int col0 = u.pn * BM + wc * 32 + 4 * fq;
#pragma unroll
        for (int ai = 0; ai < 2; ++ai)
#pragma unroll
            for (int m = 0; m < 4; ++m) { const int row = u.pm * BM + ai * HALF + wr * 64 + m * 16 + fr; const float rr = row_rs4(ss, row, fq); float* rowp = S + (size_t)row * NSW + col0;
#pragma unroll
                for (int bj = 0; bj < 2; ++bj)
#pragma unroll
                    for (int n = 0; n < 2; ++n) *(f32x4*)(rowp + bj * HALF + n * 16) = acc[ai][bj][m][n] * rr; }
    }
};
struct EpiGU {
    static constexpr bool PERM = true;
    bf16_t* act; const float* ss;
    __device__ __forceinline__ void operator()(AccRef acc, const Unit& u, int wr, int wc, int fr, int fq) const {
        bf16_t* base = act + u.pn * HALF + wc * 32 + 8 * fq;
#pragma unroll
        for (int ai = 0; ai < 2; ++ai)
#pragma unroll
            for (int m = 0; m < 4; ++m) { const int row = u.pm * BM + ai * HALF + wr * 64 + m * 16 + fr; const float rr = row_rs4(ss, row, fq); float o[8];
#pragma unroll
                for (int n = 0; n < 2; ++n)
#pragma unroll
                    for (int e = 0; e < 4; ++e) { const float g = acc[ai][0][m][n][e] * rr, up = acc[ai][1][m][n][e] * rr;
                        o[n * 4 + e] = g * __builtin_amdgcn_rcpf(1.0f + __builtin_amdgcn_exp2f(-g * LOG2E)) * up; }
                u32x4 w; w.x = cvt_pk_bf16(o[0], o[1]); w.y = cvt_pk_bf16(o[2], o[3]); w.z = cvt_pk_bf16(o[4], o[5]); w.w = cvt_pk_bf16(o[6], o[7]);
                *(u32x4*)(base + (size_t)row * DFF) = w; }
    }
};
}

namespace att {
#define SBAR() __builtin_amdgcn_sched_barrier(0)
constexpr float THR = 8.0f;
constexpr int SHM_V = 16384, SHM_K = 16384, OFF_K = 2 * SHM_V, OFF_WS = OFF_K + 2 * SHM_K, OFF_RPB = OFF_WS + 8 * 256, OFF_STG = OFF_RPB + 2048, OFF_END = OFF_STG + 8 * 8192;
constexpr int DF_R = 5, DF_D = 4;
constexpr int DF_K = DF_R * SHM_V, DF_KSZ = 8192, DF_WS = DF_K + DF_R * DF_KSZ, DF_STG = 0  , DF_END = DF_WS + 8 * 256;
static_assert(8 * 8192 <= DF_K, "output stage fits inside the V ring");
static_assert(DF_END <= 147456 && OFF_END <= 147456, "attention LDS maps fit the dynamic LDS allocation");
__device__ __forceinline__ int crow(int r, int hi) { return (r & 3) + 8 * (r >> 2) + 4 * hi; }
#define KSWZ128(row, colB) ((row) * 256 + ((colB) ^ (((row) & 7) << 4)))
#define KSWZ64(row, colB) ((row) * 128 + ((colB) ^ ((((row) >> 1) & 7) << 4)))
__device__ __forceinline__ int v_st(int k, int c) { const int kk = (k & ~0xC) | ((k & 4) << 1) | ((k & 8) >> 1); return ((kk >> 3) * 4 + (c >> 5)) * 512 + ((kk & 7) * 32 + (c & 31)) * 2; }
__device__ __forceinline__ int v_rd_base(int lane) { return ((lane & 3) << 3) | (((lane >> 2) & 3) << 6) | (((lane >> 4) & 1) << 5) | (((lane >> 5) & 1) << 8); }
constexpr int v_rd_off(int d0, int ks, int half) { return d0 * 512 + ks * 4096 + half * 2048; }
template <int OFF> __device__ __forceinline__ s16x4 tr_read(int vb) { s16x4 r; asm volatile("ds_read_b64_tr_b16 %0, %1 offset:%2" : "=&v"(r) : "v"(vb), "i"(OFF) : "memory"); return r; }
template <int D0> __device__ __forceinline__ void pv_one(f32x16& od, int vb, bf16x8 pa0, bf16x8 pa1, bf16x8 pa2, bf16x8 pa3) {
    const s16x4 l0 = tr_read<v_rd_off(D0, 0, 0)>(vb), h0 = tr_read<v_rd_off(D0, 0, 1)>(vb), l1 = tr_read<v_rd_off(D0, 1, 0)>(vb), h1 = tr_read<v_rd_off(D0, 1, 1)>(vb);
    const s16x4 l2 = tr_read<v_rd_off(D0, 2, 0)>(vb), h2 = tr_read<v_rd_off(D0, 2, 1)>(vb), l3 = tr_read<v_rd_off(D0, 3, 0)>(vb), h3 = tr_read<v_rd_off(D0, 3, 1)>(vb);
    asm volatile("s_waitcnt lgkmcnt(0)" ::: "memory"); SBAR();
#define PK(L, H) (bf16x8){L[0], L[1], L[2], L[3], H[0], H[1], H[2], H[3]}
    od = __builtin_amdgcn_mfma_f32_32x32x16_bf16(pa0, PK(l0, h0), od, 0, 0, 0);
    od = __builtin_amdgcn_mfma_f32_32x32x16_bf16(pa1, PK(l1, h1), od, 0, 0, 0);
    od = __builtin_amdgcn_mfma_f32_32x32x16_bf16(pa2, PK(l2, h2), od, 0, 0, 0);
    od = __builtin_amdgcn_mfma_f32_32x32x16_bf16(pa3, PK(l3, h3), od, 0, 0, 0);
#undef PK
}
template <int D0> __device__ __forceinline__ void pv_rd(s16x4 (&L)[4], s16x4 (&H)[4], int vb) {
    L[0] = tr_read<v_rd_off(D0, 0, 0)>(vb); H[0] = tr_read<v_rd_off(D0, 0, 1)>(vb); L[1] = tr_read<v_rd_off(D0, 1, 0)>(vb); H[1] = tr_read<v_rd_off(D0, 1, 1)>(vb);
    L[2] = tr_read<v_rd_off(D0, 2, 0)>(vb); H[2] = tr_read<v_rd_off(D0, 2, 1)>(vb); L[3] = tr_read<v_rd_off(D0, 3, 0)>(vb); H[3] = tr_read<v_rd_off(D0, 3, 1)>(vb);
}
#define PV_PK(L, H) (bf16x8){L[0], L[1], L[2], L[3], H[0], H[1], H[2], H[3]}
#define PV_MMA(od, L, H) do { od = __builtin_amdgcn_mfma_f32_32x32x16_bf16(pa0, PV_PK(L[0], H[0]), od, 0, 0, 0); od = __builtin_amdgcn_mfma_f32_32x32x16_bf16(pa1, PV_PK(L[1], H[1]), od, 0, 0, 0); \
    od = __builtin_amdgcn_mfma_f32_32x32x16_bf16(pa2, PV_PK(L[2], H[2]), od, 0, 0, 0); od = __builtin_amdgcn_mfma_f32_32x32x16_bf16(pa3, PV_PK(L[3], H[3]), od, 0, 0, 0); } while (0)
__device__ __forceinline__ void pv_all_pre(f32x16* o, int vb, bf16x8 pa0, bf16x8 pa1, bf16x8 pa2, bf16x8 pa3) {
    s16x4 L0[4], H0[4], L1[4], H1[4], L2[4], H2[4], L3[4], H3[4];
    pv_rd<0>(L0, H0, vb); pv_rd<1>(L1, H1, vb);
    asm volatile("s_waitcnt lgkmcnt(8)" ::: "memory"); SBAR(); PV_MMA(o[0], L0, H0); SBAR();
    pv_rd<2>(L2, H2, vb);
    asm volatile("s_waitcnt lgkmcnt(8)" ::: "memory"); SBAR(); PV_MMA(o[1], L1, H1); SBAR();
    pv_rd<3>(L3, H3, vb);
    asm volatile("s_waitcnt lgkmcnt(8)" ::: "memory"); SBAR(); PV_MMA(o[2], L2, H2); SBAR();
    asm volatile("s_waitcnt lgkmcnt(0)" ::: "memory"); SBAR(); PV_MMA(o[3], L3, H3); SBAR();
}
__device__ __forceinline__ void pv_all(f32x16* o, int vb, bf16x8 pa0, bf16x8 pa1, bf16x8 pa2, bf16x8 pa3) {
    pv_one<0>(o[0], vb, pa0, pa1, pa2, pa3); pv_one<1>(o[1], vb, pa0, pa1, pa2, pa3); pv_one<2>(o[2], vb, pa0, pa1, pa2, pa3); pv_one<3>(o[3], vb, pa0, pa1, pa2, pa3);
}
__device__ __forceinline__ void softmax_tile(f32x16& p0, f32x16& p1, float& m_reg, float& l_reg, float& alpha, bf16x8& pa0, bf16x8& pa1, bf16x8& pa2, bf16x8& pa3) {
    float pmax = p0[0];
#pragma unroll
    for (int r = 1; r < 16; ++r) pmax = fmaxf(pmax, p0[r]);
#pragma unroll
    for (int r = 0; r < 16; ++r) pmax = fmaxf(pmax, p1[r]);
    { auto rr = __builtin_amdgcn_permlane32_swap(__float_as_uint(pmax), __float_as_uint(pmax), false, false); pmax = fmaxf(__uint_as_float(rr[0]), __uint_as_float(rr[1])); }
    float mn;
    if (__builtin_expect(__all(pmax - m_reg <= THR), 1)) { mn = m_reg; alpha = 1.f; }
    else { mn = fmaxf(m_reg, pmax); alpha = __builtin_amdgcn_exp2f(m_reg - mn); m_reg = mn; }
#pragma unroll
    for (int r = 0; r < 16; ++r) { p0[r] = __builtin_amdgcn_exp2f(p0[r] - mn); p1[r] = __builtin_amdgcn_exp2f(p1[r] - mn); }
    float ps = 0.f;
#pragma unroll
    for (int r = 0; r < 16; ++r) ps += p0[r];
#pragma unroll
    for (int r = 0; r < 16; ++r) ps += p1[r];
    { auto rr = __builtin_amdgcn_permlane32_swap(__float_as_uint(ps), __float_as_uint(ps), false, false); ps = __uint_as_float(rr[0]) + __uint_as_float(rr[1]); }
    l_reg = l_reg * alpha + ps;
#define PK4(P, BASE, OUT) do { unsigned a0 = cvt_pk_bf16(P[BASE + 0], P[BASE + 1]), a1 = cvt_pk_bf16(P[BASE + 2], P[BASE + 3]);   \
    unsigned b0 = cvt_pk_bf16(P[BASE + 4], P[BASE + 5]), b1 = cvt_pk_bf16(P[BASE + 6], P[BASE + 7]);                              \
    auto r0 = __builtin_amdgcn_permlane32_swap(a0, b0, false, false); auto r1 = __builtin_amdgcn_permlane32_swap(a1, b1, false, false); \
    u32x4 w = {r0[0], r1[0], r0[1], r1[1]}; OUT = __builtin_bit_cast(bf16x8, w); } while (0)
    PK4(p0, 0, pa0); PK4(p0, 8, pa1); PK4(p1, 0, pa2); PK4(p1, 8, pa3);
#undef PK4
}
__device__ __forceinline__ void softmax_rel(f32x16& p0, f32x16& p1, float& m_reg, float& l_reg, f32x16& negm, float& alpha, bool first, bf16x8& pa0, bf16x8& pa1, bf16x8& pa2, bf16x8& pa3) {
    float pmax = p0[0];
#pragma unroll
    for (int r = 1; r < 16; ++r) pmax = fmaxf(pmax, p0[r]);
#pragma unroll
    for (int r = 0; r < 16; ++r) pmax = fmaxf(pmax, p1[r]);
    { auto rr = __builtin_amdgcn_permlane32_swap(__float_as_uint(pmax), __float_as_uint(pmax), false, false); pmax = fmaxf(__uint_as_float(rr[0]), __uint_as_float(rr[1])); }
    alpha = 1.f;
    if (__builtin_expect(first || !__all(pmax <= THR), 0)) {
        const float dl = first ? pmax : fmaxf(pmax, 0.f);
        m_reg += dl; alpha = first ? 1.f : __builtin_amdgcn_exp2f(-dl);
#pragma unroll
        for (int r = 0; r < 16; ++r) { p0[r] -= dl; p1[r] -= dl; negm[r] = -m_reg; }
    }
#pragma unroll
    for (int r = 0; r < 16; ++r) { p0[r] = __builtin_amdgcn_exp2f(p0[r]); p1[r] = __builtin_amdgcn_exp2f(p1[r]); }
    float ps0 = 0.f, ps1 = 0.f;
#pragma unroll
    for (int r = 0; r < 16; ++r) { ps0 += p0[r]; ps1 += p1[r]; }
    float ps = ps0 + ps1;
    { auto rr = __builtin_amdgcn_permlane32_swap(__float_as_uint(ps), __float_as_uint(ps), false, false); ps = __uint_as_float(rr[0]) + __uint_as_float(rr[1]); }
    l_reg = l_reg * alpha + ps;
#define PK4(P, BASE, OUT) do { unsigned a0 = cvt_pk_bf16(P[BASE + 0], P[BASE + 1]), a1 = cvt_pk_bf16(P[BASE + 2], P[BASE + 3]);   \
    unsigned b0 = cvt_pk_bf16(P[BASE + 4], P[BASE + 5]), b1 = cvt_pk_bf16(P[BASE + 6], P[BASE + 7]);                              \
    auto r0 = __builtin_amdgcn_permlane32_swap(a0, b0, false, false); auto r1 = __builtin_amdgcn_permlane32_swap(a1, b1, false, false); \
    u32x4 w = {r0[0], r1[0], r0[1], r1[1]}; OUT = __builtin_bit_cast(bf16x8, w); } while (0)
    PK4(p0, 0, pa0); PK4(p0, 8, pa1); PK4(p1, 0, pa2); PK4(p1, 8, pa3);
#undef PK4
}
#define ATT_RESC2(a) do { if (__any((a) < 1.f)) { if (hi == 0) al_l[r32] = (a); asm volatile("s_waitcnt lgkmcnt(0)" ::: "memory"); \
    _Pragma("unroll") for (int r = 0; r < 16; ++r) { const float f_ = al_l[crow(r, hi)]; o[0][r] *= f_; o[1][r] *= f_; o[2][r] *= f_; o[3][r] *= f_; } } } while (0)
#define ATT_RESC(a) do { if (__any((a) < 1.f)) { if (hi == 0) al_l[r32] = (a); asm volatile("s_waitcnt lgkmcnt(0)" ::: "memory"); \
    _Pragma("unroll") for (int d = 0; d < 4; ++d) _Pragma("unroll") for (int r = 0; r < 16; ++r) o[d][r] *= al_l[crow(r, hi)]; } } while (0)

__device__ __forceinline__ void diff_unit(const bf16_t* __restrict__ proj, bf16_t* __restrict__ mix, float* __restrict__ o1s, const float* __restrict__ g_sub, float lam,
                                          int rowbase, int T, int h, int qb, char* lds, int widk) {
    const int tid = tid_l(widk), wid = tid >> 6, lane = tid & 63, r32 = lane & 31, hi = lane >> 5;
    char* V_lds = lds; char* K_lds = lds + DF_K;
    float* wsf = (float*)(lds + DF_WS) + wid * 64; float* li_l = wsf; float* al_l = wsf + 32;
    LAS unsigned char* ldsl = (LAS unsigned char*)lds; const int widu = __builtin_amdgcn_readfirstlane(wid);
    unsigned kgo, vgo[2];
    { const int X = wid * 1024 + lane * 16, krow = X >> 7, kcolB = (X & 127) ^ (((krow >> 1) & 7) << 4); kgo = (unsigned)(krow * INW * 2 + kcolB); }
#pragma unroll
    for (int i = 0; i < 2; ++i) { const int X = wid * 1024 + lane * 16 + i * 8192, sub = X >> 9, e = (X & 511) >> 1, kk = (sub >> 2) * 8 + (e >> 5), cc = (sub & 3) * 32 + (e & 31);
        const int k = (kk & ~0xC) | ((kk & 4) << 1) | ((kk & 8) >> 1); vgo[i] = (unsigned)((k * INW + cc) * 2); }
    const int vb0 = (int)(uintptr_t)V_lds + v_rd_base(lane);
    const int NT = T / 64; const int q0 = qb * 256;
    const bf16_t* Vh = proj + (size_t)rowbase * INW + 5120 + h * 128;
#define BAR() do { asm volatile("" ::: "memory"); __builtin_amdgcn_s_barrier(); asm volatile("" ::: "memory"); } while (0)
#pragma unroll 1
    for (int s = 0; s < 2; ++s) {
        const bf16_t* Kh = proj + (size_t)rowbase * INW + 4096 + h * 128 + s * 64;
        const unsigned qoff = ((unsigned)(rowbase + q0 + wid * 32 + r32) * INW + 3072 + h * 128 + s * 64 + hi * 8) * 2u;
        bf16x8 qr[4];
#pragma unroll
        for (int d0 = 0; d0 < 4; ++d0) qr[d0] = *(const bf16x8*)((const char*)proj + qoff + d0 * 32);
        float m_reg = 0.f, l_reg = 0.f; f32x16 o[4], negm = f32x16{};
#pragma unroll
        for (int d = 0; d < 4; ++d) o[d] = f32x16{};
#define DDMA(j, b) do { const char* kt = (const char*)Kh + (size_t)(j) * (64 * INW * 2); const char* vt = (const char*)Vh + (size_t)(j) * (64 * INW * 2); \
        __builtin_amdgcn_global_load_lds((const unsigned*)(kt + kgo), (LAS unsigned*)(ldsl + DF_K + (b) * DF_KSZ + widu * 1024), 16, 0, 0); \
        __builtin_amdgcn_global_load_lds((const unsigned*)(vt + vgo[0]), (LAS unsigned*)(ldsl + (b) * SHM_V + widu * 1024), 16, 0, 0); \
        __builtin_amdgcn_global_load_lds((const unsigned*)(vt + vgo[1]), (LAS unsigned*)(ldsl + (b) * SHM_V + widu * 1024 + 8192), 16, 0, 0); } while (0)
#pragma unroll
        for (int t = 0; t < DF_D; ++t) DDMA(t, t);
        asm volatile("s_waitcnt vmcnt(%0)" :: "n"(3 * (DF_D - 1)) : "memory"); BAR();
        bf16x8 kf[8];
#define KLOAD(slot) do { const char* Ks_ = K_lds + (slot) * DF_KSZ; _Pragma("unroll") for (int d0 = 0; d0 < 4; ++d0) { const int cb = (d0 * 16 + hi * 8) * 2; \
            kf[2 * d0] = *(const bf16x8*)(Ks_ + KSWZ64(r32, cb)); kf[2 * d0 + 1] = *(const bf16x8*)(Ks_ + KSWZ64(32 + r32, cb)); } } while (0)
        int bsl = 0;
#pragma unroll 1
        for (int j = 0; j < NT; ++j) {
            f32x16 p0, p1;
            KLOAD(bsl);
            p0 = __builtin_amdgcn_mfma_f32_32x32x16_bf16(kf[0], qr[0], negm, 0, 0, 0); p1 = __builtin_amdgcn_mfma_f32_32x32x16_bf16(kf[1], qr[0], negm, 0, 0, 0);
#pragma unroll
            for (int d0 = 1; d0 < 4; ++d0) { p0 = __builtin_amdgcn_mfma_f32_32x32x16_bf16(kf[2 * d0], qr[d0], p0, 0, 0, 0); p1 = __builtin_amdgcn_mfma_f32_32x32x16_bf16(kf[2 * d0 + 1], qr[d0], p1, 0, 0, 0); }
            float alpha; bf16x8 pa0, pa1, pa2, pa3;
            softmax_rel(p0, p1, m_reg, l_reg, negm, alpha, j == 0, pa0, pa1, pa2, pa3);
            ATT_RESC2(alpha);
            if (j + DF_D <= NT) asm volatile("s_waitcnt vmcnt(%0) lgkmcnt(0)" :: "n"(3 * (DF_D - 2)) : "memory"); else asm volatile("s_waitcnt vmcnt(0) lgkmcnt(0)" ::: "memory");
            BAR();
            if (j + DF_D < NT) { const int b2 = bsl >= 1 ? bsl - 1 : DF_R - 1; DDMA(j + DF_D, b2); }
            const int bn = bsl == DF_R - 1 ? 0 : bsl + 1;
            pv_all_pre(o, vb0 + bsl * SHM_V, pa0, pa1, pa2, pa3);
            bsl = bn;
        }
#undef KLOAD
        asm volatile("s_waitcnt lgkmcnt(0)" ::: "memory");
        BAR();
#undef DDMA
        if (hi == 0) li_l[r32] = l_reg;
        asm volatile("s_waitcnt lgkmcnt(0)" ::: "memory");
        float rli[16];
#pragma unroll
        for (int r = 0; r < 16; ++r) rli[r] = __builtin_amdgcn_rcpf(li_l[crow(r, hi)]);
        f32x4* o1v = (f32x4*)((char*)o1s + (unsigned)tid * 256u);
        if (s == 0) {
#pragma unroll
            for (int d = 0; d < 4; ++d)
#pragma unroll
                for (int r = 0; r < 16; r += 4) o1v[d * 4 + (r >> 2)] = (f32x4){o[d][r] * rli[r], o[d][r + 1] * rli[r + 1], o[d][r + 2] * rli[r + 2], o[d][r + 3] * rli[r + 3]};
        } else {
#pragma unroll
            for (int d = 0; d < 4; ++d)
#pragma unroll
                for (int r = 0; r < 16; r += 4) { const f32x4 t = o1v[d * 4 + (r >> 2)];
#pragma unroll
                    for (int e = 0; e < 4; ++e) o[d][r + e] = t[e] - lam * (o[d][r + e] * rli[r + e]); }
            float gs[4];
#pragma unroll
            for (int d = 0; d < 4; ++d) gs[d] = g_sub[d * 32 + r32] * (1.0f - LAM_INIT);
            bf16_t* stg = (bf16_t*)(lds + DF_STG) + wid * 4096;
#pragma unroll
            for (int r = 0; r < 16; ++r) {
                float q = (o[0][r] * o[0][r] + o[1][r] * o[1][r]) + (o[2][r] * o[2][r] + o[3][r] * o[3][r]);
                q += __shfl_xor(q, 1); q += __shfl_xor(q, 2); q += __shfl_xor(q, 4); q += __shfl_xor(q, 8); q += __shfl_xor(q, 16);
                const float rn = __builtin_amdgcn_rsqf(q * (1.0f / 128.0f) + SUBLN_EPS);
#pragma unroll
                for (int d = 0; d < 4; ++d) stg[crow(r, hi) * 128 + d * 32 + r32] = (bf16_t)f2bf(o[d][r] * rn * gs[d]);
            }
            asm volatile("s_waitcnt lgkmcnt(0)" ::: "memory");
            const unsigned goff = ((unsigned)(rowbase + q0 + wid * 32 + (lane >> 4)) * DM + 1024 + h * 128 + (lane & 15) * 8) * 2u;
#pragma unroll
            for (int i = 0; i < 8; ++i) { const u32x4 v = *(const u32x4*)(stg + (i * 4 + (lane >> 4)) * 128 + (lane & 15) * 8); *(u32x4*)((char*)mix + goff + (unsigned)(i * 4 * DM * 2)) = v; }
            asm volatile("s_waitcnt lgkmcnt(0)" ::: "memory"); BAR();
        }
    }
#undef BAR
}

__device__ __forceinline__ void na_unit(const bf16_t* __restrict__ proj, bf16_t* __restrict__ mix, const float* __restrict__ rpb,
                                        int rowbase, int ROWS, int h, int rg, char* lds, int widk) {
    const int tid = tid_l(widk), wid = tid >> 6, lane = tid & 63, r32 = lane & 31, hi = lane >> 5;
    char* V_lds = lds; char* K_lds = lds + OFF_K;
    float* wsf = (float*)(lds + OFF_WS) + wid * 64; float* li_l = wsf; float* al_l = wsf + 32;
    float* rpbL = (float*)(lds + OFF_RPB);
    LAS unsigned char* ldsl = (LAS unsigned char*)lds; const int widu = __builtin_amdgcn_readfirstlane(wid);
    unsigned kgo[2], vgo[2];
#pragma unroll
    for (int i = 0; i < 2; ++i) { const int X = wid * 1024 + lane * 16 + i * 8192;
        { const int krow = X >> 8, kcolB = (X & 255) ^ ((krow & 7) << 4); kgo[i] = (unsigned)(krow * INW * 2 + kcolB); }
        { const int sub = X >> 9, e = (X & 511) >> 1, kk = (sub >> 2) * 8 + (e >> 5), cc = (sub & 3) * 32 + (e & 31); const int k = (kk & ~0xC) | ((kk & 4) << 1) | ((kk & 8) >> 1); vgo[i] = (unsigned)((k * INW + cc) * 2); } }
    const int vb0 = (int)(uintptr_t)V_lds + v_rd_base(lane);
    const int r0 = rg * 4, rq = r0 + (wid >> 1), c = 32 * (wid & 1) + r32;
    const int rsw = min(max(rq - 4, 0), ROWS - 8), cs = min(max(c - 8, 0), 48);
    const int klo = min(max(r0 - 4, 0), ROWS - 8), khi = min(max(r0 + 3 - 4, 0), ROWS - 8) + 8;
    for (int i = tid; i < 465; i += NTHREADS) rpbL[i] = rpb[h * 465 + i] * LOG2E;
    const bf16_t* Kh = proj + (size_t)rowbase * INW + 1024 + h * 128;
    const bf16_t* Vh = proj + (size_t)rowbase * INW + 2048 + h * 128;
    const bf16_t* Qw = proj + (size_t)(rowbase + rq * 64 + c) * INW + h * 128 + hi * 8;
    bf16x8 qr[8];
#pragma unroll
    for (int d0 = 0; d0 < 8; ++d0) qr[d0] = *(const bf16x8*)(Qw + d0 * 16);
    float m_reg = -1e30f, l_reg = 0.f; f32x16 o[4];
#pragma unroll
    for (int d = 0; d < 4; ++d) o[d] = f32x16{};
#define NDMA(kr, b) do { const char* kt = (const char*)Kh + (size_t)(kr) * (64 * INW * 2); const char* vt = (const char*)Vh + (size_t)(kr) * (64 * INW * 2); \
        __builtin_amdgcn_global_load_lds((const unsigned*)(kt + kgo[0]), (LAS unsigned*)(ldsl + OFF_K + (b) * SHM_K + widu * 1024), 16, 0, 0); \
        __builtin_amdgcn_global_load_lds((const unsigned*)(kt + kgo[1]), (LAS unsigned*)(ldsl + OFF_K + (b) * SHM_K + widu * 1024 + 8192), 16, 0, 0); \
        __builtin_amdgcn_global_load_lds((const unsigned*)(vt + vgo[0]), (LAS unsigned*)(ldsl + (b) * SHM_V + widu * 1024), 16, 0, 0); \
        __builtin_amdgcn_global_load_lds((const unsigned*)(vt + vgo[1]), (LAS unsigned*)(ldsl + (b) * SHM_V + widu * 1024 + 8192), 16, 0, 0); } while (0)
    NDMA(klo, 0); asm volatile("s_waitcnt vmcnt(0)" ::: "memory"); __syncthreads();
#pragma unroll 1
    for (int kr = klo; kr < khi; ++kr) {
        const int b = (kr - klo) & 1;
        if (kr + 1 < khi) NDMA(kr + 1, b ^ 1);
        if (kr >= rsw && kr < rsw + 8) {
            f32x16 p0 = f32x16{}, p1 = f32x16{};
            const char* Ks = K_lds + b * SHM_K;
#pragma unroll
            for (int d0 = 0; d0 < 8; ++d0) { const int cb = (d0 * 16 + hi * 8) * 2;
                const bf16x8 b0 = *(const bf16x8*)(Ks + KSWZ128(r32, cb)); const bf16x8 b1 = *(const bf16x8*)(Ks + KSWZ128(32 + r32, cb));
                p0 = __builtin_amdgcn_mfma_f32_32x32x16_bf16(b0, qr[d0], p0, 0, 0, 0); p1 = __builtin_amdgcn_mfma_f32_32x32x16_bf16(b1, qr[d0], p1, 0, 0, 0); }
            const float* brow = rpbL + (kr - rq + 7) * 31;
#pragma unroll
            for (int r = 0; r < 16; ++r) {
                const int kc = crow(r, hi), kc2 = kc + 32;
                const int i0 = min(max(kc - c + 15, 0), 30), i1 = min(max(kc2 - c + 15, 0), 30);
                const float b0 = brow[i0], b1 = brow[i1];
                p0[r] = ((unsigned)(kc - cs) < 16u) ? p0[r] + b0 : -1e30f;
                p1[r] = ((unsigned)(kc2 - cs) < 16u) ? p1[r] + b1 : -1e30f;
            }
            float alpha; bf16x8 pa0, pa1, pa2, pa3;
            softmax_tile(p0, p1, m_reg, l_reg, alpha, pa0, pa1, pa2, pa3);
            ATT_RESC(alpha);
            pv_all(o, vb0 + b * SHM_V, pa0, pa1, pa2, pa3);
        }
        asm volatile("s_waitcnt vmcnt(0)" ::: "memory");
        __syncthreads();
    }
#undef NDMA
    if (hi == 0) li_l[r32] = l_reg;
    asm volatile("s_waitcnt lgkmcnt(0)" ::: "memory");
    bf16_t* stg = (bf16_t*)(lds + OFF_STG) + wid * 4096;
#pragma unroll
    for (int r = 0; r < 16; ++r) { const float rl = __builtin_amdgcn_rcpf(li_l[crow(r, hi)]);
#pragma unroll
        for (int d = 0; d < 4; ++d) stg[crow(r, hi) * 128 + d * 32 + r32] = (bf16_t)f2bf(o[d][r] * rl); }
    asm volatile("s_waitcnt lgkmcnt(0)" ::: "memory");
    bf16_t* gp = mix + (size_t)(rowbase + rq * 64 + 32 * (wid & 1) + (lane >> 4)) * DM + h * 128 + (lane & 15) * 8;
#pragma unroll
    for (int i = 0; i < 8; ++i) { const u32x4 v = *(const u32x4*)(stg + (i * 4 + (lane >> 4)) * 128 + (lane & 15) * 8); *(u32x4*)gp = v; gp += 4 * DM; }
    __syncthreads();
}
#undef SBAR
}

template <int MODE> __device__ __forceinline__ int dest_row(int n) {
    if (MODE == 1) { if (n < 3072 || n >= 5120) return n; const int d = n & 63, blk = n & ~63, nn = d >> 5, dd = d & 31; return blk + 32 * (dd >> 4) + 8 * ((dd >> 2) & 3) + 4 * nn + (dd & 3); }
    if (MODE == 2) { if (n < DFF) return 256 * (n >> 7) + (n & 127); const int n2 = n - DFF; return 256 * (n2 >> 7) + 128 + (n2 & 127); }
    return n;
}
template <int MODE> __device__ __forceinline__ void p0_transpose_item(const float* __restrict__ W, int K, int N, bf16_t* __restrict__ WT, const float* __restrict__ gain, LAS float* scr, int item, int lane) {
    const int nblk = N / 32, kb = item / nblk, nb = item % nblk, k0 = 64 * kb, n0 = 32 * nb;
#pragma unroll 8
    for (int i = 0; i < 32; ++i) { const int kk = 2 * i + (lane >> 5); const float g = gain ? gain[k0 + kk] : 1.0f; scr[kk * 33 + (lane & 31)] = W[(size_t)(k0 + kk) * N + n0 + (lane & 31)] * g; }
    asm volatile("s_waitcnt lgkmcnt(0)" ::: "memory");
    const int c = lane & 7;
#pragma unroll
    for (int j = 0; j < 4; ++j) { const int n = (lane >> 3) + 8 * j; const LAS float* s = scr + (8 * c) * 33 + n;
        u32x4 o; o.x = pk2(s[0 * 33], s[1 * 33]); o.y = pk2(s[2 * 33], s[3 * 33]); o.z = pk2(s[4 * 33], s[5 * 33]); o.w = pk2(s[6 * 33], s[7 * 33]);
        *(u32x4*)(WT + (size_t)dest_row<MODE>(n0 + n) * K + k0 + 8 * c) = o; }
    asm volatile("s_waitcnt lgkmcnt(0)" ::: "memory");
}
__device__ __forceinline__ float row_ssq(const float* xrow, int lane, f32x4 (&v)[8]) {
    const f32x4* xr = (const f32x4*)xrow + lane; float s = 0.f;
#pragma unroll
    for (int j = 0; j < 8; ++j) { v[j] = xr[64 * j]; s += (v[j][0] * v[j][0] + v[j][1] * v[j][1]) + (v[j][2] * v[j][2] + v[j][3] * v[j][3]); }
    return wave_sum(s);
}
__device__ __forceinline__ void sincos_d(double x, double& sn, double& cs) {
    const double k = __builtin_rint(x * 0.6366197723675814); const double r0 = __builtin_fma(-k, 1.5707963267948966, x); const double r = __builtin_fma(-k, 6.123233995736766e-17, r0);
    const double r2 = r * r;
    double s = -1.0 / 1307674368000.0; s = s * r2 + 1.0 / 6227020800.0; s = s * r2 - 1.0 / 39916800.0; s = s * r2 + 1.0 / 362880.0; s = s * r2 - 1.0 / 5040.0; s = s * r2 + 1.0 / 120.0; s = s * r2 - 1.0 / 6.0; s = s * r2 * r + r;
    double c = 1.0 / 20922789888000.0; c = c * r2 - 1.0 / 87178291200.0; c = c * r2 + 1.0 / 479001600.0; c = c * r2 - 1.0 / 3628800.0; c = c * r2 + 1.0 / 40320.0; c = c * r2 - 1.0 / 720.0; c = c * r2 + 1.0 / 24.0; c = c * r2 - 0.5; c = c * r2 + 1.0;
    const int q = ((int)k) & 3;
    sn = (q == 0) ? s : (q == 1) ? c : (q == 2) ? -s : -c;
    cs = (q == 0) ? c : (q == 1) ? -s : (q == 2) ? -c : s;
}

struct Args { const float* in[22]; float* out; unsigned char* ws; int ph_lo, ph_hi; };
constexpr int NPHASE = 10;

__global__ void __launch_bounds__(NTHREADS, 2) fwd_kernel(Args a) {
    extern __shared__ __attribute__((aligned(16))) unsigned char lds[];
    LAS unsigned char* ldsl = (LAS unsigned char*)lds;
    const int widk = __builtin_amdgcn_readfirstlane((int)(threadIdx.x >> 6));
    const int G = gridDim.x, bx = blockIdx.x, vcu = (G % 8 == 0) ? (bx % 8) * (G / 8) + bx / 8 : bx;
#define x_p (ap->in[0])
#define x_s (ap->in[1])
#define mem_p (ap->in[2])
#define mem_s (ap->in[3])
#define g_mix (ap->in[4])
#define w_in (ap->in[5])
#define rpb (ap->in[6])
#define lam_q1 (ap->in[7])
#define lam_k1 (ap->in[8])
#define lam_q2 (ap->in[9])
#define lam_k2 (ap->in[10])
#define g_subln (ap->in[11])
#define w_out (ap->in[12])
#define g_xattn (ap->in[13])
#define g_mem (ap->in[14])
#define w_mq (ap->in[15])
#define w_mkv (ap->in[16])
#define w_mo (ap->in[17])
#define g_ffn (ap->in[18])
#define w_gu (ap->in[19])
#define w_dn (ap->in[20])
#define g_final (ap->in[21])
#define out (ap->out)
#define WSP() const __attribute__((address_space(4))) Args* ap = (const __attribute__((address_space(4))) Args*)__builtin_amdgcn_kernarg_segment_ptr(); asm volatile("" : "+s"(ap)); unsigned char* ws = ap->ws
#define SS ((float*)(ws + WS_SS))
#define RS0 ((float*)(ws + WS_RS0))
#define ROPE ((f32x2*)(ws + WS_ROPE))
#define WIN ((bf16_t*)(ws + WS_WIN))
#define WOUT ((bf16_t*)(ws + WS_WOUT))
#define WMQ ((bf16_t*)(ws + WS_WMQ))
#define WMO ((bf16_t*)(ws + WS_WMO))
#define WMKV ((bf16_t*)(ws + WS_WMKV))
#define WGU ((bf16_t*)(ws + WS_WGU))
#define WDN ((bf16_t*)(ws + WS_WDN))
#define MN ((bf16_t*)(ws + WS_MN))
#define KB ((bf16_t*)(ws + WS_KB))
#define VB ((bf16_t*)(ws + WS_VB))
#define WQK ((bf16_t*)(ws + WS_WQK))
#define WVO ((bf16_t*)(ws + WS_WVO))
#define O1S ((float*)(ws + WS_O1))
#define XB ((bf16_t*)(ws + WS_XB))
#define PROJ ((bf16_t*)(ws + WS_BIG))
#define H1B ((bf16_t*)(ws + WS_H1B))
#define SB ((float*)(ws + WS_S))
#define PB ((bf16_t*)(ws + WS_P))
#define ACT ((bf16_t*)(ws + WS_ACT))
#define MIX XB
#define H2B XB
    const int lo = a.ph_lo, hi_ph = a.ph_hi;
    if (lo < 0) cg::this_grid().sync();
#ifdef ONLY_PHASE
#define IN(k) ((k) == ONLY_PHASE && lo <= (k) && (k) < hi_ph)
#else
#define IN(k) (lo <= (k) && (k) < hi_ph)
#endif
#define SEAM(k) do { if (IN(k) && IN((k) + 1)) { WSP(); grid_barrier((unsigned*)(ws + WS_BAR), (unsigned)((k) + 1 - lo) * (unsigned)G, tid_l(widk)); } } while (0)
    const int NGW = G * 8;
#define TIDS() const int tid = tid_l(widk), lane = tid & 63, wave = __builtin_amdgcn_readfirstlane(tid >> 6), gw = vcu * 8 + wave; (void)lane; (void)gw

    if (IN(0)) { WSP(); TIDS();
        LAS float* scr = (LAS float*)(ldsl + wave * 16384);
        constexpr int I0 = (DM / 64) * (INW / 32), I1 = (DM / 64) * (DM / 32), I2 = I1, I3 = (DM / 64) * (4096 / 32), I4 = (DM / 64) * (NGU / 32), I5 = (DFF / 64) * (DM / 32);
        constexpr int NIT = I0 + I1 + I2 + I3 + I4 + I5;
        for (int it = gw; it < NIT; it += NGW) {
            int r = it;
            if (r < I0) { p0_transpose_item<1>(w_in, DM, INW, WIN, g_mix, scr, r, lane); continue; } r -= I0;
            if (r < I1) { p0_transpose_item<0>(w_out, DM, DM, WOUT, nullptr, scr, r, lane); continue; } r -= I1;
            if (r < I2) { p0_transpose_item<0>(w_mo, DM, DM, WMO, nullptr, scr, r, lane); continue; } r -= I2;
            if (r < I3) { p0_transpose_item<0>(w_mkv, DM, 4096, WMKV, nullptr, scr, r, lane); continue; } r -= I3;
            if (r < I4) { p0_transpose_item<2>(w_gu, DM, NGU, WGU, g_ffn, scr, r, lane); continue; } r -= I4;
            p0_transpose_item<0>(w_dn, DFF, DM, WDN, nullptr, scr, r, lane);
        }
        for (int k = gw; k < DM; k += NGW) { const float g = g_xattn[k]; const f32x4* src = (const f32x4*)(w_mq + (size_t)k * DM) + lane; u32x2* dst = (u32x2*)(WMQ + (size_t)k * DM) + lane;
#pragma unroll
            for (int j = 0; j < 8; ++j) { const f32x4 v = src[64 * j] * g; u32x2 w; w.x = pk2(v[0], v[1]); w.y = pk2(v[2], v[3]); dst[64 * j] = w; } }
        for (int m = gw; m < MT; m += NGW) { const float* xr = m < NP ? x_p + (size_t)m * DM : x_s + (size_t)(m - NP) * DM; f32x4 v[8];
            const float s = row_ssq(xr, lane, v); if (lane == 0) RS0[m] = 1.0f / sqrtf(s * (1.0f / DM) + RMS_EPS);
            u32x2* dst = (u32x2*)(XB + (size_t)m * DM) + lane;
#pragma unroll
            for (int j = 0; j < 8; ++j) { u32x2 w; w.x = pk2(v[j][0], v[j][1]); w.y = pk2(v[j][2], v[j][3]); dst[64 * j] = w; } }
        for (int m = gw; m < NMEM; m += NGW) { const float* xr = m < 512 ? mem_p + (size_t)m * DM : mem_s + (size_t)(m - 512) * DM; f32x4 v[8];
            const float s = row_ssq(xr, lane, v); const float rr = 1.0f / sqrtf(s * (1.0f / DM) + RMS_EPS);
            u32x2* dst = (u32x2*)(MN + (size_t)m * DM) + lane; const f32x4* gp = (const f32x4*)g_mem + lane;
#pragma unroll
            for (int j = 0; j < 8; ++j) { const f32x4 g = gp[64 * j]; u32x2 w; w.x = pk2(v[j][0] * rr * g[0], v[j][1] * rr * g[1]); w.y = pk2(v[j][2] * rr * g[2], v[j][3] * rr * g[3]); dst[64 * j] = w; } }
        for (int e = vcu * NTHREADS + tid; e < TP * 32; e += G * NTHREADS) { const int t = e >> 5, dd = e & 31;
            double pw = 1.0; for (int i = 0; i < dd; ++i) pw *= 1.333521432163324;
            const float inv = 1.0f / (float)pw; const float ang = (float)t * inv; double sn, cs; sincos_d((double)ang, sn, cs);
            ROPE[e] = (f32x2){(float)cs, (float)sn}; }
    }
    SEAM(0);

    if (IN(1)) { WSP();
        pg8::Sched S{(const char*)XB, (const char*)WIN, (const char*)MN, (const char*)WMKV, MT / 256, INW / 256, (MT / 256) * (INW / 256), NMEM / 256, (NMEM / 256) * 16,
                     (size_t)256 * DM * 2, (size_t)256 * DM * 2, 0, G, bx};
        pg8::EpiInProj E{PROJ, KB, VB, RS0, ROPE};
        pg8::gemm_phase<pg8::EpiInProj, pg8::Sched, true, true>(ldsl, widk, DM, DM, S, E);
    }
    SEAM(1);

    if (IN(2)) { WSP(); TIDS();
#if !defined(P2_PART) || P2_PART == 1
        { pg8::PreSched S{(const char*)KB, (const char*)VB, (const char*)WMQ, (const char*)WMO, G, bx}; pg8::EpiPre E{WQK, WVO};
          pg8::gemm_phase<pg8::EpiPre, pg8::PreSched, true, true>(ldsl, widk, 512, DM, S, E); }
#endif
        __syncthreads();
#if !defined(P2_PART) || P2_PART == 2
        for (int id = vcu; id < 1024 + 512; id += G) {
            const bool pr = id < 1024; const int i2 = pr ? id : id - 1024;
            const int rg = pr ? (i2 & 63) : (i2 & 15), h = pr ? ((i2 >> 6) & 7) : ((i2 >> 4) & 7), b = pr ? (i2 >> 9) : (i2 >> 7);
            att::na_unit(PROJ, MIX, rpb, pr ? b * TP : NP + b * TS, pr ? TP / 64 : TS / 64, h, rg, (char*)lds, widk);
        }
#endif
#if !defined(P2_PART) || P2_PART == 3
        float lam;
        { const float a1 = wave_sum(lam_q1[lane] * lam_k1[lane]), a2 = wave_sum(lam_q2[lane] * lam_k2[lane]); lam = __expf(a1) - __expf(a2) + LAM_INIT; lam = __builtin_bit_cast(float, __builtin_amdgcn_readfirstlane(__builtin_bit_cast(int, lam))); }
        float* o1s = O1S + (size_t)bx * 64 * NTHREADS;
#ifndef DIFF_REPS
#define DIFF_REPS 1
#endif
        for (int rep = 0; rep < DIFF_REPS; ++rep)
        for (int id = vcu; id < 1024 + 512; id += G) {
            const bool pr = id < 1024; const int i2 = pr ? id : id - 1024;
            const int qb = pr ? (i2 & 63) : (i2 & 15), bh = pr ? (i2 >> 6) : (i2 >> 4);
            att::diff_unit(PROJ, MIX, o1s, g_subln, lam, pr ? (bh >> 3) * TP : NP + (bh >> 3) * TS, pr ? TP : TS, bh & 7, qb, (char*)lds, widk);
        }
#endif
    }
    SEAM(2);

    if (IN(3)) { WSP();
        pg8::Sched S{(const char*)MIX, (const char*)WOUT, nullptr, nullptr, MT / 256, DM / 256, (MT / 256) * (DM / 256), 1, 0, (size_t)256 * DM * 2, (size_t)256 * DM * 2, 0, G, bx};
        pg8::EpiX E{x_p, x_s, H1B, SS};
        pg8::gemm_phase<pg8::EpiX, pg8::Sched, true, true>(ldsl, widk, DM, DM, S, E);
    }
    SEAM(3);

    if (IN(4)) { WSP();
        pg8::Sched S{(const char*)H1B, (const char*)WQK, nullptr, nullptr, MT / 256, NSW / 256, (MT / 256) * (NSW / 256), 1, 0, (size_t)256 * DM * 2, (size_t)256 * DM * 2, (size_t)NSW * DM * 2, G, bx};
        pg8::EpiS E{SB, SS};
        pg8::gemm_phase<pg8::EpiS, pg8::Sched, true, true>(ldsl, widk, DM, DM, S, E);
    }
    SEAM(4);

    if (IN(5)) { WSP(); TIDS();
        for (int m = gw; m < MT; m += NGW) {
            const f32x4* sp = (const f32x4*)(SB + (size_t)m * NSW) + lane; u32x2* pp = (u32x2*)(PB + (size_t)m * NSW) + lane;
#pragma unroll
            for (int hh = 0; hh < 4; ++hh) { f32x4 v = sp[64 * hh]; const float mx = wave_max(fmaxf(fmaxf(v[0], v[1]), fmaxf(v[2], v[3])));
                v[0] = __builtin_amdgcn_exp2f(v[0] - mx); v[1] = __builtin_amdgcn_exp2f(v[1] - mx); v[2] = __builtin_amdgcn_exp2f(v[2] - mx); v[3] = __builtin_amdgcn_exp2f(v[3] - mx);
                const float rl = 1.0f / wave_sum((v[0] + v[1]) + (v[2] + v[3]));
                u32x2 w; w.x = pk2(v[0] * rl, v[1] * rl); w.y = pk2(v[2] * rl, v[3] * rl); pp[64 * hh] = w; }
        }
    }
    SEAM(5);

    if (IN(6)) { WSP();
        pg8::Sched S{(const char*)PB, (const char*)WVO, nullptr, nullptr, MT / 256, DM / 256, (MT / 256) * (DM / 256), 1, 0, (size_t)256 * NSW * 2, (size_t)256 * NSW * 2, (size_t)DM * NSW * 2, G, bx};
        pg8::EpiResid E{nullptr, H1B, H2B, DM, SS};
        pg8::gemm_phase<pg8::EpiResid, pg8::Sched, true, true>(ldsl, widk, NSW, NSW, S, E);
    }
    SEAM(6);

    if (IN(7)) { WSP();
        pg8::Sched S{(const char*)H2B, (const char*)WGU, nullptr, nullptr, MT / 256, NGU / 256, (MT / 256) * (NGU / 256), 1, 0, (size_t)256 * DM * 2, (size_t)256 * DM * 2, 0, G, bx};
        pg8::EpiGU E{ACT, SS};
        pg8::gemm_phase<pg8::EpiGU, pg8::Sched, true, true>(ldsl, widk, DM, DM, S, E);
    }
    SEAM(7);

    if (IN(8)) { WSP();
        pg8::Sched S{(const char*)ACT, (const char*)WDN, nullptr, nullptr, MT / 256, DM / 256, (MT / 256) * (DM / 256), 1, 0, (size_t)256 * DFF * 2, (size_t)256 * DFF * 2, 0, G, bx};
        pg8::EpiResid E{nullptr, H2B, (bf16_t*)out + DM, 2 * DM, SS};
        pg8::gemm_phase<pg8::EpiResid, pg8::Sched, true, true>(ldsl, widk, DFF, DFF, S, E);
    }
    SEAM(8);

    if (IN(9)) { WSP(); TIDS();
        for (int m = gw; m < MT; m += NGW) {
            float sq = lane < 32 ? SS[(size_t)m * 32 + lane] : 0.f; sq = wave_sum(sq); const float rr = __builtin_amdgcn_rsqf(sq * (1.0f / DM) + RMS_EPS);
            const u32x2* hp = (const u32x2*)((const bf16_t*)out + (size_t)m * (2 * DM) + DM) + lane;
            u32x2 hv[8];
#pragma unroll
            for (int j = 0; j < 8; ++j) hv[j] = hp[64 * j];
            asm volatile("s_waitcnt vmcnt(0)" ::: "memory");
            f32x4* op = (f32x4*)(out + (size_t)m * DM) + lane; const f32x4* gp = (const f32x4*)g_final + lane;
#pragma unroll
            for (int j = 0; j < 8; ++j) { const f32x4 g = gp[64 * j];
                const f32x4 v = (f32x4){__uint_as_float(hv[j].x << 16), __uint_as_float(hv[j].x & 0xffff0000u), __uint_as_float(hv[j].y << 16), __uint_as_float(hv[j].y & 0xffff0000u)};
                op[64 * j] = v * rr * g; }
        }
    }
#undef IN
#undef SEAM
#undef TIDS
}
#undef x_p
#undef x_s
#undef mem_p
#undef mem_s
#undef g_mix
#undef w_in
#undef rpb
#undef lam_q1
#undef lam_k1
#undef lam_q2
#undef lam_k2
#undef g_subln
#undef w_out
#undef g_xattn
#undef g_mem
#undef w_mq
#undef w_mkv
#undef w_mo
#undef g_ffn
#undef w_gu
#undef w_dn
#undef g_final
#undef out
#undef WSP
#undef SS
#undef RS0
#undef ROPE
#undef WIN
#undef WOUT
#undef WMQ
#undef WMO
#undef WMKV
#undef WGU
#undef WDN
#undef MN
#undef KB
#undef VB
#undef WQK
#undef WVO
#undef O1S
#undef XB
#undef PROJ
#undef H1B
#undef SB
#undef PB
#undef ACT
#undef MIX
#undef H2B


extern "C" void kernel_launch(void* const* d_in, const int* in_sizes, int n_in, void* d_out, int out_size, void* d_ws, size_t ws_size, hipStream_t stream) {
    static int grid = 0;
    if (grid == 0) {
        if (n_in != 22 || out_size != MT * DM || ws_size < WS_END) { fprintf(stderr, "kernel_launch: unexpected shapes (n_in %d, out %d, ws %zu); nothing launched\n", n_in, out_size, ws_size); grid = -1; return; }
        int dev = 0, cus = 0, per_cu = 0;
        (void)hipGetDevice(&dev); (void)hipDeviceGetAttribute(&cus, hipDeviceAttributeMultiprocessorCount, dev);
        if (hipFuncSetAttribute((const void*)fwd_kernel, hipFuncAttributeMaxDynamicSharedMemorySize, LDS_BYTES) != hipSuccess) { fprintf(stderr, "kernel_launch: hipFuncSetAttribute failed\n"); grid = -1; return; }
        if (hipOccupancyMaxActiveBlocksPerMultiprocessor(&per_cu, (const void*)fwd_kernel, NTHREADS, LDS_BYTES) != hipSuccess || per_cu < 1) per_cu = 1;
        (void)hipGetLastError();
        grid = cus * per_cu;
    }
    if (grid < 0) return;
    Args a{};
    for (int i = 0; i < 22; ++i) a.in[i] = (const float*)d_in[i];
    a.out = (float*)d_out; a.ws = (unsigned char*)d_ws;
#if MK_MULTI
    for (int p = 0; p < NPHASE; ++p) { a.ph_lo = p; a.ph_hi = p + 1; hipLaunchKernelGGL(fwd_kernel, dim3(grid), dim3(NTHREADS), LDS_BYTES, stream, a); }
#else
    a.ph_lo = 0; a.ph_hi = NPHASE;
    (void)hipMemsetAsync((char*)d_ws + WS_BAR, 0, 256, stream);
    void* args[] = {&a};
    hipError_t e = hipLaunchCooperativeKernel((const void*)fwd_kernel, dim3(grid), dim3(NTHREADS), args, LDS_BYTES, stream);
    if (e != hipSuccess) fprintf(stderr, "cooperative launch failed: %s (grid %d)\n", hipGetErrorString(e), grid);
#endif
}
```

```cpp
#include <hip/hip_runtime.h>
#include <hip/hip_cooperative_groups.h>
#include <cstdio>
#include <cstdint>
namespace cg = cooperative_groups;

#ifndef MK_MULTI
#define MK_MULTI 0
#endif

#define LAS __attribute__((address_space(3)))
typedef unsigned short bf16_t;
typedef short bf16x8 __attribute__((ext_vector_type(8)));
typedef short s16x4 __attribute__((ext_vector_type(4)));
typedef float f32x2 __attribute__((ext_vector_type(2)));
typedef float f32x4 __attribute__((ext_vector_type(4)));
typedef float f32x16 __attribute__((ext_vector_type(16)));
typedef unsigned u32x2 __attribute__((ext_vector_type(2)));
typedef unsigned u32x4 __attribute__((ext_vector_type(4)));

constexpr int DM = 2048, TP = 16384, TS = 4096, NP = 2 * TP, NS = 4 * TS, MT = NP + NS;
constexpr int INW = 6144, DFF = 5632, NGU = 2 * DFF, MEMT = 256, NMEM = 6 * MEMT, NSW = 1024;
constexpr float RMS_EPS = 1e-6f, SUBLN_EPS = 1e-5f, LOG2E = 1.4426950408889634f;
constexpr float NA_QS = 0.08838834764831845f * LOG2E, DF_QS = 0.125f * LOG2E, MEM_QS = 0.04419417382415922f * LOG2E;
constexpr float LAM_INIT = 0.2f;

constexpr size_t MiB = 1u << 20;
constexpr size_t WS_SS = 0, WS_RS0 = 6 * MiB, WS_ROPE = 7 * MiB, WS_WIN = 11 * MiB, WS_WOUT = 35 * MiB, WS_WMQ = 43 * MiB, WS_WMO = 51 * MiB,
                 WS_WMKV = 59 * MiB, WS_WGU = 75 * MiB, WS_WDN = 119 * MiB, WS_MN = 141 * MiB, WS_KB = 147 * MiB, WS_VB = 153 * MiB,
                 WS_WQK = 159 * MiB, WS_WVO = 183 * MiB, WS_O1 = 207 * MiB, WS_XB = 239 * MiB, WS_BIG = 431 * MiB, WS_END = 1007 * MiB;
constexpr size_t WS_BAR = 6 * MiB + 512 * 1024;
constexpr size_t WS_H1B = WS_BIG, WS_S = WS_BIG + 192 * MiB, WS_P = WS_BIG + 384 * MiB, WS_ACT = WS_BIG;

constexpr int LDS_BYTES = 147456, NTHREADS = 512;

__device__ __forceinline__ unsigned cvt_pk_bf16(float lo, float hi) { unsigned r; asm volatile("v_cvt_pk_bf16_f32 %0, %1, %2" : "=v"(r) : "v"(lo), "v"(hi)); return r; }
__device__ __forceinline__ unsigned f2bf(float f) { unsigned u = __builtin_bit_cast(unsigned, f); return (u + 0x7fffu + ((u >> 16) & 1u)) >> 16; }
__device__ __forceinline__ unsigned pk2(float lo, float hi) { return f2bf(lo) | (f2bf(hi) << 16); }
__device__ __forceinline__ float wave_sum(float v) {
#pragma unroll
    for (int o = 1; o < 64; o <<= 1) v += __shfl_xor(v, o);
    return v;
}
__device__ __forceinline__ float wave_max(float v) {
#pragma unroll
    for (int o = 1; o < 64; o <<= 1) v = fmaxf(v, __shfl_xor(v, o));
    return v;
}
__device__ __forceinline__ int tid_l(int widk) { int t; asm volatile("v_mbcnt_lo_u32_b32 %0, -1, 0\n\tv_mbcnt_hi_u32_b32 %0, -1, %0\n\tv_or_b32 %0, %1, %0" : "=&v"(t) : "s"(widk << 6)); return t; }
__device__ __forceinline__ void grid_barrier(unsigned* ctr, unsigned target, int tid) {
    asm volatile("s_waitcnt vmcnt(0) lgkmcnt(0)" ::: "memory");
    __syncthreads();
    if (tid == 0) {
        __builtin_amdgcn_fence(__ATOMIC_RELEASE, "agent");
        asm volatile("s_waitcnt vmcnt(0)" ::: "memory");
        (void)__hip_atomic_fetch_add(ctr, 1u, __ATOMIC_RELAXED, __HIP_MEMORY_SCOPE_AGENT);
        unsigned spins = 0;
        while (__hip_atomic_load(ctr, __ATOMIC_RELAXED, __HIP_MEMORY_SCOPE_AGENT) < target && ++spins < (1u << 22)) __builtin_amdgcn_s_sleep(2);
        __builtin_amdgcn_fence(__ATOMIC_ACQUIRE, "agent");
        asm volatile("s_waitcnt vmcnt(0)" ::: "memory");
    }
    __syncthreads();
}
__device__ __forceinline__ int batch_of_pm(int pm) { return pm < 128 ? (pm >> 6) : 2 + ((pm - 128) >> 4); }

namespace pg8 {
constexpr int BM = 256, BK = 64, HALF = 128, HTB = HALF * BK * 2, STAGE_BYTES = 8 * HTB, NXCD = 8, WGM = 8;
__host__ __device__ __forceinline__ int lds_byte(int r, int c) { const int st = (r >> 4) * 2 + (c >> 5), rr = r & 15, cc = c & 31, ob = rr * 64 + cc * 2; return st * 1024 + (ob ^ (((ob >> 9) & 1) << 5)); }
__host__ __device__ __forceinline__ void stage_rc(int b, int& R, int& C) { const int st = b / 1024, sb = b % 1024, swz = sb ^ (((sb >> 9) & 1) << 5); R = (st >> 1) * 16 + swz / 64; C = (st & 1) * 32 + (swz % 64) / 2; }
__host__ __device__ __forceinline__ int perm32(int rho) { const int n = rho >> 4, i = rho & 15; return 8 * (i >> 2) + 4 * n + (i & 3); }

struct Unit { int pm, pn, z; };

__device__ __forceinline__ void tile_decode(int wgid, int nM, int nN, int& pm, int& pn) {
    const int nwg = nM * nN;
    { const int q = nwg / NXCD, r = nwg % NXCD, xcd = wgid % NXCD, off = wgid / NXCD; wgid = (xcd < r ? xcd * (q + 1) : r * (q + 1) + (xcd - r) * q) + off; }
    const int nig = WGM * nN, gid = wgid / nig, fm = gid * WGM, gsz = (nM - fm) < WGM ? (nM - fm) : WGM;
    pm = fm + ((wgid % nig) % gsz); pn = (wgid % nig) / gsz;
}
struct Sched {
    const char *A0, *B0, *A1, *B1; int nM0, nN0, n0, nM1, n1; size_t tA, tB, bstride; int G, c;
    __device__ __forceinline__ bool next(int i, Unit& u) const {
        int L = i * G + c;
        if (L < n0) { tile_decode(L, nM0, nN0, u.pm, u.pn); u.z = 0; return true; }
        L -= n0; if (L < n1) { u.pm = L % nM1; u.pn = L / nM1; u.z = 1; return true; }
        return false;
    }
    __device__ __forceinline__ const char* abase(const Unit& u) const { return (u.z ? A1 : A0) + (size_t)u.pm * tA; }
    __device__ __forceinline__ const char* bbase(const Unit& u) const { return (u.z ? B1 : B0) + (size_t)u.pn * tB + (bstride ? (size_t)batch_of_pm(u.pm) * bstride : (size_t)0); }
};
struct PreSched {
    const char *Kb, *Vb, *Wmq, *Wmo; int G, c;
    __device__ __forceinline__ bool next(int i, Unit& u) const { const int L = i * G + c; if (L >= 384) return false; u.z = L / 8; const int t = L & 7; if (u.z < 24) { u.pm = 0; u.pn = t; } else { u.pm = t; u.pn = 0; } return true; }
    __device__ __forceinline__ const char* abase(const Unit& u) const { const int zz = u.z % 24, b = zz >> 2, h = zz & 3;
        return u.z < 24 ? Kb + ((size_t)(b * 256) * DM + h * 512) * 2 : Wmo + ((size_t)(u.pm * 256) * DM + h * 512) * 2; }
    __device__ __forceinline__ const char* bbase(const Unit& u) const { const int zz = u.z % 24, b = zz >> 2, h = zz & 3;
        return u.z < 24 ? Wmq + ((size_t)(u.pn * 256) * DM + h * 512) * 2 : Vb + ((size_t)(b * 256) * DM + h * 512) * 2; }
};

template <class Epi, class SchedT, bool ALIGN_EPI, bool SP2>
__device__ __forceinline__ void gemm_phase(LAS unsigned char* lds, const int widk, const int K, const int ld, const SchedT& S, const Epi& E) {
    const int tid = tid_l(widk), wid = __builtin_amdgcn_readfirstlane(tid >> 6), lane = tid & 63, wr = wid >> 2, wc = wid & 3, fr = lane & 15, fq = lane >> 4;
    const int nt = K / BK;
    unsigned voffA[2], voffB[2];
#pragma unroll
    for (int i = 0; i < 2; ++i) { int R, C; stage_rc(tid * 16 + i * 8192, R, C); const int Rb = Epi::PERM ? ((R & ~31) + perm32(R & 31)) : R;
        voffA[i] = (unsigned)(R * ld + C) * 2u; voffB[i] = (unsigned)(Rb * ld + C) * 2u; }
    const size_t kstep = (size_t)(BK * 2);
    const size_t hstep = (size_t)HALF * ld * 2;
    const unsigned ldsw = (unsigned)wid * 1024u;
    const int aoff = lds_byte(wr * 64 + fr, fq * 8), boff = lds_byte(wc * 32 + fr, fq * 8);
#define PG8_SA(b, h) (((b) * 2 + (h)) * HTB)
#define PG8_SB(b, h) ((4 + (b) * 2 + (h)) * HTB)
#define PG8_STAGE(bufoff, gbase, voff) do { _Pragma("unroll") for (int _i = 0; _i < 2; ++_i) \
        __builtin_amdgcn_global_load_lds((const unsigned*)((const char*)(gbase) + (voff)[_i]), (LAS unsigned*)(lds + (bufoff) + ldsw + _i * 8192), 16, 0, 0); } while (0)
#define PG8_LDA(dst, b, h) do { _Pragma("unroll") for (int m = 0; m < 4; ++m) _Pragma("unroll") for (int k = 0; k < 2; ++k) dst[m][k] = *(const LAS bf16x8*)(lds + PG8_SA(b, h) + aoff + m * 2048 + k * 1024); } while (0)
#define PG8_LDB(dst, b, h) do { _Pragma("unroll") for (int n = 0; n < 2; ++n) _Pragma("unroll") for (int k = 0; k < 2; ++k) dst[n][k] = *(const LAS bf16x8*)(lds + PG8_SB(b, h) + boff + n * 2048 + k * 1024); } while (0)
#define PG8_MMA(ai, bj, At, Bt) do { __builtin_amdgcn_s_setprio(1); _Pragma("unroll") for (int m = 0; m < 4; ++m) _Pragma("unroll") for (int n = 0; n < 2; ++n) _Pragma("unroll") for (int k = 0; k < 2; ++k) \
        acc[ai][bj][m][n] = __builtin_amdgcn_mfma_f32_16x16x32_bf16(Bt[n][k], At[m][k], acc[ai][bj][m][n], 0, 0, 0); __builtin_amdgcn_s_setprio(0); } while (0)
#define PG8_WAIT_V(n) asm volatile("s_waitcnt vmcnt(" #n ")" ::: "memory")
#define PG8_WAIT_L(n) asm volatile("s_waitcnt lgkmcnt(" #n ")" ::: "memory")
#define PG8_BAR __builtin_amdgcn_s_barrier()
#define PG8_SCHED __builtin_amdgcn_sched_barrier(0)
    Unit cur, nxt; int ui = 0;
    if (!S.next(0, cur)) return;
    f32x4 acc[2][2][4][2];
#pragma unroll
    for (int a = 0; a < 2; ++a)
#pragma unroll
        for (int b = 0; b < 2; ++b)
#pragma unroll
            for (int m = 0; m < 4; ++m)
#pragma unroll
                for (int n = 0; n < 2; ++n) acc[a][b][m][n] = (f32x4){0.f, 0.f, 0.f, 0.f};
    bf16x8 At[4][2], B0[2][2], B1[2][2];
    const char* cA = S.abase(cur); const char* cB = S.bbase(cur);
    if constexpr (SP2) {
        PG8_STAGE(PG8_SB(0, 0), cB, voffB); PG8_STAGE(PG8_SB(0, 1), cB + hstep, voffB); PG8_STAGE(PG8_SA(0, 0), cA, voffA); PG8_STAGE(PG8_SA(0, 1), cA + hstep, voffA);
        if (wr == 1) PG8_BAR;
        PG8_WAIT_V(2); PG8_BAR;
        PG8_STAGE(PG8_SB(1, 0), cB + kstep, voffB); PG8_STAGE(PG8_SA(1, 0), cA + kstep, voffA); PG8_STAGE(PG8_SB(1, 1), cB + hstep + kstep, voffB);
        PG8_WAIT_V(6); PG8_BAR;
    } else {
        PG8_STAGE(PG8_SB(0, 0), cB, voffB); PG8_STAGE(PG8_SA(0, 0), cA, voffA); PG8_STAGE(PG8_SB(0, 1), cB + hstep, voffB); PG8_STAGE(PG8_SA(0, 1), cA + hstep, voffA);
        if (wr == 1) PG8_BAR;
        PG8_WAIT_V(4); PG8_BAR;
        PG8_STAGE(PG8_SB(1, 0), cB + kstep, voffB); PG8_STAGE(PG8_SA(1, 0), cA + kstep, voffA); PG8_STAGE(PG8_SB(1, 1), cB + hstep + kstep, voffB);
        PG8_WAIT_V(6); PG8_BAR;
    }
    for (;;) {
        const bool has_next = S.next(ui + 1, nxt);
        const char* nA = has_next ? S.abase(nxt) : cA; const char* nB = has_next ? S.bbase(nxt) : cB;
        for (int t = 0; t < nt; t += 2) {
            const bool last = (t == nt - 2);
            const char* a1 = cA + (size_t)(t + 1) * kstep;
            const char* a2 = last ? nA : cA + (size_t)(t + 2) * kstep; const char* b2 = last ? nB : cB + (size_t)(t + 2) * kstep;
            const char* a3 = a2 + kstep; const char* b3 = b2 + kstep;
            if constexpr (SP2) {
            PG8_LDB(B0, 0, 0); PG8_LDB(B1, 0, 1); PG8_SCHED; PG8_LDA(At, 0, 0); PG8_STAGE(PG8_SA(1, 1), a1 + hstep, voffA);
            PG8_WAIT_V(8); PG8_WAIT_L(0); PG8_BAR; PG8_MMA(0, 0, At, B0); PG8_MMA(0, 1, At, B1); PG8_BAR; PG8_SCHED;
            PG8_LDA(At, 0, 1); PG8_STAGE(PG8_SB(0, 0), b2, voffB); PG8_STAGE(PG8_SB(0, 1), b2 + hstep, voffB); PG8_STAGE(PG8_SA(0, 0), a2, voffA);
            PG8_WAIT_V(8); PG8_WAIT_L(0); PG8_BAR; PG8_MMA(1, 0, At, B0); PG8_MMA(1, 1, At, B1); PG8_BAR; PG8_SCHED;
            PG8_LDB(B0, 1, 0); PG8_LDB(B1, 1, 1); PG8_SCHED; PG8_LDA(At, 1, 0); PG8_STAGE(PG8_SA(0, 1), a2 + hstep, voffA);
            PG8_WAIT_V(8); PG8_WAIT_L(0); PG8_BAR; PG8_MMA(0, 0, At, B0); PG8_MMA(0, 1, At, B1); PG8_BAR; PG8_SCHED;
            PG8_LDA(At, 1, 1); PG8_STAGE(PG8_SB(1, 0), b3, voffB); PG8_STAGE(PG8_SB(1, 1), b3 + hstep, voffB); PG8_STAGE(PG8_SA(1, 0), a3, voffA);
            PG8_WAIT_V(8); PG8_WAIT_L(0); PG8_BAR; PG8_MMA(1, 0, At, B0); PG8_MMA(1, 1, At, B1); PG8_BAR; PG8_SCHED;
            } else {
            PG8_LDB(B0, 0, 0); PG8_SCHED; PG8_LDA(At, 0, 0); PG8_STAGE(PG8_SA(1, 1), a1 + hstep, voffA);
            PG8_WAIT_L(8); PG8_BAR; PG8_WAIT_L(0); PG8_MMA(0, 0, At, B0); PG8_BAR; PG8_SCHED;
            PG8_LDB(B1, 0, 1); PG8_STAGE(PG8_SB(0, 0), b2, voffB);
            PG8_BAR; PG8_WAIT_L(0); PG8_MMA(0, 1, At, B1); PG8_BAR;
            PG8_LDA(At, 0, 1); PG8_STAGE(PG8_SA(0, 0), a2, voffA);
            PG8_BAR; PG8_WAIT_L(0); PG8_MMA(1, 0, At, B0); PG8_BAR; PG8_SCHED;
            PG8_STAGE(PG8_SB(0, 1), b2 + hstep, voffB);
            PG8_WAIT_V(6); PG8_BAR; PG8_MMA(1, 1, At, B1); PG8_BAR;
            PG8_LDB(B0, 1, 0); PG8_SCHED; PG8_LDA(At, 1, 0); PG8_STAGE(PG8_SA(0, 1), a2 + hstep, voffA);
            PG8_WAIT_L(8); PG8_BAR; PG8_WAIT_L(0); PG8_MMA(0, 0, At, B0); PG8_BAR; PG8_SCHED;
            PG8_LDB(B1, 1, 1); PG8_STAGE(PG8_SB(1, 0), b3, voffB);
            PG8_BAR; PG8_WAIT_L(0); PG8_MMA(0, 1, At, B1); PG8_BAR;
            PG8_LDA(At, 1, 1); PG8_STAGE(PG8_SA(1, 0), a3, voffA);
            PG8_BAR; PG8_WAIT_L(0); PG8_MMA(1, 0, At, B0); PG8_BAR; PG8_SCHED;
            PG8_STAGE(PG8_SB(1, 1), b3 + hstep, voffB);
            PG8_WAIT_V(6); PG8_BAR; PG8_MMA(1, 1, At, B1); PG8_BAR;
            }
        }
        if constexpr (ALIGN_EPI) { if (wr == 0) PG8_BAR; }
        E(acc, cur, wr, wc, fr, fq);
        if (!has_next) break;
#pragma unroll
        for (int a = 0; a < 2; ++a)
#pragma unroll
            for (int b = 0; b < 2; ++b)
#pragma unroll
                for (int m = 0; m < 4; ++m)
#pragma unroll
                    for (int n = 0; n < 2; ++n) acc[a][b][m][n] = (f32x4){0.f, 0.f, 0.f, 0.f};
        cur = nxt; cA = nA; cB = nB; ++ui;
        if constexpr (ALIGN_EPI) { if (wr == 1) PG8_BAR; }
    }
    PG8_WAIT_V(0);
    if constexpr (!ALIGN_EPI) { if (wr == 0) PG8_BAR; }
    PG8_BAR;
#undef PG8_SA
#undef PG8_SB
#undef PG8_STAGE
#undef PG8_LDA
#undef PG8_LDB
#undef PG8_MMA
#undef PG8_WAIT_V
#undef PG8_WAIT_L
#undef PG8_BAR
#undef PG8_SCHED
}

typedef const f32x4 (&AccRef)[2][2][4][2];

__device__ __forceinline__ float row_rs(const float* ss, int row) {
    const f32x4* p = (const f32x4*)(ss + (size_t)row * 32); float s = 0.f;
#pragma unroll
    for (int i = 0; i < 8; ++i) { const f32x4 v = p[i]; s += (v[0] + v[1]) + (v[2] + v[3]); }
    return __builtin_amdgcn_rsqf(s * (1.0f / DM) + RMS_EPS);
}

struct EpiInProj {
    static constexpr bool PERM = true;
    bf16_t* proj; bf16_t* kb; bf16_t* vb; const float* rs0; const f32x2* rope;
    __device__ __forceinline__ void operator()(AccRef acc, const Unit& u, int wr, int wc, int fr, int fq) const {
        const int row0 = u.pm * BM + wr * 64 + fr;
        if (u.z == 1) {
            bf16_t* base = (u.pn < 8 ? kb : vb) + (u.pn & 7) * BM + wc * 32 + 8 * fq;
#pragma unroll
            for (int ai = 0; ai < 2; ++ai)
#pragma unroll
                for (int m = 0; m < 4; ++m) { bf16_t* rowp = base + (size_t)(row0 + ai * HALF + m * 16) * DM;
#pragma unroll
                    for (int bj = 0; bj < 2; ++bj) { const f32x4 v0 = acc[ai][bj][m][0], v1 = acc[ai][bj][m][1]; u32x4 w;
                        w.x = cvt_pk_bf16(v0[0], v0[1]); w.y = cvt_pk_bf16(v0[2], v0[3]); w.z = cvt_pk_bf16(v1[0], v1[1]); w.w = cvt_pk_bf16(v1[2], v1[3]);
                        *(u32x4*)(rowp + bj * HALF) = w; } }
            return;
        }
        const int pn = u.pn; const bool rp = (pn >= 12 && pn < 20);
        const float sc = pn < 4 ? NA_QS : ((pn >= 12 && pn < 16) ? DF_QS : 1.0f);
        if (!rp) {
            bf16_t* base = proj + pn * BM + wc * 32 + 8 * fq;
#pragma unroll
            for (int ai = 0; ai < 2; ++ai)
#pragma unroll
                for (int m = 0; m < 4; ++m) { const int row = row0 + ai * HALF + m * 16; const float rr = rs0[row] * sc; bf16_t* rowp = base + (size_t)row * INW;
#pragma unroll
                    for (int bj = 0; bj < 2; ++bj) { const f32x4 v0 = acc[ai][bj][m][0] * rr, v1 = acc[ai][bj][m][1] * rr; u32x4 w;
                        w.x = cvt_pk_bf16(v0[0], v0[1]); w.y = cvt_pk_bf16(v0[2], v0[3]); w.z = cvt_pk_bf16(v1[0], v1[1]); w.w = cvt_pk_bf16(v1[2], v1[3]);
                        *(u32x4*)(rowp + bj * HALF) = w; } }
        } else {
            const int dd0 = 16 * (wc & 1) + 4 * fq;
            bf16_t* base = proj + pn * BM + (wc >> 1) * 64 + dd0;
#pragma unroll
            for (int ai = 0; ai < 2; ++ai)
#pragma unroll
                for (int m = 0; m < 4; ++m) { const int row = row0 + ai * HALF + m * 16; const float rr = rs0[row] * sc; bf16_t* rowp = base + (size_t)row * INW;
                    const int t = row < NP ? (row & (TP - 1)) : (row & (TS - 1));
                    const f32x4 cs0 = *(const f32x4*)(rope + (size_t)t * 32 + dd0), cs1 = *(const f32x4*)(rope + (size_t)t * 32 + dd0 + 2);
#pragma unroll
                    for (int bj = 0; bj < 2; ++bj) { const f32x4 x1 = acc[ai][bj][m][0] * rr, x2 = acc[ai][bj][m][1] * rr;
                        const float a0 = x1[0] * cs0[0] - x2[0] * cs0[1], a1 = x1[1] * cs0[2] - x2[1] * cs0[3], a2 = x1[2] * cs1[0] - x2[2] * cs1[1], a3 = x1[3] * cs1[2] - x2[3] * cs1[3];
                        const float b0 = x2[0] * cs0[0] + x1[0] * cs0[1], b1 = x2[1] * cs0[2] + x1[1] * cs0[3], b2 = x2[2] * cs1[0] + x1[2] * cs1[1], b3 = x2[3] * cs1[2] + x1[3] * cs1[3];
                        u32x2 wa, wb; wa.x = cvt_pk_bf16(a0, a1); wa.y = cvt_pk_bf16(a2, a3); wb.x = cvt_pk_bf16(b0, b1); wb.y = cvt_pk_bf16(b2, b3);
                        *(u32x2*)(rowp + bj * HALF) = wa; *(u32x2*)(rowp + bj * HALF + 32) = wb; } }
        }
    }
};
struct EpiPre {
    static constexpr bool PERM = true;
    bf16_t* wqk; bf16_t* wvo;
    __device__ __forceinline__ void operator()(AccRef acc, const Unit& u, int wr, int wc, int fr, int fq) const {
        const int zz = u.z % 24, b = zz >> 2, h = zz & 3; bf16_t* base; int ldc; float sc;
        if (u.z < 24) { base = wqk + ((size_t)(b * 1024 + h * 256)) * DM + u.pn * BM; ldc = DM; sc = MEM_QS; }
        else { base = wvo + ((size_t)(b * 2048 + u.pm * BM)) * NSW + h * 256; ldc = NSW; sc = 1.0f; }
        base += wc * 32 + 8 * fq;
#pragma unroll
        for (int ai = 0; ai < 2; ++ai)
#pragma unroll
            for (int m = 0; m < 4; ++m) { bf16_t* rowp = base + (size_t)(wr * 64 + fr + ai * HALF + m * 16) * ldc;
#pragma unroll
                for (int bj = 0; bj < 2; ++bj) { const f32x4 v0 = acc[ai][bj][m][0] * sc, v1 = acc[ai][bj][m][1] * sc; u32x4 w;
                    w.x = cvt_pk_bf16(v0[0], v0[1]); w.y = cvt_pk_bf16(v0[2], v0[3]); w.z = cvt_pk_bf16(v1[0], v1[1]); w.w = cvt_pk_bf16(v1[2], v1[3]);
                    *(u32x4*)(rowp + bj * HALF) = w; } }
    }
};
__device__ __forceinline__ float row_rs4(const float* ss, int row, int fq) {
    const f32x4* p = (const f32x4*)(ss + (size_t)row * 32 + fq * 8); const f32x4 a = p[0], b = p[1];
    float s = ((a[0] + a[1]) + (a[2] + a[3])) + ((b[0] + b[1]) + (b[2] + b[3]));
    s += __shfl_xor(s, 16); s += __shfl_xor(s, 32);
    return __builtin_amdgcn_rsqf(s * (1.0f / DM) + RMS_EPS);
}
struct EpiResid {
    static constexpr bool PERM = false;
    const float* basef; const bf16_t* baseb; bf16_t* ob; int ldo; float* ss;
    __device__ __forceinline__ void operator()(AccRef acc, const Unit& u, int wr, int wc, int fr, int fq) const {
        const int col0 = u.pn * BM + wc * 32 + 4 * fq;
#pragma unroll
        for (int ai = 0; ai < 2; ++ai)
#pragma unroll
            for (int m = 0; m < 4; ++m) { const int row = u.pm * BM + ai * HALF + wr * 64 + m * 16 + fr; const size_t off = (size_t)row * DM + col0; bf16_t* orow = ob + (size_t)row * ldo + col0; float q = 0.f;
#pragma unroll
                for (int bj = 0; bj < 2; ++bj)
#pragma unroll
                    for (int n = 0; n < 2; ++n) { const int o2 = bj * HALF + n * 16; f32x4 bv;
                        if (baseb) { const u32x2 w = *(const u32x2*)(baseb + off + o2); bv = (f32x4){__uint_as_float(w.x << 16), __uint_as_float(w.x & 0xffff0000u), __uint_as_float(w.y << 16), __uint_as_float(w.y & 0xffff0000u)}; }
                        else bv = *(const f32x4*)(basef + off + o2);
                        const f32x4 o = bv + acc[ai][bj][m][n]; q += (o[0] * o[0] + o[1] * o[1]) + (o[2] * o[2] + o[3] * o[3]);
                        u32x2 w2; w2.x = cvt_pk_bf16(o[0], o[1]); w2.y = cvt_pk_bf16(o[2], o[3]); *(u32x2*)(orow + o2) = w2; }
                q += __shfl_xor(q, 16); q += __shfl_xor(q, 32);
                if (fq == 0) ss[(size_t)row * 32 + u.pn * 4 + wc] = q; }
    }
};
struct EpiX { static constexpr bool PERM = false; const float* xp; const float* xs; bf16_t* ob; float* ss;
    __device__ __forceinline__ void operator()(AccRef acc, const Unit& u, int wr, int wc, int fr, int fq) const {
        const float* base = (u.pm < NP / 256) ? xp : xs - (size_t)NP * DM; EpiResid E{base, nullptr, ob, DM, ss}; E(acc, u, wr, wc, fr, fq); } };
struct EpiS {
    static constexpr bool PERM = false;
    float* S; const float* ss;
    __device__ __forceinline__ void operator()(AccRef acc, const Unit& u, int wr, int wc, int fr, int fq) const {
        const int col0 = u.pn * BM + wc * 32 + 4 * fq;
#pragma unroll
        for (int ai = 0; ai < 2; ++ai)
#pragma unroll
            for (int m = 0; m < 4; ++m) { const int row = u.pm * BM + ai * HALF + wr * 64 + m * 16 + fr; const float rr = row_rs4(ss, row, fq); float* rowp = S + (size_t)row * NSW + col0;
#pragma unroll
                for (int bj = 0; bj < 2; ++bj)
#pragma unroll
                    for (int n = 0; n < 2; ++n) *(f32x4*)(rowp + bj * HALF + n * 16) = acc[ai][bj][m][n] * rr; }
    }
};
struct EpiGU {
    static constexpr bool PERM = true;
    bf16_t* act; const float* ss;
    __device__ __forceinline__ void operator()(AccRef acc, const Unit& u, int wr, int wc, int fr, int fq) const {
        bf16_t* base = act + u.pn * HALF + wc * 32 + 8 * fq;
#pragma unroll
        for (int ai = 0; ai < 2; ++ai)
#pragma unroll
            for (int m = 0; m < 4; ++m) { const int row = u.pm * BM + ai * HALF + wr * 64 + m * 16 + fr; const float rr = row_rs4(ss, row, fq); float o[8];
#pragma unroll
                for (int n = 0; n < 2; ++n)
#pragma unroll
                    for (int e = 0; e < 4; ++e) { const float g = acc[ai][0][m][n][e] * rr, up = acc[ai][1][m][n][e] * rr;
                        o[n * 4 + e] = g * __builtin_amdgcn_rcpf(1.0f + __builtin_amdgcn_exp2f(-g * LOG2E)) * up; }
                u32x4 w; w.x = cvt_pk_bf16(o[0], o[1]); w.y = cvt_pk_bf16(o[2], o[3]); w.z = cvt_pk_bf16(o[4], o[5]); w.w = cvt_pk_bf16(o[6], o[7]);
                *(u32x4*)(base + (size_t)row * DFF) = w; }
    }
};
}

namespace att {
#define SBAR() __builtin_amdgcn_sched_barrier(0)
constexpr float THR = 8.0f;
constexpr int SHM_V = 16384, SHM_K = 16384, OFF_K = 2 * SHM_V, OFF_WS = OFF_K + 2 * SHM_K, OFF_RPB = OFF_WS + 8 * 256, OFF_STG = OFF_RPB + 2048, OFF_END = OFF_STG + 8 * 8192;
constexpr int DF_R = 5, DF_D = 4;
constexpr int DF_K = DF_R * SHM_V, DF_KSZ = 8192, DF_WS = DF_K + DF_R * DF_KSZ, DF_STG = 0  , DF_END = DF_WS + 8 * 256;
static_assert(8 * 8192 <= DF_K, "output stage fits inside the V ring");
static_assert(DF_END <= 147456 && OFF_END <= 147456, "attention LDS maps fit the dynamic LDS allocation");
__device__ __forceinline__ int crow(int r, int hi) { return (r & 3) + 8 * (r >> 2) + 4 * hi; }
#define KSWZ128(row, colB) ((row) * 256 + ((colB) ^ (((row) & 7) << 4)))
#define KSWZ64(row, colB) ((row) * 128 + ((colB) ^ ((((row) >> 1) & 7) << 4)))
__device__ __forceinline__ int v_st(int k, int c) { const int kk = (k & ~0xC) | ((k & 4) << 1) | ((k & 8) >> 1); return ((kk >> 3) * 4 + (c >> 5)) * 512 + ((kk & 7) * 32 + (c & 31)) * 2; }
__device__ __forceinline__ int v_rd_base(int lane) { return ((lane & 3) << 3) | (((lane >> 2) & 3) << 6) | (((lane >> 4) & 1) << 5) | (((lane >> 5) & 1) << 8); }
constexpr int v_rd_off(int d0, int ks, int half) { return d0 * 512 + ks * 4096 + half * 2048; }
template <int OFF> __device__ __forceinline__ s16x4 tr_read(int vb) { s16x4 r; asm volatile("ds_read_b64_tr_b16 %0, %1 offset:%2" : "=&v"(r) : "v"(vb), "i"(OFF) : "memory"); return r; }
template <int D0> __device__ __forceinline__ void pv_one(f32x16& od, int vb, bf16x8 pa0, bf16x8 pa1, bf16x8 pa2, bf16x8 pa3) {
    const s16x4 l0 = tr_read<v_rd_off(D0, 0, 0)>(vb), h0 = tr_read<v_rd_off(D0, 0, 1)>(vb), l1 = tr_read<v_rd_off(D0, 1, 0)>(vb), h1 = tr_read<v_rd_off(D0, 1, 1)>(vb);
    const s16x4 l2 = tr_read<v_rd_off(D0, 2, 0)>(vb), h2 = tr_read<v_rd_off(D0, 2, 1)>(vb), l3 = tr_read<v_rd_off(D0, 3, 0)>(vb), h3 = tr_read<v_rd_off(D0, 3, 1)>(vb);
    asm volatile("s_waitcnt lgkmcnt(0)" ::: "memory"); SBAR();
#define PK(L, H) (bf16x8){L[0], L[1], L[2], L[3], H[0], H[1], H[2], H[3]}
    od = __builtin_amdgcn_mfma_f32_32x32x16_bf16(pa0, PK(l0, h0), od, 0, 0, 0);
    od = __builtin_amdgcn_mfma_f32_32x32x16_bf16(pa1, PK(l1, h1), od, 0, 0, 0);
    od = __builtin_amdgcn_mfma_f32_32x32x16_bf16(pa2, PK(l2, h2), od, 0, 0, 0);
    od = __builtin_amdgcn_mfma_f32_32x32x16_bf16(pa3, PK(l3, h3), od, 0, 0, 0);
#undef PK
}
template <int D0> __device__ __forceinline__ void pv_rd(s16x4 (&L)[4], s16x4 (&H)[4], int vb) {
    L[0] = tr_read<v_rd_off(D0, 0, 0)>(vb); H[0] = tr_read<v_rd_off(D0, 0, 1)>(vb); L[1] = tr_read<v_rd_off(D0, 1, 0)>(vb); H[1] = tr_read<v_rd_off(D0, 1, 1)>(vb);
    L[2] = tr_read<v_rd_off(D0, 2, 0)>(vb); H[2] = tr_read<v_rd_off(D0, 2, 1)>(vb); L[3] = tr_read<v_rd_off(D0, 3, 0)>(vb); H[3] = tr_read<v_rd_off(D0, 3, 1)>(vb);
}
#define PV_PK(L, H) (bf16x8){L[0], L[1], L[2], L[3], H[0], H[1], H[2], H[3]}
#define PV_MMA(od, L, H) do { od = __builtin_amdgcn_mfma_f32_32x32x16_bf16(pa0, PV_PK(L[0], H[0]), od, 0, 0, 0); od = __builtin_amdgcn_mfma_f32_32x32x16_bf16(pa1, PV_PK(L[1], H[1]), od, 0, 0, 0); \
    od = __builtin_amdgcn_mfma_f32_32x32x16_bf16(pa2, PV_PK(L[2], H[2]), od, 0, 0, 0); od = __builtin_amdgcn_mfma_f32_32x32x16_bf16(pa3, PV_PK(L[3], H[3]), od, 0, 0, 0); } while (0)
__device__ __forceinline__ void pv_all_pre(f32x16* o, int vb, bf16x8 pa0, bf16x8 pa1, bf16x8 pa2, bf16x8 pa3) {
    s16x4 L0[4], H0[4], L1[4], H1[4], L2[4], H2[4], L3[4], H3[4];
    pv_rd<0>(L0, H0, vb); pv_rd<1>(L1, H1, vb);
    asm volatile("s_waitcnt lgkmcnt(8)" ::: "memory"); SBAR(); PV_MMA(o[0], L0, H0); SBAR();
    pv_rd<2>(L2, H2, vb);
    asm volatile("s_waitcnt lgkmcnt(8)" ::: "memory"); SBAR(); PV_MMA(o[1], L1, H1); SBAR();
    pv_rd<3>(L3, H3, vb);
    asm volatile("s_waitcnt lgkmcnt(8)" ::: "memory"); SBAR(); PV_MMA(o[2], L2, H2); SBAR();
    asm volatile("s_waitcnt lgkmcnt(0)" ::: "memory"); SBAR(); PV_MMA(o[3], L3, H3); SBAR();
}
__device__ __forceinline__ void pv_all(f32x16* o, int vb, bf16x8 pa0, bf16x8 pa1, bf16x8 pa2, bf16x8 pa3) {
    pv_one<0>(o[0], vb, pa0, pa1, pa2, pa3); pv_one<1>(o[1], vb, pa0, pa1, pa2, pa3); pv_one<2>(o[2], vb, pa0, pa1, pa2, pa3); pv_one<3>(o[3], vb, pa0, pa1, pa2, pa3);
}
__device__ __forceinline__ void softmax_tile(f32x16& p0, f32x16& p1, float& m_reg, float& l_reg, float& alpha, bf16x8& pa0, bf16x8& pa1, bf16x8& pa2, bf16x8& pa3) {
    float pmax = p0[0];
#pragma unroll
    for (int r = 1; r < 16; ++r) pmax = fmaxf(pmax, p0[r]);
#pragma unroll
    for (int r = 0; r < 16; ++r) pmax = fmaxf(pmax, p1[r]);
    { auto rr = __builtin_amdgcn_permlane32_swap(__float_as_uint(pmax), __float_as_uint(pmax), false, false); pmax = fmaxf(__uint_as_float(rr[0]), __uint_as_float(rr[1])); }
    float mn;
    if (__builtin_expect(__all(pmax - m_reg <= THR), 1)) { mn = m_reg; alpha = 1.f; }
    else { mn = fmaxf(m_reg, pmax); alpha = __builtin_amdgcn_exp2f(m_reg - mn); m_reg = mn; }
#pragma unroll
    for (int r = 0; r < 16; ++r) { p0[r] = __builtin_amdgcn_exp2f(p0[r] - mn); p1[r] = __builtin_amdgcn_exp2f(p1[r] - mn); }
    float ps = 0.f;
#pragma unroll
    for (int r = 0; r < 16; ++r) ps += p0[r];
#pragma unroll
    for (int r = 0; r < 16; ++r) ps += p1[r];
    { auto rr = __builtin_amdgcn_permlane32_swap(__float_as_uint(ps), __float_as_uint(ps), false, false); ps = __uint_as_float(rr[0]) + __uint_as_float(rr[1]); }
    l_reg = l_reg * alpha + ps;
#define PK4(P, BASE, OUT) do { unsigned a0 = cvt_pk_bf16(P[BASE + 0], P[BASE + 1]), a1 = cvt_pk_bf16(P[BASE + 2], P[BASE + 3]);   \
    unsigned b0 = cvt_pk_bf16(P[BASE + 4], P[BASE + 5]), b1 = cvt_pk_bf16(P[BASE + 6], P[BASE + 7]);                              \
    auto r0 = __builtin_amdgcn_permlane32_swap(a0, b0, false, false); auto r1 = __builtin_amdgcn_permlane32_swap(a1, b1, false, false); \
    u32x4 w = {r0[0], r1[0], r0[1], r1[1]}; OUT = __builtin_bit_cast(bf16x8, w); } while (0)
    PK4(p0, 0, pa0); PK4(p0, 8, pa1); PK4(p1, 0, pa2); PK4(p1, 8, pa3);
#undef PK4
}
__device__ __forceinline__ void softmax_rel(f32x16& p0, f32x16& p1, float& m_reg, float& l_reg, f32x16& negm, float& alpha, bool first, bf16x8& pa0, bf16x8& pa1, bf16x8& pa2, bf16x8& pa3) {
    float ma = __builtin_fmaxf(__builtin_fmaxf(p0[0], p0[1]), p0[2]), mb = __builtin_fmaxf(__builtin_fmaxf(p0[8], p0[9]), p0[10]);
    float mc = __builtin_fmaxf(__builtin_fmaxf(p1[0], p1[1]), p1[2]), md = __builtin_fmaxf(__builtin_fmaxf(p1[8], p1[9]), p1[10]);
    ma = __builtin_fmaxf(__builtin_fmaxf(ma, p0[3]), p0[4]); mb = __builtin_fmaxf(__builtin_fmaxf(mb, p0[11]), p0[12]); mc = __builtin_fmaxf(__builtin_fmaxf(mc, p1[3]), p1[4]); md = __builtin_fmaxf(__builtin_fmaxf(md, p1[11]), p1[12]);
    ma = __builtin_fmaxf(__builtin_fmaxf(ma, p0[5]), p0[6]); mb = __builtin_fmaxf(__builtin_fmaxf(mb, p0[13]), p0[14]); mc = __builtin_fmaxf(__builtin_fmaxf(mc, p1[5]), p1[6]); md = __builtin_fmaxf(__builtin_fmaxf(md, p1[13]), p1[14]);
    ma = __builtin_fmaxf(__builtin_fmaxf(ma, p0[7]), mb); mc = __builtin_fmaxf(__builtin_fmaxf(mc, p1[7]), md);
    float pmax = __builtin_fmaxf(__builtin_fmaxf(ma, p0[15]), __builtin_fmaxf(mc, p1[15]));
    { auto rr = __builtin_amdgcn_permlane32_swap(__float_as_uint(pmax), __float_as_uint(pmax), false, false); pmax = __builtin_fmaxf(__uint_as_float(rr[0]), __uint_as_float(rr[1])); }
    alpha = 1.f;
    if (__builtin_expect(first || !__all(pmax <= THR), 0)) {
        const float dl = first ? pmax : fmaxf(pmax, 0.f);
        m_reg += dl; alpha = first ? 1.f : __builtin_amdgcn_exp2f(-dl);
#pragma unroll
        for (int r = 0; r < 16; ++r) { p0[r] -= dl; p1[r] -= dl; negm[r] = -m_reg; }
    }
#pragma unroll
    for (int r = 0; r < 16; ++r) { p0[r] = __builtin_amdgcn_exp2f(p0[r]); p1[r] = __builtin_amdgcn_exp2f(p1[r]); }
    float ps0 = p0[0], ps1 = p1[0], ps2 = p0[8], ps3 = p1[8];
#pragma unroll
    for (int r = 1; r < 8; ++r) { ps0 += p0[r]; ps1 += p1[r]; ps2 += p0[8 + r]; ps3 += p1[8 + r]; }
    l_reg = l_reg * alpha + ((ps0 + ps1) + (ps2 + ps3));
#define PK4N(P, BASE, OUT) do { u32x4 w = {cvt_pk_bf16(P[BASE + 0], P[BASE + 1]), cvt_pk_bf16(P[BASE + 2], P[BASE + 3]), cvt_pk_bf16(P[BASE + 4], P[BASE + 5]), cvt_pk_bf16(P[BASE + 6], P[BASE + 7])}; \
    OUT = __builtin_bit_cast(bf16x8, w); } while (0)
    PK4N(p0, 0, pa0); PK4N(p0, 8, pa1); PK4N(p1, 0, pa2); PK4N(p1, 8, pa3);
#undef PK4N
}
#define ATT_RESC2(a) do { if (__any((a) < 1.f)) { if (hi == 0) al_l[r32] = (a); asm volatile("s_waitcnt lgkmcnt(0)" ::: "memory"); \
    _Pragma("unroll") for (int r = 0; r < 16; ++r) { const float f_ = al_l[crow(r, hi)]; o[0][r] *= f_; o[1][r] *= f_; o[2][r] *= f_; o[3][r] *= f_; } } } while (0)
#define ATT_RESC(a) do { if (__any((a) < 1.f)) { if (hi == 0) al_l[r32] = (a); asm volatile("s_waitcnt lgkmcnt(0)" ::: "memory"); \
    _Pragma("unroll") for (int d = 0; d < 4; ++d) _Pragma("unroll") for (int r = 0; r < 16; ++r) o[d][r] *= al_l[crow(r, hi)]; } } while (0)

__device__ __forceinline__ void diff_unit(const bf16_t* __restrict__ proj, bf16_t* __restrict__ mix, float* __restrict__ o1s, const float* __restrict__ g_sub, float lam,
                                          int rowbase, int T, int h, int qb, char* lds, int widk) {
    const int tid = tid_l(widk), wid = tid >> 6, lane = tid & 63, r32 = lane & 31, hi = lane >> 5;
    char* V_lds = lds; char* K_lds = lds + DF_K;
    float* wsf = (float*)(lds + DF_WS) + wid * 64; float* li_l = wsf; float* al_l = wsf + 32;
    LAS unsigned char* ldsl = (LAS unsigned char*)lds; const int widu = __builtin_amdgcn_readfirstlane(wid);
    unsigned kgo, vgo[2];
    { const int X = wid * 1024 + lane * 16, krow = X >> 7, kcolB = (X & 127) ^ (((krow >> 1) & 7) << 4); kgo = (unsigned)(krow * INW * 2 + kcolB); }
#pragma unroll
    for (int i = 0; i < 2; ++i) { const int X = wid * 1024 + lane * 16 + i * 8192, sub = X >> 9, e = (X & 511) >> 1, kk = (sub >> 2) * 8 + (e >> 5), cc = (sub & 3) * 32 + (e & 31);
        vgo[i] = (unsigned)((kk * INW + cc) * 2); }
    const int vb0 = (int)(uintptr_t)V_lds + v_rd_base(lane);
    const int NT = T / 64; const int q0 = qb * 256;
    const bf16_t* Vh = proj + (size_t)rowbase * INW + 5120 + h * 128;
#define BAR() do { asm volatile("" ::: "memory"); __builtin_amdgcn_s_barrier(); asm volatile("" ::: "memory"); } while (0)
#pragma unroll 1
    for (int s = 0; s < 2; ++s) {
        const bf16_t* Kh = proj + (size_t)rowbase * INW + 4096 + h * 128 + s * 64;
        const unsigned qoff = ((unsigned)(rowbase + q0 + wid * 32 + r32) * INW + 3072 + h * 128 + s * 64 + hi * 8) * 2u;
        bf16x8 qr[4];
#pragma unroll
        for (int d0 = 0; d0 < 4; ++d0) qr[d0] = *(const bf16x8*)((const char*)proj + qoff + d0 * 32);
        float m_reg = 0.f, l_reg = 0.f; f32x16 o[4], negm = f32x16{};
#pragma unroll
        for (int d = 0; d < 4; ++d) o[d] = f32x16{};
#define DDMA(j, b) do { const char* kt = (const char*)Kh + (size_t)(j) * (64 * INW * 2); const char* vt = (const char*)Vh + (size_t)(j) * (64 * INW * 2); \
        __builtin_amdgcn_global_load_lds((const unsigned*)(kt + kgo), (LAS unsigned*)(ldsl + DF_K + (b) * DF_KSZ + widu * 1024), 16, 0, 0); \
        __builtin_amdgcn_global_load_lds((const unsigned*)(vt + vgo[0]), (LAS unsigned*)(ldsl + (b) * SHM_V + widu * 1024), 16, 0, 0); \
        __builtin_amdgcn_global_load_lds((const unsigned*)(vt + vgo[1]), (LAS unsigned*)(ldsl + (b) * SHM_V + widu * 1024 + 8192), 16, 0, 0); } while (0)
#pragma unroll
        for (int t = 0; t < DF_D; ++t) DDMA(t, t);
        asm volatile("s_waitcnt vmcnt(%0)" :: "n"(3 * (DF_D - 1)) : "memory"); BAR();
        int ka[4];
#pragma unroll
        for (int d0 = 0; d0 < 4; ++d0) ka[d0] = (int)(uintptr_t)K_lds + KSWZ64(r32, (d0 * 16 + hi * 8) * 2);
#define KRD(dst, addr, OFF) asm volatile("ds_read_b128 %0, %1 offset:" #OFF : "=&v"(dst) : "v"(addr) : "memory")
        int bsl = 0;
#pragma unroll 1
        for (int j = 0; j < NT; ++j) {
            f32x16 p0, p1;
            { const int kb = bsl * DF_KSZ; bf16x8 k0, k1, k2, k3, k4, k5, k6, k7; const int a0 = ka[0] + kb, a1 = ka[1] + kb, a2 = ka[2] + kb, a3 = ka[3] + kb;
              KRD(k0, a0, 0); KRD(k1, a0, 4096); KRD(k2, a1, 0); KRD(k3, a1, 4096); KRD(k4, a2, 0); KRD(k5, a2, 4096); KRD(k6, a3, 0); KRD(k7, a3, 4096);
              asm volatile("s_waitcnt lgkmcnt(6)" ::: "memory"); SBAR();
              p0 = __builtin_amdgcn_mfma_f32_32x32x16_bf16(k0, qr[0], negm, 0, 0, 0); p1 = __builtin_amdgcn_mfma_f32_32x32x16_bf16(k1, qr[0], negm, 0, 0, 0); SBAR();
              asm volatile("s_waitcnt lgkmcnt(4)" ::: "memory"); SBAR();
              p0 = __builtin_amdgcn_mfma_f32_32x32x16_bf16(k2, qr[1], p0, 0, 0, 0); p1 = __builtin_amdgcn_mfma_f32_32x32x16_bf16(k3, qr[1], p1, 0, 0, 0); SBAR();
              asm volatile("s_waitcnt lgkmcnt(2)" ::: "memory"); SBAR();
              p0 = __builtin_amdgcn_mfma_f32_32x32x16_bf16(k4, qr[2], p0, 0, 0, 0); p1 = __builtin_amdgcn_mfma_f32_32x32x16_bf16(k5, qr[2], p1, 0, 0, 0); SBAR();
              asm volatile("s_waitcnt lgkmcnt(0)" ::: "memory"); SBAR();
              p0 = __builtin_amdgcn_mfma_f32_32x32x16_bf16(k6, qr[3], p0, 0, 0, 0); p1 = __builtin_amdgcn_mfma_f32_32x32x16_bf16(k7, qr[3], p1, 0, 0, 0); SBAR(); }
            float alpha; bf16x8 pa0, pa1, pa2, pa3;
            softmax_rel(p0, p1, m_reg, l_reg, negm, alpha, j == 0, pa0, pa1, pa2, pa3);
            ATT_RESC2(alpha);
            if (j + DF_D <= NT) asm volatile("s_waitcnt vmcnt(%0) lgkmcnt(0)" :: "n"(3 * (DF_D - 2)) : "memory"); else asm volatile("s_waitcnt vmcnt(0) lgkmcnt(0)" ::: "memory");
            BAR();
            if (j + DF_D < NT) { const int b2 = bsl >= 1 ? bsl - 1 : DF_R - 1; DDMA(j + DF_D, b2); }
            const int bn = bsl == DF_R - 1 ? 0 : bsl + 1;
            __builtin_amdgcn_s_setprio(1); pv_all_pre(o, vb0 + bsl * SHM_V, pa0, pa1, pa2, pa3); __builtin_amdgcn_s_setprio(0);
            bsl = bn;
        }
#undef KRD
        asm volatile("s_waitcnt lgkmcnt(0)" ::: "memory");
        BAR();
#undef DDMA
        { auto rr = __builtin_amdgcn_permlane32_swap(__float_as_uint(l_reg), __float_as_uint(l_reg), false, false); l_reg = __uint_as_float(rr[0]) + __uint_as_float(rr[1]); }
        if (hi == 0) li_l[r32] = l_reg;
        asm volatile("s_waitcnt lgkmcnt(0)" ::: "memory");
        float rli[16];
#pragma unroll
        for (int r = 0; r < 16; ++r) rli[r] = __builtin_amdgcn_rcpf(li_l[crow(r, hi)]);
        f32x4* o1v = (f32x4*)((char*)o1s + (unsigned)tid * 256u);
        if (s == 0) {
#pragma unroll
            for (int d = 0; d < 4; ++d)
#pragma unroll
                for (int r = 0; r < 16; r += 4) o1v[d * 4 + (r >> 2)] = (f32x4){o[d][r] * rli[r], o[d][r + 1] * rli[r + 1], o[d][r + 2] * rli[r + 2], o[d][r + 3] * rli[r + 3]};
        } else {
#pragma unroll
            for (int d = 0; d < 4; ++d)
#pragma unroll
                for (int r = 0; r < 16; r += 4) { const f32x4 t = o1v[d * 4 + (r >> 2)];
#pragma unroll
                    for (int e = 0; e < 4; ++e) o[d][r + e] = t[e] - lam * (o[d][r + e] * rli[r + e]); }
            float gs[4];
#pragma unroll
            for (int d = 0; d < 4; ++d) gs[d] = g_sub[d * 32 + r32] * (1.0f - LAM_INIT);
            bf16_t* stg = (bf16_t*)(lds + DF_STG) + wid * 4096;
#pragma unroll
            for (int r = 0; r < 16; ++r) {
                float q = (o[0][r] * o[0][r] + o[1][r] * o[1][r]) + (o[2][r] * o[2][r] + o[3][r] * o[3][r]);
                q += __shfl_xor(q, 1); q += __shfl_xor(q, 2); q += __shfl_xor(q, 4); q += __shfl_xor(q, 8); q += __shfl_xor(q, 16);
                const float rn = __builtin_amdgcn_rsqf(q * (1.0f / 128.0f) + SUBLN_EPS);
#pragma unroll
                for (int d = 0; d < 4; ++d) stg[crow(r, hi) * 128 + d * 32 + r32] = (bf16_t)f2bf(o[d][r] * rn * gs[d]);
            }
            asm volatile("s_waitcnt lgkmcnt(0)" ::: "memory");
            const unsigned goff = ((unsigned)(rowbase + q0 + wid * 32 + (lane >> 4)) * DM + 1024 + h * 128 + (lane & 15) * 8) * 2u;
#pragma unroll
            for (int i = 0; i < 8; ++i) { const u32x4 v = *(const u32x4*)(stg + (i * 4 + (lane >> 4)) * 128 + (lane & 15) * 8); *(u32x4*)((char*)mix + goff + (unsigned)(i * 4 * DM * 2)) = v; }
            asm volatile("s_waitcnt lgkmcnt(0)" ::: "memory"); BAR();
        }
    }
#undef BAR
}

__device__ __forceinline__ void na_unit(const bf16_t* __restrict__ proj, bf16_t* __restrict__ mix, const float* __restrict__ rpb,
                                        int rowbase, int ROWS, int h, int rg, char* lds, int widk) {
    const int tid = tid_l(widk), wid = tid >> 6, lane = tid & 63, r32 = lane & 31, hi = lane >> 5;
    char* V_lds = lds; char* K_lds = lds + OFF_K;
    float* wsf = (float*)(lds + OFF_WS) + wid * 64; float* li_l = wsf; float* al_l = wsf + 32;
    float* rpbL = (float*)(lds + OFF_RPB);
    LAS unsigned char* ldsl = (LAS unsigned char*)lds; const int widu = __builtin_amdgcn_readfirstlane(wid);
    unsigned kgo[2], vgo[2];
#pragma unroll
    for (int i = 0; i < 2; ++i) { const int X = wid * 1024 + lane * 16 + i * 8192;
        { const int krow = X >> 8, kcolB = (X & 255) ^ ((krow & 7) << 4); kgo[i] = (unsigned)(krow * INW * 2 + kcolB); }
        { const int sub = X >> 9, e = (X & 511) >> 1, kk = (sub >> 2) * 8 + (e >> 5), cc = (sub & 3) * 32 + (e & 31); const int k = (kk & ~0xC) | ((kk & 4) << 1) | ((kk & 8) >> 1); vgo[i] = (unsigned)((k * INW + cc) * 2); } }
    const int vb0 = (int)(uintptr_t)V_lds + v_rd_base(lane);
    const int r0 = rg * 4, rq = r0 + (wid >> 1), c = 32 * (wid & 1) + r32;
    const int rsw = min(max(rq - 4, 0), ROWS - 8), cs = min(max(c - 8, 0), 48);
    const int klo = min(max(r0 - 4, 0), ROWS - 8), khi = min(max(r0 + 3 - 4, 0), ROWS - 8) + 8;
    for (int i = tid; i < 465; i += NTHREADS) rpbL[i] = rpb[h * 465 + i] * LOG2E;
    const bf16_t* Kh = proj + (size_t)rowbase * INW + 1024 + h * 128;
    const bf16_t* Vh = proj + (size_t)rowbase * INW + 2048 + h * 128;
    const bf16_t* Qw = proj + (size_t)(rowbase + rq * 64 + c) * INW + h * 128 + hi * 8;
    bf16x8 qr[8];
#pragma unroll
    for (int d0 = 0; d0 < 8; ++d0) qr[d0] = *(const bf16x8*)(Qw + d0 * 16);
    float m_reg = -1e30f, l_reg = 0.f; f32x16 o[4];
#pragma unroll
    for (int d = 0; d < 4; ++d) o[d] = f32x16{};
#define NDMA(kr, b) do { const char* kt = (const char*)Kh + (size_t)(kr) * (64 * INW * 2); const char* vt = (const char*)Vh + (size_t)(kr) * (64 * INW * 2); \
        __builtin_amdgcn_global_load_lds((const unsigned*)(kt + kgo[0]), (LAS unsigned*)(ldsl + OFF_K + (b) * SHM_K + widu * 1024), 16, 0, 0); \
        __builtin_amdgcn_global_load_lds((const unsigned*)(kt + kgo[1]), (LAS unsigned*)(ldsl + OFF_K + (b) * SHM_K + widu * 1024 + 8192), 16, 0, 0); \
        __builtin_amdgcn_global_load_lds((const unsigned*)(vt + vgo[0]), (LAS unsigned*)(ldsl + (b) * SHM_V + widu * 1024), 16, 0, 0); \
        __builtin_amdgcn_global_load_lds((const unsigned*)(vt + vgo[1]), (LAS unsigned*)(ldsl + (b) * SHM_V + widu * 1024 + 8192), 16, 0, 0); } while (0)
    NDMA(klo, 0); asm volatile("s_waitcnt vmcnt(0)" ::: "memory"); __syncthreads();
#pragma unroll 1
    for (int kr = klo; kr < khi; ++kr) {
        const int b = (kr - klo) & 1;
        if (kr + 1 < khi) NDMA(kr + 1, b ^ 1);
        if (kr >= rsw && kr < rsw + 8) {
            f32x16 p0 = f32x16{}, p1 = f32x16{};
            const char* Ks = K_lds + b * SHM_K;
#pragma unroll
            for (int d0 = 0; d0 < 8; ++d0) { const int cb = (d0 * 16 + hi * 8) * 2;
                const bf16x8 b0 = *(const bf16x8*)(Ks + KSWZ128(r32, cb)); const bf16x8 b1 = *(const bf16x8*)(Ks + KSWZ128(32 + r32, cb));
                p0 = __builtin_amdgcn_mfma_f32_32x32x16_bf16(b0, qr[d0], p0, 0, 0, 0); p1 = __builtin_amdgcn_mfma_f32_32x32x16_bf16(b1, qr[d0], p1, 0, 0, 0); }
            const float* brow = rpbL + (kr - rq + 7) * 31;
#pragma unroll
            for (int r = 0; r < 16; ++r) {
                const int kc = crow(r, hi), kc2 = kc + 32;
                const int i0 = min(max(kc - c + 15, 0), 30), i1 = min(max(kc2 - c + 15, 0), 30);
                const float b0 = brow[i0], b1 = brow[i1];
                p0[r] = ((unsigned)(kc - cs) < 16u) ? p0[r] + b0 : -1e30f;
                p1[r] = ((unsigned)(kc2 - cs) < 16u) ? p1[r] + b1 : -1e30f;
            }
            float alpha; bf16x8 pa0, pa1, pa2, pa3;
            softmax_tile(p0, p1, m_reg, l_reg, alpha, pa0, pa1, pa2, pa3);
            ATT_RESC(alpha);
            pv_all(o, vb0 + b * SHM_V, pa0, pa1, pa2, pa3);
        }
        asm volatile("s_waitcnt vmcnt(0)" ::: "memory");
        __syncthreads();
    }
#undef NDMA
    if (hi == 0) li_l[r32] = l_reg;
    asm volatile("s_waitcnt lgkmcnt(0)" ::: "memory");
    bf16_t* stg = (bf16_t*)(lds + OFF_STG) + wid * 4096;
#pragma unroll
    for (int r = 0; r < 16; ++r) { const float rl = __builtin_amdgcn_rcpf(li_l[crow(r, hi)]);
#pragma unroll
        for (int d = 0; d < 4; ++d) stg[crow(r, hi) * 128 + d * 32 + r32] = (bf16_t)f2bf(o[d][r] * rl); }
    asm volatile("s_waitcnt lgkmcnt(0)" ::: "memory");
    bf16_t* gp = mix + (size_t)(rowbase + rq * 64 + 32 * (wid & 1) + (lane >> 4)) * DM + h * 128 + (lane & 15) * 8;
#pragma unroll
    for (int i = 0; i < 8; ++i) { const u32x4 v = *(const u32x4*)(stg + (i * 4 + (lane >> 4)) * 128 + (lane & 15) * 8); *(u32x4*)gp = v; gp += 4 * DM; }
    __syncthreads();
}
#undef SBAR
}

template <int MODE> __device__ __forceinline__ int dest_row(int n) {
    if (MODE == 1) { if (n < 3072 || n >= 5120) return n; const int d = n & 63, blk = n & ~63, nn = d >> 5, dd = d & 31; return blk + 32 * (dd >> 4) + 8 * ((dd >> 2) & 3) + 4 * nn + (dd & 3); }
    if (MODE == 2) { if (n < DFF) return 256 * (n >> 7) + (n & 127); const int n2 = n - DFF; return 256 * (n2 >> 7) + 128 + (n2 & 127); }
    return n;
}
template <int MODE> __device__ __forceinline__ void p0_transpose_item(const float* __restrict__ W, int K, int N, bf16_t* __restrict__ WT, const float* __restrict__ gain, LAS float* scr, int item, int lane) {
    const int nblk = N / 32, kb = item / nblk, nb = item % nblk, k0 = 64 * kb, n0 = 32 * nb;
#pragma unroll 8
    for (int i = 0; i < 32; ++i) { const int kk = 2 * i + (lane >> 5); const float g = gain ? gain[k0 + kk] : 1.0f; scr[kk * 33 + (lane & 31)] = W[(size_t)(k0 + kk) * N + n0 + (lane & 31)] * g; }
    asm volatile("s_waitcnt lgkmcnt(0)" ::: "memory");
    const int c = lane & 7;
#pragma unroll
    for (int j = 0; j < 4; ++j) { const int n = (lane >> 3) + 8 * j; const LAS float* s = scr + (8 * c) * 33 + n;
        u32x4 o; o.x = pk2(s[0 * 33], s[1 * 33]); o.y = pk2(s[2 * 33], s[3 * 33]); o.z = pk2(s[4 * 33], s[5 * 33]); o.w = pk2(s[6 * 33], s[7 * 33]);
        *(u32x4*)(WT + (size_t)dest_row<MODE>(n0 + n) * K + k0 + 8 * c) = o; }
    asm volatile("s_waitcnt lgkmcnt(0)" ::: "memory");
}
__device__ __forceinline__ float row_ssq(const float* xrow, int lane, f32x4 (&v)[8]) {
    const f32x4* xr = (const f32x4*)xrow + lane; float s = 0.f;
#pragma unroll
    for (int j = 0; j < 8; ++j) { v[j] = xr[64 * j]; s += (v[j][0] * v[j][0] + v[j][1] * v[j][1]) + (v[j][2] * v[j][2] + v[j][3] * v[j][3]); }
    return wave_sum(s);
}
__device__ __forceinline__ void sincos_d(double x, double& sn, double& cs) {
    const double k = __builtin_rint(x * 0.6366197723675814); const double r0 = __builtin_fma(-k, 1.5707963267948966, x); const double r = __builtin_fma(-k, 6.123233995736766e-17, r0);
    const double r2 = r * r;
    double s = -1.0 / 1307674368000.0; s = s * r2 + 1.0 / 6227020800.0; s = s * r2 - 1.0 / 39916800.0; s = s * r2 + 1.0 / 362880.0; s = s * r2 - 1.0 / 5040.0; s = s * r2 + 1.0 / 120.0; s = s * r2 - 1.0 / 6.0; s = s * r2 * r + r;
    double c = 1.0 / 20922789888000.0; c = c * r2 - 1.0 / 87178291200.0; c = c * r2 + 1.0 / 479001600.0; c = c * r2 - 1.0 / 3628800.0; c = c * r2 + 1.0 / 40320.0; c = c * r2 - 1.0 / 720.0; c = c * r2 + 1.0 / 24.0; c = c * r2 - 0.5; c = c * r2 + 1.0;
    const int q = ((int)k) & 3;
    sn = (q == 0) ? s : (q == 1) ? c : (q == 2) ? -s : -c;
    cs = (q == 0) ? c : (q == 1) ? -s : (q == 2) ? -c : s;
}

struct Args { const float* in[22]; float* out; unsigned char* ws; int ph_lo, ph_hi; };
constexpr int NPHASE = 10;

__global__ void __launch_bounds__(NTHREADS, 2) fwd_kernel(Args a) {
    extern __shared__ __attribute__((aligned(16))) unsigned char lds[];
    LAS unsigned char* ldsl = (LAS unsigned char*)lds;
    const int widk = __builtin_amdgcn_readfirstlane((int)(threadIdx.x >> 6));
    const int G = gridDim.x, bx = blockIdx.x, vcu = (G % 8 == 0) ? (bx % 8) * (G / 8) + bx / 8 : bx;
#define x_p (ap->in[0])
#define x_s (ap->in[1])
#define mem_p (ap->in[2])
#define mem_s (ap->in[3])
#define g_mix (ap->in[4])
#define w_in (ap->in[5])
#define rpb (ap->in[6])
#define lam_q1 (ap->in[7])
#define lam_k1 (ap->in[8])
#define lam_q2 (ap->in[9])
#define lam_k2 (ap->in[10])
#define g_subln (ap->in[11])
#define w_out (ap->in[12])
#define g_xattn (ap->in[13])
#define g_mem (ap->in[14])
#define w_mq (ap->in[15])
#define w_mkv (ap->in[16])
#define w_mo (ap->in[17])
#define g_ffn (ap->in[18])
#define w_gu (ap->in[19])
#define w_dn (ap->in[20])
#define g_final (ap->in[21])
#define out (ap->out)
#define WSP() const __attribute__((address_space(4))) Args* ap = (const __attribute__((address_space(4))) Args*)__builtin_amdgcn_kernarg_segment_ptr(); asm volatile("" : "+s"(ap)); unsigned char* ws = ap->ws
#define SS ((float*)(ws + WS_SS))
#define RS0 ((float*)(ws + WS_RS0))
#define ROPE ((f32x2*)(ws + WS_ROPE))
#define WIN ((bf16_t*)(ws + WS_WIN))
#define WOUT ((bf16_t*)(ws + WS_WOUT))
#define WMQ ((bf16_t*)(ws + WS_WMQ))
#define WMO ((bf16_t*)(ws + WS_WMO))
#define WMKV ((bf16_t*)(ws + WS_WMKV))
#define WGU ((bf16_t*)(ws + WS_WGU))
#define WDN ((bf16_t*)(ws + WS_WDN))
#define MN ((bf16_t*)(ws + WS_MN))
#define KB ((bf16_t*)(ws + WS_KB))
#define VB ((bf16_t*)(ws + WS_VB))
#define WQK ((bf16_t*)(ws + WS_WQK))
#define WVO ((bf16_t*)(ws + WS_WVO))
#define O1S ((float*)(ws + WS_O1))
#define XB ((bf16_t*)(ws + WS_XB))
#define PROJ ((bf16_t*)(ws + WS_BIG))
#define H1B ((bf16_t*)(ws + WS_H1B))
#define SB ((float*)(ws + WS_S))
#define PB ((bf16_t*)(ws + WS_P))
#define ACT ((bf16_t*)(ws + WS_ACT))
#define MIX XB
#define H2B XB
    const int lo = a.ph_lo, hi_ph = a.ph_hi;
    if (lo < 0) cg::this_grid().sync();
#ifdef ONLY_PHASE
#define IN(k) ((k) == ONLY_PHASE && lo <= (k) && (k) < hi_ph)
#else
#define IN(k) (lo <= (k) && (k) < hi_ph)
#endif
#define SEAM(k) do { if (IN(k) && IN((k) + 1)) { WSP(); grid_barrier((unsigned*)(ws + WS_BAR), (unsigned)((k) + 1 - lo) * (unsigned)G, tid_l(widk)); } } while (0)
    const int NGW = G * 8;
#define TIDS() const int tid = tid_l(widk), lane = tid & 63, wave = __builtin_amdgcn_readfirstlane(tid >> 6), gw = vcu * 8 + wave; (void)lane; (void)gw

    if (IN(0)) { WSP(); TIDS();
        LAS float* scr = (LAS float*)(ldsl + wave * 16384);
        constexpr int I0 = (DM / 64) * (INW / 32), I1 = (DM / 64) * (DM / 32), I2 = I1, I3 = (DM / 64) * (4096 / 32), I4 = (DM / 64) * (NGU / 32), I5 = (DFF / 64) * (DM / 32);
        constexpr int NIT = I0 + I1 + I2 + I3 + I4 + I5;
        for (int it = gw; it < NIT; it += NGW) {
            int r = it;
            if (r < I0) { p0_transpose_item<1>(w_in, DM, INW, WIN, g_mix, scr, r, lane); continue; } r -= I0;
            if (r < I1) { p0_transpose_item<0>(w_out, DM, DM, WOUT, nullptr, scr, r, lane); continue; } r -= I1;
            if (r < I2) { p0_transpose_item<0>(w_mo, DM, DM, WMO, nullptr, scr, r, lane); continue; } r -= I2;
            if (r < I3) { p0_transpose_item<0>(w_mkv, DM, 4096, WMKV, nullptr, scr, r, lane); continue; } r -= I3;
            if (r < I4) { p0_transpose_item<2>(w_gu, DM, NGU, WGU, g_ffn, scr, r, lane); continue; } r -= I4;
            p0_transpose_item<0>(w_dn, DFF, DM, WDN, nullptr, scr, r, lane);
        }
        for (int k = gw; k < DM; k += NGW) { const float g = g_xattn[k]; const f32x4* src = (const f32x4*)(w_mq + (size_t)k * DM) + lane; u32x2* dst = (u32x2*)(WMQ + (size_t)k * DM) + lane;
#pragma unroll
            for (int j = 0; j < 8; ++j) { const f32x4 v = src[64 * j] * g; u32x2 w; w.x = pk2(v[0], v[1]); w.y = pk2(v[2], v[3]); dst[64 * j] = w; } }
        for (int m = gw; m < MT; m += NGW) { const float* xr = m < NP ? x_p + (size_t)m * DM : x_s + (size_t)(m - NP) * DM; f32x4 v[8];
            const float s = row_ssq(xr, lane, v); if (lane == 0) RS0[m] = 1.0f / sqrtf(s * (1.0f / DM) + RMS_EPS);
            u32x2* dst = (u32x2*)(XB + (size_t)m * DM) + lane;
#pragma unroll
            for (int j = 0; j < 8; ++j) { u32x2 w; w.x = pk2(v[j][0], v[j][1]); w.y = pk2(v[j][2], v[j][3]); dst[64 * j] = w; } }
        for (int m = gw; m < NMEM; m += NGW) { const float* xr = m < 512 ? mem_p + (size_t)m * DM : mem_s + (size_t)(m - 512) * DM; f32x4 v[8];
            const float s = row_ssq(xr, lane, v); const float rr = 1.0f / sqrtf(s * (1.0f / DM) + RMS_EPS);
            u32x2* dst = (u32x2*)(MN + (size_t)m * DM) + lane; const f32x4* gp = (const f32x4*)g_mem + lane;
#pragma unroll
            for (int j = 0; j < 8; ++j) { const f32x4 g = gp[64 * j]; u32x2 w; w.x = pk2(v[j][0] * rr * g[0], v[j][1] * rr * g[1]); w.y = pk2(v[j][2] * rr * g[2], v[j][3] * rr * g[3]); dst[64 * j] = w; } }
        for (int e = vcu * NTHREADS + tid; e < TP * 32; e += G * NTHREADS) { const int t = e >> 5, dd = e & 31;
            double pw = 1.0; for (int i = 0; i < dd; ++i) pw *= 1.333521432163324;
            const float inv = 1.0f / (float)pw; const float ang = (float)t * inv; double sn, cs; sincos_d((double)ang, sn, cs);
            ROPE[e] = (f32x2){(float)cs, (float)sn}; }
    }
    SEAM(0);

    if (IN(1)) { WSP();
        pg8::Sched S{(const char*)XB, (const char*)WIN, (const char*)MN, (const char*)WMKV, MT / 256, INW / 256, (MT / 256) * (INW / 256), NMEM / 256, (NMEM / 256) * 16,
                     (size_t)256 * DM * 2, (size_t)256 * DM * 2, 0, G, bx};
        pg8::EpiInProj E{PROJ, KB, VB, RS0, ROPE};
        pg8::gemm_phase<pg8::EpiInProj, pg8::Sched, true, true>(ldsl, widk, DM, DM, S, E);
    }
    SEAM(1);

    if (IN(2)) { WSP(); TIDS();
#if !defined(P2_PART) || P2_PART == 1
        { pg8::PreSched S{(const char*)KB, (const char*)VB, (const char*)WMQ, (const char*)WMO, G, bx}; pg8::EpiPre E{WQK, WVO};
          pg8::gemm_phase<pg8::EpiPre, pg8::PreSched, true, true>(ldsl, widk, 512, DM, S, E); }
#endif
        __syncthreads();
#if !defined(P2_PART) || P2_PART == 2
        for (int id = vcu; id < 1024 + 512; id += G) {
            const bool pr = id < 1024; const int i2 = pr ? id : id - 1024;
            const int rg = pr ? (i2 & 63) : (i2 & 15), h = pr ? ((i2 >> 6) & 7) : ((i2 >> 4) & 7), b = pr ? (i2 >> 9) : (i2 >> 7);
            att::na_unit(PROJ, MIX, rpb, pr ? b * TP : NP + b * TS, pr ? TP / 64 : TS / 64, h, rg, (char*)lds, widk);
        }
#endif
#if !defined(P2_PART) || P2_PART == 3
        float lam;
        { const float a1 = wave_sum(lam_q1[lane] * lam_k1[lane]), a2 = wave_sum(lam_q2[lane] * lam_k2[lane]); lam = __expf(a1) - __expf(a2) + LAM_INIT; lam = __builtin_bit_cast(float, __builtin_amdgcn_readfirstlane(__builtin_bit_cast(int, lam))); }
        float* o1s = O1S + (size_t)bx * 64 * NTHREADS;
#ifndef DIFF_REPS
#define DIFF_REPS 1
#endif
        for (int rep = 0; rep < DIFF_REPS; ++rep)
        for (int id = vcu; id < 1024 + 512; id += G) {
            const bool pr = id < 1024; const int i2 = pr ? id : id - 1024;
            const int qb = pr ? (i2 & 63) : (i2 & 15), bh = pr ? (i2 >> 6) : (i2 >> 4);
            att::diff_unit(PROJ, MIX, o1s, g_subln, lam, pr ? (bh >> 3) * TP : NP + (bh >> 3) * TS, pr ? TP : TS, bh & 7, qb, (char*)lds, widk);
        }
#endif
    }
    SEAM(2);

    if (IN(3)) { WSP();
        pg8::Sched S{(const char*)MIX, (const char*)WOUT, nullptr, nullptr, MT / 256, DM / 256, (MT / 256) * (DM / 256), 1, 0, (size_t)256 * DM * 2, (size_t)256 * DM * 2, 0, G, bx};
        pg8::EpiX E{x_p, x_s, H1B, SS};
        pg8::gemm_phase<pg8::EpiX, pg8::Sched, true, true>(ldsl, widk, DM, DM, S, E);
    }
    SEAM(3);

    if (IN(4)) { WSP();
        pg8::Sched S{(const char*)H1B, (const char*)WQK, nullptr, nullptr, MT / 256, NSW / 256, (MT / 256) * (NSW / 256), 1, 0, (size_t)256 * DM * 2, (size_t)256 * DM * 2, (size_t)NSW * DM * 2, G, bx};
        pg8::EpiS E{SB, SS};
        pg8::gemm_phase<pg8::EpiS, pg8::Sched, true, true>(ldsl, widk, DM, DM, S, E);
    }
    SEAM(4);

    if (IN(5)) { WSP(); TIDS();
        for (int m = gw; m < MT; m += NGW) {
            const f32x4* sp = (const f32x4*)(SB + (size_t)m * NSW) + lane; u32x2* pp = (u32x2*)(PB + (size_t)m * NSW) + lane;
#pragma unroll
            for (int hh = 0; hh < 4; ++hh) { f32x4 v = sp[64 * hh]; const float mx = wave_max(fmaxf(fmaxf(v[0], v[1]), fmaxf(v[2], v[3])));
                v[0] = __builtin_amdgcn_exp2f(v[0] - mx); v[1] = __builtin_amdgcn_exp2f(v[1] - mx); v[2] = __builtin_amdgcn_exp2f(v[2] - mx); v[3] = __builtin_amdgcn_exp2f(v[3] - mx);
                const float rl = 1.0f / wave_sum((v[0] + v[1]) + (v[2] + v[3]));
                u32x2 w; w.x = pk2(v[0] * rl, v[1] * rl); w.y = pk2(v[2] * rl, v[3] * rl); pp[64 * hh] = w; }
        }
    }
    SEAM(5);

    if (IN(6)) { WSP();
        pg8::Sched S{(const char*)PB, (const char*)WVO, nullptr, nullptr, MT / 256, DM / 256, (MT / 256) * (DM / 256), 1, 0, (size_t)256 * NSW * 2, (size_t)256 * NSW * 2, (size_t)DM * NSW * 2, G, bx};
        pg8::EpiResid E{nullptr, H1B, H2B, DM, SS};
        pg8::gemm_phase<pg8::EpiResid, pg8::Sched, true, true>(ldsl, widk, NSW, NSW, S, E);
    }
    SEAM(6);

    if (IN(7)) { WSP();
        pg8::Sched S{(const char*)H2B, (const char*)WGU, nullptr, nullptr, MT / 256, NGU / 256, (MT / 256) * (NGU / 256), 1, 0, (size_t)256 * DM * 2, (size_t)256 * DM * 2, 0, G, bx};
        pg8::EpiGU E{ACT, SS};
        pg8::gemm_phase<pg8::EpiGU, pg8::Sched, true, true>(ldsl, widk, DM, DM, S, E);
    }
    SEAM(7);

    if (IN(8)) { WSP();
        pg8::Sched S{(const char*)ACT, (const char*)WDN, nullptr, nullptr, MT / 256, DM / 256, (MT / 256) * (DM / 256), 1, 0, (size_t)256 * DFF * 2, (size_t)256 * DFF * 2, 0, G, bx};
        pg8::EpiResid E{nullptr, H2B, (bf16_t*)out + DM, 2 * DM, SS};
        pg8::gemm_phase<pg8::EpiResid, pg8::Sched, true, true>(ldsl, widk, DFF, DFF, S, E);
    }
    SEAM(8);

    if (IN(9)) { WSP(); TIDS();
        for (int m = gw; m < MT; m += NGW) {
            float sq = lane < 32 ? SS[(size_t)m * 32 + lane] : 0.f; sq = wave_sum(sq); const float rr = __builtin_amdgcn_rsqf(sq * (1.0f / DM) + RMS_EPS);
            const u32x2* hp = (const u32x2*)((const bf16_t*)out + (size_t)m * (2 * DM) + DM) + lane;
            u32x2 hv[8];
#pragma unroll
            for (int j = 0; j < 8; ++j) hv[j] = hp[64 * j];
            asm volatile("s_waitcnt vmcnt(0)" ::: "memory");
            f32x4* op = (f32x4*)(out + (size_t)m * DM) + lane; const f32x4* gp = (const f32x4*)g_final + lane;
#pragma unroll
            for (int j = 0; j < 8; ++j) { const f32x4 g = gp[64 * j];
                const f32x4 v = (f32x4){__uint_as_float(hv[j].x << 16), __uint_as_float(hv[j].x & 0xffff0000u), __uint_as_float(hv[j].y << 16), __uint_as_float(hv[j].y & 0xffff0000u)};
                op[64 * j] = v * rr * g; }
        }
    }
#undef IN
#undef SEAM
#undef TIDS
}
#undef x_p
#undef x_s
#undef mem_p
#undef mem_s
#undef g_mix
#undef w_in
#undef rpb
#undef lam_q1
#undef lam_k1
#undef lam_q2
#undef lam_k2
#undef g_subln
#undef w_out
#undef g_xattn
#undef g_mem
#undef w_mq
#undef w_mkv
#undef w_mo
#undef g_ffn
#undef w_gu
#undef w_dn
#undef g_final
#undef out
#undef WSP
#undef SS
#undef RS0
#undef ROPE
#undef WIN
#undef WOUT
#undef WMQ
#undef WMO
#undef WMKV
#undef WGU
#undef WDN
#undef MN
#undef KB
#undef VB
#undef WQK
#undef WVO
#undef O1S
#undef XB
#undef PROJ
#undef H1B
#undef SB
#undef PB
#undef ACT
#undef MIX
#undef H2B


extern "C" void kernel_launch(void* const* d_in, const int* in_sizes, int n_in, void* d_out, int out_size, void* d_ws, size_t ws_size, hipStream_t stream) {
    static int grid = 0;
    if (grid == 0) {
        if (n_in != 22 || out_size != MT * DM || ws_size < WS_END) { fprintf(stderr, "kernel_launch: unexpected shapes (n_in %d, out %d, ws %zu); nothing launched\n", n_in, out_size, ws_size); grid = -1; return; }
        int dev = 0, cus = 0, per_cu = 0;
        (void)hipGetDevice(&dev); (void)hipDeviceGetAttribute(&cus, hipDeviceAttributeMultiprocessorCount, dev);
        if (hipFuncSetAttribute((const void*)fwd_kernel, hipFuncAttributeMaxDynamicSharedMemorySize, LDS_BYTES) != hipSuccess) { fprintf(stderr, "kernel_launch: hipFuncSetAttribute failed\n"); grid = -1; return; }
        if (hipOccupancyMaxActiveBlocksPerMultiprocessor(&per_cu, (const void*)fwd_kernel, NTHREADS, LDS_BYTES) != hipSuccess || per_cu < 1) per_cu = 1;
        (void)hipGetLastError();
        grid = cus * per_cu;
    }
    if (grid < 0) return;
    Args a{};
    for (int i = 0; i < 22; ++i) a.in[i] = (const float*)d_in[i];
    a.out = (float*)d_out; a.ws = (unsigned char*)d_ws;
#if MK_MULTI
    for (int p = 0; p < NPHASE; ++p) { a.ph_lo = p; a.ph_hi = p + 1; hipLaunchKernelGGL(fwd_kernel, dim3(grid), dim3(NTHREADS), LDS_BYTES, stream, a); }
#else
    a.ph_lo = 0; a.ph_hi = NPHASE;
    (void)hipMemsetAsync((char*)d_ws + WS_BAR, 0, 256, stream);
    void* args[] = {&a};
    hipError_t e = hipLaunchCooperativeKernel((const void*)fwd_kernel, dim3(grid), dim3(NTHREADS), args, LDS_BYTES, stream);
    if (e != hipSuccess) fprintf(stderr, "cooperative launch failed: %s (grid %d)\n", hipGetErrorString(e), grid);
#endif
}
```

```cpp
#include <hip/hip_runtime.h>
#include <hip/hip_cooperative_groups.h>
#include <cstdio>
#include <cstdint>
namespace cg = cooperative_groups;

#ifndef MK_MULTI
#define MK_MULTI 0
#endif

#define LAS __attribute__((address_space(3)))
typedef unsigned short bf16_t;
typedef short bf16x8 __attribute__((ext_vector_type(8)));
typedef short s16x4 __attribute__((ext_vector_type(4)));
typedef float f32x2 __attribute__((ext_vector_type(2)));
typedef float f32x4 __attribute__((ext_vector_type(4)));
typedef float f32x16 __attribute__((ext_vector_type(16)));
typedef unsigned u32x2 __attribute__((ext_vector_type(2)));
typedef unsigned u32x4 __attribute__((ext_vector_type(4)));

constexpr int DM = 2048, TP = 16384, TS = 4096, NP = 2 * TP, NS = 4 * TS, MT = NP + NS;
constexpr int INW = 6144, DFF = 5632, NGU = 2 * DFF, MEMT = 256, NMEM = 6 * MEMT, NSW = 1024;
constexpr float RMS_EPS = 1e-6f, SUBLN_EPS = 1e-5f, LOG2E = 1.4426950408889634f;
constexpr float NA_QS = 0.08838834764831845f * LOG2E, DF_QS = 0.125f * LOG2E, MEM_QS = 0.04419417382415922f * LOG2E;
constexpr float LAM_INIT = 0.2f;

constexpr size_t MiB = 1u << 20;
constexpr size_t WS_SS = 0, WS_RS0 = 6 * MiB, WS_ROPE = 7 * MiB, WS_WIN = 11 * MiB, WS_WOUT = 35 * MiB, WS_WMQ = 43 * MiB, WS_WMO = 51 * MiB,
                 WS_WMKV = 59 * MiB, WS_WGU = 75 * MiB, WS_WDN = 119 * MiB, WS_MN = 141 * MiB, WS_KB = 147 * MiB, WS_VB = 153 * MiB,
                 WS_WQK = 159 * MiB, WS_WVO = 183 * MiB, WS_O1 = 207 * MiB, WS_XB = 239 * MiB, WS_BIG = 431 * MiB, WS_END = 1007 * MiB;
constexpr size_t WS_BAR = 6 * MiB + 512 * 1024;
constexpr size_t WS_H1B = WS_BIG, WS_S = WS_BIG + 192 * MiB, WS_P = WS_BIG + 384 * MiB, WS_ACT = WS_BIG;

constexpr int LDS_BYTES = 147456, NTHREADS = 512;

__device__ __forceinline__ unsigned cvt_pk_bf16(float lo, float hi) { unsigned r; asm volatile("v_cvt_pk_bf16_f32 %0, %1, %2" : "=v"(r) : "v"(lo), "v"(hi)); return r; }
__device__ __forceinline__ unsigned f2bf(float f) { unsigned u = __builtin_bit_cast(unsigned, f); return (u + 0x7fffu + ((u >> 16) & 1u)) >> 16; }
__device__ __forceinline__ unsigned pk2(float lo, float hi) { return f2bf(lo) | (f2bf(hi) << 16); }
__device__ __forceinline__ float wave_sum(float v) {
#pragma unroll
    for (int o = 1; o < 64; o <<= 1) v += __shfl_xor(v, o);
    return v;
}
__device__ __forceinline__ float wave_max(float v) {
#pragma unroll
    for (int o = 1; o < 64; o <<= 1) v = fmaxf(v, __shfl_xor(v, o));
    return v;
}
__device__ __forceinline__ int tid_l(int widk) { int t; asm volatile("v_mbcnt_lo_u32_b32 %0, -1, 0\n\tv_mbcnt_hi_u32_b32 %0, -1, %0\n\tv_or_b32 %0, %1, %0" : "=&v"(t) : "s"(widk << 6)); return t; }
__device__ __forceinline__ void grid_barrier(unsigned* ctr, unsigned target, int tid) {
    asm volatile("s_waitcnt vmcnt(0) lgkmcnt(0)" ::: "memory");
    __syncthreads();
    if (tid == 0) {
        __builtin_amdgcn_fence(__ATOMIC_RELEASE, "agent");
        asm volatile("s_waitcnt vmcnt(0)" ::: "memory");
        (void)__hip_atomic_fetch_add(ctr, 1u, __ATOMIC_RELAXED, __HIP_MEMORY_SCOPE_AGENT);
        unsigned spins = 0;
        while (__hip_atomic_load(ctr, __ATOMIC_RELAXED, __HIP_MEMORY_SCOPE_AGENT) < target && ++spins < (1u << 22)) __builtin_amdgcn_s_sleep(2);
        __builtin_amdgcn_fence(__ATOMIC_ACQUIRE, "agent");
        asm volatile("s_waitcnt vmcnt(0)" ::: "memory");
    }
    __syncthreads();
}
__device__ __forceinline__ int batch_of_pm(int pm) { return pm < 128 ? (pm >> 6) : 2 + ((pm - 128) >> 4); }

namespace pg8 {
constexpr int BM = 256, BK = 64, HALF = 128, HTB = HALF * BK * 2, STAGE_BYTES = 8 * HTB, NXCD = 8, WGM = 8;
__host__ __device__ __forceinline__ int lds_byte(int r, int c) { const int st = (r >> 4) * 2 + (c >> 5), rr = r & 15, cc = c & 31, ob = rr * 64 + cc * 2; return st * 1024 + (ob ^ (((ob >> 9) & 1) << 5)); }
__host__ __device__ __forceinline__ void stage_rc(int b, int& R, int& C) { const int st = b / 1024, sb = b % 1024, swz = sb ^ (((sb >> 9) & 1) << 5); R = (st >> 1) * 16 + swz / 64; C = (st & 1) * 32 + (swz % 64) / 2; }
__host__ __device__ __forceinline__ int perm32(int rho) { const int n = rho >> 4, i = rho & 15; return 8 * (i >> 2) + 4 * n + (i & 3); }

struct Unit { int pm, pn, z; };

__device__ __forceinline__ void tile_decode(int wgid, int nM, int nN, int& pm, int& pn) {
    const int nwg = nM * nN;
    { const int q = nwg / NXCD, r = nwg % NXCD, xcd = wgid % NXCD, off = wgid / NXCD; wgid = (xcd < r ? xcd * (q + 1) : r * (q + 1) + (xcd - r) * q) + off; }
    const int nig = WGM * nN, gid = wgid / nig, fm = gid * WGM, gsz = (nM - fm) < WGM ? (nM - fm) : WGM;
    pm = fm + ((wgid % nig) % gsz); pn = (wgid % nig) / gsz;
}
struct Sched {
    const char *A0, *B0, *A1, *B1; int nM0, nN0, n0, nM1, n1; size_t tA, tB, bstride; int G, c;
    __device__ __forceinline__ bool next(int i, Unit& u) const {
        int L = i * G + c;
        if (L < n0) { tile_decode(L, nM0, nN0, u.pm, u.pn); u.z = 0; return true; }
        L -= n0; if (L < n1) { u.pm = L % nM1; u.pn = L / nM1; u.z = 1; return true; }
        return false;
    }
    __device__ __forceinline__ const char* abase(const Unit& u) const { return (u.z ? A1 : A0) + (size_t)u.pm * tA; }
    __device__ __forceinline__ const char* bbase(const Unit& u) const { return (u.z ? B1 : B0) + (size_t)u.pn * tB + (bstride ? (size_t)batch_of_pm(u.pm) * bstride : (size_t)0); }
};
struct PreSched {
    const char *Kb, *Vb, *Wmq, *Wmo; int G, c;
    __device__ __forceinline__ bool next(int i, Unit& u) const { const int L = i * G + c; if (L >= 384) return false; u.z = L / 8; const int t = L & 7; if (u.z < 24) { u.pm = 0; u.pn = t; } else { u.pm = t; u.pn = 0; } return true; }
    __device__ __forceinline__ const char* abase(const Unit& u) const { const int zz = u.z % 24, b = zz >> 2, h = zz & 3;
        return u.z < 24 ? Kb + ((size_t)(b * 256) * DM + h * 512) * 2 : Wmo + ((size_t)(u.pm * 256) * DM + h * 512) * 2; }
    __device__ __forceinline__ const char* bbase(const Unit& u) const { const int zz = u.z % 24, b = zz >> 2, h = zz & 3;
        return u.z < 24 ? Wmq + ((size_t)(u.pn * 256) * DM + h * 512) * 2 : Vb + ((size_t)(b * 256) * DM + h * 512) * 2; }
};

template <class Epi, class SchedT, bool ALIGN_EPI, bool SP2>
__device__ __forceinline__ void gemm_phase(LAS unsigned char* lds, const int widk, const int K, const int ld, const SchedT& S, const Epi& E) {
    const int tid = tid_l(widk), wid = __builtin_amdgcn_readfirstlane(tid >> 6), lane = tid & 63, wr = wid >> 2, wc = wid & 3, fr = lane & 15, fq = lane >> 4;
    const int nt = K / BK;
    unsigned voffA[2], voffB[2];
#pragma unroll
    for (int i = 0; i < 2; ++i) { int R, C; stage_rc(tid * 16 + i * 8192, R, C); const int Rb = Epi::PERM ? ((R & ~31) + perm32(R & 31)) : R;
        voffA[i] = (unsigned)(R * ld + C) * 2u; voffB[i] = (unsigned)(Rb * ld + C) * 2u; }
    const size_t kstep = (size_t)(BK * 2);
    const size_t hstep = (size_t)HALF * ld * 2;
    const unsigned ldsw = (unsigned)wid * 1024u;
    const int aoff = lds_byte(wr * 64 + fr, fq * 8), boff = lds_byte(wc * 32 + fr, fq * 8);
#define PG8_SA(b, h) (((b) * 2 + (h)) * HTB)
#define PG8_SB(b, h) ((4 + (b) * 2 + (h)) * HTB)
#define PG8_STAGE(bufoff, gbase, voff) do { _Pragma("unroll") for (int _i = 0; _i < 2; ++_i) \
        __builtin_amdgcn_global_load_lds((const unsigned*)((const char*)(gbase) + (voff)[_i]), (LAS unsigned*)(lds + (bufoff) + ldsw + _i * 8192), 16, 0, 0); } while (0)
#define PG8_LDA(dst, b, h) do { _Pragma("unroll") for (int m = 0; m < 4; ++m) _Pragma("unroll") for (int k = 0; k < 2; ++k) dst[m][k] = *(const LAS bf16x8*)(lds + PG8_SA(b, h) + aoff + m * 2048 + k * 1024); } while (0)
#define PG8_LDB(dst, b, h) do { _Pragma("unroll") for (int n = 0; n < 2; ++n) _Pragma("unroll") for (int k = 0; k < 2; ++k) dst[n][k] = *(const LAS bf16x8*)(lds + PG8_SB(b, h) + boff + n * 2048 + k * 1024); } while (0)
#define PG8_MMA(ai, bj, At, Bt) do { __builtin_amdgcn_s_setprio(1); _Pragma("unroll") for (int m = 0; m < 4; ++m) _Pragma("unroll") for (int n = 0; n < 2; ++n) _Pragma("unroll") for (int k = 0; k < 2; ++k) \
        acc[ai][bj][m][n] = __builtin_amdgcn_mfma_f32_16x16x32_bf16(Bt[n][k], At[m][k], acc[ai][bj][m][n], 0, 0, 0); __builtin_amdgcn_s_setprio(0); } while (0)
#define PG8_WAIT_V(n) asm volatile("s_waitcnt vmcnt(" #n ")" ::: "memory")
#define PG8_WAIT_L(n) asm volatile("s_waitcnt lgkmcnt(" #n ")" ::: "memory")
#define PG8_BAR __builtin_amdgcn_s_barrier()
#define PG8_SCHED __builtin_amdgcn_sched_barrier(0)
    Unit cur, nxt; int ui = 0;
    if (!S.next(0, cur)) return;
    f32x4 acc[2][2][4][2];
#pragma unroll
    for (int a = 0; a < 2; ++a)
#pragma unroll
        for (int b = 0; b < 2; ++b)
#pragma unroll
            for (int m = 0; m < 4; ++m)
#pragma unroll
                for (int n = 0; n < 2; ++n) acc[a][b][m][n] = (f32x4){0.f, 0.f, 0.f, 0.f};
    bf16x8 At[4][2], B0[2][2], B1[2][2];
    const char* cA = S.abase(cur); const char* cB = S.bbase(cur);
    if constexpr (SP2) {
        PG8_STAGE(PG8_SB(0, 0), cB, voffB); PG8_STAGE(PG8_SB(0, 1), cB + hstep, voffB); PG8_STAGE(PG8_SA(0, 0), cA, voffA); PG8_STAGE(PG8_SA(0, 1), cA + hstep, voffA);
        if (wr == 1) PG8_BAR;
        PG8_WAIT_V(2); PG8_BAR;
        PG8_STAGE(PG8_SB(1, 0), cB + kstep, voffB); PG8_STAGE(PG8_SA(1, 0), cA + kstep, voffA); PG8_STAGE(PG8_SB(1, 1), cB + hstep + kstep, voffB);
        PG8_WAIT_V(6); PG8_BAR;
    } else {
        PG8_STAGE(PG8_SB(0, 0), cB, voffB); PG8_STAGE(PG8_SA(0, 0), cA, voffA); PG8_STAGE(PG8_SB(0, 1), cB + hstep, voffB); PG8_STAGE(PG8_SA(0, 1), cA + hstep, voffA);
        if (wr == 1) PG8_BAR;
        PG8_WAIT_V(4); PG8_BAR;
        PG8_STAGE(PG8_SB(1, 0), cB + kstep, voffB); PG8_STAGE(PG8_SA(1, 0), cA + kstep, voffA); PG8_STAGE(PG8_SB(1, 1), cB + hstep + kstep, voffB);
        PG8_WAIT_V(6); PG8_BAR;
    }
    for (;;) {
        const bool has_next = S.next(ui + 1, nxt);
        const char* nA = has_next ? S.abase(nxt) : cA; const char* nB = has_next ? S.bbase(nxt) : cB;
        for (int t = 0; t < nt; t += 2) {
            const bool last = (t == nt - 2);
            const char* a1 = cA + (size_t)(t + 1) * kstep;
            const char* a2 = last ? nA : cA + (size_t)(t + 2) * kstep; const char* b2 = last ? nB : cB + (size_t)(t + 2) * kstep;
            const char* a3 = a2 + kstep; const char* b3 = b2 + kstep;
            if constexpr (SP2) {
            PG8_LDB(B0, 0, 0); PG8_LDB(B1, 0, 1); PG8_SCHED; PG8_LDA(At, 0, 0); PG8_STAGE(PG8_SA(1, 1), a1 + hstep, voffA);
            PG8_WAIT_V(8); PG8_WAIT_L(0); PG8_BAR; PG8_MMA(0, 0, At, B0); PG8_MMA(0, 1, At, B1); PG8_BAR; PG8_SCHED;
            PG8_LDA(At, 0, 1); PG8_STAGE(PG8_SB(0, 0), b2, voffB); PG8_STAGE(PG8_SB(0, 1), b2 + hstep, voffB); PG8_STAGE(PG8_SA(0, 0), a2, voffA);
            PG8_WAIT_V(8); PG8_WAIT_L(0); PG8_BAR; PG8_MMA(1, 0, At, B0); PG8_MMA(1, 1, At, B1); PG8_BAR; PG8_SCHED;
            PG8_LDB(B0, 1, 0); PG8_LDB(B1, 1, 1); PG8_SCHED; PG8_LDA(At, 1, 0); PG8_STAGE(PG8_SA(0, 1), a2 + hstep, voffA);
            PG8_WAIT_V(8); PG8_WAIT_L(0); PG8_BAR; PG8_MMA(0, 0, At, B0); PG8_MMA(0, 1, At, B1); PG8_BAR; PG8_SCHED;
            PG8_LDA(At, 1, 1); PG8_STAGE(PG8_SB(1, 0), b3, voffB); PG8_STAGE(PG8_SB(1, 1), b3 + hstep, voffB); PG8_STAGE(PG8_SA(1, 0), a3, voffA);
            PG8_WAIT_V(8); PG8_WAIT_L(0); PG8_BAR; PG8_MMA(1, 0, At, B0); PG8_MMA(1, 1, At, B1); PG8_BAR; PG8_SCHED;
            } else {
            PG8_LDB(B0, 0, 0); PG8_SCHED; PG8_LDA(At, 0, 0); PG8_STAGE(PG8_SA(1, 1), a1 + hstep, voffA);
            PG8_WAIT_L(8); PG8_BAR; PG8_WAIT_L(0); PG8_MMA(0, 0, At, B0); PG8_BAR; PG8_SCHED;
            PG8_LDB(B1, 0, 1); PG8_STAGE(PG8_SB(0, 0), b2, voffB);
            PG8_BAR; PG8_WAIT_L(0); PG8_MMA(0, 1, At, B1); PG8_BAR;
            PG8_LDA(At, 0, 1); PG8_STAGE(PG8_SA(0, 0), a2, voffA);
            PG8_BAR; PG8_WAIT_L(0); PG8_MMA(1, 0, At, B0); PG8_BAR; PG8_SCHED;
            PG8_STAGE(PG8_SB(0, 1), b2 + hstep, voffB);
            PG8_WAIT_V(6); PG8_BAR; PG8_MMA(1, 1, At, B1); PG8_BAR;
            PG8_LDB(B0, 1, 0); PG8_SCHED; PG8_LDA(At, 1, 0); PG8_STAGE(PG8_SA(0, 1), a2 + hstep, voffA);
            PG8_WAIT_L(8); PG8_BAR; PG8_WAIT_L(0); PG8_MMA(0, 0, At, B0); PG8_BAR; PG8_SCHED;
            PG8_LDB(B1, 1, 1); PG8_STAGE(PG8_SB(1, 0), b3, voffB);
            PG8_BAR; PG8_WAIT_L(0); PG8_MMA(0, 1, At, B1); PG8_BAR;
            PG8_LDA(At, 1, 1); PG8_STAGE(PG8_SA(1, 0), a3, voffA);
            PG8_BAR; PG8_WAIT_L(0); PG8_MMA(1, 0, At, B0); PG8_BAR; PG8_SCHED;
            PG8_STAGE(PG8_SB(1, 1), b3 + hstep, voffB);
            PG8_WAIT_V(6); PG8_BAR; PG8_MMA(1, 1, At, B1); PG8_BAR;
            }
        }
        if constexpr (ALIGN_EPI) { if (wr == 0) PG8_BAR; }
        E(acc, cur, wr, wc, fr, fq);
        if (!has_next) break;
#pragma unroll
        for (int a = 0; a < 2; ++a)
#pragma unroll
            for (int b = 0; b < 2; ++b)
#pragma unroll
                for (int m = 0; m < 4; ++m)
#pragma unroll
                    for (int n = 0; n < 2; ++n) acc[a][b][m][n] = (f32x4){0.f, 0.f, 0.f, 0.f};
        cur = nxt; cA = nA; cB = nB; ++ui;
        if constexpr (ALIGN_EPI) { if (wr == 1) PG8_BAR; }
    }
    PG8_WAIT_V(0);
    if constexpr (!ALIGN_EPI) { if (wr == 0) PG8_BAR; }
    PG8_BAR;
#undef PG8_SA
#undef PG8_SB
#undef PG8_STAGE
#undef PG8_LDA
#undef PG8_LDB
#undef PG8_MMA
#undef PG8_WAIT_V
#undef PG8_WAIT_L
#undef PG8_BAR
#undef PG8_SCHED
}

typedef const f32x4 (&AccRef)[2][2][4][2];

__device__ __forceinline__ float row_rs(const float* ss, int row) {
    const f32x4* p = (const f32x4*)(ss + (size_t)row * 32); float s = 0.f;
#pragma unroll
    for (int i = 0; i < 8; ++i) { const f32x4 v = p[i]; s += (v[0] + v[1]) + (v[2] + v[3]); }
    return __builtin_amdgcn_rsqf(s * (1.0f / DM) + RMS_EPS);
}

struct EpiInProj {
    static constexpr bool PERM = true;
    bf16_t* proj; bf16_t* kb; bf16_t* vb; const float* rs0; const f32x2* rope;
    __device__ __forceinline__ void operator()(AccRef acc, const Unit& u, int wr, int wc, int fr, int fq) const {
        const int row0 = u.pm * BM + wr * 64 + fr;
        if (u.z == 1) {
            bf16_t* base = (u.pn < 8 ? kb : vb) + (u.pn & 7) * BM + wc * 32 + 8 * fq;
#pragma unroll
            for (int ai = 0; ai < 2; ++ai)
#pragma unroll
                for (int m = 0; m < 4; ++m) { bf16_t* rowp = base + (size_t)(row0 + ai * HALF + m * 16) * DM;
#pragma unroll
                    for (int bj = 0; bj < 2; ++bj) { const f32x4 v0 = acc[ai][bj][m][0], v1 = acc[ai][bj][m][1]; u32x4 w;
                        w.x = cvt_pk_bf16(v0[0], v0[1]); w.y = cvt_pk_bf16(v0[2], v0[3]); w.z = cvt_pk_bf16(v1[0], v1[1]); w.w = cvt_pk_bf16(v1[2], v1[3]);
                        *(u32x4*)(rowp + bj * HALF) = w; } }
            return;
        }
        const int pn = u.pn; const bool rp = (pn >= 12 && pn < 20);
        const float sc = pn < 4 ? NA_QS : ((pn >= 12 && pn < 16) ? DF_QS : 1.0f);
        if (!rp) {
            bf16_t* base = proj + pn * BM + wc * 32 + 8 * fq;
#pragma unroll
            for (int ai = 0; ai < 2; ++ai)
#pragma unroll
                for (int m = 0; m < 4; ++m) { const int row = row0 + ai * HALF + m * 16; const float rr = rs0[row] * sc; bf16_t* rowp = base + (size_t)row * INW;
#pragma unroll
                    for (int bj = 0; bj < 2; ++bj) { const f32x4 v0 = acc[ai][bj][m][0] * rr, v1 = acc[ai][bj][m][1] * rr; u32x4 w;
                        w.x = cvt_pk_bf16(v0[0], v0[1]); w.y = cvt_pk_bf16(v0[2], v0[3]); w.z = cvt_pk_bf16(v1[0], v1[1]); w.w = cvt_pk_bf16(v1[2], v1[3]);
                        *(u32x4*)(rowp + bj * HALF) = w; } }
        } else {
            const int dd0 = 16 * (wc & 1) + 4 * fq;
            bf16_t* base = proj + pn * BM + (wc >> 1) * 64 + dd0;
#pragma unroll
            for (int ai = 0; ai < 2; ++ai)
#pragma unroll
                for (int m = 0; m < 4; ++m) { const int row = row0 + ai * HALF + m * 16; const float rr = rs0[row] * sc; bf16_t* rowp = base + (size_t)row * INW;
                    const int t = row < NP ? (row & (TP - 1)) : (row & (TS - 1));
                    const f32x4 cs0 = *(const f32x4*)(rope + (size_t)t * 32 + dd0), cs1 = *(const f32x4*)(rope + (size_t)t * 32 + dd0 + 2);
#pragma unroll
                    for (int bj = 0; bj < 2; ++bj) { const f32x4 x1 = acc[ai][bj][m][0] * rr, x2 = acc[ai][bj][m][1] * rr;
                        const float a0 = x1[0] * cs0[0] - x2[0] * cs0[1], a1 = x1[1] * cs0[2] - x2[1] * cs0[3], a2 = x1[2] * cs1[0] - x2[2] * cs1[1], a3 = x1[3] * cs1[2] - x2[3] * cs1[3];
                        const float b0 = x2[0] * cs0[0] + x1[0] * cs0[1], b1 = x2[1] * cs0[2] + x1[1] * cs0[3], b2 = x2[2] * cs1[0] + x1[2] * cs1[1], b3 = x2[3] * cs1[2] + x1[3] * cs1[3];
                        u32x2 wa, wb; wa.x = cvt_pk_bf16(a0, a1); wa.y = cvt_pk_bf16(a2, a3); wb.x = cvt_pk_bf16(b0, b1); wb.y = cvt_pk_bf16(b2, b3);
                        *(u32x2*)(rowp + bj * HALF) = wa; *(u32x2*)(rowp + bj * HALF + 32) = wb; } }
        }
    }
};
struct EpiPre {
    static constexpr bool PERM = true;
    bf16_t* wqk; bf16_t* wvo;
    __device__ __forceinline__ void operator()(AccRef acc, const Unit& u, int wr, int wc, int fr, int fq) const {
        const int zz = u.z % 24, b = zz >> 2, h = zz & 3; bf16_t* base; int ldc; float sc;
        if (u.z < 24) { base = wqk + ((size_t)(b * 1024 + h * 256)) * DM + u.pn * BM; ldc = DM; sc = MEM_QS; }
        else { base = wvo + ((size_t)(b * 2048 + u.pm * BM)) * NSW + h * 256; ldc = NSW; sc = 1.0f; }
        base += wc * 32 + 8 * fq;
#pragma unroll
        for (int ai = 0; ai < 2; ++ai)
#pragma unroll
            for (int m = 0; m < 4; ++m) { bf16_t* rowp = base + (size_t)(wr * 64 + fr + ai * HALF + m * 16) * ldc;
#pragma unroll
                for (int bj = 0; bj < 2; ++bj) { const f32x4 v0 = acc[ai][bj][m][0] * sc, v1 = acc[ai][bj][m][1] * sc; u32x4 w;
                    w.x = cvt_pk_bf16(v0[0], v0[1]); w.y = cvt_pk_bf16(v0[2], v0[3]); w.z = cvt_pk_bf16(v1[0], v1[1]); w.w = cvt_pk_bf16(v1[2], v1[3]);
                    *(u32x4*)(rowp + bj * HALF) = w; } }
    }
};
__device__ __forceinline__ float row_rs4(const float* ss, int row, int fq) {
    const f32x4* p = (const f32x4*)(ss + (size_t)row * 32 + fq * 8); const f32x4 a = p[0], b = p[1];
    float s = ((a[0] + a[1]) + (a[2] + a[3])) + ((b[0] + b[1]) + (b[2] + b[3]));
    s += __shfl_xor(s, 16); s += __shfl_xor(s, 32);
    return __builtin_amdgcn_rsqf(s * (1.0f / DM) + RMS_EPS);
}
struct EpiResid {
    static constexpr bool PERM = false;
    const float* basef; const bf16_t* baseb; bf16_t* ob; int ldo; float* ss;
    __device__ __forceinline__ void operator()(AccRef acc, const Unit& u, int wr, int wc, int fr, int fq) const {
        const int col0 = u.pn * BM + wc * 32 + 4 * fq;
#pragma unroll
        for (int ai = 0; ai < 2; ++ai)
#pragma unroll
            for (int m = 0; m < 4; ++m) { const int row = u.pm * BM + ai * HALF + wr * 64 + m * 16 + fr; const size_t off = (size_t)row * DM + col0; bf16_t* orow = ob + (size_t)row * ldo + col0; float q = 0.f;
#pragma unroll
                for (int bj = 0; bj < 2; ++bj)
#pragma unroll
                    for (int n = 0; n < 2; ++n) { const int o2 = bj * HALF + n * 16; f32x4 bv;
                        if (baseb) { const u32x2 w = *(const u32x2*)(baseb + off + o2); bv = (f32x4){__uint_as_float(w.x << 16), __uint_as_float(w.x & 0xffff0000u), __uint_as_float(w.y << 16), __uint_as_float(w.y & 0xffff0000u)}; }
                        else bv = *(const f32x4*)(basef + off + o2);
                        const f32x4 o = bv + acc[ai][bj][m][n]; q += (o[0] * o[0] + o[1] * o[1]) + (o[2] * o[2] + o[3] * o[3]);
                        u32x2 w2; w2.x = cvt_pk_bf16(o[0], o[1]); w2.y = cvt_pk_bf16(o[2], o[3]); *(u32x2*)(orow + o2) = w2; }
                q += __shfl_xor(q, 16); q += __shfl_xor(q, 32);
                if (fq == 0) ss[(size_t)row * 32 + u.pn * 4 + wc] = q; }
    }
};
struct EpiX { static constexpr bool PERM = false; const float* xp; const float* xs; bf16_t* ob; float* ss;
    __device__ __forceinline__ void operator()(AccRef acc, const Unit& u, int wr, int wc, int fr, int fq) const {
        const float* base = (u.pm < NP / 256) ? xp : xs - (size_t)NP * DM; EpiResid E{base, nullptr, ob, DM, ss}; E(acc, u, wr, wc, fr, fq); } };
struct EpiS {
    static constexpr bool PERM = false;
    float* S; const float* ss;
    __device__ __forceinline__ void operator()(AccRef acc, const Unit& u, int wr, int wc, int fr, int fq) const {
        const int col0 = u.pn * BM + wc * 32 + 4 * fq;
#pragma unroll
        for (int ai = 0; ai < 2; ++ai)
#pragma unroll
            for (int m = 0; m < 4; ++m) { const int row = u.pm * BM + ai * HALF + wr * 64 + m * 16 + fr; const float rr = row_rs4(ss, row, fq); float* rowp = S + (size_t)row * NSW + col0;
#pragma unroll
                for (int bj = 0; bj < 2; ++bj)
#pragma unroll
                    for (int n = 0; n < 2; ++n) *(f32x4*)(rowp + bj * HALF + n * 16) = acc[ai][bj][m][n] * rr; }
    }
};
struct EpiGU {
    static constexpr bool PERM = true;
    bf16_t* act; const float* ss;
    __device__ __forceinline__ void operator()(AccRef acc, const Unit& u, int wr, int wc, int fr, int fq) const {
        bf16_t* base = act + u.pn * HALF + wc * 32 + 8 * fq;
#pragma unroll
        for (int ai = 0; ai < 2; ++ai)
#pragma unroll
            for (int m = 0; m < 4; ++m) { const int row = u.pm * BM + ai * HALF + wr * 64 + m * 16 + fr; const float rr = row_rs4(ss, row, fq); float o[8];
#pragma unroll
                for (int n = 0; n < 2; ++n)
#pragma unroll
                    for (int e = 0; e < 4; ++e) { const float g = acc[ai][0][m][n][e] * rr, up = acc[ai][1][m][n][e] * rr;
                        o[n * 4 + e] = g * __builtin_amdgcn_rcpf(1.0f + __builtin_amdgcn_exp2f(-g * LOG2E)) * up; }
                u32x4 w; w.x = cvt_pk_bf16(o[0], o[1]); w.y = cvt_pk_bf16(o[2], o[3]); w.z = cvt_pk_bf16(o[4], o[5]); w.w = cvt_pk_bf16(o[6], o[7]);
                *(u32x4*)(base + (size_t)row * DFF) = w; }
    }
};
}

namespace att {
#define SBAR() __builtin_amdgcn_sched_barrier(0)
constexpr float THR = 8.0f;
constexpr int SHM_V = 16384, SHM_K = 16384, OFF_K = 2 * SHM_V, OFF_WS = OFF_K + 2 * SHM_K, OFF_RPB = OFF_WS + 8 * 256, OFF_STG = OFF_RPB + 2048, OFF_END = OFF_STG + 8 * 8192;
constexpr int DF_R = 5, DF_D = 4;
constexpr int DF_K = DF_R * SHM_V, DF_KSZ = 8192, DF_WS = DF_K + DF_R * DF_KSZ, DF_STG = 0  , DF_END = DF_WS + 8 * 256;
static_assert(8 * 8192 <= DF_K, "output stage fits inside the V ring");
static_assert(DF_END <= 147456 && OFF_END <= 147456, "attention LDS maps fit the dynamic LDS allocation");
__device__ __forceinline__ int crow(int r, int hi) { return (r & 3) + 8 * (r >> 2) + 4 * hi; }
#define KSWZ128(row, colB) ((row) * 256 + ((colB) ^ (((row) & 7) << 4)))
#define KSWZ64(row, colB) ((row) * 128 + ((colB) ^ ((((row) >> 1) & 7) << 4)))
__device__ __forceinline__ int v_st(int k, int c) { const int kk = (k & ~0xC) | ((k & 4) << 1) | ((k & 8) >> 1); return ((kk >> 3) * 4 + (c >> 5)) * 512 + ((kk & 7) * 32 + (c & 31)) * 2; }
__device__ __forceinline__ int v_rd_base(int lane) { return ((lane & 3) << 3) | (((lane >> 2) & 3) << 6) | (((lane >> 4) & 1) << 5) | (((lane >> 5) & 1) << 8); }
constexpr int v_rd_off(int d0, int ks, int half) { return d0 * 512 + ks * 4096 + half * 2048; }
template <int OFF> __device__ __forceinline__ s16x4 tr_read(int vb) { s16x4 r; asm volatile("ds_read_b64_tr_b16 %0, %1 offset:%2" : "=&v"(r) : "v"(vb), "i"(OFF) : "memory"); return r; }
template <int D0> __device__ __forceinline__ void pv_one(f32x16& od, int vb, bf16x8 pa0, bf16x8 pa1, bf16x8 pa2, bf16x8 pa3) {
    const s16x4 l0 = tr_read<v_rd_off(D0, 0, 0)>(vb), h0 = tr_read<v_rd_off(D0, 0, 1)>(vb), l1 = tr_read<v_rd_off(D0, 1, 0)>(vb), h1 = tr_read<v_rd_off(D0, 1, 1)>(vb);
    const s16x4 l2 = tr_read<v_rd_off(D0, 2, 0)>(vb), h2 = tr_read<v_rd_off(D0, 2, 1)>(vb), l3 = tr_read<v_rd_off(D0, 3, 0)>(vb), h3 = tr_read<v_rd_off(D0, 3, 1)>(vb);
    asm volatile("s_waitcnt lgkmcnt(0)" ::: "memory"); SBAR();
#define PK(L, H) (bf16x8){L[0], L[1], L[2], L[3], H[0], H[1], H[2], H[3]}
    od = __builtin_amdgcn_mfma_f32_32x32x16_bf16(pa0, PK(l0, h0), od, 0, 0, 0);
    od = __builtin_amdgcn_mfma_f32_32x32x16_bf16(pa1, PK(l1, h1), od, 0, 0, 0);
    od = __builtin_amdgcn_mfma_f32_32x32x16_bf16(pa2, PK(l2, h2), od, 0, 0, 0);
    od = __builtin_amdgcn_mfma_f32_32x32x16_bf16(pa3, PK(l3, h3), od, 0, 0, 0);
#undef PK
}
template <int D0> __device__ __forceinline__ void pv_rd(s16x4 (&L)[4], s16x4 (&H)[4], int vb) {
    L[0] = tr_read<v_rd_off(D0, 0, 0)>(vb); H[0] = tr_read<v_rd_off(D0, 0, 1)>(vb); L[1] = tr_read<v_rd_off(D0, 1, 0)>(vb); H[1] = tr_read<v_rd_off(D0, 1, 1)>(vb);
    L[2] = tr_read<v_rd_off(D0, 2, 0)>(vb); H[2] = tr_read<v_rd_off(D0, 2, 1)>(vb); L[3] = tr_read<v_rd_off(D0, 3, 0)>(vb); H[3] = tr_read<v_rd_off(D0, 3, 1)>(vb);
}
#define PV_PK(L, H) (bf16x8){L[0], L[1], L[2], L[3], H[0], H[1], H[2], H[3]}
#define PV_MMA(od, L, H) do { od = __builtin_amdgcn_mfma_f32_32x32x16_bf16(pa0, PV_PK(L[0], H[0]), od, 0, 0, 0); od = __builtin_amdgcn_mfma_f32_32x32x16_bf16(pa1, PV_PK(L[1], H[1]), od, 0, 0, 0); \
    od = __builtin_amdgcn_mfma_f32_32x32x16_bf16(pa2, PV_PK(L[2], H[2]), od, 0, 0, 0); od = __builtin_amdgcn_mfma_f32_32x32x16_bf16(pa3, PV_PK(L[3], H[3]), od, 0, 0, 0); } while (0)
__device__ __forceinline__ void pv_all_pre(f32x16* o, int vb, bf16x8 pa0, bf16x8 pa1, bf16x8 pa2, bf16x8 pa3) {
    s16x4 L0[4], H0[4], L1[4], H1[4], L2[4], H2[4], L3[4], H3[4];
    pv_rd<0>(L0, H0, vb); pv_rd<1>(L1, H1, vb);
    asm volatile("s_waitcnt lgkmcnt(8)" ::: "memory"); SBAR(); PV_MMA(o[0], L0, H0); SBAR();
    pv_rd<2>(L2, H2, vb);
    asm volatile("s_waitcnt lgkmcnt(8)" ::: "memory"); SBAR(); PV_MMA(o[1], L1, H1); SBAR();
    pv_rd<3>(L3, H3, vb);
    asm volatile("s_waitcnt lgkmcnt(8)" ::: "memory"); SBAR(); PV_MMA(o[2], L2, H2); SBAR();
    asm volatile("s_waitcnt lgkmcnt(0)" ::: "memory"); SBAR(); PV_MMA(o[3], L3, H3); SBAR();
}
__device__ __forceinline__ void pv_all(f32x16* o, int vb, bf16x8 pa0, bf16x8 pa1, bf16x8 pa2, bf16x8 pa3) {
    pv_one<0>(o[0], vb, pa0, pa1, pa2, pa3); pv_one<1>(o[1], vb, pa0, pa1, pa2, pa3); pv_one<2>(o[2], vb, pa0, pa1, pa2, pa3); pv_one<3>(o[3], vb, pa0, pa1, pa2, pa3);
}
__device__ __forceinline__ void softmax_tile(f32x16& p0, f32x16& p1, float& m_reg, float& l_reg, float& alpha, bf16x8& pa0, bf16x8& pa1, bf16x8& pa2, bf16x8& pa3) {
    float pmax = p0[0];
#pragma unroll
    for (int r = 1; r < 16; ++r) pmax = fmaxf(pmax, p0[r]);
#pragma unroll
    for (int r = 0; r < 16; ++r) pmax = fmaxf(pmax, p1[r]);
    { auto rr = __builtin_amdgcn_permlane32_swap(__float_as_uint(pmax), __float_as_uint(pmax), false, false); pmax = fmaxf(__uint_as_float(rr[0]), __uint_as_float(rr[1])); }
    float mn;
    if (__builtin_expect(__all(pmax - m_reg <= THR), 1)) { mn = m_reg; alpha = 1.f; }
    else { mn = fmaxf(m_reg, pmax); alpha = __builtin_amdgcn_exp2f(m_reg - mn); m_reg = mn; }
#pragma unroll
    for (int r = 0; r < 16; ++r) { p0[r] = __builtin_amdgcn_exp2f(p0[r] - mn); p1[r] = __builtin_amdgcn_exp2f(p1[r] - mn); }
    float ps = 0.f;
#pragma unroll
    for (int r = 0; r < 16; ++r) ps += p0[r];
#pragma unroll
    for (int r = 0; r < 16; ++r) ps += p1[r];
    { auto rr = __builtin_amdgcn_permlane32_swap(__float_as_uint(ps), __float_as_uint(ps), false, false); ps = __uint_as_float(rr[0]) + __uint_as_float(rr[1]); }
    l_reg = l_reg * alpha + ps;
#define PK4(P, BASE, OUT) do { unsigned a0 = cvt_pk_bf16(P[BASE + 0], P[BASE + 1]), a1 = cvt_pk_bf16(P[BASE + 2], P[BASE + 3]);   \
    unsigned b0 = cvt_pk_bf16(P[BASE + 4], P[BASE + 5]), b1 = cvt_pk_bf16(P[BASE + 6], P[BASE + 7]);                              \
    auto r0 = __builtin_amdgcn_permlane32_swap(a0, b0, false, false); auto r1 = __builtin_amdgcn_permlane32_swap(a1, b1, false, false); \
    u32x4 w = {r0[0], r1[0], r0[1], r1[1]}; OUT = __builtin_bit_cast(bf16x8, w); } while (0)
    PK4(p0, 0, pa0); PK4(p0, 8, pa1); PK4(p1, 0, pa2); PK4(p1, 8, pa3);
#undef PK4
}
__device__ __forceinline__ void softmax_rel(f32x16& p0, f32x16& p1, float& m_reg, float& l_reg, f32x16& negm, float& alpha, bool first, bf16x8& pa0, bf16x8& pa1, bf16x8& pa2, bf16x8& pa3) {
    float ma = __builtin_fmaxf(__builtin_fmaxf(p0[0], p0[1]), p0[2]), mb = __builtin_fmaxf(__builtin_fmaxf(p0[8], p0[9]), p0[10]);
    float mc = __builtin_fmaxf(__builtin_fmaxf(p1[0], p1[1]), p1[2]), md = __builtin_fmaxf(__builtin_fmaxf(p1[8], p1[9]), p1[10]);
    ma = __builtin_fmaxf(__builtin_fmaxf(ma, p0[3]), p0[4]); mb = __builtin_fmaxf(__builtin_fmaxf(mb, p0[11]), p0[12]); mc = __builtin_fmaxf(__builtin_fmaxf(mc, p1[3]), p1[4]); md = __builtin_fmaxf(__builtin_fmaxf(md, p1[11]), p1[12]);
    ma = __builtin_fmaxf(__builtin_fmaxf(ma, p0[5]), p0[6]); mb = __builtin_fmaxf(__builtin_fmaxf(mb, p0[13]), p0[14]); mc = __builtin_fmaxf(__builtin_fmaxf(mc, p1[5]), p1[6]); md = __builtin_fmaxf(__builtin_fmaxf(md, p1[13]), p1[14]);
    ma = __builtin_fmaxf(__builtin_fmaxf(ma, p0[7]), mb); mc = __builtin_fmaxf(__builtin_fmaxf(mc, p1[7]), md);
    float pmax = __builtin_fmaxf(__builtin_fmaxf(ma, p0[15]), __builtin_fmaxf(mc, p1[15]));
    { auto rr = __builtin_amdgcn_permlane32_swap(__float_as_uint(pmax), __float_as_uint(pmax), false, false); pmax = __builtin_fmaxf(__uint_as_float(rr[0]), __uint_as_float(rr[1])); }
    alpha = 1.f;
    if (__builtin_expect(first || !__all(pmax <= THR), 0)) {
        const float dl = first ? pmax : fmaxf(pmax, 0.f);
        m_reg += dl; alpha = first ? 1.f : __builtin_amdgcn_exp2f(-dl);
#pragma unroll
        for (int r = 0; r < 16; ++r) { p0[r] -= dl; p1[r] -= dl; negm[r] = -m_reg; }
    }
#pragma unroll
    for (int r = 0; r < 16; ++r) { p0[r] = __builtin_amdgcn_exp2f(p0[r]); p1[r] = __builtin_amdgcn_exp2f(p1[r]); }
    float ps0 = p0[0], ps1 = p1[0], ps2 = p0[8], ps3 = p1[8];
#pragma unroll
    for (int r = 1; r < 8; ++r) { ps0 += p0[r]; ps1 += p1[r]; ps2 += p0[8 + r]; ps3 += p1[8 + r]; }
    l_reg = l_reg * alpha + ((ps0 + ps1) + (ps2 + ps3));
#define PK4N(P, BASE, OUT) do { u32x4 w = {cvt_pk_bf16(P[BASE + 0], P[BASE + 1]), cvt_pk_bf16(P[BASE + 2], P[BASE + 3]), cvt_pk_bf16(P[BASE + 4], P[BASE + 5]), cvt_pk_bf16(P[BASE + 6], P[BASE + 7])}; \
    OUT = __builtin_bit_cast(bf16x8, w); } while (0)
    PK4N(p0, 0, pa0); PK4N(p0, 8, pa1); PK4N(p1, 0, pa2); PK4N(p1, 8, pa3);
#undef PK4N
}
#define ATT_RESC2(a) do { if (__any((a) < 1.f)) { if (hi == 0) al_l[r32] = (a); asm volatile("s_waitcnt lgkmcnt(0)" ::: "memory"); \
    _Pragma("unroll") for (int r = 0; r < 16; ++r) { const float f_ = al_l[crow(r, hi)]; o[0][r] *= f_; o[1][r] *= f_; o[2][r] *= f_; o[3][r] *= f_; } } } while (0)
#define ATT_RESC(a) do { if (__any((a) < 1.f)) { if (hi == 0) al_l[r32] = (a); asm volatile("s_waitcnt lgkmcnt(0)" ::: "memory"); \
    _Pragma("unroll") for (int d = 0; d < 4; ++d) _Pragma("unroll") for (int r = 0; r < 16; ++r) o[d][r] *= al_l[crow(r, hi)]; } } while (0)

__device__ __forceinline__ void diff_unit(const bf16_t* __restrict__ proj, bf16_t* __restrict__ mix, float* __restrict__ o1s, const float* __restrict__ g_sub, float lam,
                                          int rowbase, int T, int h, int qb, char* lds, int widk) {
    const int tid = tid_l(widk), wid = tid >> 6, lane = tid & 63, r32 = lane & 31, hi = lane >> 5;
    char* V_lds = lds; char* K_lds = lds + DF_K;
    float* wsf = (float*)(lds + DF_WS) + wid * 64; float* li_l = wsf; float* al_l = wsf + 32;
    LAS unsigned char* ldsl = (LAS unsigned char*)lds; const int widu = __builtin_amdgcn_readfirstlane(wid); const int grp = widu >> 2;
    unsigned kgo, vgo[2];
    { const int X = wid * 1024 + lane * 16, krow = X >> 7, kcolB = (X & 127) ^ (((krow >> 1) & 7) << 4); kgo = (unsigned)(krow * INW * 2 + kcolB); }
#pragma unroll
    for (int i = 0; i < 2; ++i) { const int X = wid * 1024 + lane * 16 + i * 8192, sub = X >> 9, e = (X & 511) >> 1, kk = (sub >> 2) * 8 + (e >> 5), cc = (sub & 3) * 32 + (e & 31);
        vgo[i] = (unsigned)((kk * INW + cc) * 2); }
    const int vb0 = (int)(uintptr_t)V_lds + v_rd_base(lane);
    const int NT = T / 64; const int q0 = qb * 256;
    const bf16_t* Vh = proj + (size_t)rowbase * INW + 5120 + h * 128;
#define BAR() do { asm volatile("" ::: "memory"); __builtin_amdgcn_s_barrier(); asm volatile("" ::: "memory"); } while (0)
#pragma unroll 1
    for (int s = 0; s < 2; ++s) {
        const bf16_t* Kh = proj + (size_t)rowbase * INW + 4096 + h * 128 + s * 64;
        const unsigned qoff = ((unsigned)(rowbase + q0 + wid * 32 + r32) * INW + 3072 + h * 128 + s * 64 + hi * 8) * 2u;
        bf16x8 qr[4];
#pragma unroll
        for (int d0 = 0; d0 < 4; ++d0) qr[d0] = *(const bf16x8*)((const char*)proj + qoff + d0 * 32);
        float m_reg = 0.f, l_reg = 0.f; f32x16 o[4], negm = f32x16{};
#pragma unroll
        for (int d = 0; d < 4; ++d) o[d] = f32x16{};
#define DDMA(j, b) do { const char* kt = (const char*)Kh + (size_t)(j) * (64 * INW * 2); const char* vt = (const char*)Vh + (size_t)(j) * (64 * INW * 2); \
        __builtin_amdgcn_global_load_lds((const unsigned*)(kt + kgo), (LAS unsigned*)(ldsl + DF_K + (b) * DF_KSZ + widu * 1024), 16, 0, 0); \
        __builtin_amdgcn_global_load_lds((const unsigned*)(vt + vgo[0]), (LAS unsigned*)(ldsl + (b) * SHM_V + widu * 1024), 16, 0, 0); \
        __builtin_amdgcn_global_load_lds((const unsigned*)(vt + vgo[1]), (LAS unsigned*)(ldsl + (b) * SHM_V + widu * 1024 + 8192), 16, 0, 0); } while (0)
#pragma unroll
        for (int t = 0; t < DF_D; ++t) DDMA(t, t);
        asm volatile("s_waitcnt vmcnt(%0)" :: "n"(3 * (DF_D - 1)) : "memory"); BAR();
        int ka[4];
#pragma unroll
        for (int d0 = 0; d0 < 4; ++d0) ka[d0] = (int)(uintptr_t)K_lds + KSWZ64(r32, (d0 * 16 + hi * 8) * 2);
#define KRD(dst, addr, OFF) asm volatile("ds_read_b128 %0, %1 offset:" #OFF : "=&v"(dst) : "v"(addr) : "memory")
        if (grp) BAR();
        int bsl = 0;
#pragma unroll 1
        for (int j = 0; j < NT; ++j) {
            BAR();
            f32x16 p0, p1;
            __builtin_amdgcn_s_setprio(1);
            { const int kb = bsl * DF_KSZ; bf16x8 k0, k1, k2, k3, k4, k5, k6, k7; const int a0 = ka[0] + kb, a1 = ka[1] + kb, a2 = ka[2] + kb, a3 = ka[3] + kb;
              KRD(k0, a0, 0); KRD(k1, a0, 4096); KRD(k2, a1, 0); KRD(k3, a1, 4096); KRD(k4, a2, 0); KRD(k5, a2, 4096); KRD(k6, a3, 0); KRD(k7, a3, 4096);
              asm volatile("s_waitcnt lgkmcnt(6)" ::: "memory"); SBAR();
              p0 = __builtin_amdgcn_mfma_f32_32x32x16_bf16(k0, qr[0], negm, 0, 0, 0); p1 = __builtin_amdgcn_mfma_f32_32x32x16_bf16(k1, qr[0], negm, 0, 0, 0); SBAR();
              asm volatile("s_waitcnt lgkmcnt(4)" ::: "memory"); SBAR();
              p0 = __builtin_amdgcn_mfma_f32_32x32x16_bf16(k2, qr[1], p0, 0, 0, 0); p1 = __builtin_amdgcn_mfma_f32_32x32x16_bf16(k3, qr[1], p1, 0, 0, 0); SBAR();
              asm volatile("s_waitcnt lgkmcnt(2)" ::: "memory"); SBAR();
              p0 = __builtin_amdgcn_mfma_f32_32x32x16_bf16(k4, qr[2], p0, 0, 0, 0); p1 = __builtin_amdgcn_mfma_f32_32x32x16_bf16(k5, qr[2], p1, 0, 0, 0); SBAR();
              asm volatile("s_waitcnt lgkmcnt(0)" ::: "memory"); SBAR();
              p0 = __builtin_amdgcn_mfma_f32_32x32x16_bf16(k6, qr[3], p0, 0, 0, 0); p1 = __builtin_amdgcn_mfma_f32_32x32x16_bf16(k7, qr[3], p1, 0, 0, 0); SBAR(); }
            __builtin_amdgcn_s_setprio(0);
            float alpha; bf16x8 pa0, pa1, pa2, pa3;
            softmax_rel(p0, p1, m_reg, l_reg, negm, alpha, j == 0, pa0, pa1, pa2, pa3);
            ATT_RESC2(alpha);
            if (j + DF_D <= NT) asm volatile("s_waitcnt vmcnt(%0) lgkmcnt(0)" :: "n"(3 * (DF_D - 2)) : "memory"); else asm volatile("s_waitcnt vmcnt(0) lgkmcnt(0)" ::: "memory");
            BAR();
            if (j + DF_D < NT) { const int b2 = bsl >= 1 ? bsl - 1 : DF_R - 1; DDMA(j + DF_D, b2); }
            const int bn = bsl == DF_R - 1 ? 0 : bsl + 1;
            pv_all_pre(o, vb0 + bsl * SHM_V, pa0, pa1, pa2, pa3);
            bsl = bn;
        }
#undef KRD
        asm volatile("s_waitcnt lgkmcnt(0)" ::: "memory");
        if (!grp) BAR();
        BAR();
#undef DDMA
        { auto rr = __builtin_amdgcn_permlane32_swap(__float_as_uint(l_reg), __float_as_uint(l_reg), false, false); l_reg = __uint_as_float(rr[0]) + __uint_as_float(rr[1]); }
        if (hi == 0) li_l[r32] = l_reg;
        asm volatile("s_waitcnt lgkmcnt(0)" ::: "memory");
        float rli[16];
#pragma unroll
        for (int r = 0; r < 16; ++r) rli[r] = __builtin_amdgcn_rcpf(li_l[crow(r, hi)]);
        f32x4* o1v = (f32x4*)((char*)o1s + (unsigned)tid * 256u);
        if (s == 0) {
#pragma unroll
            for (int d = 0; d < 4; ++d)
#pragma unroll
                for (int r = 0; r < 16; r += 4) o1v[d * 4 + (r >> 2)] = (f32x4){o[d][r] * rli[r], o[d][r + 1] * rli[r + 1], o[d][r + 2] * rli[r + 2], o[d][r + 3] * rli[r + 3]};
        } else {
#pragma unroll
            for (int d = 0; d < 4; ++d)
#pragma unroll
                for (int r = 0; r < 16; r += 4) { const f32x4 t = o1v[d * 4 + (r >> 2)];
#pragma unroll
                    for (int e = 0; e < 4; ++e) o[d][r + e] = t[e] - lam * (o[d][r + e] * rli[r + e]); }
            float gs[4];
#pragma unroll
            for (int d = 0; d < 4; ++d) gs[d] = g_sub[d * 32 + r32] * (1.0f - LAM_INIT);
            bf16_t* stg = (bf16_t*)(lds + DF_STG) + wid * 4096;
#pragma unroll
            for (int r = 0; r < 16; ++r) {
                float q = (o[0][r] * o[0][r] + o[1][r] * o[1][r]) + (o[2][r] * o[2][r] + o[3][r] * o[3][r]);
                q += __shfl_xor(q, 1); q += __shfl_xor(q, 2); q += __shfl_xor(q, 4); q += __shfl_xor(q, 8); q += __shfl_xor(q, 16);
                const float rn = __builtin_amdgcn_rsqf(q * (1.0f / 128.0f) + SUBLN_EPS);
#pragma unroll
                for (int d = 0; d < 4; ++d) stg[crow(r, hi) * 128 + d * 32 + r32] = (bf16_t)f2bf(o[d][r] * rn * gs[d]);
            }
            asm volatile("s_waitcnt lgkmcnt(0)" ::: "memory");
            const unsigned goff = ((unsigned)(rowbase + q0 + wid * 32 + (lane >> 4)) * DM + 1024 + h * 128 + (lane & 15) * 8) * 2u;
#pragma unroll
            for (int i = 0; i < 8; ++i) { const u32x4 v = *(const u32x4*)(stg + (i * 4 + (lane >> 4)) * 128 + (lane & 15) * 8); *(u32x4*)((char*)mix + goff + (unsigned)(i * 4 * DM * 2)) = v; }
            asm volatile("s_waitcnt lgkmcnt(0)" ::: "memory"); BAR();
        }
    }
#undef BAR
}

__device__ __forceinline__ void na_unit(const bf16_t* __restrict__ proj, bf16_t* __restrict__ mix, const float* __restrict__ rpb,
                                        int rowbase, int ROWS, int h, int rg, char* lds, int widk) {
    const int tid = tid_l(widk), wid = tid >> 6, lane = tid & 63, r32 = lane & 31, hi = lane >> 5;
    char* V_lds = lds; char* K_lds = lds + OFF_K;
    float* wsf = (float*)(lds + OFF_WS) + wid * 64; float* li_l = wsf; float* al_l = wsf + 32;
    float* rpbL = (float*)(lds + OFF_RPB);
    LAS unsigned char* ldsl = (LAS unsigned char*)lds; const int widu = __builtin_amdgcn_readfirstlane(wid);
    unsigned kgo[2], vgo[2];
#pragma unroll
    for (int i = 0; i < 2; ++i) { const int X = wid * 1024 + lane * 16 + i * 8192;
        { const int krow = X >> 8, kcolB = (X & 255) ^ ((krow & 7) << 4); kgo[i] = (unsigned)(krow * INW * 2 + kcolB); }
        { const int sub = X >> 9, e = (X & 511) >> 1, kk = (sub >> 2) * 8 + (e >> 5), cc = (sub & 3) * 32 + (e & 31); const int k = (kk & ~0xC) | ((kk & 4) << 1) | ((kk & 8) >> 1); vgo[i] = (unsigned)((k * INW + cc) * 2); } }
    const int vb0 = (int)(uintptr_t)V_lds + v_rd_base(lane);
    const int r0 = rg * 4, rq = r0 + (wid >> 1), c = 32 * (wid & 1) + r32;
    const int rsw = min(max(rq - 4, 0), ROWS - 8), cs = min(max(c - 8, 0), 48);
    const int klo = min(max(r0 - 4, 0), ROWS - 8), khi = min(max(r0 + 3 - 4, 0), ROWS - 8) + 8;
    for (int i = tid; i < 465; i += NTHREADS) rpbL[i] = rpb[h * 465 + i] * LOG2E;
    const bf16_t* Kh = proj + (size_t)rowbase * INW + 1024 + h * 128;
    const bf16_t* Vh = proj + (size_t)rowbase * INW + 2048 + h * 128;
    const bf16_t* Qw = proj + (size_t)(rowbase + rq * 64 + c) * INW + h * 128 + hi * 8;
    bf16x8 qr[8];
#pragma unroll
    for (int d0 = 0; d0 < 8; ++d0) qr[d0] = *(const bf16x8*)(Qw + d0 * 16);
    float m_reg = -1e30f, l_reg = 0.f; f32x16 o[4];
#pragma unroll
    for (int d = 0; d < 4; ++d) o[d] = f32x16{};
#define NDMA(kr, b) do { const char* kt = (const char*)Kh + (size_t)(kr) * (64 * INW * 2); const char* vt = (const char*)Vh + (size_t)(kr) * (64 * INW * 2); \
        __builtin_amdgcn_global_load_lds((const unsigned*)(kt + kgo[0]), (LAS unsigned*)(ldsl + OFF_K + (b) * SHM_K + widu * 1024), 16, 0, 0); \
        __builtin_amdgcn_global_load_lds((const unsigned*)(kt + kgo[1]), (LAS unsigned*)(ldsl + OFF_K + (b) * SHM_K + widu * 1024 + 8192), 16, 0, 0); \
        __builtin_amdgcn_global_load_lds((const unsigned*)(vt + vgo[0]), (LAS unsigned*)(ldsl + (b) * SHM_V + widu * 1024), 16, 0, 0); \
        __builtin_amdgcn_global_load_lds((const unsigned*)(vt + vgo[1]), (LAS unsigned*)(ldsl + (b) * SHM_V + widu * 1024 + 8192), 16, 0, 0); } while (0)
    NDMA(klo, 0); asm volatile("s_waitcnt vmcnt(0)" ::: "memory"); __syncthreads();
#pragma unroll 1
    for (int kr = klo; kr < khi; ++kr) {
        const int b = (kr - klo) & 1;
        if (kr + 1 < khi) NDMA(kr + 1, b ^ 1);
        if (kr >= rsw && kr < rsw + 8) {
            f32x16 p0 = f32x16{}, p1 = f32x16{};
            const char* Ks = K_lds + b * SHM_K;
#pragma unroll
            for (int d0 = 0; d0 < 8; ++d0) { const int cb = (d0 * 16 + hi * 8) * 2;
                const bf16x8 b0 = *(const bf16x8*)(Ks + KSWZ128(r32, cb)); const bf16x8 b1 = *(const bf16x8*)(Ks + KSWZ128(32 + r32, cb));
                p0 = __builtin_amdgcn_mfma_f32_32x32x16_bf16(b0, qr[d0], p0, 0, 0, 0); p1 = __builtin_amdgcn_mfma_f32_32x32x16_bf16(b1, qr[d0], p1, 0, 0, 0); }
            const float* brow = rpbL + (kr - rq + 7) * 31;
#pragma unroll
            for (int r = 0; r < 16; ++r) {
                const int kc = crow(r, hi), kc2 = kc + 32;
                const int i0 = min(max(kc - c + 15, 0), 30), i1 = min(max(kc2 - c + 15, 0), 30);
                const float b0 = brow[i0], b1 = brow[i1];
                p0[r] = ((unsigned)(kc - cs) < 16u) ? p0[r] + b0 : -1e30f;
                p1[r] = ((unsigned)(kc2 - cs) < 16u) ? p1[r] + b1 : -1e30f;
            }
            float alpha; bf16x8 pa0, pa1, pa2, pa3;
            softmax_tile(p0, p1, m_reg, l_reg, alpha, pa0, pa1, pa2, pa3);
            ATT_RESC(alpha);
            pv_all(o, vb0 + b * SHM_V, pa0, pa1, pa2, pa3);
        }
        asm volatile("s_waitcnt vmcnt(0)" ::: "memory");
        __syncthreads();
    }
#undef NDMA
    if (hi == 0) li_l[r32] = l_reg;
    asm volatile("s_waitcnt lgkmcnt(0)" ::: "memory");
    bf16_t* stg = (bf16_t*)(lds + OFF_STG) + wid * 4096;
#pragma unroll
    for (int r = 0; r < 16; ++r) { const float rl = __builtin_amdgcn_rcpf(li_l[crow(r, hi)]);
#pragma unroll
        for (int d = 0; d < 4; ++d) stg[crow(r, hi) * 128 + d * 32 + r32] = (bf16_t)f2bf(o[d][r] * rl); }
    asm volatile("s_waitcnt lgkmcnt(0)" ::: "memory");
    bf16_t* gp = mix + (size_t)(rowbase + rq * 64 + 32 * (wid & 1) + (lane >> 4)) * DM + h * 128 + (lane & 15) * 8;
#pragma unroll
    for (int i = 0; i < 8; ++i) { const u32x4 v = *(const u32x4*)(stg + (i * 4 + (lane >> 4)) * 128 + (lane & 15) * 8); *(u32x4*)gp = v; gp += 4 * DM; }
    __syncthreads();
}
#undef SBAR
}

template <int MODE> __device__ __forceinline__ int dest_row(int n) {
    if (MODE == 1) { if (n < 3072 || n >= 5120) return n; const int d = n & 63, blk = n & ~63, nn = d >> 5, dd = d & 31; return blk + 32 * (dd >> 4) + 8 * ((dd >> 2) & 3) + 4 * nn + (dd & 3); }
    if (MODE == 2) { if (n < DFF) return 256 * (n >> 7) + (n & 127); const int n2 = n - DFF; return 256 * (n2 >> 7) + 128 + (n2 & 127); }
    return n;
}
template <int MODE> __device__ __forceinline__ void p0_transpose_item(const float* __restrict__ W, int K, int N, bf16_t* __restrict__ WT, const float* __restrict__ gain, LAS float* scr, int item, int lane) {
    const int nblk = N / 32, kb = item / nblk, nb = item % nblk, k0 = 64 * kb, n0 = 32 * nb;
#pragma unroll 8
    for (int i = 0; i < 32; ++i) { const int kk = 2 * i + (lane >> 5); const float g = gain ? gain[k0 + kk] : 1.0f; scr[kk * 33 + (lane & 31)] = W[(size_t)(k0 + kk) * N + n0 + (lane & 31)] * g; }
    asm volatile("s_waitcnt lgkmcnt(0)" ::: "memory");
    const int c = lane & 7;
#pragma unroll
    for (int j = 0; j < 4; ++j) { const int n = (lane >> 3) + 8 * j; const LAS float* s = scr + (8 * c) * 33 + n;
        u32x4 o; o.x = pk2(s[0 * 33], s[1 * 33]); o.y = pk2(s[2 * 33], s[3 * 33]); o.z = pk2(s[4 * 33], s[5 * 33]); o.w = pk2(s[6 * 33], s[7 * 33]);
        *(u32x4*)(WT + (size_t)dest_row<MODE>(n0 + n) * K + k0 + 8 * c) = o; }
    asm volatile("s_waitcnt lgkmcnt(0)" ::: "memory");
}
__device__ __forceinline__ float row_ssq(const float* xrow, int lane, f32x4 (&v)[8]) {
    const f32x4* xr = (const f32x4*)xrow + lane; float s = 0.f;
#pragma unroll
    for (int j = 0; j < 8; ++j) { v[j] = xr[64 * j]; s += (v[j][0] * v[j][0] + v[j][1] * v[j][1]) + (v[j][2] * v[j][2] + v[j][3] * v[j][3]); }
    return wave_sum(s);
}
__device__ __forceinline__ void sincos_d(double x, double& sn, double& cs) {
    const double k = __builtin_rint(x * 0.6366197723675814); const double r0 = __builtin_fma(-k, 1.5707963267948966, x); const double r = __builtin_fma(-k, 6.123233995736766e-17, r0);
    const double r2 = r * r;
    double s = -1.0 / 1307674368000.0; s = s * r2 + 1.0 / 6227020800.0; s = s * r2 - 1.0 / 39916800.0; s = s * r2 + 1.0 / 362880.0; s = s * r2 - 1.0 / 5040.0; s = s * r2 + 1.0 / 120.0; s = s * r2 - 1.0 / 6.0; s = s * r2 * r + r;
    double c = 1.0 / 20922789888000.0; c = c * r2 - 1.0 / 87178291200.0; c = c * r2 + 1.0 / 479001600.0; c = c * r2 - 1.0 / 3628800.0; c = c * r2 + 1.0 / 40320.0; c = c * r2 - 1.0 / 720.0; c = c * r2 + 1.0 / 24.0; c = c * r2 - 0.5; c = c * r2 + 1.0;
    const int q = ((int)k) & 3;
    sn = (q == 0) ? s : (q == 1) ? c : (q == 2) ? -s : -c;
    cs = (q == 0) ? c : (q == 1) ? -s : (q == 2) ? -c : s;
}

struct Args { const float* in[22]; float* out; unsigned char* ws; int ph_lo, ph_hi; };
constexpr int NPHASE = 10;

__global__ void __launch_bounds__(NTHREADS, 2) fwd_kernel(Args a) {
    extern __shared__ __attribute__((aligned(16))) unsigned char lds[];
    LAS unsigned char* ldsl = (LAS unsigned char*)lds;
    const int widk = __builtin_amdgcn_readfirstlane((int)(threadIdx.x >> 6));
    const int G = gridDim.x, bx = blockIdx.x, vcu = (G % 8 == 0) ? (bx % 8) * (G / 8) + bx / 8 : bx;
#define x_p (ap->in[0])
#define x_s (ap->in[1])
#define mem_p (ap->in[2])
#define mem_s (ap->in[3])
#define g_mix (ap->in[4])
#define w_in (ap->in[5])
#define rpb (ap->in[6])
#define lam_q1 (ap->in[7])
#define lam_k1 (ap->in[8])
#define lam_q2 (ap->in[9])
#define lam_k2 (ap->in[10])
#define g_subln (ap->in[11])
#define w_out (ap->in[12])
#define g_xattn (ap->in[13])
#define g_mem (ap->in[14])
#define w_mq (ap->in[15])
#define w_mkv (ap->in[16])
#define w_mo (ap->in[17])
#define g_ffn (ap->in[18])
#define w_gu (ap->in[19])
#define w_dn (ap->in[20])
#define g_final (ap->in[21])
#define out (ap->out)
#define WSP() const __attribute__((address_space(4))) Args* ap = (const __attribute__((address_space(4))) Args*)__builtin_amdgcn_kernarg_segment_ptr(); asm volatile("" : "+s"(ap)); unsigned char* ws = ap->ws
#define SS ((float*)(ws + WS_SS))
#define RS0 ((float*)(ws + WS_RS0))
#define ROPE ((f32x2*)(ws + WS_ROPE))
#define WIN ((bf16_t*)(ws + WS_WIN))
#define WOUT ((bf16_t*)(ws + WS_WOUT))
#define WMQ ((bf16_t*)(ws + WS_WMQ))
#define WMO ((bf16_t*)(ws + WS_WMO))
#define WMKV ((bf16_t*)(ws + WS_WMKV))
#define WGU ((bf16_t*)(ws + WS_WGU))
#define WDN ((bf16_t*)(ws + WS_WDN))
#define MN ((bf16_t*)(ws + WS_MN))
#define KB ((bf16_t*)(ws + WS_KB))
#define VB ((bf16_t*)(ws + WS_VB))
#define WQK ((bf16_t*)(ws + WS_WQK))
#define WVO ((bf16_t*)(ws + WS_WVO))
#define O1S ((float*)(ws + WS_O1))
#define XB ((bf16_t*)(ws + WS_XB))
#define PROJ ((bf16_t*)(ws + WS_BIG))
#define H1B ((bf16_t*)(ws + WS_H1B))
#define SB ((float*)(ws + WS_S))
#define PB ((bf16_t*)(ws + WS_P))
#define ACT ((bf16_t*)(ws + WS_ACT))
#define MIX XB
#define H2B XB
    const int lo = a.ph_lo, hi_ph = a.ph_hi;
    if (lo < 0) cg::this_grid().sync();
#ifdef ONLY_PHASE
#define IN(k) ((k) == ONLY_PHASE && lo <= (k) && (k) < hi_ph)
#else
#define IN(k) (lo <= (k) && (k) < hi_ph)
#endif
#define SEAM(k) do { if (IN(k) && IN((k) + 1)) { WSP(); grid_barrier((unsigned*)(ws + WS_BAR), (unsigned)((k) + 1 - lo) * (unsigned)G, tid_l(widk)); } } while (0)
    const int NGW = G * 8;
#define TIDS() const int tid = tid_l(widk), lane = tid & 63, wave = __builtin_amdgcn_readfirstlane(tid >> 6), gw = vcu * 8 + wave; (void)lane; (void)gw

    if (IN(0)) { WSP(); TIDS();
        LAS float* scr = (LAS float*)(ldsl + wave * 16384);
        constexpr int I0 = (DM / 64) * (INW / 32), I1 = (DM / 64) * (DM / 32), I2 = I1, I3 = (DM / 64) * (4096 / 32), I4 = (DM / 64) * (NGU / 32), I5 = (DFF / 64) * (DM / 32);
        constexpr int NIT = I0 + I1 + I2 + I3 + I4 + I5;
        for (int it = gw; it < NIT; it += NGW) {
            int r = it;
            if (r < I0) { p0_transpose_item<1>(w_in, DM, INW, WIN, g_mix, scr, r, lane); continue; } r -= I0;
            if (r < I1) { p0_transpose_item<0>(w_out, DM, DM, WOUT, nullptr, scr, r, lane); continue; } r -= I1;
            if (r < I2) { p0_transpose_item<0>(w_mo, DM, DM, WMO, nullptr, scr, r, lane); continue; } r -= I2;
            if (r < I3) { p0_transpose_item<0>(w_mkv, DM, 4096, WMKV, nullptr, scr, r, lane); continue; } r -= I3;
            if (r < I4) { p0_transpose_item<2>(w_gu, DM, NGU, WGU, g_ffn, scr, r, lane); continue; } r -= I4;
            p0_transpose_item<0>(w_dn, DFF, DM, WDN, nullptr, scr, r, lane);
        }
        for (int k = gw; k < DM; k += NGW) { const float g = g_xattn[k]; const f32x4* src = (const f32x4*)(w_mq + (size_t)k * DM) + lane; u32x2* dst = (u32x2*)(WMQ + (size_t)k * DM) + lane;
#pragma unroll
            for (int j = 0; j < 8; ++j) { const f32x4 v = src[64 * j] * g; u32x2 w; w.x = pk2(v[0], v[1]); w.y = pk2(v[2], v[3]); dst[64 * j] = w; } }
        for (int m = gw; m < MT; m += NGW) { const float* xr = m < NP ? x_p + (size_t)m * DM : x_s + (size_t)(m - NP) * DM; f32x4 v[8];
            const float s = row_ssq(xr, lane, v); if (lane == 0) RS0[m] = 1.0f / sqrtf(s * (1.0f / DM) + RMS_EPS);
            u32x2* dst = (u32x2*)(XB + (size_t)m * DM) + lane;
#pragma unroll
            for (int j = 0; j < 8; ++j) { u32x2 w; w.x = pk2(v[j][0], v[j][1]); w.y = pk2(v[j][2], v[j][3]); dst[64 * j] = w; } }
        for (int m = gw; m < NMEM; m += NGW) { const float* xr = m < 512 ? mem_p + (size_t)m * DM : mem_s + (size_t)(m - 512) * DM; f32x4 v[8];
            const float s = row_ssq(xr, lane, v); const float rr = 1.0f / sqrtf(s * (1.0f / DM) + RMS_EPS);
            u32x2* dst = (u32x2*)(MN + (size_t)m * DM) + lane; const f32x4* gp = (const f32x4*)g_mem + lane;
#pragma unroll
            for (int j = 0; j < 8; ++j) { const f32x4 g = gp[64 * j]; u32x2 w; w.x = pk2(v[j][0] * rr * g[0], v[j][1] * rr * g[1]); w.y = pk2(v[j][2] * rr * g[2], v[j][3] * rr * g[3]); dst[64 * j] = w; } }
        for (int e = vcu * NTHREADS + tid; e < TP * 32; e += G * NTHREADS) { const int t = e >> 5, dd = e & 31;
            double pw = 1.0; for (int i = 0; i < dd; ++i) pw *= 1.333521432163324;
            const float inv = 1.0f / (float)pw; const float ang = (float)t * inv; double sn, cs; sincos_d((double)ang, sn, cs);
            ROPE[e] = (f32x2){(float)cs, (float)sn}; }
    }
    SEAM(0);

    if (IN(1)) { WSP();
        pg8::Sched S{(const char*)XB, (const char*)WIN, (const char*)MN, (const char*)WMKV, MT / 256, INW / 256, (MT / 256) * (INW / 256), NMEM / 256, (NMEM / 256) * 16,
                     (size_t)256 * DM * 2, (size_t)256 * DM * 2, 0, G, bx};
        pg8::EpiInProj E{PROJ, KB, VB, RS0, ROPE};
        pg8::gemm_phase<pg8::EpiInProj, pg8::Sched, true, true>(ldsl, widk, DM, DM, S, E);
    }
    SEAM(1);

    if (IN(2)) { WSP(); TIDS();
#if !defined(P2_PART) || P2_PART == 1
        { pg8::PreSched S{(const char*)KB, (const char*)VB, (const char*)WMQ, (const char*)WMO, G, bx}; pg8::EpiPre E{WQK, WVO};
          pg8::gemm_phase<pg8::EpiPre, pg8::PreSched, true, true>(ldsl, widk, 512, DM, S, E); }
#endif
        __syncthreads();
#if !defined(P2_PART) || P2_PART == 2
        for (int id = vcu; id < 1024 + 512; id += G) {
            const bool pr = id < 1024; const int i2 = pr ? id : id - 1024;
            const int rg = pr ? (i2 & 63) : (i2 & 15), h = pr ? ((i2 >> 6) & 7) : ((i2 >> 4) & 7), b = pr ? (i2 >> 9) : (i2 >> 7);
            att::na_unit(PROJ, MIX, rpb, pr ? b * TP : NP + b * TS, pr ? TP / 64 : TS / 64, h, rg, (char*)lds, widk);
        }
#endif
#if !defined(P2_PART) || P2_PART == 3
        float lam;
        { const float a1 = wave_sum(lam_q1[lane] * lam_k1[lane]), a2 = wave_sum(lam_q2[lane] * lam_k2[lane]); lam = __expf(a1) - __expf(a2) + LAM_INIT; lam = __builtin_bit_cast(float, __builtin_amdgcn_readfirstlane(__builtin_bit_cast(int, lam))); }
        float* o1s = O1S + (size_t)bx * 64 * NTHREADS;
#ifndef DIFF_REPS
#define DIFF_REPS 1
#endif
        for (int rep = 0; rep < DIFF_REPS; ++rep)
        for (int id = vcu; id < 1024 + 512; id += G) {
            const bool pr = id < 1024; const int i2 = pr ? id : id - 1024;
            const int qb = pr ? (i2 & 63) : (i2 & 15), bh = pr ? (i2 >> 6) : (i2 >> 4);
            att::diff_unit(PROJ, MIX, o1s, g_subln, lam, pr ? (bh >> 3) * TP : NP + (bh >> 3) * TS, pr ? TP : TS, bh & 7, qb, (char*)lds, widk);
        }
#endif
    }
    SEAM(2);

    if (IN(3)) { WSP();
        pg8::Sched S{(const char*)MIX, (const char*)WOUT, nullptr, nullptr, MT / 256, DM / 256, (MT / 256) * (DM / 256), 1, 0, (size_t)256 * DM * 2, (size_t)256 * DM * 2, 0, G, bx};
        pg8::EpiX E{x_p, x_s, H1B, SS};
        pg8::gemm_phase<pg8::EpiX, pg8::Sched, true, true>(ldsl, widk, DM, DM, S, E);
    }
    SEAM(3);

    if (IN(4)) { WSP();
        pg8::Sched S{(const char*)H1B, (const char*)WQK, nullptr, nullptr, MT / 256, NSW / 256, (MT / 256) * (NSW / 256), 1, 0, (size_t)256 * DM * 2, (size_t)256 * DM * 2, (size_t)NSW * DM * 2, G, bx};
        pg8::EpiS E{SB, SS};
        pg8::gemm_phase<pg8::EpiS, pg8::Sched, true, true>(ldsl, widk, DM, DM, S, E);
    }
    SEAM(4);

    if (IN(5)) { WSP(); TIDS();
        for (int m = gw; m < MT; m += NGW) {
            const f32x4* sp = (const f32x4*)(SB + (size_t)m * NSW) + lane; u32x2* pp = (u32x2*)(PB + (size_t)m * NSW) + lane;
#pragma unroll
            for (int hh = 0; hh < 4; ++hh) { f32x4 v = sp[64 * hh]; const float mx = wave_max(fmaxf(fmaxf(v[0], v[1]), fmaxf(v[2], v[3])));
                v[0] = __builtin_amdgcn_exp2f(v[0] - mx); v[1] = __builtin_amdgcn_exp2f(v[1] - mx); v[2] = __builtin_amdgcn_exp2f(v[2] - mx); v[3] = __builtin_amdgcn_exp2f(v[3] - mx);
                const float rl = 1.0f / wave_sum((v[0] + v[1]) + (v[2] + v[3]));
                u32x2 w; w.x = pk2(v[0] * rl, v[1] * rl); w.y = pk2(v[2] * rl, v[3] * rl); pp[64 * hh] = w; }
        }
    }
    SEAM(5);

    if (IN(6)) { WSP();
        pg8::Sched S{(const char*)PB, (const char*)WVO, nullptr, nullptr, MT / 256, DM / 256, (MT / 256) * (DM / 256), 1, 0, (size_t)256 * NSW * 2, (size_t)256 * NSW * 2, (size_t)DM * NSW * 2, G, bx};
        pg8::EpiResid E{nullptr, H1B, H2B, DM, SS};
        pg8::gemm_phase<pg8::EpiResid, pg8::Sched, true, true>(ldsl, widk, NSW, NSW, S, E);
    }
    SEAM(6);

    if (IN(7)) { WSP();
        pg8::Sched S{(const char*)H2B, (const char*)WGU, nullptr, nullptr, MT / 256, NGU / 256, (MT / 256) * (NGU / 256), 1, 0, (size_t)256 * DM * 2, (size_t)256 * DM * 2, 0, G, bx};
        pg8::EpiGU E{ACT, SS};
        pg8::gemm_phase<pg8::EpiGU, pg8::Sched, true, true>(ldsl, widk, DM, DM, S, E);
    }
    SEAM(7);

    if (IN(8)) { WSP();
        pg8::Sched S{(const char*)ACT, (const char*)WDN, nullptr, nullptr, MT / 256, DM / 256, (MT / 256) * (DM / 256), 1, 0, (size_t)256 * DFF * 2, (size_t)256 * DFF * 2, 0, G, bx};
        pg8::EpiResid E{nullptr, H2B, (bf16_t*)out + DM, 2 * DM, SS};
        pg8::gemm_phase<pg8::EpiResid, pg8::Sched, true, true>(ldsl, widk, DFF, DFF, S, E);
    }
    SEAM(8);

    if (IN(9)) { WSP(); TIDS();
        for (int m = gw; m < MT; m += NGW) {
            float sq = lane < 32 ? SS[(size_t)m * 32 + lane] : 0.f; sq = wave_sum(sq); const float rr = __builtin_amdgcn_rsqf(sq * (1.0f / DM) + RMS_EPS);
            const u32x2* hp = (const u32x2*)((const bf16_t*)out + (size_t)m * (2 * DM) + DM) + lane;
            u32x2 hv[8];
#pragma unroll
            for (int j = 0; j < 8; ++j) hv[j] = hp[64 * j];
            asm volatile("s_waitcnt vmcnt(0)" ::: "memory");
            f32x4* op = (f32x4*)(out + (size_t)m * DM) + lane; const f32x4* gp = (const f32x4*)g_final + lane;
#pragma unroll
            for (int j = 0; j < 8; ++j) { const f32x4 g = gp[64 * j];
                const f32x4 v = (f32x4){__uint_as_float(hv[j].x << 16), __uint_as_float(hv[j].x & 0xffff0000u), __uint_as_float(hv[j].y << 16), __uint_as_float(hv[j].y & 0xffff0000u)};
                op[64 * j] = v * rr * g; }
        }
    }
#undef IN
#undef SEAM
#undef TIDS
}
#undef x_p
#undef x_s
#undef mem_p
#undef mem_s
#undef g_mix
#undef w_in
#undef rpb
#undef lam_q1
#undef lam_k1
#undef lam_q2
#undef lam_k2
#undef g_subln
#undef w_out
#undef g_xattn
#undef g_mem
#undef w_mq
#undef w_mkv
#undef w_mo
#undef g_ffn
#undef w_gu
#undef w_dn
#undef g_final
#undef out
#undef WSP
#undef SS
#undef RS0
#undef ROPE
#undef WIN
#undef WOUT
#undef WMQ
#undef WMO
#undef WMKV
#undef WGU
#undef WDN
#undef MN
#undef KB
#undef VB
#undef WQK
#undef WVO
#undef O1S
#undef XB
#undef PROJ
#undef H1B
#undef SB
#undef PB
#undef ACT
#undef MIX
#undef H2B


extern "C" void kernel_launch(void* const* d_in, const int* in_sizes, int n_in, void* d_out, int out_size, void* d_ws, size_t ws_size, hipStream_t stream) {
    static int grid = 0;
    if (grid == 0) {
        if (n_in != 22 || out_size != MT * DM || ws_size < WS_END) { fprintf(stderr, "kernel_launch: unexpected shapes (n_in %d, out %d, ws %zu); nothing launched\n", n_in, out_size, ws_size); grid = -1; return; }
        int dev = 0, cus = 0, per_cu = 0;
        (void)hipGetDevice(&dev); (void)hipDeviceGetAttribute(&cus, hipDeviceAttributeMultiprocessorCount, dev);
        if (hipFuncSetAttribute((const void*)fwd_kernel, hipFuncAttributeMaxDynamicSharedMemorySize, LDS_BYTES) != hipSuccess) { fprintf(stderr, "kernel_launch: hipFuncSetAttribute failed\n"); grid = -1; return; }
        if (hipOccupancyMaxActiveBlocksPerMultiprocessor(&per_cu, (const void*)fwd_kernel, NTHREADS, LDS_BYTES) != hipSuccess || per_cu < 1) per_cu = 1;
        (void)hipGetLastError();
        grid = cus * per_cu;
    }
    if (grid < 0) return;
    Args a{};
    for (int i = 0; i < 22; ++i) a.in[i] = (const float*)d_in[i];
    a.out = (float*)d_out; a.ws = (unsigned char*)d_ws;
#if MK_MULTI
    for (int p = 0; p < NPHASE; ++p) { a.ph_lo = p; a.ph_hi = p + 1; hipLaunchKernelGGL(fwd_kernel, dim3(grid), dim3(NTHREADS), LDS_BYTES, stream, a); }
#else
    a.ph_lo = 0; a.ph_hi = NPHASE;
    (void)hipMemsetAsync((char*)d_ws + WS_BAR, 0, 256, stream);
    void* args[] = {&a};
    hipError_t e = hipLaunchCooperativeKernel((const void*)fwd_kernel, dim3(grid), dim3(NTHREADS), args, LDS_BYTES, stream);
    if (e != hipSuccess) fprintf(stderr, "cooperative launch failed: %s (grid %d)\n", hipGetErrorString(e), grid);
#endif
}
```

```cpp
#include <hip/hip_runtime.h>
#include <hip/hip_cooperative_groups.h>
#include <cstdio>
#include <cstdint>
namespace cg = cooperative_groups;

#ifndef MK_MULTI
#define MK_MULTI 0
#endif

#define LAS __attribute__((address_space(3)))
typedef unsigned short bf16_t;
typedef short bf16x8 __attribute__((ext_vector_type(8)));
typedef short s16x4 __attribute__((ext_vector_type(4)));
typedef float f32x2 __attribute__((ext_vector_type(2)));
typedef float f32x4 __attribute__((ext_vector_type(4)));
typedef float f32x16 __attribute__((ext_vector_type(16)));
typedef unsigned u32x2 __attribute__((ext_vector_type(2)));
typedef unsigned u32x4 __attribute__((ext_vector_type(4)));

constexpr int DM = 2048, TP = 16384, TS = 4096, NP = 2 * TP, NS = 4 * TS, MT = NP + NS;
constexpr int INW = 6144, DFF = 5632, NGU = 2 * DFF, MEMT = 256, NMEM = 6 * MEMT, NSW = 1024;
constexpr float RMS_EPS = 1e-6f, SUBLN_EPS = 1e-5f, LOG2E = 1.4426950408889634f;
constexpr float NA_QS = 0.08838834764831845f * LOG2E, DF_QS = 0.125f * LOG2E, MEM_QS = 0.04419417382415922f * LOG2E;
constexpr float LAM_INIT = 0.2f;

constexpr size_t MiB = 1u << 20;
constexpr size_t WS_SS = 0, WS_RS0 = 6 * MiB, WS_ROPE = 7 * MiB, WS_WIN = 11 * MiB, WS_WOUT = 35 * MiB, WS_WMQ = 43 * MiB, WS_WMO = 51 * MiB,
                 WS_WMKV = 59 * MiB, WS_WGU = 75 * MiB, WS_WDN = 119 * MiB, WS_MN = 141 * MiB, WS_KB = 147 * MiB, WS_VB = 153 * MiB,
                 WS_WQK = 159 * MiB, WS_WVO = 183 * MiB, WS_O1 = 207 * MiB, WS_XB = 239 * MiB, WS_BIG = 431 * MiB, WS_END = 1007 * MiB;
constexpr size_t WS_BAR = 6 * MiB + 512 * 1024;
constexpr size_t WS_H1B = WS_BIG, WS_S = WS_BIG + 192 * MiB, WS_P = WS_BIG + 384 * MiB, WS_ACT = WS_BIG;

constexpr int LDS_BYTES = 147456, NTHREADS = 512;

__device__ __forceinline__ unsigned cvt_pk_bf16(float lo, float hi) { unsigned r; asm volatile("v_cvt_pk_bf16_f32 %0, %1, %2" : "=v"(r) : "v"(lo), "v"(hi)); return r; }
__device__ __forceinline__ unsigned f2bf(float f) { unsigned u = __builtin_bit_cast(unsigned, f); return (u + 0x7fffu + ((u >> 16) & 1u)) >> 16; }
__device__ __forceinline__ unsigned pk2(float lo, float hi) { return f2bf(lo) | (f2bf(hi) << 16); }
__device__ __forceinline__ float wave_sum(float v) {
#pragma unroll
    for (int o = 1; o < 64; o <<= 1) v += __shfl_xor(v, o);
    return v;
}
__device__ __forceinline__ float wave_max(float v) {
#pragma unroll
    for (int o = 1; o < 64; o <<= 1) v = fmaxf(v, __shfl_xor(v, o));
    return v;
}
__device__ __forceinline__ int tid_l(int widk) { int t; asm volatile("v_mbcnt_lo_u32_b32 %0, -1, 0\n\tv_mbcnt_hi_u32_b32 %0, -1, %0\n\tv_or_b32 %0, %1, %0" : "=&v"(t) : "s"(widk << 6)); return t; }
__device__ __forceinline__ void grid_barrier(unsigned* ctr, unsigned target, int tid) {
    asm volatile("s_waitcnt vmcnt(0) lgkmcnt(0)" ::: "memory");
    __syncthreads();
    if (tid == 0) {
        __builtin_amdgcn_fence(__ATOMIC_RELEASE, "agent");
        asm volatile("s_waitcnt vmcnt(0)" ::: "memory");
        (void)__hip_atomic_fetch_add(ctr, 1u, __ATOMIC_RELAXED, __HIP_MEMORY_SCOPE_AGENT);
        unsigned spins = 0;
        while (__hip_atomic_load(ctr, __ATOMIC_RELAXED, __HIP_MEMORY_SCOPE_AGENT) < target && ++spins < (1u << 22)) __builtin_amdgcn_s_sleep(2);
        __builtin_amdgcn_fence(__ATOMIC_ACQUIRE, "agent");
        asm volatile("s_waitcnt vmcnt(0)" ::: "memory");
    }
    __syncthreads();
}
__device__ __forceinline__ int batch_of_pm(int pm) { return pm < 128 ? (pm >> 6) : 2 + ((pm - 128) >> 4); }

namespace pg8 {
constexpr int BM = 256, BK = 64, HALF = 128, HTB = HALF * BK * 2, STAGE_BYTES = 8 * HTB, NXCD = 8, WGM = 4;
__host__ __device__ __forceinline__ int lds_byte(int r, int c) { const int st = (r >> 4) * 2 + (c >> 5), rr = r & 15, cc = c & 31, ob = rr * 64 + cc * 2; return st * 1024 + (ob ^ (((ob >> 9) & 1) << 5)); }
__host__ __device__ __forceinline__ void stage_rc(int b, int& R, int& C) { const int st = b / 1024, sb = b % 1024, swz = sb ^ (((sb >> 9) & 1) << 5); R = (st >> 1) * 16 + swz / 64; C = (st & 1) * 32 + (swz % 64) / 2; }
__host__ __device__ __forceinline__ int perm32(int rho) { const int n = rho >> 4, i = rho & 15; return 8 * (i >> 2) + 4 * n + (i & 3); }

struct Unit { int pm, pn, z; };

__device__ __forceinline__ void tile_decode(int wgid, int nM, int nN, int& pm, int& pn) {
    const int nwg = nM * nN;
    { const int q = nwg / NXCD, r = nwg % NXCD, xcd = wgid % NXCD, off = wgid / NXCD; wgid = (xcd < r ? xcd * (q + 1) : r * (q + 1) + (xcd - r) * q) + off; }
    const int nig = WGM * nN, gid = wgid / nig, fm = gid * WGM, gsz = (nM - fm) < WGM ? (nM - fm) : WGM;
    pm = fm + ((wgid % nig) % gsz); pn = (wgid % nig) / gsz;
}
struct Sched {
    const char *A0, *B0, *A1, *B1; int nM0, nN0, n0, nM1, n1; size_t tA, tB, bstride; int G, c;
    __device__ __forceinline__ bool next(int i, Unit& u) const {
        int L = i * G + c;
        if (L < n0) { tile_decode(L, nM0, nN0, u.pm, u.pn); u.z = 0; return true; }
        L -= n0; if (L < n1) { u.pm = L % nM1; u.pn = L / nM1; u.z = 1; return true; }
        return false;
    }
    __device__ __forceinline__ const char* abase(const Unit& u) const { return (u.z ? A1 : A0) + (size_t)u.pm * tA; }
    __device__ __forceinline__ const char* bbase(const Unit& u) const { return (u.z ? B1 : B0) + (size_t)u.pn * tB + (bstride ? (size_t)batch_of_pm(u.pm) * bstride : (size_t)0); }
};
struct PreSched {
    const char *Kb, *Vb, *Wmq, *Wmo; int G, c;
    __device__ __forceinline__ bool next(int i, Unit& u) const { const int L = i * G + c; if (L >= 384) return false; u.z = L / 8; const int t = L & 7; if (u.z < 24) { u.pm = 0; u.pn = t; } else { u.pm = t; u.pn = 0; } return true; }
    __device__ __forceinline__ const char* abase(const Unit& u) const { const int zz = u.z % 24, b = zz >> 2, h = zz & 3;
        return u.z < 24 ? Kb + ((size_t)(b * 256) * DM + h * 512) * 2 : Wmo + ((size_t)(u.pm * 256) * DM + h * 512) * 2; }
    __device__ __forceinline__ const char* bbase(const Unit& u) const { const int zz = u.z % 24, b = zz >> 2, h = zz & 3;
        return u.z < 24 ? Wmq + ((size_t)(u.pn * 256) * DM + h * 512) * 2 : Vb + ((size_t)(b * 256) * DM + h * 512) * 2; }
};

template <class Epi, class SchedT, bool ALIGN_EPI, bool SP2>
__device__ __forceinline__ void gemm_phase(LAS unsigned char* lds, const int widk, const int K, const int ld, const SchedT& S, const Epi& E) {
    const int tid = tid_l(widk), wid = __builtin_amdgcn_readfirstlane(tid >> 6), lane = tid & 63, wr = wid >> 2, wc = wid & 3, fr = lane & 15, fq = lane >> 4;
    const int nt = K / BK;
    unsigned voffA[2], voffB[2];
#pragma unroll
    for (int i = 0; i < 2; ++i) { int R, C; stage_rc(tid * 16 + i * 8192, R, C); const int Rb = Epi::PERM ? ((R & ~31) + perm32(R & 31)) : R;
        voffA[i] = (unsigned)(R * ld + C) * 2u; voffB[i] = (unsigned)(Rb * ld + C) * 2u; }
    const size_t kstep = (size_t)(BK * 2);
    const size_t hstep = (size_t)HALF * ld * 2;
    const unsigned ldsw = (unsigned)wid * 1024u;
    const int aoff = lds_byte(wr * 64 + fr, fq * 8), boff = lds_byte(wc * 32 + fr, fq * 8);
#define PG8_SA(b, h) (((b) * 2 + (h)) * HTB)
#define PG8_SB(b, h) ((4 + (b) * 2 + (h)) * HTB)
#define PG8_STAGE(bufoff, gbase, voff) do { _Pragma("unroll") for (int _i = 0; _i < 2; ++_i) \
        __builtin_amdgcn_global_load_lds((const unsigned*)((const char*)(gbase) + (voff)[_i]), (LAS unsigned*)(lds + (bufoff) + ldsw + _i * 8192), 16, 0, 0); } while (0)
#define PG8_LDA(dst, b, h) do { _Pragma("unroll") for (int m = 0; m < 4; ++m) _Pragma("unroll") for (int k = 0; k < 2; ++k) dst[m][k] = *(const LAS bf16x8*)(lds + PG8_SA(b, h) + aoff + m * 2048 + k * 1024); } while (0)
#define PG8_LDB(dst, b, h) do { _Pragma("unroll") for (int n = 0; n < 2; ++n) _Pragma("unroll") for (int k = 0; k < 2; ++k) dst[n][k] = *(const LAS bf16x8*)(lds + PG8_SB(b, h) + boff + n * 2048 + k * 1024); } while (0)
#define PG8_MMA(ai, bj, At, Bt) do { __builtin_amdgcn_s_setprio(1); _Pragma("unroll") for (int m = 0; m < 4; ++m) _Pragma("unroll") for (int n = 0; n < 2; ++n) _Pragma("unroll") for (int k = 0; k < 2; ++k) \
        acc[ai][bj][m][n] = __builtin_amdgcn_mfma_f32_16x16x32_bf16(Bt[n][k], At[m][k], acc[ai][bj][m][n], 0, 0, 0); __builtin_amdgcn_s_setprio(0); } while (0)
#define PG8_WAIT_V(n) asm volatile("s_waitcnt vmcnt(" #n ")" ::: "memory")
#define PG8_WAIT_L(n) asm volatile("s_waitcnt lgkmcnt(" #n ")" ::: "memory")
#define PG8_BAR __builtin_amdgcn_s_barrier()
#define PG8_SCHED __builtin_amdgcn_sched_barrier(0)
    Unit cur, nxt; int ui = 0;
    if (!S.next(0, cur)) return;
    f32x4 acc[2][2][4][2];
#pragma unroll
    for (int a = 0; a < 2; ++a)
#pragma unroll
        for (int b = 0; b < 2; ++b)
#pragma unroll
            for (int m = 0; m < 4; ++m)
#pragma unroll
                for (int n = 0; n < 2; ++n) acc[a][b][m][n] = (f32x4){0.f, 0.f, 0.f, 0.f};
    bf16x8 At[4][2], B0[2][2], B1[2][2];
    const char* cA = S.abase(cur); const char* cB = S.bbase(cur);
    if constexpr (SP2) {
        PG8_STAGE(PG8_SB(0, 0), cB, voffB); PG8_STAGE(PG8_SB(0, 1), cB + hstep, voffB); PG8_STAGE(PG8_SA(0, 0), cA, voffA); PG8_STAGE(PG8_SA(0, 1), cA + hstep, voffA);
        if (wr == 1) PG8_BAR;
        PG8_WAIT_V(2); PG8_BAR;
        PG8_STAGE(PG8_SB(1, 0), cB + kstep, voffB); PG8_STAGE(PG8_SA(1, 0), cA + kstep, voffA); PG8_STAGE(PG8_SB(1, 1), cB + hstep + kstep, voffB);
        PG8_WAIT_V(6); PG8_BAR;
    } else {
        PG8_STAGE(PG8_SB(0, 0), cB, voffB); PG8_STAGE(PG8_SA(0, 0), cA, voffA); PG8_STAGE(PG8_SB(0, 1), cB + hstep, voffB); PG8_STAGE(PG8_SA(0, 1), cA + hstep, voffA);
        if (wr == 1) PG8_BAR;
        PG8_WAIT_V(4); PG8_BAR;
        PG8_STAGE(PG8_SB(1, 0), cB + kstep, voffB); PG8_STAGE(PG8_SA(1, 0), cA + kstep, voffA); PG8_STAGE(PG8_SB(1, 1), cB + hstep + kstep, voffB);
        PG8_WAIT_V(6); PG8_BAR;
    }
    for (;;) {
        const bool has_next = S.next(ui + 1, nxt);
        const char* nA = has_next ? S.abase(nxt) : cA; const char* nB = has_next ? S.bbase(nxt) : cB;
        for (int t = 0; t < nt; t += 2) {
            const bool last = (t == nt - 2);
            const char* a1 = cA + (size_t)(t + 1) * kstep;
            const char* a2 = last ? nA : cA + (size_t)(t + 2) * kstep; const char* b2 = last ? nB : cB + (size_t)(t + 2) * kstep;
            const char* a3 = a2 + kstep; const char* b3 = b2 + kstep;
            if constexpr (SP2) {
            PG8_LDB(B0, 0, 0); PG8_LDB(B1, 0, 1); PG8_SCHED; PG8_LDA(At, 0, 0); PG8_STAGE(PG8_SA(1, 1), a1 + hstep, voffA);
            PG8_WAIT_V(8); PG8_WAIT_L(0); PG8_BAR; PG8_MMA(0, 0, At, B0); PG8_MMA(0, 1, At, B1); PG8_BAR; PG8_SCHED;
            PG8_LDA(At, 0, 1); PG8_STAGE(PG8_SB(0, 0), b2, voffB); PG8_STAGE(PG8_SB(0, 1), b2 + hstep, voffB); PG8_STAGE(PG8_SA(0, 0), a2, voffA);
            PG8_WAIT_V(8); PG8_WAIT_L(0); PG8_BAR; PG8_MMA(1, 0, At, B0); PG8_MMA(1, 1, At, B1); PG8_BAR; PG8_SCHED;
            PG8_LDB(B0, 1, 0); PG8_LDB(B1, 1, 1); PG8_SCHED; PG8_LDA(At, 1, 0); PG8_STAGE(PG8_SA(0, 1), a2 + hstep, voffA);
            PG8_WAIT_V(8); PG8_WAIT_L(0); PG8_BAR; PG8_MMA(0, 0, At, B0); PG8_MMA(0, 1, At, B1); PG8_BAR; PG8_SCHED;
            PG8_LDA(At, 1, 1); PG8_STAGE(PG8_SB(1, 0), b3, voffB); PG8_STAGE(PG8_SB(1, 1), b3 + hstep, voffB); PG8_STAGE(PG8_SA(1, 0), a3, voffA);
            PG8_WAIT_V(8); PG8_WAIT_L(0); PG8_BAR; PG8_MMA(1, 0, At, B0); PG8_MMA(1, 1, At, B1); PG8_BAR; PG8_SCHED;
            } else {
            PG8_LDB(B0, 0, 0); PG8_SCHED; PG8_LDA(At, 0, 0); PG8_STAGE(PG8_SA(1, 1), a1 + hstep, voffA);
            PG8_WAIT_L(8); PG8_BAR; PG8_WAIT_L(0); PG8_MMA(0, 0, At, B0); PG8_BAR; PG8_SCHED;
            PG8_LDB(B1, 0, 1); PG8_STAGE(PG8_SB(0, 0), b2, voffB);
            PG8_BAR; PG8_WAIT_L(0); PG8_MMA(0, 1, At, B1); PG8_BAR;
            PG8_LDA(At, 0, 1); PG8_STAGE(PG8_SA(0, 0), a2, voffA);
            PG8_BAR; PG8_WAIT_L(0); PG8_MMA(1, 0, At, B0); PG8_BAR; PG8_SCHED;
            PG8_STAGE(PG8_SB(0, 1), b2 + hstep, voffB);
            PG8_WAIT_V(6); PG8_BAR; PG8_MMA(1, 1, At, B1); PG8_BAR;
            PG8_LDB(B0, 1, 0); PG8_SCHED; PG8_LDA(At, 1, 0); PG8_STAGE(PG8_SA(0, 1), a2 + hstep, voffA);
            PG8_WAIT_L(8); PG8_BAR; PG8_WAIT_L(0); PG8_MMA(0, 0, At, B0); PG8_BAR; PG8_SCHED;
            PG8_LDB(B1, 1, 1); PG8_STAGE(PG8_SB(1, 0), b3, voffB);
            PG8_BAR; PG8_WAIT_L(0); PG8_MMA(0, 1, At, B1); PG8_BAR;
            PG8_LDA(At, 1, 1); PG8_STAGE(PG8_SA(1, 0), a3, voffA);
            PG8_BAR; PG8_WAIT_L(0); PG8_MMA(1, 0, At, B0); PG8_BAR; PG8_SCHED;
            PG8_STAGE(PG8_SB(1, 1), b3 + hstep, voffB);
            PG8_WAIT_V(6); PG8_BAR; PG8_MMA(1, 1, At, B1); PG8_BAR;
            }
        }
        if constexpr (ALIGN_EPI) { if (wr == 0) PG8_BAR; }
        E(acc, cur, wr, wc, fr, fq);
        if (!has_next) break;
#pragma unroll
        for (int a = 0; a < 2; ++a)
#pragma unroll
            for (int b = 0; b < 2; ++b)
#pragma unroll
                for (int m = 0; m < 4; ++m)
#pragma unroll
                    for (int n = 0; n < 2; ++n) acc[a][b][m][n] = (f32x4){0.f, 0.f, 0.f, 0.f};
        cur = nxt; cA = nA; cB = nB; ++ui;
        if constexpr (ALIGN_EPI) { if (wr == 1) PG8_BAR; }
    }
    PG8_WAIT_V(0);
    if constexpr (!ALIGN_EPI) { if (wr == 0) PG8_BAR; }
    PG8_BAR;
#undef PG8_SA
#undef PG8_SB
#undef PG8_STAGE
#undef PG8_LDA
#undef PG8_LDB
#undef PG8_MMA
#undef PG8_WAIT_V
#undef PG8_WAIT_L
#undef PG8_BAR
#undef PG8_SCHED
}

typedef const f32x4 (&AccRef)[2][2][4][2];

__device__ __forceinline__ float row_rs(const float* ss, int row) {
    const f32x4* p = (const f32x4*)(ss + (size_t)row * 32); float s = 0.f;
#pragma unroll
    for (int i = 0; i < 8; ++i) { const f32x4 v = p[i]; s += (v[0] + v[1]) + (v[2] + v[3]); }
    return __builtin_amdgcn_rsqf(s * (1.0f / DM) + RMS_EPS);
}

struct EpiInProj {
    static constexpr bool PERM = true;
    bf16_t* proj; bf16_t* kb; bf16_t* vb; const float* rs0; const f32x2* rope;
    __device__ __forceinline__ void operator()(AccRef acc, const Unit& u, int wr, int wc, int fr, int fq) const {
        const int row0 = u.pm * BM + wr * 64 + fr;
        if (u.z == 1) {
            bf16_t* base = (u.pn < 8 ? kb : vb) + (u.pn & 7) * BM + wc * 32 + 8 * fq;
#pragma unroll
            for (int ai = 0; ai < 2; ++ai)
#pragma unroll
                for (int m = 0; m < 4; ++m) { bf16_t* rowp = base + (size_t)(row0 + ai * HALF + m * 16) * DM;
#pragma unroll
                    for (int bj = 0; bj < 2; ++bj) { const f32x4 v0 = acc[ai][bj][m][0], v1 = acc[ai][bj][m][1]; u32x4 w;
                        w.x = cvt_pk_bf16(v0[0], v0[1]); w.y = cvt_pk_bf16(v0[2], v0[3]); w.z = cvt_pk_bf16(v1[0], v1[1]); w.w = cvt_pk_bf16(v1[2], v1[3]);
                        *(u32x4*)(rowp + bj * HALF) = w; } }
            return;
        }
        const int pn = u.pn; const bool rp = (pn >= 12 && pn < 20);
        const float sc = pn < 4 ? NA_QS : ((pn >= 12 && pn < 16) ? DF_QS : 1.0f);
        if (!rp) {
            bf16_t* base = proj + pn * BM + wc * 32 + 8 * fq;
#pragma unroll
            for (int ai = 0; ai < 2; ++ai)
#pragma unroll
                for (int m = 0; m < 4; ++m) { const int row = row0 + ai * HALF + m * 16; const float rr = rs0[row] * sc; bf16_t* rowp = base + (size_t)row * INW;
#pragma unroll
                    for (int bj = 0; bj < 2; ++bj) { const f32x4 v0 = acc[ai][bj][m][0] * rr, v1 = acc[ai][bj][m][1] * rr; u32x4 w;
                        w.x = cvt_pk_bf16(v0[0], v0[1]); w.y = cvt_pk_bf16(v0[2], v0[3]); w.z = cvt_pk_bf16(v1[0], v1[1]); w.w = cvt_pk_bf16(v1[2], v1[3]);
                        *(u32x4*)(rowp + bj * HALF) = w; } }
        } else {
            const int dd0 = 16 * (wc & 1) + 4 * fq;
            bf16_t* base = proj + pn * BM + (wc >> 1) * 64 + dd0;
#pragma unroll
            for (int ai = 0; ai < 2; ++ai)
#pragma unroll
                for (int m = 0; m < 4; ++m) { const int row = row0 + ai * HALF + m * 16; const float rr = rs0[row] * sc; bf16_t* rowp = base + (size_t)row * INW;
                    const int t = row < NP ? (row & (TP - 1)) : (row & (TS - 1));
                    const f32x4 cs0 = *(const f32x4*)(rope + (size_t)t * 32 + dd0), cs1 = *(const f32x4*)(rope + (size_t)t * 32 + dd0 + 2);
#pragma unroll
                    for (int bj = 0; bj < 2; ++bj) { const f32x4 x1 = acc[ai][bj][m][0] * rr, x2 = acc[ai][bj][m][1] * rr;
                        const float a0 = x1[0] * cs0[0] - x2[0] * cs0[1], a1 = x1[1] * cs0[2] - x2[1] * cs0[3], a2 = x1[2] * cs1[0] - x2[2] * cs1[1], a3 = x1[3] * cs1[2] - x2[3] * cs1[3];
                        const float b0 = x2[0] * cs0[0] + x1[0] * cs0[1], b1 = x2[1] * cs0[2] + x1[1] * cs0[3], b2 = x2[2] * cs1[0] + x1[2] * cs1[1], b3 = x2[3] * cs1[2] + x1[3] * cs1[3];
                        u32x2 wa, wb; wa.x = cvt_pk_bf16(a0, a1); wa.y = cvt_pk_bf16(a2, a3); wb.x = cvt_pk_bf16(b0, b1); wb.y = cvt_pk_bf16(b2, b3);
                        *(u32x2*)(rowp + bj * HALF) = wa; *(u32x2*)(rowp + bj * HALF + 32) = wb; } }
        }
    }
};
struct EpiPre {
    static constexpr bool PERM = true;
    bf16_t* wqk; bf16_t* wvo;
    __device__ __forceinline__ void operator()(AccRef acc, const Unit& u, int wr, int wc, int fr, int fq) const {
        const int zz = u.z % 24, b = zz >> 2, h = zz & 3; bf16_t* base; int ldc; float sc;
        if (u.z < 24) { base = wqk + ((size_t)(b * 1024 + h * 256)) * DM + u.pn * BM; ldc = DM; sc = MEM_QS; }
        else { base = wvo + ((size_t)(b * 2048 + u.pm * BM)) * NSW + h * 256; ldc = NSW; sc = 1.0f; }
        base += wc * 32 + 8 * fq;
#pragma unroll
        for (int ai = 0; ai < 2; ++ai)
#pragma unroll
            for (int m = 0; m < 4; ++m) { bf16_t* rowp = base + (size_t)(wr * 64 + fr + ai * HALF + m * 16) * ldc;
#pragma unroll
                for (int bj = 0; bj < 2; ++bj) { const f32x4 v0 = acc[ai][bj][m][0] * sc, v1 = acc[ai][bj][m][1] * sc; u32x4 w;
                    w.x = cvt_pk_bf16(v0[0], v0[1]); w.y = cvt_pk_bf16(v0[2], v0[3]); w.z = cvt_pk_bf16(v1[0], v1[1]); w.w = cvt_pk_bf16(v1[2], v1[3]);
                    *(u32x4*)(rowp + bj * HALF) = w; } }
    }
};
__device__ __forceinline__ float row_rs4(const float* ss, int row, int fq) {
    const f32x4* p = (const f32x4*)(ss + (size_t)row * 32 + fq * 8); const f32x4 a = p[0], b = p[1];
    float s = ((a[0] + a[1]) + (a[2] + a[3])) + ((b[0] + b[1]) + (b[2] + b[3]));
    s += __shfl_xor(s, 16); s += __shfl_xor(s, 32);
    return __builtin_amdgcn_rsqf(s * (1.0f / DM) + RMS_EPS);
}
struct EpiResid {
    static constexpr bool PERM = false;
    const float* basef; const bf16_t* baseb; bf16_t* ob; int ldo; float* ss;
    __device__ __forceinline__ void operator()(AccRef acc, const Unit& u, int wr, int wc, int fr, int fq) const {
        const int col0 = u.pn * BM + wc * 32 + 4 * fq;
#pragma unroll
        for (int ai = 0; ai < 2; ++ai)
#pragma unroll
            for (int m = 0; m < 4; ++m) { const int row = u.pm * BM + ai * HALF + wr * 64 + m * 16 + fr; const size_t off = (size_t)row * DM + col0; bf16_t* orow = ob + (size_t)row * ldo + col0; float q = 0.f;
#pragma unroll
                for (int bj = 0; bj < 2; ++bj)
#pragma unroll
                    for (int n = 0; n < 2; ++n) { const int o2 = bj * HALF + n * 16; f32x4 bv;
                        if (baseb) { const u32x2 w = *(const u32x2*)(baseb + off + o2); bv = (f32x4){__uint_as_float(w.x << 16), __uint_as_float(w.x & 0xffff0000u), __uint_as_float(w.y << 16), __uint_as_float(w.y & 0xffff0000u)}; }
                        else bv = *(const f32x4*)(basef + off + o2);
                        const f32x4 o = bv + acc[ai][bj][m][n]; q += (o[0] * o[0] + o[1] * o[1]) + (o[2] * o[2] + o[3] * o[3]);
                        u32x2 w2; w2.x = cvt_pk_bf16(o[0], o[1]); w2.y = cvt_pk_bf16(o[2], o[3]); *(u32x2*)(orow + o2) = w2; }
                q += __shfl_xor(q, 16); q += __shfl_xor(q, 32);
                if (fq == 0) ss[(size_t)row * 32 + u.pn * 4 + wc] = q; }
    }
};
struct EpiX { static constexpr bool PERM = false; const float* xp; const float* xs; bf16_t* ob; float* ss;
    __device__ __forceinline__ void operator()(AccRef acc, const Unit& u, int wr, int wc, int fr, int fq) const {
        const float* base = (u.pm < NP / 256) ? xp : xs - (size_t)NP * DM; EpiResid E{base, nullptr, ob, DM, ss}; E(acc, u, wr, wc, fr, fq); } };
struct EpiSm {
    static constexpr bool PERM = false;
    bf16_t* P; const float* ss; LAS unsigned char* tab;
    __device__ __forceinline__ void operator()(AccRef acc, const Unit& u, int wr, int wc, int fr, int fq) const {
        float rr[2][4];
#pragma unroll
        for (int ai = 0; ai < 2; ++ai)
#pragma unroll
            for (int m = 0; m < 4; ++m) { const int rl = ai * HALF + wr * 64 + m * 16 + fr; const float r_ = row_rs4(ss, u.pm * BM + rl, fq); rr[ai][m] = r_;
                float mx = acc[ai][0][m][0][0];
#pragma unroll
                for (int bj = 0; bj < 2; ++bj)
#pragma unroll
                    for (int n = 0; n < 2; ++n) { const f32x4 v = acc[ai][bj][m][n]; mx = fmaxf(fmaxf(mx, fmaxf(v[0], v[1])), fmaxf(v[2], v[3])); }
                mx *= r_; mx = fmaxf(mx, __shfl_xor(mx, 16)); mx = fmaxf(mx, __shfl_xor(mx, 32));
                float sm = 0.f;
#pragma unroll
                for (int bj = 0; bj < 2; ++bj)
#pragma unroll
                    for (int n = 0; n < 2; ++n) { const f32x4 v = acc[ai][bj][m][n];
                        sm += (__builtin_amdgcn_exp2f(v[0] * r_ - mx) + __builtin_amdgcn_exp2f(v[1] * r_ - mx)) + (__builtin_amdgcn_exp2f(v[2] * r_ - mx) + __builtin_amdgcn_exp2f(v[3] * r_ - mx)); }
                sm += __shfl_xor(sm, 16); sm += __shfl_xor(sm, 32);
                if (fq == 0) *(LAS f32x2*)(tab + (rl * 4 + wc) * 8) = (f32x2){mx, sm}; }
        asm volatile("s_waitcnt lgkmcnt(0)" ::: "memory"); __builtin_amdgcn_s_barrier(); asm volatile("" ::: "memory");
        const int col0 = u.pn * BM + wc * 32 + 4 * fq;
#pragma unroll
        for (int ai = 0; ai < 2; ++ai)
#pragma unroll
            for (int m = 0; m < 4; ++m) { const int rl = ai * HALF + wr * 64 + m * 16 + fr; const float r_ = rr[ai][m];
                const f32x4 t0 = *(const LAS f32x4*)(tab + rl * 32), t1 = *(const LAS f32x4*)(tab + rl * 32 + 16);
                const float M = fmaxf(fmaxf(t0[0], t0[2]), fmaxf(t1[0], t1[2]));
                const float L = (t0[1] * __builtin_amdgcn_exp2f(t0[0] - M) + t0[3] * __builtin_amdgcn_exp2f(t0[2] - M)) + (t1[1] * __builtin_amdgcn_exp2f(t1[0] - M) + t1[3] * __builtin_amdgcn_exp2f(t1[2] - M));
                const float inv = __builtin_amdgcn_rcpf(L);
                bf16_t* rowp = P + (size_t)(u.pm * BM + rl) * NSW + col0;
#pragma unroll
                for (int bj = 0; bj < 2; ++bj)
#pragma unroll
                    for (int n = 0; n < 2; ++n) { const f32x4 v = acc[ai][bj][m][n]; u32x2 w;
                        w.x = cvt_pk_bf16(__builtin_amdgcn_exp2f(v[0] * r_ - M) * inv, __builtin_amdgcn_exp2f(v[1] * r_ - M) * inv);
                        w.y = cvt_pk_bf16(__builtin_amdgcn_exp2f(v[2] * r_ - M) * inv, __builtin_amdgcn_exp2f(v[3] * r_ - M) * inv);
                        *(u32x2*)(rowp + bj * HALF + n * 16) = w; } }
    }
};
struct EpiGU {
    static constexpr bool PERM = true;
    bf16_t* act; const float* ss;
    __device__ __forceinline__ void operator()(AccRef acc, const Unit& u, int wr, int wc, int fr, int fq) const {
        bf16_t* base = act + u.pn * HALF + wc * 32 + 8 * fq;
#pragma unroll
        for (int ai = 0; ai < 2; ++ai)
#pragma unroll
            for (int m = 0; m < 4; ++m) { const int row = u.pm * BM + ai * HALF + wr * 64 + m * 16 + fr; const float rr = row_rs4(ss, row, fq); float o[8];
#pragma unroll
                for (int n = 0; n < 2; ++n)
#pragma unroll
                    for (int e = 0; e < 4; ++e) { const float g = acc[ai][0][m][n][e] * rr, up = acc[ai][1][m][n][e] * rr;
                        o[n * 4 + e] = g * __builtin_amdgcn_rcpf(1.0f + __builtin_amdgcn_exp2f(-g * LOG2E)) * up; }
                u32x4 w; w.x = cvt_pk_bf16(o[0], o[1]); w.y = cvt_pk_bf16(o[2], o[3]); w.z = cvt_pk_bf16(o[4], o[5]); w.w = cvt_pk_bf16(o[6], o[7]);
                *(u32x4*)(base + (size_t)row * DFF) = w; }
    }
};
}

namespace att {
#define SBAR() __builtin_amdgcn_sched_barrier(0)
constexpr float THR = 8.0f;
constexpr int SHM_V = 16384, SHM_K = 16384, OFF_K = 2 * SHM_V, OFF_WS = OFF_K + 2 * SHM_K, OFF_RPB = OFF_WS + 8 * 256, OFF_STG = OFF_RPB + 2048, OFF_END = OFF_STG + 8 * 8192;
constexpr int DF_R = 5, DF_D = 4;
constexpr int DF_K = DF_R * SHM_V, DF_KSZ = 8192, DF_WS = DF_K + DF_R * DF_KSZ, DF_STG = 0  , DF_END = DF_WS + 8 * 256;
static_assert(8 * 8192 <= DF_K, "output stage fits inside the V ring");
static_assert(DF_END <= 147456 && OFF_END <= 147456, "attention LDS maps fit the dynamic LDS allocation");
__device__ __forceinline__ int crow(int r, int hi) { return (r & 3) + 8 * (r >> 2) + 4 * hi; }
#define KSWZ128(row, colB) ((row) * 256 + ((colB) ^ (((row) & 7) << 4)))
#define KSWZ64(row, colB) ((row) * 128 + ((colB) ^ ((((row) >> 1) & 7) << 4)))
__device__ __forceinline__ int v_st(int k, int c) { const int kk = (k & ~0xC) | ((k & 4) << 1) | ((k & 8) >> 1); return ((kk >> 3) * 4 + (c >> 5)) * 512 + ((kk & 7) * 32 + (c & 31)) * 2; }
__device__ __forceinline__ int v_rd_base(int lane) { return ((lane & 3) << 3) | (((lane >> 2) & 3) << 6) | (((lane >> 4) & 1) << 5) | (((lane >> 5) & 1) << 8); }
constexpr int v_rd_off(int d0, int ks, int half) { return d0 * 512 + ks * 4096 + half * 2048; }
template <int OFF> __device__ __forceinline__ s16x4 tr_read(int vb) { s16x4 r; asm volatile("ds_read_b64_tr_b16 %0, %1 offset:%2" : "=&v"(r) : "v"(vb), "i"(OFF) : "memory"); return r; }
template <int D0> __device__ __forceinline__ void pv_one(f32x16& od, int vb, bf16x8 pa0, bf16x8 pa1, bf16x8 pa2, bf16x8 pa3) {
    const s16x4 l0 = tr_read<v_rd_off(D0, 0, 0)>(vb), h0 = tr_read<v_rd_off(D0, 0, 1)>(vb), l1 = tr_read<v_rd_off(D0, 1, 0)>(vb), h1 = tr_read<v_rd_off(D0, 1, 1)>(vb);
    const s16x4 l2 = tr_read<v_rd_off(D0, 2, 0)>(vb), h2 = tr_read<v_rd_off(D0, 2, 1)>(vb), l3 = tr_read<v_rd_off(D0, 3, 0)>(vb), h3 = tr_read<v_rd_off(D0, 3, 1)>(vb);
    asm volatile("s_waitcnt lgkmcnt(0)" ::: "memory"); SBAR();
#define PK(L, H) (bf16x8){L[0], L[1], L[2], L[3], H[0], H[1], H[2], H[3]}
    od = __builtin_amdgcn_mfma_f32_32x32x16_bf16(pa0, PK(l0, h0), od, 0, 0, 0);
    od = __builtin_amdgcn_mfma_f32_32x32x16_bf16(pa1, PK(l1, h1), od, 0, 0, 0);
    od = __builtin_amdgcn_mfma_f32_32x32x16_bf16(pa2, PK(l2, h2), od, 0, 0, 0);
    od = __builtin_amdgcn_mfma_f32_32x32x16_bf16(pa3, PK(l3, h3), od, 0, 0, 0);
#undef PK
}
template <int D0> __device__ __forceinline__ void pv_rd(s16x4 (&L)[4], s16x4 (&H)[4], int vb) {
    L[0] = tr_read<v_rd_off(D0, 0, 0)>(vb); H[0] = tr_read<v_rd_off(D0, 0, 1)>(vb); L[1] = tr_read<v_rd_off(D0, 1, 0)>(vb); H[1] = tr_read<v_rd_off(D0, 1, 1)>(vb);
    L[2] = tr_read<v_rd_off(D0, 2, 0)>(vb); H[2] = tr_read<v_rd_off(D0, 2, 1)>(vb); L[3] = tr_read<v_rd_off(D0, 3, 0)>(vb); H[3] = tr_read<v_rd_off(D0, 3, 1)>(vb);
}
#define PV_PK(L, H) (bf16x8){L[0], L[1], L[2], L[3], H[0], H[1], H[2], H[3]}
#define PV_MMA(od, L, H) do { od = __builtin_amdgcn_mfma_f32_32x32x16_bf16(pa0, PV_PK(L[0], H[0]), od, 0, 0, 0); od = __builtin_amdgcn_mfma_f32_32x32x16_bf16(pa1, PV_PK(L[1], H[1]), od, 0, 0, 0); \
    od = __builtin_amdgcn_mfma_f32_32x32x16_bf16(pa2, PV_PK(L[2], H[2]), od, 0, 0, 0); od = __builtin_amdgcn_mfma_f32_32x32x16_bf16(pa3, PV_PK(L[3], H[3]), od, 0, 0, 0); } while (0)
__device__ __forceinline__ void pv_all_pre(f32x16* o, int vb, bf16x8 pa0, bf16x8 pa1, bf16x8 pa2, bf16x8 pa3) {
    s16x4 L0[4], H0[4], L1[4], H1[4], L2[4], H2[4], L3[4], H3[4];
    pv_rd<0>(L0, H0, vb); pv_rd<1>(L1, H1, vb);
    asm volatile("s_waitcnt lgkmcnt(8)" ::: "memory"); SBAR(); PV_MMA(o[0], L0, H0); SBAR();
    pv_rd<2>(L2, H2, vb);
    asm volatile("s_waitcnt lgkmcnt(8)" ::: "memory"); SBAR(); PV_MMA(o[1], L1, H1); SBAR();
    pv_rd<3>(L3, H3, vb);
    asm volatile("s_waitcnt lgkmcnt(8)" ::: "memory"); SBAR(); PV_MMA(o[2], L2, H2); SBAR();
    asm volatile("s_waitcnt lgkmcnt(0)" ::: "memory"); SBAR(); PV_MMA(o[3], L3, H3); SBAR();
}
__device__ __forceinline__ void pv_all(f32x16* o, int vb, bf16x8 pa0, bf16x8 pa1, bf16x8 pa2, bf16x8 pa3) {
    pv_one<0>(o[0], vb, pa0, pa1, pa2, pa3); pv_one<1>(o[1], vb, pa0, pa1, pa2, pa3); pv_one<2>(o[2], vb, pa0, pa1, pa2, pa3); pv_one<3>(o[3], vb, pa0, pa1, pa2, pa3);
}
__device__ __forceinline__ void softmax_tile(f32x16& p0, f32x16& p1, float& m_reg, float& l_reg, float& alpha, bf16x8& pa0, bf16x8& pa1, bf16x8& pa2, bf16x8& pa3) {
    float pmax = p0[0];
#pragma unroll
    for (int r = 1; r < 16; ++r) pmax = fmaxf(pmax, p0[r]);
#pragma unroll
    for (int r = 0; r < 16; ++r) pmax = fmaxf(pmax, p1[r]);
    { auto rr = __builtin_amdgcn_permlane32_swap(__float_as_uint(pmax), __float_as_uint(pmax), false, false); pmax = fmaxf(__uint_as_float(rr[0]), __uint_as_float(rr[1])); }
    float mn;
    if (__builtin_expect(__all(pmax - m_reg <= THR), 1)) { mn = m_reg; alpha = 1.f; }
    else { mn = fmaxf(m_reg, pmax); alpha = __builtin_amdgcn_exp2f(m_reg - mn); m_reg = mn; }
#pragma unroll
    for (int r = 0; r < 16; ++r) { p0[r] = __builtin_amdgcn_exp2f(p0[r] - mn); p1[r] = __builtin_amdgcn_exp2f(p1[r] - mn); }
    float ps = 0.f;
#pragma unroll
    for (int r = 0; r < 16; ++r) ps += p0[r];
#pragma unroll
    for (int r = 0; r < 16; ++r) ps += p1[r];
    { auto rr = __builtin_amdgcn_permlane32_swap(__float_as_uint(ps), __float_as_uint(ps), false, false); ps = __uint_as_float(rr[0]) + __uint_as_float(rr[1]); }
    l_reg = l_reg * alpha + ps;
#define PK4(P, BASE, OUT) do { unsigned a0 = cvt_pk_bf16(P[BASE + 0], P[BASE + 1]), a1 = cvt_pk_bf16(P[BASE + 2], P[BASE + 3]);   \
    unsigned b0 = cvt_pk_bf16(P[BASE + 4], P[BASE + 5]), b1 = cvt_pk_bf16(P[BASE + 6], P[BASE + 7]);                              \
    auto r0 = __builtin_amdgcn_permlane32_swap(a0, b0, false, false); auto r1 = __builtin_amdgcn_permlane32_swap(a1, b1, false, false); \
    u32x4 w = {r0[0], r1[0], r0[1], r1[1]}; OUT = __builtin_bit_cast(bf16x8, w); } while (0)
    PK4(p0, 0, pa0); PK4(p0, 8, pa1); PK4(p1, 0, pa2); PK4(p1, 8, pa3);
#undef PK4
}
__device__ __forceinline__ void softmax_rel(f32x16& p0, f32x16& p1, float& m_reg, float& l_reg, f32x16& negm, float& alpha, bool first, bf16x8& pa0, bf16x8& pa1, bf16x8& pa2, bf16x8& pa3) {
    float ma = __builtin_fmaxf(__builtin_fmaxf(p0[0], p0[1]), p0[2]), mb = __builtin_fmaxf(__builtin_fmaxf(p0[8], p0[9]), p0[10]);
    float mc = __builtin_fmaxf(__builtin_fmaxf(p1[0], p1[1]), p1[2]), md = __builtin_fmaxf(__builtin_fmaxf(p1[8], p1[9]), p1[10]);
    ma = __builtin_fmaxf(__builtin_fmaxf(ma, p0[3]), p0[4]); mb = __builtin_fmaxf(__builtin_fmaxf(mb, p0[11]), p0[12]); mc = __builtin_fmaxf(__builtin_fmaxf(mc, p1[3]), p1[4]); md = __builtin_fmaxf(__builtin_fmaxf(md, p1[11]), p1[12]);
    ma = __builtin_fmaxf(__builtin_fmaxf(ma, p0[5]), p0[6]); mb = __builtin_fmaxf(__builtin_fmaxf(mb, p0[13]), p0[14]); mc = __builtin_fmaxf(__builtin_fmaxf(mc, p1[5]), p1[6]); md = __builtin_fmaxf(__builtin_fmaxf(md, p1[13]), p1[14]);
    ma = __builtin_fmaxf(__builtin_fmaxf(ma, p0[7]), mb); mc = __builtin_fmaxf(__builtin_fmaxf(mc, p1[7]), md);
    float pmax = __builtin_fmaxf(__builtin_fmaxf(ma, p0[15]), __builtin_fmaxf(mc, p1[15]));
    { auto rr = __builtin_amdgcn_permlane32_swap(__float_as_uint(pmax), __float_as_uint(pmax), false, false); pmax = __builtin_fmaxf(__uint_as_float(rr[0]), __uint_as_float(rr[1])); }
    alpha = 1.f;
    if (__builtin_expect(first || !__all(pmax <= THR), 0)) {
        const float dl = first ? pmax : fmaxf(pmax, 0.f);
        m_reg += dl; alpha = first ? 1.f : __builtin_amdgcn_exp2f(-dl);
#pragma unroll
        for (int r = 0; r < 16; ++r) { p0[r] -= dl; p1[r] -= dl; negm[r] = -m_reg; }
    }
#pragma unroll
    for (int r = 0; r < 16; ++r) { p0[r] = __builtin_amdgcn_exp2f(p0[r]); p1[r] = __builtin_amdgcn_exp2f(p1[r]); }
    float ps0 = p0[0], ps1 = p1[0], ps2 = p0[8], ps3 = p1[8];
#pragma unroll
    for (int r = 1; r < 8; ++r) { ps0 += p0[r]; ps1 += p1[r]; ps2 += p0[8 + r]; ps3 += p1[8 + r]; }
    l_reg = l_reg * alpha + ((ps0 + ps1) + (ps2 + ps3));
#define PK4N(P, BASE, OUT) do { u32x4 w = {cvt_pk_bf16(P[BASE + 0], P[BASE + 1]), cvt_pk_bf16(P[BASE + 2], P[BASE + 3]), cvt_pk_bf16(P[BASE + 4], P[BASE + 5]), cvt_pk_bf16(P[BASE + 6], P[BASE + 7])}; \
    OUT = __builtin_bit_cast(bf16x8, w); } while (0)
    PK4N(p0, 0, pa0); PK4N(p0, 8, pa1); PK4N(p1, 0, pa2); PK4N(p1, 8, pa3);
#undef PK4N
}
#define ATT_RESC2(a) do { if (__any((a) < 1.f)) { if (hi == 0) al_l[r32] = (a); asm volatile("s_waitcnt lgkmcnt(0)" ::: "memory"); \
    _Pragma("unroll") for (int r = 0; r < 16; ++r) { const float f_ = al_l[crow(r, hi)]; o[0][r] *= f_; o[1][r] *= f_; o[2][r] *= f_; o[3][r] *= f_; } } } while (0)
#define ATT_RESC(a) do { if (__any((a) < 1.f)) { if (hi == 0) al_l[r32] = (a); asm volatile("s_waitcnt lgkmcnt(0)" ::: "memory"); \
    _Pragma("unroll") for (int d = 0; d < 4; ++d) _Pragma("unroll") for (int r = 0; r < 16; ++r) o[d][r] *= al_l[crow(r, hi)]; } } while (0)

__device__ __forceinline__ void diff_unit(const bf16_t* __restrict__ proj, bf16_t* __restrict__ mix, float* __restrict__ o1s, const float* __restrict__ g_sub, float lam,
                                          int rowbase, int T, int h, int qb, char* lds, int widk) {
    const int tid = tid_l(widk), wid = tid >> 6, lane = tid & 63, r32 = lane & 31, hi = lane >> 5;
    char* V_lds = lds; char* K_lds = lds + DF_K;
    float* wsf = (float*)(lds + DF_WS) + wid * 64; float* li_l = wsf; float* al_l = wsf + 32;
    LAS unsigned char* ldsl = (LAS unsigned char*)lds; const int widu = __builtin_amdgcn_readfirstlane(wid); const int grp = widu >> 2;
    unsigned kgo, vgo[2];
    { const int X = wid * 1024 + lane * 16, krow = X >> 7, kcolB = (X & 127) ^ (((krow >> 1) & 7) << 4); kgo = (unsigned)(krow * INW * 2 + kcolB); }
#pragma unroll
    for (int i = 0; i < 2; ++i) { const int X = wid * 1024 + lane * 16 + i * 8192, sub = X >> 9, e = (X & 511) >> 1, kk = (sub >> 2) * 8 + (e >> 5), cc = (sub & 3) * 32 + (e & 31);
        vgo[i] = (unsigned)((kk * INW + cc) * 2); }
    const int vb0 = (int)(uintptr_t)V_lds + v_rd_base(lane);
    const int NT = T / 64; const int q0 = qb * 256;
    const bf16_t* Vh = proj + (size_t)rowbase * INW + 5120 + h * 128;
#define BAR() do { asm volatile("" ::: "memory"); __builtin_amdgcn_s_barrier(); asm volatile("" ::: "memory"); } while (0)
#pragma unroll 1
    for (int s = 0; s < 2; ++s) {
        const bf16_t* Kh = proj + (size_t)rowbase * INW + 4096 + h * 128 + s * 64;
        const unsigned qoff = ((unsigned)(rowbase + q0 + wid * 32 + r32) * INW + 3072 + h * 128 + s * 64 + hi * 8) * 2u;
        bf16x8 qr[4];
#pragma unroll
        for (int d0 = 0; d0 < 4; ++d0) qr[d0] = *(const bf16x8*)((const char*)proj + qoff + d0 * 32);
        float m_reg = 0.f, l_reg = 0.f; f32x16 o[4], negm = f32x16{};
#pragma unroll
        for (int d = 0; d < 4; ++d) o[d] = f32x16{};
#define DDMA(j, b) do { const char* kt = (const char*)Kh + (size_t)(j) * (64 * INW * 2); const char* vt = (const char*)Vh + (size_t)(j) * (64 * INW * 2); \
        __builtin_amdgcn_global_load_lds((const unsigned*)(kt + kgo), (LAS unsigned*)(ldsl + DF_K + (b) * DF_KSZ + widu * 1024), 16, 0, 0); \
        __builtin_amdgcn_global_load_lds((const unsigned*)(vt + vgo[0]), (LAS unsigned*)(ldsl + (b) * SHM_V + widu * 1024), 16, 0, 0); \
        __builtin_amdgcn_global_load_lds((const unsigned*)(vt + vgo[1]), (LAS unsigned*)(ldsl + (b) * SHM_V + widu * 1024 + 8192), 16, 0, 0); } while (0)
#pragma unroll
        for (int t = 0; t < DF_D; ++t) DDMA(t, t);
        asm volatile("s_waitcnt vmcnt(%0)" :: "n"(3 * (DF_D - 1)) : "memory"); BAR();
        int ka[4];
#pragma unroll
        for (int d0 = 0; d0 < 4; ++d0) ka[d0] = (int)(uintptr_t)K_lds + KSWZ64(r32, (d0 * 16 + hi * 8) * 2);
#define KRD(dst, addr, OFF) asm volatile("ds_read_b128 %0, %1 offset:" #OFF : "=&v"(dst) : "v"(addr) : "memory")
        if (grp) BAR();
        int bsl = 0;
#pragma unroll 1
        for (int j = 0; j < NT; ++j) {
            BAR();
            f32x16 p0, p1;
            __builtin_amdgcn_s_setprio(1);
            { const int kb = bsl * DF_KSZ; bf16x8 k0, k1, k2, k3, k4, k5, k6, k7; const int a0 = ka[0] + kb, a1 = ka[1] + kb, a2 = ka[2] + kb, a3 = ka[3] + kb;
              KRD(k0, a0, 0); KRD(k1, a0, 4096); KRD(k2, a1, 0); KRD(k3, a1, 4096); KRD(k4, a2, 0); KRD(k5, a2, 4096); KRD(k6, a3, 0); KRD(k7, a3, 4096);
              asm volatile("s_waitcnt lgkmcnt(6)" ::: "memory"); SBAR();
              p0 = __builtin_amdgcn_mfma_f32_32x32x16_bf16(k0, qr[0], negm, 0, 0, 0); p1 = __builtin_amdgcn_mfma_f32_32x32x16_bf16(k1, qr[0], negm, 0, 0, 0); SBAR();
              asm volatile("s_waitcnt lgkmcnt(4)" ::: "memory"); SBAR();
              p0 = __builtin_amdgcn_mfma_f32_32x32x16_bf16(k2, qr[1], p0, 0, 0, 0); p1 = __builtin_amdgcn_mfma_f32_32x32x16_bf16(k3, qr[1], p1, 0, 0, 0); SBAR();
              asm volatile("s_waitcnt lgkmcnt(2)" ::: "memory"); SBAR();
              p0 = __builtin_amdgcn_mfma_f32_32x32x16_bf16(k4, qr[2], p0, 0, 0, 0); p1 = __builtin_amdgcn_mfma_f32_32x32x16_bf16(k5, qr[2], p1, 0, 0, 0); SBAR();
              asm volatile("s_waitcnt lgkmcnt(0)" ::: "memory"); SBAR();
              p0 = __builtin_amdgcn_mfma_f32_32x32x16_bf16(k6, qr[3], p0, 0, 0, 0); p1 = __builtin_amdgcn_mfma_f32_32x32x16_bf16(k7, qr[3], p1, 0, 0, 0); SBAR(); }
            __builtin_amdgcn_s_setprio(0);
            float alpha; bf16x8 pa0, pa1, pa2, pa3;
            softmax_rel(p0, p1, m_reg, l_reg, negm, alpha, j == 0, pa0, pa1, pa2, pa3);
            ATT_RESC2(alpha);
            if (j + DF_D <= NT) asm volatile("s_waitcnt vmcnt(%0) lgkmcnt(0)" :: "n"(3 * (DF_D - 2)) : "memory"); else asm volatile("s_waitcnt vmcnt(0) lgkmcnt(0)" ::: "memory");
            BAR();
            if (j + DF_D < NT) { const int b2 = bsl >= 1 ? bsl - 1 : DF_R - 1; DDMA(j + DF_D, b2); }
            const int bn = bsl == DF_R - 1 ? 0 : bsl + 1;
            pv_all_pre(o, vb0 + bsl * SHM_V, pa0, pa1, pa2, pa3);
            bsl = bn;
        }
#undef KRD
        asm volatile("s_waitcnt lgkmcnt(0)" ::: "memory");
        if (!grp) BAR();
        BAR();
#undef DDMA
        { auto rr = __builtin_amdgcn_permlane32_swap(__float_as_uint(l_reg), __float_as_uint(l_reg), false, false); l_reg = __uint_as_float(rr[0]) + __uint_as_float(rr[1]); }
        if (hi == 0) li_l[r32] = l_reg;
        asm volatile("s_waitcnt lgkmcnt(0)" ::: "memory");
        float rli[16];
#pragma unroll
        for (int r = 0; r < 16; ++r) rli[r] = __builtin_amdgcn_rcpf(li_l[crow(r, hi)]);
        f32x4* o1v = (f32x4*)((char*)o1s + (unsigned)tid * 256u);
        if (s == 0) {
#pragma unroll
            for (int d = 0; d < 4; ++d)
#pragma unroll
                for (int r = 0; r < 16; r += 4) o1v[d * 4 + (r >> 2)] = (f32x4){o[d][r] * rli[r], o[d][r + 1] * rli[r + 1], o[d][r + 2] * rli[r + 2], o[d][r + 3] * rli[r + 3]};
        } else {
#pragma unroll
            for (int d = 0; d < 4; ++d)
#pragma unroll
                for (int r = 0; r < 16; r += 4) { const f32x4 t = o1v[d * 4 + (r >> 2)];
#pragma unroll
                    for (int e = 0; e < 4; ++e) o[d][r + e] = t[e] - lam * (o[d][r + e] * rli[r + e]); }
            float gs[4];
#pragma unroll
            for (int d = 0; d < 4; ++d) gs[d] = g_sub[d * 32 + r32] * (1.0f - LAM_INIT);
            bf16_t* stg = (bf16_t*)(lds + DF_STG) + wid * 4096;
#pragma unroll
            for (int r = 0; r < 16; ++r) {
                float q = (o[0][r] * o[0][r] + o[1][r] * o[1][r]) + (o[2][r] * o[2][r] + o[3][r] * o[3][r]);
                q += __shfl_xor(q, 1); q += __shfl_xor(q, 2); q += __shfl_xor(q, 4); q += __shfl_xor(q, 8); q += __shfl_xor(q, 16);
                const float rn = __builtin_amdgcn_rsqf(q * (1.0f / 128.0f) + SUBLN_EPS);
#pragma unroll
                for (int d = 0; d < 4; ++d) stg[crow(r, hi) * 128 + d * 32 + r32] = (bf16_t)f2bf(o[d][r] * rn * gs[d]);
            }
            asm volatile("s_waitcnt lgkmcnt(0)" ::: "memory");
            const unsigned goff = ((unsigned)(rowbase + q0 + wid * 32 + (lane >> 4)) * DM + 1024 + h * 128 + (lane & 15) * 8) * 2u;
#pragma unroll
            for (int i = 0; i < 8; ++i) { const u32x4 v = *(const u32x4*)(stg + (i * 4 + (lane >> 4)) * 128 + (lane & 15) * 8); *(u32x4*)((char*)mix + goff + (unsigned)(i * 4 * DM * 2)) = v; }
            asm volatile("s_waitcnt lgkmcnt(0)" ::: "memory"); BAR();
        }
    }
#undef BAR
}

__device__ __forceinline__ void na_unit(const bf16_t* __restrict__ proj, bf16_t* __restrict__ mix, const float* __restrict__ rpb,
                                        int rowbase, int ROWS, int h, int rg, char* lds, int widk) {
    const int tid = tid_l(widk), wid = tid >> 6, lane = tid & 63, r32 = lane & 31, hi = lane >> 5;
    char* V_lds = lds; char* K_lds = lds + OFF_K;
    float* wsf = (float*)(lds + OFF_WS) + wid * 64; float* li_l = wsf; float* al_l = wsf + 32;
    float* rpbL = (float*)(lds + OFF_RPB);
    LAS unsigned char* ldsl = (LAS unsigned char*)lds; const int widu = __builtin_amdgcn_readfirstlane(wid);
    unsigned kgo[2], vgo[2];
#pragma unroll
    for (int i = 0; i < 2; ++i) { const int X = wid * 1024 + lane * 16 + i * 8192;
        { const int krow = X >> 8, kcolB = (X & 255) ^ ((krow & 7) << 4); kgo[i] = (unsigned)(krow * INW * 2 + kcolB); }
        { const int sub = X >> 9, e = (X & 511) >> 1, kk = (sub >> 2) * 8 + (e >> 5), cc = (sub & 3) * 32 + (e & 31); const int k = (kk & ~0xC) | ((kk & 4) << 1) | ((kk & 8) >> 1); vgo[i] = (unsigned)((k * INW + cc) * 2); } }
    const int vb0 = (int)(uintptr_t)V_lds + v_rd_base(lane);
    const int r0 = rg * 4, rq = r0 + (wid >> 1), c = 32 * (wid & 1) + r32;
    const int rsw = min(max(rq - 4, 0), ROWS - 8), cs = min(max(c - 8, 0), 48);
    const int klo = min(max(r0 - 4, 0), ROWS - 8), khi = min(max(r0 + 3 - 4, 0), ROWS - 8) + 8;
    for (int i = tid; i < 465; i += NTHREADS) rpbL[i] = rpb[h * 465 + i] * LOG2E;
    const bf16_t* Kh = proj + (size_t)rowbase * INW + 1024 + h * 128;
    const bf16_t* Vh = proj + (size_t)rowbase * INW + 2048 + h * 128;
    const bf16_t* Qw = proj + (size_t)(rowbase + rq * 64 + c) * INW + h * 128 + hi * 8;
    bf16x8 qr[8];
#pragma unroll
    for (int d0 = 0; d0 < 8; ++d0) qr[d0] = *(const bf16x8*)(Qw + d0 * 16);
    float m_reg = -1e30f, l_reg = 0.f; f32x16 o[4];
#pragma unroll
    for (int d = 0; d < 4; ++d) o[d] = f32x16{};
#define NDMA(kr, b) do { const char* kt = (const char*)Kh + (size_t)(kr) * (64 * INW * 2); const char* vt = (const char*)Vh + (size_t)(kr) * (64 * INW * 2); \
        __builtin_amdgcn_global_load_lds((const unsigned*)(kt + kgo[0]), (LAS unsigned*)(ldsl + OFF_K + (b) * SHM_K + widu * 1024), 16, 0, 0); \
        __builtin_amdgcn_global_load_lds((const unsigned*)(kt + kgo[1]), (LAS unsigned*)(ldsl + OFF_K + (b) * SHM_K + widu * 1024 + 8192), 16, 0, 0); \
        __builtin_amdgcn_global_load_lds((const unsigned*)(vt + vgo[0]), (LAS unsigned*)(ldsl + (b) * SHM_V + widu * 1024), 16, 0, 0); \
        __builtin_amdgcn_global_load_lds((const unsigned*)(vt + vgo[1]), (LAS unsigned*)(ldsl + (b) * SHM_V + widu * 1024 + 8192), 16, 0, 0); } while (0)
    NDMA(klo, 0); asm volatile("s_waitcnt vmcnt(0)" ::: "memory"); __syncthreads();
#pragma unroll 1
    for (int kr = klo; kr < khi; ++kr) {
        const int b = (kr - klo) & 1;
        if (kr + 1 < khi) NDMA(kr + 1, b ^ 1);
        if (kr >= rsw && kr < rsw + 8) {
            f32x16 p0 = f32x16{}, p1 = f32x16{};
            const char* Ks = K_lds + b * SHM_K;
#pragma unroll
            for (int d0 = 0; d0 < 8; ++d0) { const int cb = (d0 * 16 + hi * 8) * 2;
                const bf16x8 b0 = *(const bf16x8*)(Ks + KSWZ128(r32, cb)); const bf16x8 b1 = *(const bf16x8*)(Ks + KSWZ128(32 + r32, cb));
                p0 = __builtin_amdgcn_mfma_f32_32x32x16_bf16(b0, qr[d0], p0, 0, 0, 0); p1 = __builtin_amdgcn_mfma_f32_32x32x16_bf16(b1, qr[d0], p1, 0, 0, 0); }
            const float* brow = rpbL + (kr - rq + 7) * 31;
#pragma unroll
            for (int r = 0; r < 16; ++r) {
                const int kc = crow(r, hi), kc2 = kc + 32;
                const int i0 = min(max(kc - c + 15, 0), 30), i1 = min(max(kc2 - c + 15, 0), 30);
                const float b0 = brow[i0], b1 = brow[i1];
                p0[r] = ((unsigned)(kc - cs) < 16u) ? p0[r] + b0 : -1e30f;
                p1[r] = ((unsigned)(kc2 - cs) < 16u) ? p1[r] + b1 : -1e30f;
            }
            float alpha; bf16x8 pa0, pa1, pa2, pa3;
            softmax_tile(p0, p1, m_reg, l_reg, alpha, pa0, pa1, pa2, pa3);
            ATT_RESC(alpha);
            pv_all(o, vb0 + b * SHM_V, pa0, pa1, pa2, pa3);
        }
        asm volatile("s_waitcnt vmcnt(0)" ::: "memory");
        __syncthreads();
    }
#undef NDMA
    if (hi == 0) li_l[r32] = l_reg;
    asm volatile("s_waitcnt lgkmcnt(0)" ::: "memory");
    bf16_t* stg = (bf16_t*)(lds + OFF_STG) + wid * 4096;
#pragma unroll
    for (int r = 0; r < 16; ++r) { const float rl = __builtin_amdgcn_rcpf(li_l[crow(r, hi)]);
#pragma unroll
        for (int d = 0; d < 4; ++d) stg[crow(r, hi) * 128 + d * 32 + r32] = (bf16_t)f2bf(o[d][r] * rl); }
    asm volatile("s_waitcnt lgkmcnt(0)" ::: "memory");
    bf16_t* gp = mix + (size_t)(rowbase + rq * 64 + 32 * (wid & 1) + (lane >> 4)) * DM + h * 128 + (lane & 15) * 8;
#pragma unroll
    for (int i = 0; i < 8; ++i) { const u32x4 v = *(const u32x4*)(stg + (i * 4 + (lane >> 4)) * 128 + (lane & 15) * 8); *(u32x4*)gp = v; gp += 4 * DM; }
    __syncthreads();
}
#undef SBAR
}

template <int MODE> __device__ __forceinline__ int dest_row(int n) {
    if (MODE == 1) { if (n < 3072 || n >= 5120) return n; const int d = n & 63, blk = n & ~63, nn = d >> 5, dd = d & 31; return blk + 32 * (dd >> 4) + 8 * ((dd >> 2) & 3) + 4 * nn + (dd & 3); }
    if (MODE == 2) { if (n < DFF) return 256 * (n >> 7) + (n & 127); const int n2 = n - DFF; return 256 * (n2 >> 7) + 128 + (n2 & 127); }
    return n;
}
template <int MODE> __device__ __forceinline__ void p0_transpose_item(const float* __restrict__ W, int K, int N, bf16_t* __restrict__ WT, const float* __restrict__ gain, LAS float* scr, int item, int lane) {
    const int nblk = N / 32, kb = item / nblk, nb = item % nblk, k0 = 64 * kb, n0 = 32 * nb;
#pragma unroll 8
    for (int i = 0; i < 32; ++i) { const int kk = 2 * i + (lane >> 5); const float g = gain ? gain[k0 + kk] : 1.0f; scr[kk * 33 + (lane & 31)] = W[(size_t)(k0 + kk) * N + n0 + (lane & 31)] * g; }
    asm volatile("s_waitcnt lgkmcnt(0)" ::: "memory");
    const int c = lane & 7;
#pragma unroll
    for (int j = 0; j < 4; ++j) { const int n = (lane >> 3) + 8 * j; const LAS float* s = scr + (8 * c) * 33 + n;
        u32x4 o; o.x = pk2(s[0 * 33], s[1 * 33]); o.y = pk2(s[2 * 33], s[3 * 33]); o.z = pk2(s[4 * 33], s[5 * 33]); o.w = pk2(s[6 * 33], s[7 * 33]);
        *(u32x4*)(WT + (size_t)dest_row<MODE>(n0 + n) * K + k0 + 8 * c) = o; }
    asm volatile("s_waitcnt lgkmcnt(0)" ::: "memory");
}
__device__ __forceinline__ float row_ssq(const float* xrow, int lane, f32x4 (&v)[8]) {
    const f32x4* xr = (const f32x4*)xrow + lane; float s = 0.f;
#pragma unroll
    for (int j = 0; j < 8; ++j) { v[j] = xr[64 * j]; s += (v[j][0] * v[j][0] + v[j][1] * v[j][1]) + (v[j][2] * v[j][2] + v[j][3] * v[j][3]); }
    return wave_sum(s);
}
__device__ __forceinline__ void sincos_d(double x, double& sn, double& cs) {
    const double k = __builtin_rint(x * 0.6366197723675814); const double r0 = __builtin_fma(-k, 1.5707963267948966, x); const double r = __builtin_fma(-k, 6.123233995736766e-17, r0);
    const double r2 = r * r;
    double s = -1.0 / 1307674368000.0; s = s * r2 + 1.0 / 6227020800.0; s = s * r2 - 1.0 / 39916800.0; s = s * r2 + 1.0 / 362880.0; s = s * r2 - 1.0 / 5040.0; s = s * r2 + 1.0 / 120.0; s = s * r2 - 1.0 / 6.0; s = s * r2 * r + r;
    double c = 1.0 / 20922789888000.0; c = c * r2 - 1.0 / 87178291200.0; c = c * r2 + 1.0 / 479001600.0; c = c * r2 - 1.0 / 3628800.0; c = c * r2 + 1.0 / 40320.0; c = c * r2 - 1.0 / 720.0; c = c * r2 + 1.0 / 24.0; c = c * r2 - 0.5; c = c * r2 + 1.0;
    const int q = ((int)k) & 3;
    sn = (q == 0) ? s : (q == 1) ? c : (q == 2) ? -s : -c;
    cs = (q == 0) ? c : (q == 1) ? -s : (q == 2) ? -c : s;
}

struct Args { const float* in[22]; float* out; unsigned char* ws; int ph_lo, ph_hi; };
constexpr int NPHASE = 10;

__global__ void __launch_bounds__(NTHREADS, 2) fwd_kernel(Args a) {
    extern __shared__ __attribute__((aligned(16))) unsigned char lds[];
    LAS unsigned char* ldsl = (LAS unsigned char*)lds;
    const int widk = __builtin_amdgcn_readfirstlane((int)(threadIdx.x >> 6));
    const int G = gridDim.x, bx = blockIdx.x, vcu = (G % 8 == 0) ? (bx % 8) * (G / 8) + bx / 8 : bx;
#define x_p (ap->in[0])
#define x_s (ap->in[1])
#define mem_p (ap->in[2])
#define mem_s (ap->in[3])
#define g_mix (ap->in[4])
#define w_in (ap->in[5])
#define rpb (ap->in[6])
#define lam_q1 (ap->in[7])
#define lam_k1 (ap->in[8])
#define lam_q2 (ap->in[9])
#define lam_k2 (ap->in[10])
#define g_subln (ap->in[11])
#define w_out (ap->in[12])
#define g_xattn (ap->in[13])
#define g_mem (ap->in[14])
#define w_mq (ap->in[15])
#define w_mkv (ap->in[16])
#define w_mo (ap->in[17])
#define g_ffn (ap->in[18])
#define w_gu (ap->in[19])
#define w_dn (ap->in[20])
#define g_final (ap->in[21])
#define out (ap->out)
#define WSP() const __attribute__((address_space(4))) Args* ap = (const __attribute__((address_space(4))) Args*)__builtin_amdgcn_kernarg_segment_ptr(); asm volatile("" : "+s"(ap)); unsigned char* ws = ap->ws
#define SS ((float*)(ws + WS_SS))
#define RS0 ((float*)(ws + WS_RS0))
#define ROPE ((f32x2*)(ws + WS_ROPE))
#define WIN ((bf16_t*)(ws + WS_WIN))
#define WOUT ((bf16_t*)(ws + WS_WOUT))
#define WMQ ((bf16_t*)(ws + WS_WMQ))
#define WMO ((bf16_t*)(ws + WS_WMO))
#define WMKV ((bf16_t*)(ws + WS_WMKV))
#define WGU ((bf16_t*)(ws + WS_WGU))
#define WDN ((bf16_t*)(ws + WS_WDN))
#define MN ((bf16_t*)(ws + WS_MN))
#define KB ((bf16_t*)(ws + WS_KB))
#define VB ((bf16_t*)(ws + WS_VB))
#define WQK ((bf16_t*)(ws + WS_WQK))
#define WVO ((bf16_t*)(ws + WS_WVO))
#define O1S ((float*)(ws + WS_O1))
#define XB ((bf16_t*)(ws + WS_XB))
#define PROJ ((bf16_t*)(ws + WS_BIG))
#define H1B ((bf16_t*)(ws + WS_H1B))
#define SB ((float*)(ws + WS_S))
#define PB ((bf16_t*)(ws + WS_P))
#define ACT ((bf16_t*)(ws + WS_ACT))
#define MIX XB
#define H2B XB
    const int lo = a.ph_lo, hi_ph = a.ph_hi;
    if (lo < 0) cg::this_grid().sync();
#ifdef ONLY_PHASE
#define IN(k) ((k) == ONLY_PHASE && lo <= (k) && (k) < hi_ph)
#else
#define IN(k) (lo <= (k) && (k) < hi_ph)
#endif
    int nbar = 0;
#define SEAM(k) do { if (IN(k) && IN((k) + 1)) { WSP(); ++nbar; grid_barrier((unsigned*)(ws + WS_BAR), (unsigned)nbar * (unsigned)G, tid_l(widk)); } } while (0)
    const int NGW = G * 8;
#define TIDS() const int tid = tid_l(widk), lane = tid & 63, wave = __builtin_amdgcn_readfirstlane(tid >> 6), gw = vcu * 8 + wave; (void)lane; (void)gw

    if (IN(0)) { WSP(); TIDS();
        LAS float* scr = (LAS float*)(ldsl + wave * 16384);
        constexpr int I0 = (DM / 64) * (INW / 32), I1 = (DM / 64) * (DM / 32), I2 = I1, I3 = (DM / 64) * (4096 / 32), I4 = (DM / 64) * (NGU / 32), I5 = (DFF / 64) * (DM / 32);
        constexpr int NIT = I0 + I1 + I2 + I3 + I4 + I5;
        for (int it = gw; it < NIT; it += NGW) {
            int r = it;
            if (r < I0) { p0_transpose_item<1>(w_in, DM, INW, WIN, g_mix, scr, r, lane); continue; } r -= I0;
            if (r < I1) { p0_transpose_item<0>(w_out, DM, DM, WOUT, nullptr, scr, r, lane); continue; } r -= I1;
            if (r < I2) { p0_transpose_item<0>(w_mo, DM, DM, WMO, nullptr, scr, r, lane); continue; } r -= I2;
            if (r < I3) { p0_transpose_item<0>(w_mkv, DM, 4096, WMKV, nullptr, scr, r, lane); continue; } r -= I3;
            if (r < I4) { p0_transpose_item<2>(w_gu, DM, NGU, WGU, g_ffn, scr, r, lane); continue; } r -= I4;
            p0_transpose_item<0>(w_dn, DFF, DM, WDN, nullptr, scr, r, lane);
        }
        for (int k = gw; k < DM; k += NGW) { const float g = g_xattn[k]; const f32x4* src = (const f32x4*)(w_mq + (size_t)k * DM) + lane; u32x2* dst = (u32x2*)(WMQ + (size_t)k * DM) + lane;
#pragma unroll
            for (int j = 0; j < 8; ++j) { const f32x4 v = src[64 * j] * g; u32x2 w; w.x = pk2(v[0], v[1]); w.y = pk2(v[2], v[3]); dst[64 * j] = w; } }
        for (int m = gw; m < MT; m += NGW) { const float* xr = m < NP ? x_p + (size_t)m * DM : x_s + (size_t)(m - NP) * DM; f32x4 v[8];
            const float s = row_ssq(xr, lane, v); if (lane == 0) RS0[m] = 1.0f / sqrtf(s * (1.0f / DM) + RMS_EPS);
            u32x2* dst = (u32x2*)(XB + (size_t)m * DM) + lane;
#pragma unroll
            for (int j = 0; j < 8; ++j) { u32x2 w; w.x = pk2(v[j][0], v[j][1]); w.y = pk2(v[j][2], v[j][3]); dst[64 * j] = w; } }
        for (int m = gw; m < NMEM; m += NGW) { const float* xr = m < 512 ? mem_p + (size_t)m * DM : mem_s + (size_t)(m - 512) * DM; f32x4 v[8];
            const float s = row_ssq(xr, lane, v); const float rr = 1.0f / sqrtf(s * (1.0f / DM) + RMS_EPS);
            u32x2* dst = (u32x2*)(MN + (size_t)m * DM) + lane; const f32x4* gp = (const f32x4*)g_mem + lane;
#pragma unroll
            for (int j = 0; j < 8; ++j) { const f32x4 g = gp[64 * j]; u32x2 w; w.x = pk2(v[j][0] * rr * g[0], v[j][1] * rr * g[1]); w.y = pk2(v[j][2] * rr * g[2], v[j][3] * rr * g[3]); dst[64 * j] = w; } }
        for (int e = vcu * NTHREADS + tid; e < TP * 32; e += G * NTHREADS) { const int t = e >> 5, dd = e & 31;
            double pw = 1.0; for (int i = 0; i < dd; ++i) pw *= 1.333521432163324;
            const float inv = 1.0f / (float)pw; const float ang = (float)t * inv; double sn, cs; sincos_d((double)ang, sn, cs);
            ROPE[e] = (f32x2){(float)cs, (float)sn}; }
    }
    SEAM(0);

    if (IN(1)) { WSP();
        pg8::Sched S{(const char*)XB, (const char*)WIN, (const char*)MN, (const char*)WMKV, MT / 256, INW / 256, (MT / 256) * (INW / 256), NMEM / 256, (NMEM / 256) * 16,
                     (size_t)256 * DM * 2, (size_t)256 * DM * 2, 0, G, bx};
        pg8::EpiInProj E{PROJ, KB, VB, RS0, ROPE};
        pg8::gemm_phase<pg8::EpiInProj, pg8::Sched, true, true>(ldsl, widk, DM, DM, S, E);
    }
    SEAM(1);

    if (IN(2)) { WSP(); TIDS();
#if !defined(P2_PART) || P2_PART == 1
        { pg8::PreSched S{(const char*)KB, (const char*)VB, (const char*)WMQ, (const char*)WMO, G, bx}; pg8::EpiPre E{WQK, WVO};
          pg8::gemm_phase<pg8::EpiPre, pg8::PreSched, true, true>(ldsl, widk, 512, DM, S, E); }
#endif
        __syncthreads();
#if !defined(P2_PART) || P2_PART == 2
        for (int id = vcu; id < 1024 + 512; id += G) {
            const bool pr = id < 1024; const int i2 = pr ? id : id - 1024;
            const int rg = pr ? (i2 & 63) : (i2 & 15), h = pr ? ((i2 >> 6) & 7) : ((i2 >> 4) & 7), b = pr ? (i2 >> 9) : (i2 >> 7);
            att::na_unit(PROJ, MIX, rpb, pr ? b * TP : NP + b * TS, pr ? TP / 64 : TS / 64, h, rg, (char*)lds, widk);
        }
#endif
#if !defined(P2_PART) || P2_PART == 3
        float lam;
        { const float a1 = wave_sum(lam_q1[lane] * lam_k1[lane]), a2 = wave_sum(lam_q2[lane] * lam_k2[lane]); lam = __expf(a1) - __expf(a2) + LAM_INIT; lam = __builtin_bit_cast(float, __builtin_amdgcn_readfirstlane(__builtin_bit_cast(int, lam))); }
        float* o1s = O1S + (size_t)bx * 64 * NTHREADS;
#ifndef DIFF_REPS
#define DIFF_REPS 1
#endif
        for (int rep = 0; rep < DIFF_REPS; ++rep)
        for (int id = vcu; id < 1024 + 512; id += G) {
            const bool pr = id < 1024; const int i2 = pr ? id : id - 1024;
            const int qb = pr ? (i2 & 63) : (i2 & 15), bh = pr ? (i2 >> 6) : (i2 >> 4);
            att::diff_unit(PROJ, MIX, o1s, g_subln, lam, pr ? (bh >> 3) * TP : NP + (bh >> 3) * TS, pr ? TP : TS, bh & 7, qb, (char*)lds, widk);
        }
#endif
    }
    SEAM(2);

    if (IN(3)) { WSP();
        pg8::Sched S{(const char*)MIX, (const char*)WOUT, nullptr, nullptr, MT / 256, DM / 256, (MT / 256) * (DM / 256), 1, 0, (size_t)256 * DM * 2, (size_t)256 * DM * 2, 0, G, bx};
        pg8::EpiX E{x_p, x_s, H1B, SS};
        pg8::gemm_phase<pg8::EpiX, pg8::Sched, true, true>(ldsl, widk, DM, DM, S, E);
    }
    SEAM(3);

    if (IN(4)) { WSP();
        pg8::Sched S{(const char*)H1B, (const char*)WQK, nullptr, nullptr, MT / 256, NSW / 256, (MT / 256) * (NSW / 256), 1, 0, (size_t)256 * DM * 2, (size_t)256 * DM * 2, (size_t)NSW * DM * 2, G, bx};
        pg8::EpiSm E{PB, SS, ldsl + pg8::STAGE_BYTES};
        pg8::gemm_phase<pg8::EpiSm, pg8::Sched, true, true>(ldsl, widk, DM, DM, S, E);
    }
    SEAM(4);


    if (IN(6)) { WSP();
        pg8::Sched S{(const char*)PB, (const char*)WVO, nullptr, nullptr, MT / 256, DM / 256, (MT / 256) * (DM / 256), 1, 0, (size_t)256 * NSW * 2, (size_t)256 * NSW * 2, (size_t)DM * NSW * 2, G, bx};
        pg8::EpiResid E{nullptr, H1B, H2B, DM, SS};
        pg8::gemm_phase<pg8::EpiResid, pg8::Sched, true, true>(ldsl, widk, NSW, NSW, S, E);
    }
    SEAM(6);

    if (IN(7)) { WSP();
        pg8::Sched S{(const char*)H2B, (const char*)WGU, nullptr, nullptr, MT / 256, NGU / 256, (MT / 256) * (NGU / 256), 1, 0, (size_t)256 * DM * 2, (size_t)256 * DM * 2, 0, G, bx};
        pg8::EpiGU E{ACT, SS};
        pg8::gemm_phase<pg8::EpiGU, pg8::Sched, true, true>(ldsl, widk, DM, DM, S, E);
    }
    SEAM(7);

    if (IN(8)) { WSP();
        pg8::Sched S{(const char*)ACT, (const char*)WDN, nullptr, nullptr, MT / 256, DM / 256, (MT / 256) * (DM / 256), 1, 0, (size_t)256 * DFF * 2, (size_t)256 * DFF * 2, 0, G, bx};
        pg8::EpiResid E{nullptr, H2B, (bf16_t*)out + DM, 2 * DM, SS};
        pg8::gemm_phase<pg8::EpiResid, pg8::Sched, true, true>(ldsl, widk, DFF, DFF, S, E);
    }
    SEAM(8);

    if (IN(9)) { WSP(); TIDS();
        for (int m = gw; m < MT; m += NGW) {
            float sq = lane < 32 ? SS[(size_t)m * 32 + lane] : 0.f; sq = wave_sum(sq); const float rr = __builtin_amdgcn_rsqf(sq * (1.0f / DM) + RMS_EPS);
            const u32x2* hp = (const u32x2*)((const bf16_t*)out + (size_t)m * (2 * DM) + DM) + lane;
            u32x2 hv[8];
#pragma unroll
            for (int j = 0; j < 8; ++j) hv[j] = hp[64 * j];
            asm volatile("s_waitcnt vmcnt(0)" ::: "memory");
            f32x4* op = (f32x4*)(out + (size_t)m * DM) + lane; const f32x4* gp = (const f32x4*)g_final + lane;
#pragma unroll
            for (int j = 0; j < 8; ++j) { const f32x4 g = gp[64 * j];
                const f32x4 v = (f32x4){__uint_as_float(hv[j].x << 16), __uint_as_float(hv[j].x & 0xffff0000u), __uint_as_float(hv[j].y << 16), __uint_as_float(hv[j].y & 0xffff0000u)};
                op[64 * j] = v * rr * g; }
        }
    }
#undef IN
#undef SEAM
#undef TIDS
}
#undef x_p
#undef x_s
#undef mem_p
#undef mem_s
#undef g_mix
#undef w_in
#undef rpb
#undef lam_q1
#undef lam_k1
#undef lam_q2
#undef lam_k2
#undef g_subln
#undef w_out
#undef g_xattn
#undef g_mem
#undef w_mq
#undef w_mkv
#undef w_mo
#undef g_ffn
#undef w_gu
#undef w_dn
#undef g_final
#undef out
#undef WSP
#undef SS
#undef RS0
#undef ROPE
#undef WIN
#undef WOUT
#undef WMQ
#undef WMO
#undef WMKV
#undef WGU
#undef WDN
#undef MN
#undef KB
#undef VB
#undef WQK
#undef WVO
#undef O1S
#undef XB
#undef PROJ
#undef H1B
#undef SB
#undef PB
#undef ACT
#undef MIX
#undef H2B


extern "C" void kernel_launch(void* const* d_in, const int* in_sizes, int n_in, void* d_out, int out_size, void* d_ws, size_t ws_size, hipStream_t stream) {
    static int grid = 0;
    if (grid == 0) {
        if (n_in != 22 || out_size != MT * DM || ws_size < WS_END) { fprintf(stderr, "kernel_launch: unexpected shapes (n_in %d, out %d, ws %zu); nothing launched\n", n_in, out_size, ws_size); grid = -1; return; }
        int dev = 0, cus = 0, per_cu = 0;
        (void)hipGetDevice(&dev); (void)hipDeviceGetAttribute(&cus, hipDeviceAttributeMultiprocessorCount, dev);
        if (hipFuncSetAttribute((const void*)fwd_kernel, hipFuncAttributeMaxDynamicSharedMemorySize, LDS_BYTES) != hipSuccess) { fprintf(stderr, "kernel_launch: hipFuncSetAttribute failed\n"); grid = -1; return; }
        if (hipOccupancyMaxActiveBlocksPerMultiprocessor(&per_cu, (const void*)fwd_kernel, NTHREADS, LDS_BYTES) != hipSuccess || per_cu < 1) per_cu = 1;
        (void)hipGetLastError();
        grid = cus * per_cu;
    }
    if (grid < 0) return;
    Args a{};
    for (int i = 0; i < 22; ++i) a.in[i] = (const float*)d_in[i];
    a.out = (float*)d_out; a.ws = (unsigned char*)d_ws;
#if MK_MULTI
    for (int p = 0; p < NPHASE; ++p) { a.ph_lo = p; a.ph_hi = p + 1; hipLaunchKernelGGL(fwd_kernel, dim3(grid), dim3(NTHREADS), LDS_BYTES, stream, a); }
#else
    a.ph_lo = 0; a.ph_hi = NPHASE;
    (void)hipMemsetAsync((char*)d_ws + WS_BAR, 0, 256, stream);
    void* args[] = {&a};
    hipError_t e = hipLaunchCooperativeKernel((const void*)fwd_kernel, dim3(grid), dim3(NTHREADS), args, LDS_BYTES, stream);
    if (e != hipSuccess) fprintf(stderr, "cooperative launch failed: %s (grid %d)\n", hipGetErrorString(e), grid);
#endif
}
```

```cpp
#include <hip/hip_runtime.h>
#include <hip/hip_cooperative_groups.h>
#include <cstdio>
#include <cstdint>
namespace cg = cooperative_groups;

#ifndef MK_MULTI
#define MK_MULTI 0
#endif

#define LAS __attribute__((address_space(3)))
typedef unsigned short bf16_t;
typedef short bf16x8 __attribute__((ext_vector_type(8)));
typedef short s16x4 __attribute__((ext_vector_type(4)));
typedef float f32x2 __attribute__((ext_vector_type(2)));
typedef float f32x4 __attribute__((ext_vector_type(4)));
typedef float f32x16 __attribute__((ext_vector_type(16)));
typedef unsigned u32x2 __attribute__((ext_vector_type(2)));
typedef unsigned u32x4 __attribute__((ext_vector_type(4)));

constexpr int DM = 2048, TP = 16384, TS = 4096, NP = 2 * TP, NS = 4 * TS, MT = NP + NS;
constexpr int INW = 6144, DFF = 5632, NGU = 2 * DFF, MEMT = 256, NMEM = 6 * MEMT, NSW = 1024;
constexpr float RMS_EPS = 1e-6f, SUBLN_EPS = 1e-5f, LOG2E = 1.4426950408889634f;
constexpr float NA_QS = 0.08838834764831845f * LOG2E, DF_QS = 0.125f * LOG2E, MEM_QS = 0.04419417382415922f * LOG2E;
constexpr float LAM_INIT = 0.2f;

constexpr size_t MiB = 1u << 20;
constexpr size_t WS_SS = 0, WS_RS0 = 6 * MiB, WS_ROPE = 7 * MiB, WS_WIN = 11 * MiB, WS_WOUT = 35 * MiB, WS_WMQ = 43 * MiB, WS_WMO = 51 * MiB,
                 WS_WMKV = 59 * MiB, WS_WGU = 75 * MiB, WS_WDN = 119 * MiB, WS_MN = 141 * MiB, WS_KB = 147 * MiB, WS_VB = 153 * MiB,
                 WS_WQK = 159 * MiB, WS_WVO = 183 * MiB, WS_O1 = 207 * MiB, WS_XB = 239 * MiB, WS_BIG = 431 * MiB, WS_END = 1007 * MiB;
constexpr size_t WS_BAR = 6 * MiB + 512 * 1024;
constexpr size_t WS_H1B = WS_BIG, WS_S = WS_BIG + 192 * MiB, WS_P = WS_BIG + 384 * MiB, WS_ACT = WS_BIG;

constexpr int LDS_BYTES = 147456, NTHREADS = 512;

__device__ __forceinline__ unsigned cvt_pk_bf16(float lo, float hi) { unsigned r; asm volatile("v_cvt_pk_bf16_f32 %0, %1, %2" : "=v"(r) : "v"(lo), "v"(hi)); return r; }
__device__ __forceinline__ unsigned f2bf(float f) { unsigned u = __builtin_bit_cast(unsigned, f); return (u + 0x7fffu + ((u >> 16) & 1u)) >> 16; }
__device__ __forceinline__ unsigned pk2(float lo, float hi) { return f2bf(lo) | (f2bf(hi) << 16); }
__device__ __forceinline__ float wave_sum(float v) {
#pragma unroll
    for (int o = 1; o < 64; o <<= 1) v += __shfl_xor(v, o);
    return v;
}
__device__ __forceinline__ float wave_max(float v) {
#pragma unroll
    for (int o = 1; o < 64; o <<= 1) v = fmaxf(v, __shfl_xor(v, o));
    return v;
}
__device__ __forceinline__ int tid_l(int widk) { int t; asm volatile("v_mbcnt_lo_u32_b32 %0, -1, 0\n\tv_mbcnt_hi_u32_b32 %0, -1, %0\n\tv_or_b32 %0, %1, %0" : "=&v"(t) : "s"(widk << 6)); return t; }
__device__ __forceinline__ void grid_barrier(unsigned* ctr, unsigned target, int tid) {
    asm volatile("s_waitcnt vmcnt(0) lgkmcnt(0)" ::: "memory");
    __syncthreads();
    if (tid == 0) {
        __builtin_amdgcn_fence(__ATOMIC_RELEASE, "agent");
        asm volatile("s_waitcnt vmcnt(0)" ::: "memory");
        (void)__hip_atomic_fetch_add(ctr, 1u, __ATOMIC_RELAXED, __HIP_MEMORY_SCOPE_AGENT);
        unsigned spins = 0;
        while (__hip_atomic_load(ctr, __ATOMIC_RELAXED, __HIP_MEMORY_SCOPE_AGENT) < target && ++spins < (1u << 22)) __builtin_amdgcn_s_sleep(2);
        __builtin_amdgcn_fence(__ATOMIC_ACQUIRE, "agent");
        asm volatile("s_waitcnt vmcnt(0)" ::: "memory");
    }
    __syncthreads();
}
__device__ __forceinline__ int batch_of_pm(int pm) { return pm < 128 ? (pm >> 6) : 2 + ((pm - 128) >> 4); }

namespace pg8 {
constexpr int BM = 256, BK = 64, HALF = 128, HTB = HALF * BK * 2, STAGE_BYTES = 8 * HTB, NXCD = 8, WGM = 4;
__host__ __device__ __forceinline__ int lds_byte(int r, int c) { const int st = (r >> 4) * 2 + (c >> 5), rr = r & 15, cc = c & 31, ob = rr * 64 + cc * 2; return st * 1024 + (ob ^ (((ob >> 9) & 1) << 5)); }
__host__ __device__ __forceinline__ void stage_rc(int b, int& R, int& C) { const int st = b / 1024, sb = b % 1024, swz = sb ^ (((sb >> 9) & 1) << 5); R = (st >> 1) * 16 + swz / 64; C = (st & 1) * 32 + (swz % 64) / 2; }
__host__ __device__ __forceinline__ int perm32(int rho) { const int n = rho >> 4, i = rho & 15; return 8 * (i >> 2) + 4 * n + (i & 3); }

struct Unit { int pm, pn, z; };

__device__ __forceinline__ void tile_decode(int wgid, int nM, int nN, int& pm, int& pn) {
    const int nwg = nM * nN;
    { const int q = nwg / NXCD, r = nwg % NXCD, xcd = wgid % NXCD, off = wgid / NXCD; wgid = (xcd < r ? xcd * (q + 1) : r * (q + 1) + (xcd - r) * q) + off; }
    const int nig = WGM * nN, gid = wgid / nig, fm = gid * WGM, gsz = (nM - fm) < WGM ? (nM - fm) : WGM;
    pm = fm + ((wgid % nig) % gsz); pn = (wgid % nig) / gsz;
}
struct Sched {
    const char *A0, *B0, *A1, *B1; int nM0, nN0, n0, nM1, n1; size_t tA, tB, bstride; int G, c;
    __device__ __forceinline__ bool next(int i, Unit& u) const {
        int L = i * G + c;
        if (L < n0) { tile_decode(L, nM0, nN0, u.pm, u.pn); u.z = 0; return true; }
        L -= n0; if (L < n1) { u.pm = L % nM1; u.pn = L / nM1; u.z = 1; return true; }
        return false;
    }
    __device__ __forceinline__ const char* abase(const Unit& u) const { return (u.z ? A1 : A0) + (size_t)u.pm * tA; }
    __device__ __forceinline__ const char* bbase(const Unit& u) const { return (u.z ? B1 : B0) + (size_t)u.pn * tB + (bstride ? (size_t)batch_of_pm(u.pm) * bstride : (size_t)0); }
};
struct PreSched {
    const char *Kb, *Vb, *Wmq, *Wmo; int G, c;
    __device__ __forceinline__ bool next(int i, Unit& u) const { const int L = i * G + c; if (L >= 384) return false; u.z = L / 8; const int t = L & 7; if (u.z < 24) { u.pm = 0; u.pn = t; } else { u.pm = t; u.pn = 0; } return true; }
    __device__ __forceinline__ const char* abase(const Unit& u) const { const int zz = u.z % 24, b = zz >> 2, h = zz & 3;
        return u.z < 24 ? Kb + ((size_t)(b * 256) * DM + h * 512) * 2 : Wmo + ((size_t)(u.pm * 256) * DM + h * 512) * 2; }
    __device__ __forceinline__ const char* bbase(const Unit& u) const { const int zz = u.z % 24, b = zz >> 2, h = zz & 3;
        return u.z < 24 ? Wmq + ((size_t)(u.pn * 256) * DM + h * 512) * 2 : Vb + ((size_t)(b * 256) * DM + h * 512) * 2; }
};

template <class Epi, class SchedT, bool ALIGN_EPI, bool SP2>
__device__ __forceinline__ void gemm_phase(LAS unsigned char* lds, const int widk, const int K, const int ld, const SchedT& S, const Epi& E) {
    const int tid = tid_l(widk), wid = __builtin_amdgcn_readfirstlane(tid >> 6), lane = tid & 63, wr = wid >> 2, wc = wid & 3, fr = lane & 15, fq = lane >> 4;
    const int nt = K / BK;
    unsigned voffA[2], voffB[2];
#pragma unroll
    for (int i = 0; i < 2; ++i) { int R, C; stage_rc(tid * 16 + i * 8192, R, C); const int Rb = Epi::PERM ? ((R & ~31) + perm32(R & 31)) : R;
        voffA[i] = (unsigned)(R * ld + C) * 2u; voffB[i] = (unsigned)(Rb * ld + C) * 2u; }
    const size_t kstep = (size_t)(BK * 2);
    const size_t hstep = (size_t)HALF * ld * 2;
    const unsigned ldsw = (unsigned)wid * 1024u;
    const int aoff = lds_byte(wr * 64 + fr, fq * 8), boff = lds_byte(wc * 32 + fr, fq * 8);
#define PG8_SA(b, h) (((b) * 2 + (h)) * HTB)
#define PG8_SB(b, h) ((4 + (b) * 2 + (h)) * HTB)
#define PG8_STAGE(bufoff, gbase, voff) do { _Pragma("unroll") for (int _i = 0; _i < 2; ++_i) \
        __builtin_amdgcn_global_load_lds((const unsigned*)((const char*)(gbase) + (voff)[_i]), (LAS unsigned*)(lds + (bufoff) + ldsw + _i * 8192), 16, 0, 0); } while (0)
#define PG8_LDA(dst, b, h) do { _Pragma("unroll") for (int m = 0; m < 4; ++m) _Pragma("unroll") for (int k = 0; k < 2; ++k) dst[m][k] = *(const LAS bf16x8*)(lds + PG8_SA(b, h) + aoff + m * 2048 + k * 1024); } while (0)
#define PG8_LDB(dst, b, h) do { _Pragma("unroll") for (int n = 0; n < 2; ++n) _Pragma("unroll") for (int k = 0; k < 2; ++k) dst[n][k] = *(const LAS bf16x8*)(lds + PG8_SB(b, h) + boff + n * 2048 + k * 1024); } while (0)
#define PG8_MMA(ai, bj, At, Bt) do { __builtin_amdgcn_s_setprio(1); _Pragma("unroll") for (int m = 0; m < 4; ++m) _Pragma("unroll") for (int n = 0; n < 2; ++n) _Pragma("unroll") for (int k = 0; k < 2; ++k) \
        acc[ai][bj][m][n] = __builtin_amdgcn_mfma_f32_16x16x32_bf16(Bt[n][k], At[m][k], acc[ai][bj][m][n], 0, 0, 0); __builtin_amdgcn_s_setprio(0); } while (0)
#define PG8_WAIT_V(n) asm volatile("s_waitcnt vmcnt(" #n ")" ::: "memory")
#define PG8_WAIT_L(n) asm volatile("s_waitcnt lgkmcnt(" #n ")" ::: "memory")
#define PG8_BAR __builtin_amdgcn_s_barrier()
#define PG8_SCHED __builtin_amdgcn_sched_barrier(0)
    Unit cur, nxt; int ui = 0;
    if (!S.next(0, cur)) return;
    f32x4 acc[2][2][4][2];
#pragma unroll
    for (int a = 0; a < 2; ++a)
#pragma unroll
        for (int b = 0; b < 2; ++b)
#pragma unroll
            for (int m = 0; m < 4; ++m)
#pragma unroll
                for (int n = 0; n < 2; ++n) acc[a][b][m][n] = (f32x4){0.f, 0.f, 0.f, 0.f};
    bf16x8 At[4][2], B0[2][2], B1[2][2];
    const char* cA = S.abase(cur); const char* cB = S.bbase(cur);
    if constexpr (SP2) {
        PG8_STAGE(PG8_SB(0, 0), cB, voffB); PG8_STAGE(PG8_SB(0, 1), cB + hstep, voffB); PG8_STAGE(PG8_SA(0, 0), cA, voffA); PG8_STAGE(PG8_SA(0, 1), cA + hstep, voffA);
        if (wr == 1) PG8_BAR;
        PG8_WAIT_V(2); PG8_BAR;
        PG8_STAGE(PG8_SB(1, 0), cB + kstep, voffB); PG8_STAGE(PG8_SA(1, 0), cA + kstep, voffA); PG8_STAGE(PG8_SB(1, 1), cB + hstep + kstep, voffB);
        PG8_WAIT_V(6); PG8_BAR;
    } else {
        PG8_STAGE(PG8_SB(0, 0), cB, voffB); PG8_STAGE(PG8_SA(0, 0), cA, voffA); PG8_STAGE(PG8_SB(0, 1), cB + hstep, voffB); PG8_STAGE(PG8_SA(0, 1), cA + hstep, voffA);
        if (wr == 1) PG8_BAR;
        PG8_WAIT_V(4); PG8_BAR;
        PG8_STAGE(PG8_SB(1, 0), cB + kstep, voffB); PG8_STAGE(PG8_SA(1, 0), cA + kstep, voffA); PG8_STAGE(PG8_SB(1, 1), cB + hstep + kstep, voffB);
        PG8_WAIT_V(6); PG8_BAR;
    }
    for (;;) {
        const bool has_next = S.next(ui + 1, nxt);
        const char* nA = has_next ? S.abase(nxt) : cA; const char* nB = has_next ? S.bbase(nxt) : cB;
        for (int t = 0; t < nt; t += 2) {
            const bool last = (t == nt - 2);
            const char* a1 = cA + (size_t)(t + 1) * kstep;
            const char* a2 = last ? nA : cA + (size_t)(t + 2) * kstep; const char* b2 = last ? nB : cB + (size_t)(t + 2) * kstep;
            const char* a3 = a2 + kstep; const char* b3 = b2 + kstep;
            if constexpr (SP2) {
            PG8_LDB(B0, 0, 0); PG8_LDB(B1, 0, 1); PG8_SCHED; PG8_LDA(At, 0, 0); PG8_STAGE(PG8_SA(1, 1), a1 + hstep, voffA);
            PG8_WAIT_V(8); PG8_WAIT_L(0); PG8_BAR; PG8_MMA(0, 0, At, B0); PG8_MMA(0, 1, At, B1); PG8_BAR; PG8_SCHED;
            PG8_LDA(At, 0, 1); PG8_STAGE(PG8_SB(0, 0), b2, voffB); PG8_STAGE(PG8_SB(0, 1), b2 + hstep, voffB); PG8_STAGE(PG8_SA(0, 0), a2, voffA);
            PG8_WAIT_V(8); PG8_WAIT_L(0); PG8_BAR; PG8_MMA(1, 0, At, B0); PG8_MMA(1, 1, At, B1); PG8_BAR; PG8_SCHED;
            PG8_LDB(B0, 1, 0); PG8_LDB(B1, 1, 1); PG8_SCHED; PG8_LDA(At, 1, 0); PG8_STAGE(PG8_SA(0, 1), a2 + hstep, voffA);
            PG8_WAIT_V(8); PG8_WAIT_L(0); PG8_BAR; PG8_MMA(0, 0, At, B0); PG8_MMA(0, 1, At, B1); PG8_BAR; PG8_SCHED;
            PG8_LDA(At, 1, 1); PG8_STAGE(PG8_SB(1, 0), b3, voffB); PG8_STAGE(PG8_SB(1, 1), b3 + hstep, voffB); PG8_STAGE(PG8_SA(1, 0), a3, voffA);
            PG8_WAIT_V(8); PG8_WAIT_L(0); PG8_BAR; PG8_MMA(1, 0, At, B0); PG8_MMA(1, 1, At, B1); PG8_BAR; PG8_SCHED;
            } else {
            PG8_LDB(B0, 0, 0); PG8_SCHED; PG8_LDA(At, 0, 0); PG8_STAGE(PG8_SA(1, 1), a1 + hstep, voffA);
            PG8_WAIT_L(8); PG8_BAR; PG8_WAIT_L(0); PG8_MMA(0, 0, At, B0); PG8_BAR; PG8_SCHED;
            PG8_LDB(B1, 0, 1); PG8_STAGE(PG8_SB(0, 0), b2, voffB);
            PG8_BAR; PG8_WAIT_L(0); PG8_MMA(0, 1, At, B1); PG8_BAR;
            PG8_LDA(At, 0, 1); PG8_STAGE(PG8_SA(0, 0), a2, voffA);
            PG8_BAR; PG8_WAIT_L(0); PG8_MMA(1, 0, At, B0); PG8_BAR; PG8_SCHED;
            PG8_STAGE(PG8_SB(0, 1), b2 + hstep, voffB);
            PG8_WAIT_V(6); PG8_BAR; PG8_MMA(1, 1, At, B1); PG8_BAR;
            PG8_LDB(B0, 1, 0); PG8_SCHED; PG8_LDA(At, 1, 0); PG8_STAGE(PG8_SA(0, 1), a2 + hstep, voffA);
            PG8_WAIT_L(8); PG8_BAR; PG8_WAIT_L(0); PG8_MMA(0, 0, At, B0); PG8_BAR; PG8_SCHED;
            PG8_LDB(B1, 1, 1); PG8_STAGE(PG8_SB(1, 0), b3, voffB);
            PG8_BAR; PG8_WAIT_L(0); PG8_MMA(0, 1, At, B1); PG8_BAR;
            PG8_LDA(At, 1, 1); PG8_STAGE(PG8_SA(1, 0), a3, voffA);
            PG8_BAR; PG8_WAIT_L(0); PG8_MMA(1, 0, At, B0); PG8_BAR; PG8_SCHED;
            PG8_STAGE(PG8_SB(1, 1), b3 + hstep, voffB);
            PG8_WAIT_V(6); PG8_BAR; PG8_MMA(1, 1, At, B1); PG8_BAR;
            }
        }
        if constexpr (ALIGN_EPI) { if (wr == 0) PG8_BAR; }
        E(acc, cur, wr, wc, fr, fq);
        if (!has_next) break;
#pragma unroll
        for (int a = 0; a < 2; ++a)
#pragma unroll
            for (int b = 0; b < 2; ++b)
#pragma unroll
                for (int m = 0; m < 4; ++m)
#pragma unroll
                    for (int n = 0; n < 2; ++n) acc[a][b][m][n] = (f32x4){0.f, 0.f, 0.f, 0.f};
        cur = nxt; cA = nA; cB = nB; ++ui;
        if constexpr (ALIGN_EPI) { if (wr == 1) PG8_BAR; }
    }
    PG8_WAIT_V(0);
    if constexpr (!ALIGN_EPI) { if (wr == 0) PG8_BAR; }
    PG8_BAR;
#undef PG8_SA
#undef PG8_SB
#undef PG8_STAGE
#undef PG8_LDA
#undef PG8_LDB
#undef PG8_MMA
#undef PG8_WAIT_V
#undef PG8_WAIT_L
#undef PG8_BAR
#undef PG8_SCHED
}

typedef const f32x4 (&AccRef)[2][2][4][2];

__device__ __forceinline__ float row_rs(const float* ss, int row) {
    const f32x4* p = (const f32x4*)(ss + (size_t)row * 32); float s = 0.f;
#pragma unroll
    for (int i = 0; i < 8; ++i) { const f32x4 v = p[i]; s += (v[0] + v[1]) + (v[2] + v[3]); }
    return __builtin_amdgcn_rsqf(s * (1.0f / DM) + RMS_EPS);
}

struct EpiInProj {
    static constexpr bool PERM = true;
    bf16_t* proj; bf16_t* kb; bf16_t* vb; const float* rs0; const f32x2* rope;
    __device__ __forceinline__ void operator()(AccRef acc, const Unit& u, int wr, int wc, int fr, int fq) const {
        const int row0 = u.pm * BM + wr * 64 + fr;
        if (u.z == 1) {
            bf16_t* base = (u.pn < 8 ? kb : vb) + (u.pn & 7) * BM + wc * 32 + 8 * fq;
#pragma unroll
            for (int ai = 0; ai < 2; ++ai)
#pragma unroll
                for (int m = 0; m < 4; ++m) { bf16_t* rowp = base + (size_t)(row0 + ai * HALF + m * 16) * DM;
#pragma unroll
                    for (int bj = 0; bj < 2; ++bj) { const f32x4 v0 = acc[ai][bj][m][0], v1 = acc[ai][bj][m][1]; u32x4 w;
                        w.x = cvt_pk_bf16(v0[0], v0[1]); w.y = cvt_pk_bf16(v0[2], v0[3]); w.z = cvt_pk_bf16(v1[0], v1[1]); w.w = cvt_pk_bf16(v1[2], v1[3]);
                        *(u32x4*)(rowp + bj * HALF) = w; } }
            return;
        }
        const int pn = u.pn; const bool rp = (pn >= 12 && pn < 20);
        const float sc = pn < 4 ? NA_QS : ((pn >= 12 && pn < 16) ? DF_QS : 1.0f);
        if (!rp) {
            bf16_t* base = proj + pn * BM + wc * 32 + 8 * fq;
#pragma unroll
            for (int ai = 0; ai < 2; ++ai)
#pragma unroll
                for (int m = 0; m < 4; ++m) { const int row = row0 + ai * HALF + m * 16; const float rr = rs0[row] * sc; bf16_t* rowp = base + (size_t)row * INW;
#pragma unroll
                    for (int bj = 0; bj < 2; ++bj) { const f32x4 v0 = acc[ai][bj][m][0] * rr, v1 = acc[ai][bj][m][1] * rr; u32x4 w;
                        w.x = cvt_pk_bf16(v0[0], v0[1]); w.y = cvt_pk_bf16(v0[2], v0[3]); w.z = cvt_pk_bf16(v1[0], v1[1]); w.w = cvt_pk_bf16(v1[2], v1[3]);
                        *(u32x4*)(rowp + bj * HALF) = w; } }
        } else {
            const int dd0 = 16 * (wc & 1) + 4 * fq;
            bf16_t* base = proj + pn * BM + (wc >> 1) * 64 + dd0;
#pragma unroll
            for (int ai = 0; ai < 2; ++ai)
#pragma unroll
                for (int m = 0; m < 4; ++m) { const int row = row0 + ai * HALF + m * 16; const float rr = rs0[row] * sc; bf16_t* rowp = base + (size_t)row * INW;
                    const int t = row < NP ? (row & (TP - 1)) : (row & (TS - 1));
                    const f32x4 cs0 = *(const f32x4*)(rope + (size_t)t * 32 + dd0), cs1 = *(const f32x4*)(rope + (size_t)t * 32 + dd0 + 2);
#pragma unroll
                    for (int bj = 0; bj < 2; ++bj) { const f32x4 x1 = acc[ai][bj][m][0] * rr, x2 = acc[ai][bj][m][1] * rr;
                        const float a0 = x1[0] * cs0[0] - x2[0] * cs0[1], a1 = x1[1] * cs0[2] - x2[1] * cs0[3], a2 = x1[2] * cs1[0] - x2[2] * cs1[1], a3 = x1[3] * cs1[2] - x2[3] * cs1[3];
                        const float b0 = x2[0] * cs0[0] + x1[0] * cs0[1], b1 = x2[1] * cs0[2] + x1[1] * cs0[3], b2 = x2[2] * cs1[0] + x1[2] * cs1[1], b3 = x2[3] * cs1[2] + x1[3] * cs1[3];
                        u32x2 wa, wb; wa.x = cvt_pk_bf16(a0, a1); wa.y = cvt_pk_bf16(a2, a3); wb.x = cvt_pk_bf16(b0, b1); wb.y = cvt_pk_bf16(b2, b3);
                        *(u32x2*)(rowp + bj * HALF) = wa; *(u32x2*)(rowp + bj * HALF + 32) = wb; } }
        }
    }
};
struct EpiPre {
    static constexpr bool PERM = true;
    bf16_t* wqk; bf16_t* wvo;
    __device__ __forceinline__ void operator()(AccRef acc, const Unit& u, int wr, int wc, int fr, int fq) const {
        const int zz = u.z % 24, b = zz >> 2, h = zz & 3; bf16_t* base; int ldc; float sc;
        if (u.z < 24) { base = wqk + ((size_t)(b * 1024 + h * 256)) * DM + u.pn * BM; ldc = DM; sc = MEM_QS; }
        else { base = wvo + ((size_t)(b * 2048 + u.pm * BM)) * NSW + h * 256; ldc = NSW; sc = 1.0f; }
        base += wc * 32 + 8 * fq;
#pragma unroll
        for (int ai = 0; ai < 2; ++ai)
#pragma unroll
            for (int m = 0; m < 4; ++m) { bf16_t* rowp = base + (size_t)(wr * 64 + fr + ai * HALF + m * 16) * ldc;
#pragma unroll
                for (int bj = 0; bj < 2; ++bj) { const f32x4 v0 = acc[ai][bj][m][0] * sc, v1 = acc[ai][bj][m][1] * sc; u32x4 w;
                    w.x = cvt_pk_bf16(v0[0], v0[1]); w.y = cvt_pk_bf16(v0[2], v0[3]); w.z = cvt_pk_bf16(v1[0], v1[1]); w.w = cvt_pk_bf16(v1[2], v1[3]);
                    *(u32x4*)(rowp + bj * HALF) = w; } }
    }
};
__device__ __forceinline__ float row_rs4(const float* ss, int row, int fq) {
    const f32x4* p = (const f32x4*)(ss + (size_t)row * 32 + fq * 8); const f32x4 a = p[0], b = p[1];
    float s = ((a[0] + a[1]) + (a[2] + a[3])) + ((b[0] + b[1]) + (b[2] + b[3]));
    s += __shfl_xor(s, 16); s += __shfl_xor(s, 32);
    return __builtin_amdgcn_rsqf(s * (1.0f / DM) + RMS_EPS);
}
struct EpiResid {
    static constexpr bool PERM = false;
    const float* basef; const bf16_t* baseb; bf16_t* ob; int ldo; float* ss;
    __device__ __forceinline__ void operator()(AccRef acc, const Unit& u, int wr, int wc, int fr, int fq) const {
        const int col0 = u.pn * BM + wc * 32 + 4 * fq;
#pragma unroll
        for (int ai = 0; ai < 2; ++ai)
#pragma unroll
            for (int m = 0; m < 4; ++m) { const int row = u.pm * BM + ai * HALF + wr * 64 + m * 16 + fr; const size_t off = (size_t)row * DM + col0; bf16_t* orow = ob + (size_t)row * ldo + col0; float q = 0.f;
#pragma unroll
                for (int bj = 0; bj < 2; ++bj)
#pragma unroll
                    for (int n = 0; n < 2; ++n) { const int o2 = bj * HALF + n * 16; f32x4 bv;
                        if (baseb) { const u32x2 w = *(const u32x2*)(baseb + off + o2); bv = (f32x4){__uint_as_float(w.x << 16), __uint_as_float(w.x & 0xffff0000u), __uint_as_float(w.y << 16), __uint_as_float(w.y & 0xffff0000u)}; }
                        else bv = *(const f32x4*)(basef + off + o2);
                        const f32x4 o = bv + acc[ai][bj][m][n]; q += (o[0] * o[0] + o[1] * o[1]) + (o[2] * o[2] + o[3] * o[3]);
                        u32x2 w2; w2.x = cvt_pk_bf16(o[0], o[1]); w2.y = cvt_pk_bf16(o[2], o[3]); *(u32x2*)(orow + o2) = w2; }
                q += __shfl_xor(q, 16); q += __shfl_xor(q, 32);
                if (fq == 0) ss[(size_t)row * 32 + u.pn * 4 + wc] = q; }
    }
};
struct EpiX { static constexpr bool PERM = false; const float* xp; const float* xs; bf16_t* ob; float* ss;
    __device__ __forceinline__ void operator()(AccRef acc, const Unit& u, int wr, int wc, int fr, int fq) const {
        const float* base = (u.pm < NP / 256) ? xp : xs - (size_t)NP * DM; EpiResid E{base, nullptr, ob, DM, ss}; E(acc, u, wr, wc, fr, fq); } };
struct EpiSm {
    static constexpr bool PERM = false;
    bf16_t* P; const float* ss; LAS unsigned char* tab;
    __device__ __forceinline__ void operator()(AccRef acc, const Unit& u, int wr, int wc, int fr, int fq) const {
        float rr[2][4];
#pragma unroll
        for (int ai = 0; ai < 2; ++ai)
#pragma unroll
            for (int m = 0; m < 4; ++m) { const int rl = ai * HALF + wr * 64 + m * 16 + fr; const float r_ = row_rs4(ss, u.pm * BM + rl, fq); rr[ai][m] = r_;
                float mx = acc[ai][0][m][0][0];
#pragma unroll
                for (int bj = 0; bj < 2; ++bj)
#pragma unroll
                    for (int n = 0; n < 2; ++n) { const f32x4 v = acc[ai][bj][m][n]; mx = fmaxf(fmaxf(mx, fmaxf(v[0], v[1])), fmaxf(v[2], v[3])); }
                mx *= r_; mx = fmaxf(mx, __shfl_xor(mx, 16)); mx = fmaxf(mx, __shfl_xor(mx, 32));
                float sm = 0.f;
#pragma unroll
                for (int bj = 0; bj < 2; ++bj)
#pragma unroll
                    for (int n = 0; n < 2; ++n) { const f32x4 v = acc[ai][bj][m][n];
                        sm += (__builtin_amdgcn_exp2f(v[0] * r_ - mx) + __builtin_amdgcn_exp2f(v[1] * r_ - mx)) + (__builtin_amdgcn_exp2f(v[2] * r_ - mx) + __builtin_amdgcn_exp2f(v[3] * r_ - mx)); }
                sm += __shfl_xor(sm, 16); sm += __shfl_xor(sm, 32);
                if (fq == 0) *(LAS f32x2*)(tab + (rl * 4 + wc) * 8) = (f32x2){mx, sm}; }
        asm volatile("s_waitcnt lgkmcnt(0)" ::: "memory"); __builtin_amdgcn_s_barrier(); asm volatile("" ::: "memory");
        const int col0 = u.pn * BM + wc * 32 + 4 * fq;
#pragma unroll
        for (int ai = 0; ai < 2; ++ai)
#pragma unroll
            for (int m = 0; m < 4; ++m) { const int rl = ai * HALF + wr * 64 + m * 16 + fr; const float r_ = rr[ai][m];
                const f32x4 t0 = *(const LAS f32x4*)(tab + rl * 32), t1 = *(const LAS f32x4*)(tab + rl * 32 + 16);
                const float M = fmaxf(fmaxf(t0[0], t0[2]), fmaxf(t1[0], t1[2]));
                const float L = (t0[1] * __builtin_amdgcn_exp2f(t0[0] - M) + t0[3] * __builtin_amdgcn_exp2f(t0[2] - M)) + (t1[1] * __builtin_amdgcn_exp2f(t1[0] - M) + t1[3] * __builtin_amdgcn_exp2f(t1[2] - M));
                const float inv = __builtin_amdgcn_rcpf(L);
                bf16_t* rowp = P + (size_t)(u.pm * BM + rl) * NSW + col0;
#pragma unroll
                for (int bj = 0; bj < 2; ++bj)
#pragma unroll
                    for (int n = 0; n < 2; ++n) { const f32x4 v = acc[ai][bj][m][n]; u32x2 w;
                        w.x = cvt_pk_bf16(__builtin_amdgcn_exp2f(v[0] * r_ - M) * inv, __builtin_amdgcn_exp2f(v[1] * r_ - M) * inv);
                        w.y = cvt_pk_bf16(__builtin_amdgcn_exp2f(v[2] * r_ - M) * inv, __builtin_amdgcn_exp2f(v[3] * r_ - M) * inv);
                        *(u32x2*)(rowp + bj * HALF + n * 16) = w; } }
    }
};
struct EpiGU {
    static constexpr bool PERM = true;
    bf16_t* act; const float* ss;
    __device__ __forceinline__ void operator()(AccRef acc, const Unit& u, int wr, int wc, int fr, int fq) const {
        bf16_t* base = act + u.pn * HALF + wc * 32 + 8 * fq;
#pragma unroll
        for (int ai = 0; ai < 2; ++ai)
#pragma unroll
            for (int m = 0; m < 4; ++m) { const int row = u.pm * BM + ai * HALF + wr * 64 + m * 16 + fr; const float rr = row_rs4(ss, row, fq); float o[8];
#pragma unroll
                for (int n = 0; n < 2; ++n)
#pragma unroll
                    for (int e = 0; e < 4; ++e) { const float g = acc[ai][0][m][n][e] * rr, up = acc[ai][1][m][n][e] * rr;
                        o[n * 4 + e] = g * __builtin_amdgcn_rcpf(1.0f + __builtin_amdgcn_exp2f(-g * LOG2E)) * up; }
                u32x4 w; w.x = cvt_pk_bf16(o[0], o[1]); w.y = cvt_pk_bf16(o[2], o[3]); w.z = cvt_pk_bf16(o[4], o[5]); w.w = cvt_pk_bf16(o[6], o[7]);
                *(u32x4*)(base + (size_t)row * DFF) = w; }
    }
};
}

namespace att {
#define SBAR() __builtin_amdgcn_sched_barrier(0)
constexpr float THR = 8.0f;
constexpr int SHM_V = 16384, SHM_K = 16384, OFF_K = 2 * SHM_V, OFF_WS = OFF_K + 2 * SHM_K, OFF_RPB = OFF_WS + 8 * 256, OFF_STG = OFF_RPB + 2048, OFF_END = OFF_STG + 8 * 8192;
constexpr int DF_R = 5, DF_D = 4;
constexpr int DF_K = DF_R * SHM_V, DF_KSZ = 8192, DF_WS = DF_K + DF_R * DF_KSZ, DF_STG = 0  , DF_END = DF_WS + 8 * 256;
static_assert(8 * 8192 <= DF_K, "output stage fits inside the V ring");
static_assert(DF_END <= 147456 && OFF_END <= 147456, "attention LDS maps fit the dynamic LDS allocation");
__device__ __forceinline__ int crow(int r, int hi) { return (r & 3) + 8 * (r >> 2) + 4 * hi; }
#define KSWZ128(row, colB) ((row) * 256 + ((colB) ^ (((row) & 7) << 4)))
#define KSWZ64(row, colB) ((row) * 128 + ((colB) ^ ((((row) >> 1) & 7) << 4)))
__device__ __forceinline__ int v_st(int k, int c) { const int kk = (k & ~0xC) | ((k & 4) << 1) | ((k & 8) >> 1); return ((kk >> 3) * 4 + (c >> 5)) * 512 + ((kk & 7) * 32 + (c & 31)) * 2; }
__device__ __forceinline__ int v_rd_base(int lane) { return ((lane & 3) << 3) | (((lane >> 2) & 3) << 6) | (((lane >> 4) & 1) << 5) | (((lane >> 5) & 1) << 8); }
constexpr int v_rd_off(int d0, int ks, int half) { return d0 * 512 + ks * 4096 + half * 2048; }
template <int OFF> __device__ __forceinline__ s16x4 tr_read(int vb) { s16x4 r; asm volatile("ds_read_b64_tr_b16 %0, %1 offset:%2" : "=&v"(r) : "v"(vb), "i"(OFF) : "memory"); return r; }
template <int D0> __device__ __forceinline__ void pv_one(f32x16& od, int vb, bf16x8 pa0, bf16x8 pa1, bf16x8 pa2, bf16x8 pa3) {
    const s16x4 l0 = tr_read<v_rd_off(D0, 0, 0)>(vb), h0 = tr_read<v_rd_off(D0, 0, 1)>(vb), l1 = tr_read<v_rd_off(D0, 1, 0)>(vb), h1 = tr_read<v_rd_off(D0, 1, 1)>(vb);
    const s16x4 l2 = tr_read<v_rd_off(D0, 2, 0)>(vb), h2 = tr_read<v_rd_off(D0, 2, 1)>(vb), l3 = tr_read<v_rd_off(D0, 3, 0)>(vb), h3 = tr_read<v_rd_off(D0, 3, 1)>(vb);
    asm volatile("s_waitcnt lgkmcnt(0)" ::: "memory"); SBAR();
#define PK(L, H) (bf16x8){L[0], L[1], L[2], L[3], H[0], H[1], H[2], H[3]}
    od = __builtin_amdgcn_mfma_f32_32x32x16_bf16(pa0, PK(l0, h0), od, 0, 0, 0);
    od = __builtin_amdgcn_mfma_f32_32x32x16_bf16(pa1, PK(l1, h1), od, 0, 0, 0);
    od = __builtin_amdgcn_mfma_f32_32x32x16_bf16(pa2, PK(l2, h2), od, 0, 0, 0);
    od = __builtin_amdgcn_mfma_f32_32x32x16_bf16(pa3, PK(l3, h3), od, 0, 0, 0);
#undef PK
}
template <int D0> __device__ __forceinline__ void pv_rd(s16x4 (&L)[4], s16x4 (&H)[4], int vb) {
    L[0] = tr_read<v_rd_off(D0, 0, 0)>(vb); H[0] = tr_read<v_rd_off(D0, 0, 1)>(vb); L[1] = tr_read<v_rd_off(D0, 1, 0)>(vb); H[1] = tr_read<v_rd_off(D0, 1, 1)>(vb);
    L[2] = tr_read<v_rd_off(D0, 2, 0)>(vb); H[2] = tr_read<v_rd_off(D0, 2, 1)>(vb); L[3] = tr_read<v_rd_off(D0, 3, 0)>(vb); H[3] = tr_read<v_rd_off(D0, 3, 1)>(vb);
}
#define PV_PK(L, H) (bf16x8){L[0], L[1], L[2], L[3], H[0], H[1], H[2], H[3]}
#define PV_MMA(od, L, H) do { od = __builtin_amdgcn_mfma_f32_32x32x16_bf16(pa0, PV_PK(L[0], H[0]), od, 0, 0, 0); od = __builtin_amdgcn_mfma_f32_32x32x16_bf16(pa1, PV_PK(L[1], H[1]), od, 0, 0, 0); \
    od = __builtin_amdgcn_mfma_f32_32x32x16_bf16(pa2, PV_PK(L[2], H[2]), od, 0, 0, 0); od = __builtin_amdgcn_mfma_f32_32x32x16_bf16(pa3, PV_PK(L[3], H[3]), od, 0, 0, 0); } while (0)
__device__ __forceinline__ void pv_all_pre(f32x16* o, int vb, bf16x8 pa0, bf16x8 pa1, bf16x8 pa2, bf16x8 pa3) {
    s16x4 L0[4], H0[4], L1[4], H1[4], L2[4], H2[4], L3[4], H3[4];
    pv_rd<0>(L0, H0, vb); pv_rd<1>(L1, H1, vb);
    asm volatile("s_waitcnt lgkmcnt(8)" ::: "memory"); SBAR(); PV_MMA(o[0], L0, H0); SBAR();
    pv_rd<2>(L2, H2, vb);
    asm volatile("s_waitcnt lgkmcnt(8)" ::: "memory"); SBAR(); PV_MMA(o[1], L1, H1); SBAR();
    pv_rd<3>(L3, H3, vb);
    asm volatile("s_waitcnt lgkmcnt(8)" ::: "memory"); SBAR(); PV_MMA(o[2], L2, H2); SBAR();
    asm volatile("s_waitcnt lgkmcnt(0)" ::: "memory"); SBAR(); PV_MMA(o[3], L3, H3); SBAR();
}
__device__ __forceinline__ void pv_all(f32x16* o, int vb, bf16x8 pa0, bf16x8 pa1, bf16x8 pa2, bf16x8 pa3) {
    pv_one<0>(o[0], vb, pa0, pa1, pa2, pa3); pv_one<1>(o[1], vb, pa0, pa1, pa2, pa3); pv_one<2>(o[2], vb, pa0, pa1, pa2, pa3); pv_one<3>(o[3], vb, pa0, pa1, pa2, pa3);
}
__device__ __forceinline__ void softmax_tile(f32x16& p0, f32x16& p1, float& m_reg, float& l_reg, float& alpha, bf16x8& pa0, bf16x8& pa1, bf16x8& pa2, bf16x8& pa3) {
    float pmax = p0[0];
#pragma unroll
    for (int r = 1; r < 16; ++r) pmax = fmaxf(pmax, p0[r]);
#pragma unroll
    for (int r = 0; r < 16; ++r) pmax = fmaxf(pmax, p1[r]);
    { auto rr = __builtin_amdgcn_permlane32_swap(__float_as_uint(pmax), __float_as_uint(pmax), false, false); pmax = fmaxf(__uint_as_float(rr[0]), __uint_as_float(rr[1])); }
    float mn;
    if (__builtin_expect(__all(pmax - m_reg <= THR), 1)) { mn = m_reg; alpha = 1.f; }
    else { mn = fmaxf(m_reg, pmax); alpha = __builtin_amdgcn_exp2f(m_reg - mn); m_reg = mn; }
#pragma unroll
    for (int r = 0; r < 16; ++r) { p0[r] = __builtin_amdgcn_exp2f(p0[r] - mn); p1[r] = __builtin_amdgcn_exp2f(p1[r] - mn); }
    float ps = 0.f;
#pragma unroll
    for (int r = 0; r < 16; ++r) ps += p0[r];
#pragma unroll
    for (int r = 0; r < 16; ++r) ps += p1[r];
    { auto rr = __builtin_amdgcn_permlane32_swap(__float_as_uint(ps), __float_as_uint(ps), false, false); ps = __uint_as_float(rr[0]) + __uint_as_float(rr[1]); }
    l_reg = l_reg * alpha + ps;
#define PK4(P, BASE, OUT) do { unsigned a0 = cvt_pk_bf16(P[BASE + 0], P[BASE + 1]), a1 = cvt_pk_bf16(P[BASE + 2], P[BASE + 3]);   \
    unsigned b0 = cvt_pk_bf16(P[BASE + 4], P[BASE + 5]), b1 = cvt_pk_bf16(P[BASE + 6], P[BASE + 7]);                              \
    auto r0 = __builtin_amdgcn_permlane32_swap(a0, b0, false, false); auto r1 = __builtin_amdgcn_permlane32_swap(a1, b1, false, false); \
    u32x4 w = {r0[0], r1[0], r0[1], r1[1]}; OUT = __builtin_bit_cast(bf16x8, w); } while (0)
    PK4(p0, 0, pa0); PK4(p0, 8, pa1); PK4(p1, 0, pa2); PK4(p1, 8, pa3);
#undef PK4
}
__device__ __forceinline__ void softmax_rel(f32x16& p0, f32x16& p1, float& m_reg, float& l_reg, f32x16& negm, float& alpha, bool first, bf16x8& pa0, bf16x8& pa1, bf16x8& pa2, bf16x8& pa3) {
    float ma = __builtin_fmaxf(__builtin_fmaxf(p0[0], p0[1]), p0[2]), mb = __builtin_fmaxf(__builtin_fmaxf(p0[8], p0[9]), p0[10]);
    float mc = __builtin_fmaxf(__builtin_fmaxf(p1[0], p1[1]), p1[2]), md = __builtin_fmaxf(__builtin_fmaxf(p1[8], p1[9]), p1[10]);
    ma = __builtin_fmaxf(__builtin_fmaxf(ma, p0[3]), p0[4]); mb = __builtin_fmaxf(__builtin_fmaxf(mb, p0[11]), p0[12]); mc = __builtin_fmaxf(__builtin_fmaxf(mc, p1[3]), p1[4]); md = __builtin_fmaxf(__builtin_fmaxf(md, p1[11]), p1[12]);
    ma = __builtin_fmaxf(__builtin_fmaxf(ma, p0[5]), p0[6]); mb = __builtin_fmaxf(__builtin_fmaxf(mb, p0[13]), p0[14]); mc = __builtin_fmaxf(__builtin_fmaxf(mc, p1[5]), p1[6]); md = __builtin_fmaxf(__builtin_fmaxf(md, p1[13]), p1[14]);
    ma = __builtin_fmaxf(__builtin_fmaxf(ma, p0[7]), mb); mc = __builtin_fmaxf(__builtin_fmaxf(mc, p1[7]), md);
    float pmax = __builtin_fmaxf(__builtin_fmaxf(ma, p0[15]), __builtin_fmaxf(mc, p1[15]));
    { auto rr = __builtin_amdgcn_permlane32_swap(__float_as_uint(pmax), __float_as_uint(pmax), false, false); pmax = __builtin_fmaxf(__uint_as_float(rr[0]), __uint_as_float(rr[1])); }
    alpha = 1.f;
    if (__builtin_expect(first || !__all(pmax <= THR), 0)) {
        const float dl = first ? pmax : fmaxf(pmax, 0.f);
        m_reg += dl; alpha = first ? 1.f : __builtin_amdgcn_exp2f(-dl);
#pragma unroll
        for (int r = 0; r < 16; ++r) { p0[r] -= dl; p1[r] -= dl; negm[r] = -m_reg; }
    }
#pragma unroll
    for (int r = 0; r < 16; ++r) { p0[r] = __builtin_amdgcn_exp2f(p0[r]); p1[r] = __builtin_amdgcn_exp2f(p1[r]); }
    float ps0 = p0[0], ps1 = p1[0], ps2 = p0[8], ps3 = p1[8];
#pragma unroll
    for (int r = 1; r < 8; ++r) { ps0 += p0[r]; ps1 += p1[r]; ps2 += p0[8 + r]; ps3 += p1[8 + r]; }
    l_reg = l_reg * alpha + ((ps0 + ps1) + (ps2 + ps3));
#define PK4N(P, BASE, OUT) do { u32x4 w = {cvt_pk_bf16(P[BASE + 0], P[BASE + 1]), cvt_pk_bf16(P[BASE + 2], P[BASE + 3]), cvt_pk_bf16(P[BASE + 4], P[BASE + 5]), cvt_pk_bf16(P[BASE + 6], P[BASE + 7])}; \
    OUT = __builtin_bit_cast(bf16x8, w); } while (0)
    PK4N(p0, 0, pa0); PK4N(p0, 8, pa1); PK4N(p1, 0, pa2); PK4N(p1, 8, pa3);
#undef PK4N
}
#define ATT_RESC2(a) do { if (__any((a) < 1.f)) { if (hi == 0) al_l[r32] = (a); asm volatile("s_waitcnt lgkmcnt(0)" ::: "memory"); \
    _Pragma("unroll") for (int r = 0; r < 16; ++r) { const float f_ = al_l[crow(r, hi)]; o[0][r] *= f_; o[1][r] *= f_; o[2][r] *= f_; o[3][r] *= f_; } } } while (0)
#define ATT_RESC(a) do { if (__any((a) < 1.f)) { if (hi == 0) al_l[r32] = (a); asm volatile("s_waitcnt lgkmcnt(0)" ::: "memory"); \
    _Pragma("unroll") for (int d = 0; d < 4; ++d) _Pragma("unroll") for (int r = 0; r < 16; ++r) o[d][r] *= al_l[crow(r, hi)]; } } while (0)

__device__ __forceinline__ void diff_unit(const bf16_t* __restrict__ proj, bf16_t* __restrict__ mix, float* __restrict__ o1s, const float* __restrict__ g_sub, float lam,
                                          int rowbase, int T, int h, int qb, char* lds, int widk) {
    const int tid = tid_l(widk), wid = tid >> 6, lane = tid & 63, r32 = lane & 31, hi = lane >> 5;
    char* V_lds = lds; char* K_lds = lds + DF_K;
    float* wsf = (float*)(lds + DF_WS) + wid * 64; float* li_l = wsf; float* al_l = wsf + 32;
    LAS unsigned char* ldsl = (LAS unsigned char*)lds; const int widu = __builtin_amdgcn_readfirstlane(wid); const int grp = widu >> 2;
    unsigned kgo, vgo[2];
    { const int X = wid * 1024 + lane * 16, krow = X >> 7, kcolB = (X & 127) ^ (((krow >> 1) & 7) << 4); kgo = (unsigned)(krow * INW * 2 + kcolB); }
#pragma unroll
    for (int i = 0; i < 2; ++i) { const int X = wid * 1024 + lane * 16 + i * 8192, sub = X >> 9, e = (X & 511) >> 1, kk = (sub >> 2) * 8 + (e >> 5), cc = (sub & 3) * 32 + (e & 31);
        vgo[i] = (unsigned)((kk * INW + cc) * 2); }
    const int vb0 = (int)(uintptr_t)V_lds + v_rd_base(lane);
    const int NT = T / 64; const int q0 = qb * 256;
    const bf16_t* Vh = proj + (size_t)rowbase * INW + 5120 + h * 128;
#define BAR() do { asm volatile("" ::: "memory"); __builtin_amdgcn_s_barrier(); asm volatile("" ::: "memory"); } while (0)
#pragma unroll 1
    for (int s = 0; s < 2; ++s) {
        const bf16_t* Kh = proj + (size_t)rowbase * INW + 4096 + h * 128 + s * 64;
        const unsigned qoff = ((unsigned)(rowbase + q0 + wid * 32 + r32) * INW + 3072 + h * 128 + s * 64 + hi * 8) * 2u;
        bf16x8 qr[4];
#pragma unroll
        for (int d0 = 0; d0 < 4; ++d0) qr[d0] = *(const bf16x8*)((const char*)proj + qoff + d0 * 32);
        float m_reg = 0.f, l_reg = 0.f; f32x16 o[4], negm = f32x16{};
#pragma unroll
        for (int d = 0; d < 4; ++d) o[d] = f32x16{};
#define DDMA(j, b) do { const char* kt = (const char*)Kh + (size_t)(j) * (64 * INW * 2); const char* vt = (const char*)Vh + (size_t)(j) * (64 * INW * 2); \
        __builtin_amdgcn_global_load_lds((const unsigned*)(kt + kgo), (LAS unsigned*)(ldsl + DF_K + (b) * DF_KSZ + widu * 1024), 16, 0, 0); \
        __builtin_amdgcn_global_load_lds((const unsigned*)(vt + vgo[0]), (LAS unsigned*)(ldsl + (b) * SHM_V + widu * 1024), 16, 0, 0); \
        __builtin_amdgcn_global_load_lds((const unsigned*)(vt + vgo[1]), (LAS unsigned*)(ldsl + (b) * SHM_V + widu * 1024 + 8192), 16, 0, 0); } while (0)
#pragma unroll
        for (int t = 0; t < DF_D; ++t) DDMA(t, t);
        asm volatile("s_waitcnt vmcnt(%0)" :: "n"(3 * (DF_D - 1)) : "memory"); BAR();
        int ka[4];
#pragma unroll
        for (int d0 = 0; d0 < 4; ++d0) ka[d0] = (int)(uintptr_t)K_lds + KSWZ64(r32, (d0 * 16 + hi * 8) * 2);
#define KRD(dst, addr, OFF) asm volatile("ds_read_b128 %0, %1 offset:" #OFF : "=&v"(dst) : "v"(addr) : "memory")
        if (grp) BAR();
        int bsl = 0;
#pragma unroll 1
        for (int j = 0; j < NT; ++j) {
            BAR();
            f32x16 p0, p1;
            __builtin_amdgcn_s_setprio(1);
            { const int kb = bsl * DF_KSZ; bf16x8 k0, k1, k2, k3, k4, k5, k6, k7; const int a0 = ka[0] + kb, a1 = ka[1] + kb, a2 = ka[2] + kb, a3 = ka[3] + kb;
              KRD(k0, a0, 0); KRD(k1, a0, 4096); KRD(k2, a1, 0); KRD(k3, a1, 4096); KRD(k4, a2, 0); KRD(k5, a2, 4096); KRD(k6, a3, 0); KRD(k7, a3, 4096);
              asm volatile("s_waitcnt lgkmcnt(6)" ::: "memory"); SBAR();
              asm volatile("v_mfma_f32_32x32x16_bf16 %0, %1, %2, %3" : "=&v"(p0) : "v"(k0), "v"(qr[0]), "v"(negm));
              asm volatile("v_mfma_f32_32x32x16_bf16 %0, %1, %2, %3" : "=&v"(p1) : "v"(k1), "v"(qr[0]), "v"(negm)); SBAR();
              asm volatile("s_waitcnt lgkmcnt(4)" ::: "memory"); SBAR();
              p0 = __builtin_amdgcn_mfma_f32_32x32x16_bf16(k2, qr[1], p0, 0, 0, 0); p1 = __builtin_amdgcn_mfma_f32_32x32x16_bf16(k3, qr[1], p1, 0, 0, 0); SBAR();
              asm volatile("s_waitcnt lgkmcnt(2)" ::: "memory"); SBAR();
              p0 = __builtin_amdgcn_mfma_f32_32x32x16_bf16(k4, qr[2], p0, 0, 0, 0); p1 = __builtin_amdgcn_mfma_f32_32x32x16_bf16(k5, qr[2], p1, 0, 0, 0); SBAR();
              asm volatile("s_waitcnt lgkmcnt(0)" ::: "memory"); SBAR();
              p0 = __builtin_amdgcn_mfma_f32_32x32x16_bf16(k6, qr[3], p0, 0, 0, 0); p1 = __builtin_amdgcn_mfma_f32_32x32x16_bf16(k7, qr[3], p1, 0, 0, 0); SBAR(); }
            __builtin_amdgcn_s_setprio(0);
            float alpha; bf16x8 pa0, pa1, pa2, pa3;
            softmax_rel(p0, p1, m_reg, l_reg, negm, alpha, j == 0, pa0, pa1, pa2, pa3);
            ATT_RESC2(alpha);
            if (j + DF_D <= NT) asm volatile("s_waitcnt vmcnt(%0) lgkmcnt(0)" :: "n"(3 * (DF_D - 2)) : "memory"); else asm volatile("s_waitcnt vmcnt(0) lgkmcnt(0)" ::: "memory");
            BAR();
            if (j + DF_D < NT) { const int b2 = bsl >= 1 ? bsl - 1 : DF_R - 1; DDMA(j + DF_D, b2); }
            const int bn = bsl == DF_R - 1 ? 0 : bsl + 1;
            pv_all_pre(o, vb0 + bsl * SHM_V, pa0, pa1, pa2, pa3);
            bsl = bn;
        }
#undef KRD
        asm volatile("s_waitcnt lgkmcnt(0)" ::: "memory");
        if (!grp) BAR();
        BAR();
#undef DDMA
        { auto rr = __builtin_amdgcn_permlane32_swap(__float_as_uint(l_reg), __float_as_uint(l_reg), false, false); l_reg = __uint_as_float(rr[0]) + __uint_as_float(rr[1]); }
        if (hi == 0) li_l[r32] = l_reg;
        asm volatile("s_waitcnt lgkmcnt(0)" ::: "memory");
        float rli[16];
#pragma unroll
        for (int r = 0; r < 16; ++r) rli[r] = __builtin_amdgcn_rcpf(li_l[crow(r, hi)]);
        f32x4* o1v = (f32x4*)((char*)o1s + (unsigned)tid * 256u);
        if (s == 0) {
#pragma unroll
            for (int d = 0; d < 4; ++d)
#pragma unroll
                for (int r = 0; r < 16; r += 4) o1v[d * 4 + (r >> 2)] = (f32x4){o[d][r] * rli[r], o[d][r + 1] * rli[r + 1], o[d][r + 2] * rli[r + 2], o[d][r + 3] * rli[r + 3]};
        } else {
#pragma unroll
            for (int d = 0; d < 4; ++d)
#pragma unroll
                for (int r = 0; r < 16; r += 4) { const f32x4 t = o1v[d * 4 + (r >> 2)];
#pragma unroll
                    for (int e = 0; e < 4; ++e) o[d][r + e] = t[e] - lam * (o[d][r + e] * rli[r + e]); }
            float gs[4];
#pragma unroll
            for (int d = 0; d < 4; ++d) gs[d] = g_sub[d * 32 + r32] * (1.0f - LAM_INIT);
            bf16_t* stg = (bf16_t*)(lds + DF_STG) + wid * 4096;
#pragma unroll
            for (int r = 0; r < 16; ++r) {
                float q = (o[0][r] * o[0][r] + o[1][r] * o[1][r]) + (o[2][r] * o[2][r] + o[3][r] * o[3][r]);
                q += __shfl_xor(q, 1); q += __shfl_xor(q, 2); q += __shfl_xor(q, 4); q += __shfl_xor(q, 8); q += __shfl_xor(q, 16);
                const float rn = __builtin_amdgcn_rsqf(q * (1.0f / 128.0f) + SUBLN_EPS);
#pragma unroll
                for (int d = 0; d < 4; ++d) stg[crow(r, hi) * 128 + d * 32 + r32] = (bf16_t)f2bf(o[d][r] * rn * gs[d]);
            }
            asm volatile("s_waitcnt lgkmcnt(0)" ::: "memory");
            const unsigned goff = ((unsigned)(rowbase + q0 + wid * 32 + (lane >> 4)) * DM + 1024 + h * 128 + (lane & 15) * 8) * 2u;
#pragma unroll
            for (int i = 0; i < 8; ++i) { const u32x4 v = *(const u32x4*)(stg + (i * 4 + (lane >> 4)) * 128 + (lane & 15) * 8); *(u32x4*)((char*)mix + goff + (unsigned)(i * 4 * DM * 2)) = v; }
            asm volatile("s_waitcnt lgkmcnt(0)" ::: "memory"); BAR();
        }
    }
#undef BAR
}

__device__ __forceinline__ void na_unit(const bf16_t* __restrict__ proj, bf16_t* __restrict__ mix, const float* __restrict__ rpb,
                                        int rowbase, int ROWS, int h, int rg, char* lds, int widk) {
    const int tid = tid_l(widk), wid = tid >> 6, lane = tid & 63, r32 = lane & 31, hi = lane >> 5;
    char* V_lds = lds; char* K_lds = lds + OFF_K;
    float* wsf = (float*)(lds + OFF_WS) + wid * 64; float* li_l = wsf; float* al_l = wsf + 32;
    float* rpbL = (float*)(lds + OFF_RPB);
    LAS unsigned char* ldsl = (LAS unsigned char*)lds; const int widu = __builtin_amdgcn_readfirstlane(wid);
    unsigned kgo[2], vgo[2];
#pragma unroll
    for (int i = 0; i < 2; ++i) { const int X = wid * 1024 + lane * 16 + i * 8192;
        { const int krow = X >> 8, kcolB = (X & 255) ^ ((krow & 7) << 4); kgo[i] = (unsigned)(krow * INW * 2 + kcolB); }
        { const int sub = X >> 9, e = (X & 511) >> 1, kk = (sub >> 2) * 8 + (e >> 5), cc = (sub & 3) * 32 + (e & 31); const int k = (kk & ~0xC) | ((kk & 4) << 1) | ((kk & 8) >> 1); vgo[i] = (unsigned)((k * INW + cc) * 2); } }
    const int vb0 = (int)(uintptr_t)V_lds + v_rd_base(lane);
    const int r0 = rg * 4, rq = r0 + (wid >> 1), c = 32 * (wid & 1) + r32;
    const int rsw = min(max(rq - 4, 0), ROWS - 8), cs = min(max(c - 8, 0), 48);
    const int klo = min(max(r0 - 4, 0), ROWS - 8), khi = min(max(r0 + 3 - 4, 0), ROWS - 8) + 8;
    for (int i = tid; i < 465; i += NTHREADS) rpbL[i] = rpb[h * 465 + i] * LOG2E;
    const bf16_t* Kh = proj + (size_t)rowbase * INW + 1024 + h * 128;
    const bf16_t* Vh = proj + (size_t)rowbase * INW + 2048 + h * 128;
    const bf16_t* Qw = proj + (size_t)(rowbase + rq * 64 + c) * INW + h * 128 + hi * 8;
    bf16x8 qr[8];
#pragma unroll
    for (int d0 = 0; d0 < 8; ++d0) qr[d0] = *(const bf16x8*)(Qw + d0 * 16);
    float m_reg = -1e30f, l_reg = 0.f; f32x16 o[4];
#pragma unroll
    for (int d = 0; d < 4; ++d) o[d] = f32x16{};
#define NDMA(kr, b) do { const char* kt = (const char*)Kh + (size_t)(kr) * (64 * INW * 2); const char* vt = (const char*)Vh + (size_t)(kr) * (64 * INW * 2); \
        __builtin_amdgcn_global_load_lds((const unsigned*)(kt + kgo[0]), (LAS unsigned*)(ldsl + OFF_K + (b) * SHM_K + widu * 1024), 16, 0, 0); \
        __builtin_amdgcn_global_load_lds((const unsigned*)(kt + kgo[1]), (LAS unsigned*)(ldsl + OFF_K + (b) * SHM_K + widu * 1024 + 8192), 16, 0, 0); \
        __builtin_amdgcn_global_load_lds((const unsigned*)(vt + vgo[0]), (LAS unsigned*)(ldsl + (b) * SHM_V + widu * 1024), 16, 0, 0); \
        __builtin_amdgcn_global_load_lds((const unsigned*)(vt + vgo[1]), (LAS unsigned*)(ldsl + (b) * SHM_V + widu * 1024 + 8192), 16, 0, 0); } while (0)
    NDMA(klo, 0); asm volatile("s_waitcnt vmcnt(0)" ::: "memory"); __syncthreads();
#pragma unroll 1
    for (int kr = klo; kr < khi; ++kr) {
        const int b = (kr - klo) & 1;
        if (kr + 1 < khi) NDMA(kr + 1, b ^ 1);
        if (kr >= rsw && kr < rsw + 8) {
            f32x16 p0 = f32x16{}, p1 = f32x16{};
            const char* Ks = K_lds + b * SHM_K;
#pragma unroll
            for (int d0 = 0; d0 < 8; ++d0) { const int cb = (d0 * 16 + hi * 8) * 2;
                const bf16x8 b0 = *(const bf16x8*)(Ks + KSWZ128(r32, cb)); const bf16x8 b1 = *(const bf16x8*)(Ks + KSWZ128(32 + r32, cb));
                p0 = __builtin_amdgcn_mfma_f32_32x32x16_bf16(b0, qr[d0], p0, 0, 0, 0); p1 = __builtin_amdgcn_mfma_f32_32x32x16_bf16(b1, qr[d0], p1, 0, 0, 0); }
            const float* brow = rpbL + (kr - rq + 7) * 31;
#pragma unroll
            for (int r = 0; r < 16; ++r) {
                const int kc = crow(r, hi), kc2 = kc + 32;
                const int i0 = min(max(kc - c + 15, 0), 30), i1 = min(max(kc2 - c + 15, 0), 30);
                const float b0 = brow[i0], b1 = brow[i1];
                p0[r] = ((unsigned)(kc - cs) < 16u) ? p0[r] + b0 : -1e30f;
                p1[r] = ((unsigned)(kc2 - cs) < 16u) ? p1[r] + b1 : -1e30f;
            }
            float alpha; bf16x8 pa0, pa1, pa2, pa3;
            softmax_tile(p0, p1, m_reg, l_reg, alpha, pa0, pa1, pa2, pa3);
            ATT_RESC(alpha);
            pv_all(o, vb0 + b * SHM_V, pa0, pa1, pa2, pa3);
        }
        asm volatile("s_waitcnt vmcnt(0)" ::: "memory");
        __syncthreads();
    }
#undef NDMA
    if (hi == 0) li_l[r32] = l_reg;
    asm volatile("s_waitcnt lgkmcnt(0)" ::: "memory");
    bf16_t* stg = (bf16_t*)(lds + OFF_STG) + wid * 4096;
#pragma unroll
    for (int r = 0; r < 16; ++r) { const float rl = __builtin_amdgcn_rcpf(li_l[crow(r, hi)]);
#pragma unroll
        for (int d = 0; d < 4; ++d) stg[crow(r, hi) * 128 + d * 32 + r32] = (bf16_t)f2bf(o[d][r] * rl); }
    asm volatile("s_waitcnt lgkmcnt(0)" ::: "memory");
    bf16_t* gp = mix + (size_t)(rowbase + rq * 64 + 32 * (wid & 1) + (lane >> 4)) * DM + h * 128 + (lane & 15) * 8;
#pragma unroll
    for (int i = 0; i < 8; ++i) { const u32x4 v = *(const u32x4*)(stg + (i * 4 + (lane >> 4)) * 128 + (lane & 15) * 8); *(u32x4*)gp = v; gp += 4 * DM; }
    __syncthreads();
}
#undef SBAR
}

template <int MODE> __device__ __forceinline__ int dest_row(int n) {
    if (MODE == 1) { if (n < 3072 || n >= 5120) return n; const int d = n & 63, blk = n & ~63, nn = d >> 5, dd = d & 31; return blk + 32 * (dd >> 4) + 8 * ((dd >> 2) & 3) + 4 * nn + (dd & 3); }
    if (MODE == 2) { if (n < DFF) return 256 * (n >> 7) + (n & 127); const int n2 = n - DFF; return 256 * (n2 >> 7) + 128 + (n2 & 127); }
    return n;
}
template <int MODE> __device__ __forceinline__ void p0_transpose_item(const float* __restrict__ W, int K, int N, bf16_t* __restrict__ WT, const float* __restrict__ gain, LAS float* scr, int item, int lane) {
    const int nblk = N / 32, kb = item / nblk, nb = item % nblk, k0 = 64 * kb, n0 = 32 * nb;
#pragma unroll 8
    for (int i = 0; i < 32; ++i) { const int kk = 2 * i + (lane >> 5); const float g = gain ? gain[k0 + kk] : 1.0f; scr[kk * 33 + (lane & 31)] = W[(size_t)(k0 + kk) * N + n0 + (lane & 31)] * g; }
    asm volatile("s_waitcnt lgkmcnt(0)" ::: "memory");
    const int c = lane & 7;
#pragma unroll
    for (int j = 0; j < 4; ++j) { const int n = (lane >> 3) + 8 * j; const LAS float* s = scr + (8 * c) * 33 + n;
        u32x4 o; o.x = pk2(s[0 * 33], s[1 * 33]); o.y = pk2(s[2 * 33], s[3 * 33]); o.z = pk2(s[4 * 33], s[5 * 33]); o.w = pk2(s[6 * 33], s[7 * 33]);
        *(u32x4*)(WT + (size_t)dest_row<MODE>(n0 + n) * K + k0 + 8 * c) = o; }
    asm volatile("s_waitcnt lgkmcnt(0)" ::: "memory");
}
__device__ __forceinline__ float row_ssq(const float* xrow, int lane, f32x4 (&v)[8]) {
    const f32x4* xr = (const f32x4*)xrow + lane; float s = 0.f;
#pragma unroll
    for (int j = 0; j < 8; ++j) { v[j] = xr[64 * j]; s += (v[j][0] * v[j][0] + v[j][1] * v[j][1]) + (v[j][2] * v[j][2] + v[j][3] * v[j][3]); }
    return wave_sum(s);
}
__device__ __forceinline__ void sincos_d(double x, double& sn, double& cs) {
    const double k = __builtin_rint(x * 0.6366197723675814); const double r0 = __builtin_fma(-k, 1.5707963267948966, x); const double r = __builtin_fma(-k, 6.123233995736766e-17, r0);
    const double r2 = r * r;
    double s = -1.0 / 1307674368000.0; s = s * r2 + 1.0 / 6227020800.0; s = s * r2 - 1.0 / 39916800.0; s = s * r2 + 1.0 / 362880.0; s = s * r2 - 1.0 / 5040.0; s = s * r2 + 1.0 / 120.0; s = s * r2 - 1.0 / 6.0; s = s * r2 * r + r;
    double c = 1.0 / 20922789888000.0; c = c * r2 - 1.0 / 87178291200.0; c = c * r2 + 1.0 / 479001600.0; c = c * r2 - 1.0 / 3628800.0; c = c * r2 + 1.0 / 40320.0; c = c * r2 - 1.0 / 720.0; c = c * r2 + 1.0 / 24.0; c = c * r2 - 0.5; c = c * r2 + 1.0;
    const int q = ((int)k) & 3;
    sn = (q == 0) ? s : (q == 1) ? c : (q == 2) ? -s : -c;
    cs = (q == 0) ? c : (q == 1) ? -s : (q == 2) ? -c : s;
}

struct Args { const float* in[22]; float* out; unsigned char* ws; int ph_lo, ph_hi; };
constexpr int NPHASE = 10;

__global__ void __launch_bounds__(NTHREADS, 2) fwd_kernel(Args a) {
    extern __shared__ __attribute__((aligned(16))) unsigned char lds[];
    LAS unsigned char* ldsl = (LAS unsigned char*)lds;
    const int widk = __builtin_amdgcn_readfirstlane((int)(threadIdx.x >> 6));
    const int G = gridDim.x, bx = blockIdx.x, vcu = (G % 8 == 0) ? (bx % 8) * (G / 8) + bx / 8 : bx;
#define x_p (ap->in[0])
#define x_s (ap->in[1])
#define mem_p (ap->in[2])
#define mem_s (ap->in[3])
#define g_mix (ap->in[4])
#define w_in (ap->in[5])
#define rpb (ap->in[6])
#define lam_q1 (ap->in[7])
#define lam_k1 (ap->in[8])
#define lam_q2 (ap->in[9])
#define lam_k2 (ap->in[10])
#define g_subln (ap->in[11])
#define w_out (ap->in[12])
#define g_xattn (ap->in[13])
#define g_mem (ap->in[14])
#define w_mq (ap->in[15])
#define w_mkv (ap->in[16])
#define w_mo (ap->in[17])
#define g_ffn (ap->in[18])
#define w_gu (ap->in[19])
#define w_dn (ap->in[20])
#define g_final (ap->in[21])
#define out (ap->out)
#define WSP() const __attribute__((address_space(4))) Args* ap = (const __attribute__((address_space(4))) Args*)__builtin_amdgcn_kernarg_segment_ptr(); asm volatile("" : "+s"(ap)); unsigned char* ws = ap->ws
#define SS ((float*)(ws + WS_SS))
#define RS0 ((float*)(ws + WS_RS0))
#define ROPE ((f32x2*)(ws + WS_ROPE))
#define WIN ((bf16_t*)(ws + WS_WIN))
#define WOUT ((bf16_t*)(ws + WS_WOUT))
#define WMQ ((bf16_t*)(ws + WS_WMQ))
#define WMO ((bf16_t*)(ws + WS_WMO))
#define WMKV ((bf16_t*)(ws + WS_WMKV))
#define WGU ((bf16_t*)(ws + WS_WGU))
#define WDN ((bf16_t*)(ws + WS_WDN))
#define MN ((bf16_t*)(ws + WS_MN))
#define KB ((bf16_t*)(ws + WS_KB))
#define VB ((bf16_t*)(ws + WS_VB))
#define WQK ((bf16_t*)(ws + WS_WQK))
#define WVO ((bf16_t*)(ws + WS_WVO))
#define O1S ((float*)(ws + WS_O1))
#define XB ((bf16_t*)(ws + WS_XB))
#define PROJ ((bf16_t*)(ws + WS_BIG))
#define H1B ((bf16_t*)(ws + WS_H1B))
#define SB ((float*)(ws + WS_S))
#define PB ((bf16_t*)(ws + WS_P))
#define ACT ((bf16_t*)(ws + WS_ACT))
#define MIX XB
#define H2B XB
    const int lo = a.ph_lo, hi_ph = a.ph_hi;
    if (lo < 0) cg::this_grid().sync();
#ifdef ONLY_PHASE
#define IN(k) ((k) == ONLY_PHASE && lo <= (k) && (k) < hi_ph)
#else
#define IN(k) (lo <= (k) && (k) < hi_ph)
#endif
    int nbar = 0;
#define SEAM(k) do { if (IN(k) && IN((k) + 1)) { WSP(); ++nbar; grid_barrier((unsigned*)(ws + WS_BAR), (unsigned)nbar * (unsigned)G, tid_l(widk)); } } while (0)
    const int NGW = G * 8;
#define TIDS() const int tid = tid_l(widk), lane = tid & 63, wave = __builtin_amdgcn_readfirstlane(tid >> 6), gw = vcu * 8 + wave; (void)lane; (void)gw

    if (IN(0)) { WSP(); TIDS();
        LAS float* scr = (LAS float*)(ldsl + wave * 16384);
        constexpr int I0 = (DM / 64) * (INW / 32), I1 = (DM / 64) * (DM / 32), I2 = I1, I3 = (DM / 64) * (4096 / 32), I4 = (DM / 64) * (NGU / 32), I5 = (DFF / 64) * (DM / 32);
        constexpr int NIT = I0 + I1 + I2 + I3 + I4 + I5;
        for (int it = gw; it < NIT; it += NGW) {
            int r = it;
            if (r < I0) { p0_transpose_item<1>(w_in, DM, INW, WIN, g_mix, scr, r, lane); continue; } r -= I0;
            if (r < I1) { p0_transpose_item<0>(w_out, DM, DM, WOUT, nullptr, scr, r, lane); continue; } r -= I1;
            if (r < I2) { p0_transpose_item<0>(w_mo, DM, DM, WMO, nullptr, scr, r, lane); continue; } r -= I2;
            if (r < I3) { p0_transpose_item<0>(w_mkv, DM, 4096, WMKV, nullptr, scr, r, lane); continue; } r -= I3;
            if (r < I4) { p0_transpose_item<2>(w_gu, DM, NGU, WGU, g_ffn, scr, r, lane); continue; } r -= I4;
            p0_transpose_item<0>(w_dn, DFF, DM, WDN, nullptr, scr, r, lane);
        }
        for (int k = gw; k < DM; k += NGW) { const float g = g_xattn[k]; const f32x4* src = (const f32x4*)(w_mq + (size_t)k * DM) + lane; u32x2* dst = (u32x2*)(WMQ + (size_t)k * DM) + lane;
#pragma unroll
            for (int j = 0; j < 8; ++j) { const f32x4 v = src[64 * j] * g; u32x2 w; w.x = pk2(v[0], v[1]); w.y = pk2(v[2], v[3]); dst[64 * j] = w; } }
        for (int m = gw; m < MT; m += NGW) { const float* xr = m < NP ? x_p + (size_t)m * DM : x_s + (size_t)(m - NP) * DM; f32x4 v[8];
            const float s = row_ssq(xr, lane, v); if (lane == 0) RS0[m] = 1.0f / sqrtf(s * (1.0f / DM) + RMS_EPS);
            u32x2* dst = (u32x2*)(XB + (size_t)m * DM) + lane;
#pragma unroll
            for (int j = 0; j < 8; ++j) { u32x2 w; w.x = pk2(v[j][0], v[j][1]); w.y = pk2(v[j][2], v[j][3]); dst[64 * j] = w; } }
        for (int m = gw; m < NMEM; m += NGW) { const float* xr = m < 512 ? mem_p + (size_t)m * DM : mem_s + (size_t)(m - 512) * DM; f32x4 v[8];
            const float s = row_ssq(xr, lane, v); const float rr = 1.0f / sqrtf(s * (1.0f / DM) + RMS_EPS);
            u32x2* dst = (u32x2*)(MN + (size_t)m * DM) + lane; const f32x4* gp = (const f32x4*)g_mem + lane;
#pragma unroll
            for (int j = 0; j < 8; ++j) { const f32x4 g = gp[64 * j]; u32x2 w; w.x = pk2(v[j][0] * rr * g[0], v[j][1] * rr * g[1]); w.y = pk2(v[j][2] * rr * g[2], v[j][3] * rr * g[3]); dst[64 * j] = w; } }
        for (int e = vcu * NTHREADS + tid; e < TP * 32; e += G * NTHREADS) { const int t = e >> 5, dd = e & 31;
            double pw = 1.0; for (int i = 0; i < dd; ++i) pw *= 1.333521432163324;
            const float inv = 1.0f / (float)pw; const float ang = (float)t * inv; double sn, cs; sincos_d((double)ang, sn, cs);
            ROPE[e] = (f32x2){(float)cs, (float)sn}; }
    }
    SEAM(0);

    if (IN(1)) { WSP();
        pg8::Sched S{(const char*)XB, (const char*)WIN, (const char*)MN, (const char*)WMKV, MT / 256, INW / 256, (MT / 256) * (INW / 256), NMEM / 256, (NMEM / 256) * 16,
                     (size_t)256 * DM * 2, (size_t)256 * DM * 2, 0, G, bx};
        pg8::EpiInProj E{PROJ, KB, VB, RS0, ROPE};
        pg8::gemm_phase<pg8::EpiInProj, pg8::Sched, true, true>(ldsl, widk, DM, DM, S, E);
    }
    SEAM(1);

    if (IN(2)) { WSP(); TIDS();
#if !defined(P2_PART) || P2_PART == 1
        { pg8::PreSched S{(const char*)KB, (const char*)VB, (const char*)WMQ, (const char*)WMO, G, bx}; pg8::EpiPre E{WQK, WVO};
          pg8::gemm_phase<pg8::EpiPre, pg8::PreSched, true, true>(ldsl, widk, 512, DM, S, E); }
#endif
        __syncthreads();
#if !defined(P2_PART) || P2_PART == 2
        for (int id = vcu; id < 1024 + 512; id += G) {
            const bool pr = id < 1024; const int i2 = pr ? id : id - 1024;
            const int rg = pr ? (i2 & 63) : (i2 & 15), h = pr ? ((i2 >> 6) & 7) : ((i2 >> 4) & 7), b = pr ? (i2 >> 9) : (i2 >> 7);
            att::na_unit(PROJ, MIX, rpb, pr ? b * TP : NP + b * TS, pr ? TP / 64 : TS / 64, h, rg, (char*)lds, widk);
        }
#endif
#if !defined(P2_PART) || P2_PART == 3
        float lam;
        { const float a1 = wave_sum(lam_q1[lane] * lam_k1[lane]), a2 = wave_sum(lam_q2[lane] * lam_k2[lane]); lam = __expf(a1) - __expf(a2) + LAM_INIT; lam = __builtin_bit_cast(float, __builtin_amdgcn_readfirstlane(__builtin_bit_cast(int, lam))); }
        float* o1s = O1S + (size_t)bx * 64 * NTHREADS;
#ifndef DIFF_REPS
#define DIFF_REPS 1
#endif
        for (int rep = 0; rep < DIFF_REPS; ++rep)
        for (int id = vcu; id < 1024 + 512; id += G) {
            const bool pr = id < 1024; const int i2 = pr ? id : id - 1024;
            const int qb = pr ? (i2 & 63) : (i2 & 15), bh = pr ? (i2 >> 6) : (i2 >> 4);
            att::diff_unit(PROJ, MIX, o1s, g_subln, lam, pr ? (bh >> 3) * TP : NP + (bh >> 3) * TS, pr ? TP : TS, bh & 7, qb, (char*)lds, widk);
        }
#endif
    }
    SEAM(2);

    if (IN(3)) { WSP();
        pg8::Sched S{(const char*)MIX, (const char*)WOUT, nullptr, nullptr, MT / 256, DM / 256, (MT / 256) * (DM / 256), 1, 0, (size_t)256 * DM * 2, (size_t)256 * DM * 2, 0, G, bx};
        pg8::EpiX E{x_p, x_s, H1B, SS};
        pg8::gemm_phase<pg8::EpiX, pg8::Sched, true, true>(ldsl, widk, DM, DM, S, E);
    }
    SEAM(3);

    if (IN(4)) { WSP();
        pg8::Sched S{(const char*)H1B, (const char*)WQK, nullptr, nullptr, MT / 256, NSW / 256, (MT / 256) * (NSW / 256), 1, 0, (size_t)256 * DM * 2, (size_t)256 * DM * 2, (size_t)NSW * DM * 2, G, bx};
        pg8::EpiSm E{PB, SS, ldsl + pg8::STAGE_BYTES};
        pg8::gemm_phase<pg8::EpiSm, pg8::Sched, true, true>(ldsl, widk, DM, DM, S, E);
    }
    SEAM(4);


    if (IN(6)) { WSP();
        pg8::Sched S{(const char*)PB, (const char*)WVO, nullptr, nullptr, MT / 256, DM / 256, (MT / 256) * (DM / 256), 1, 0, (size_t)256 * NSW * 2, (size_t)256 * NSW * 2, (size_t)DM * NSW * 2, G, bx};
        pg8::EpiResid E{nullptr, H1B, H2B, DM, SS};
        pg8::gemm_phase<pg8::EpiResid, pg8::Sched, true, true>(ldsl, widk, NSW, NSW, S, E);
    }
    SEAM(6);

    if (IN(7)) { WSP();
        pg8::Sched S{(const char*)H2B, (const char*)WGU, nullptr, nullptr, MT / 256, NGU / 256, (MT / 256) * (NGU / 256), 1, 0, (size_t)256 * DM * 2, (size_t)256 * DM * 2, 0, G, bx};
        pg8::EpiGU E{ACT, SS};
        pg8::gemm_phase<pg8::EpiGU, pg8::Sched, true, true>(ldsl, widk, DM, DM, S, E);
    }
    SEAM(7);

    if (IN(8)) { WSP();
        pg8::Sched S{(const char*)ACT, (const char*)WDN, nullptr, nullptr, MT / 256, DM / 256, (MT / 256) * (DM / 256), 1, 0, (size_t)256 * DFF * 2, (size_t)256 * DFF * 2, 0, G, bx};
        pg8::EpiResid E{nullptr, H2B, (bf16_t*)out + DM, 2 * DM, SS};
        pg8::gemm_phase<pg8::EpiResid, pg8::Sched, true, true>(ldsl, widk, DFF, DFF, S, E);
    }
    SEAM(8);

    if (IN(9)) { WSP(); TIDS();
        for (int m = gw; m < MT; m += NGW) {
            float sq = lane < 32 ? SS[(size_t)m * 32 + lane] : 0.f; sq = wave_sum(sq); const float rr = __builtin_amdgcn_rsqf(sq * (1.0f / DM) + RMS_EPS);
            const u32x2* hp = (const u32x2*)((const bf16_t*)out + (size_t)m * (2 * DM) + DM) + lane;
            u32x2 hv[8];
#pragma unroll
            for (int j = 0; j < 8; ++j) hv[j] = hp[64 * j];
            asm volatile("s_waitcnt vmcnt(0)" ::: "memory");
            f32x4* op = (f32x4*)(out + (size_t)m * DM) + lane; const f32x4* gp = (const f32x4*)g_final + lane;
#pragma unroll
            for (int j = 0; j < 8; ++j) { const f32x4 g = gp[64 * j];
                const f32x4 v = (f32x4){__uint_as_float(hv[j].x << 16), __uint_as_float(hv[j].x & 0xffff0000u), __uint_as_float(hv[j].y << 16), __uint_as_float(hv[j].y & 0xffff0000u)};
                op[64 * j] = v * rr * g; }
        }
    }
#undef IN
#undef SEAM
#undef TIDS
}
#undef x_p
#undef x_s
#undef mem_p
#undef mem_s
#undef g_mix
#undef w_in
#undef rpb
#undef lam_q1
#undef lam_k1
#undef lam_q2
#undef lam_k2
#undef g_subln
#undef w_out
#undef g_xattn
#undef g_mem
#undef w_mq
#undef w_mkv
#undef w_mo
#undef g_ffn
#undef w_gu
#undef w_dn
#undef g_final
#undef out
#undef WSP
#undef SS
#undef RS0
#undef ROPE
#undef WIN
#undef WOUT
#undef WMQ
#undef WMO
#undef WMKV
#undef WGU
#undef WDN
#undef MN
#undef KB
#undef VB
#undef WQK
#undef WVO
#undef O1S
#undef XB
#undef PROJ
#undef H1B
#undef SB
#undef PB
#undef ACT
#undef MIX
#undef H2B


extern "C" void kernel_launch(void* const* d_in, const int* in_sizes, int n_in, void* d_out, int out_size, void* d_ws, size_t ws_size, hipStream_t stream) {
    static int grid = 0;
    if (grid == 0) {
        if (n_in != 22 || out_size != MT * DM || ws_size < WS_END) { fprintf(stderr, "kernel_launch: unexpected shapes (n_in %d, out %d, ws %zu); nothing launched\n", n_in, out_size, ws_size); grid = -1; return; }
        int dev = 0, cus = 0, per_cu = 0;
        (void)hipGetDevice(&dev); (void)hipDeviceGetAttribute(&cus, hipDeviceAttributeMultiprocessorCount, dev);
        if (hipFuncSetAttribute((const void*)fwd_kernel, hipFuncAttributeMaxDynamicSharedMemorySize, LDS_BYTES) != hipSuccess) { fprintf(stderr, "kernel_launch: hipFuncSetAttribute failed\n"); grid = -1; return; }
        if (hipOccupancyMaxActiveBlocksPerMultiprocessor(&per_cu, (const void*)fwd_kernel, NTHREADS, LDS_BYTES) != hipSuccess || per_cu < 1) per_cu = 1;
        (void)hipGetLastError();
        grid = cus * per_cu;
    }
    if (grid < 0) return;
    Args a{};
    for (int i = 0; i < 22; ++i) a.in[i] = (const float*)d_in[i];
    a.out = (float*)d_out; a.ws = (unsigned char*)d_ws;
#if MK_MULTI
    for (int p = 0; p < NPHASE; ++p) { a.ph_lo = p; a.ph_hi = p + 1; hipLaunchKernelGGL(fwd_kernel, dim3(grid), dim3(NTHREADS), LDS_BYTES, stream, a); }
#else
    a.ph_lo = 0; a.ph_hi = NPHASE;
    (void)hipMemsetAsync((char*)d_ws + WS_BAR, 0, 256, stream);
    void* args[] = {&a};
    hipError_t e = hipLaunchCooperativeKernel((const void*)fwd_kernel, dim3(grid), dim3(NTHREADS), args, LDS_BYTES, stream);
    if (e != hipSuccess) fprintf(stderr, "cooperative launch failed: %s (grid %d)\n", hipGetErrorString(e), grid);
#endif
}
```

```cpp
#include <hip/hip_runtime.h>
#include <hip/hip_cooperative_groups.h>
#include <cstdio>
#include <cstdint>
namespace cg = cooperative_groups;

#ifndef MK_MULTI
#define MK_MULTI 0
#endif

#define LAS __attribute__((address_space(3)))
typedef unsigned short bf16_t;
typedef short bf16x8 __attribute__((ext_vector_type(8)));
typedef short s16x4 __attribute__((ext_vector_type(4)));
typedef float f32x2 __attribute__((ext_vector_type(2)));
typedef float f32x4 __attribute__((ext_vector_type(4)));
typedef float f32x16 __attribute__((ext_vector_type(16)));
typedef unsigned u32x2 __attribute__((ext_vector_type(2)));
typedef unsigned u32x4 __attribute__((ext_vector_type(4)));

constexpr int DM = 2048, TP = 16384, TS = 4096, NP = 2 * TP, NS = 4 * TS, MT = NP + NS;
constexpr int INW = 6144, DFF = 5632, NGU = 2 * DFF, MEMT = 256, NMEM = 6 * MEMT, NSW = 1024;
constexpr float RMS_EPS = 1e-6f, SUBLN_EPS = 1e-5f, LOG2E = 1.4426950408889634f;
constexpr float NA_QS = 0.08838834764831845f * LOG2E, DF_QS = 0.125f * LOG2E, MEM_QS = 0.04419417382415922f * LOG2E;
constexpr float LAM_INIT = 0.2f;

constexpr size_t MiB = 1u << 20;
constexpr size_t WS_SS = 0, WS_RS0 = 6 * MiB, WS_ROPE = 7 * MiB, WS_WIN = 11 * MiB, WS_WOUT = 35 * MiB, WS_WMQ = 43 * MiB, WS_WMO = 51 * MiB,
                 WS_WMKV = 59 * MiB, WS_WGU = 75 * MiB, WS_WDN = 119 * MiB, WS_MN = 141 * MiB, WS_KB = 147 * MiB, WS_VB = 153 * MiB,
                 WS_WQK = 159 * MiB, WS_WVO = 183 * MiB, WS_O1 = 207 * MiB, WS_XB = 239 * MiB, WS_BIG = 431 * MiB, WS_END = 1007 * MiB;
constexpr size_t WS_BAR = 6 * MiB + 512 * 1024;
constexpr size_t WS_H1B = WS_BIG, WS_S = WS_BIG + 192 * MiB, WS_P = WS_BIG + 384 * MiB, WS_ACT = WS_BIG;

constexpr int LDS_BYTES = 147456, NTHREADS = 512;

__device__ __forceinline__ unsigned cvt_pk_bf16(float lo, float hi) { unsigned r; asm volatile("v_cvt_pk_bf16_f32 %0, %1, %2" : "=v"(r) : "v"(lo), "v"(hi)); return r; }
__device__ __forceinline__ unsigned f2bf(float f) { unsigned u = __builtin_bit_cast(unsigned, f); return (u + 0x7fffu + ((u >> 16) & 1u)) >> 16; }
__device__ __forceinline__ unsigned pk2(float lo, float hi) { return f2bf(lo) | (f2bf(hi) << 16); }
__device__ __forceinline__ float wave_sum(float v) {
#pragma unroll
    for (int o = 1; o < 64; o <<= 1) v += __shfl_xor(v, o);
    return v;
}
__device__ __forceinline__ float wave_max(float v) {
#pragma unroll
    for (int o = 1; o < 64; o <<= 1) v = fmaxf(v, __shfl_xor(v, o));
    return v;
}
__device__ __forceinline__ int tid_l(int widk) { int t; asm volatile("v_mbcnt_lo_u32_b32 %0, -1, 0\n\tv_mbcnt_hi_u32_b32 %0, -1, %0\n\tv_or_b32 %0, %1, %0" : "=&v"(t) : "s"(widk << 6)); return t; }
__device__ __forceinline__ void grid_barrier(unsigned* ctr, unsigned target, int tid) {
    asm volatile("s_waitcnt vmcnt(0) lgkmcnt(0)" ::: "memory");
    __syncthreads();
    if (tid == 0) {
        __builtin_amdgcn_fence(__ATOMIC_RELEASE, "agent");
        asm volatile("s_waitcnt vmcnt(0)" ::: "memory");
        (void)__hip_atomic_fetch_add(ctr, 1u, __ATOMIC_RELAXED, __HIP_MEMORY_SCOPE_AGENT);
        unsigned spins = 0;
        while (__hip_atomic_load(ctr, __ATOMIC_RELAXED, __HIP_MEMORY_SCOPE_AGENT) < target && ++spins < (1u << 22)) __builtin_amdgcn_s_sleep(2);
        __builtin_amdgcn_fence(__ATOMIC_ACQUIRE, "agent");
        asm volatile("s_waitcnt vmcnt(0)" ::: "memory");
    }
    __syncthreads();
}
#define XB_TMO      128
#define XB_XCNT(j)  (256  + 64 * (j))
#define XB_XSUB(j)  (1280 + 64 * (j))
#define XB_XGEN(j)  (2304 + 64 * (j))
#define XB_TOP      3328
#define XB_TOPGEN   3392
#define XCD_BAR_WORDS 3456
#define XB_SPIN_CAP (1u << 20)
__device__ __forceinline__ unsigned xb_ld(unsigned* p)              { return __hip_atomic_load(p, __ATOMIC_RELAXED, __HIP_MEMORY_SCOPE_AGENT); }
__device__ __forceinline__ unsigned xb_add(unsigned* p, unsigned v) { return __hip_atomic_fetch_add(p, v, __ATOMIC_RELAXED, __HIP_MEMORY_SCOPE_AGENT); }
__device__ __forceinline__ unsigned xb_xcc_id() { return (unsigned)__builtin_amdgcn_s_getreg((3 << 11) | 20) & 0xFu; }
#define XB_SPIN(cond, bar) do { unsigned _sp = 0; while (cond) { __builtin_amdgcn_s_sleep(1); \
    if ((++_sp & 255u) == 0u) { if (xb_ld(&(bar)[XB_TMO])) break; if (_sp > XB_SPIN_CAP) { (void)xb_add(&(bar)[XB_TMO], 1u); break; } } } } while (0)
__device__ __forceinline__ void xcd_barrier_complete(unsigned* bar, unsigned x, unsigned G, unsigned& nloc, unsigned& nx) {
    unsigned sum, cnt, mine, sp = 0u;
    for (;;) {
        sum = 0u; cnt = 0u; mine = 0u;
#pragma unroll
        for (unsigned j = 0; j < 16; ++j) { const unsigned c = xb_ld(&bar[XB_XCNT(j)]); sum += c; cnt += (c > 0u) ? 1u : 0u; mine = (j == x) ? c : mine; }
        if (sum == G) break;
        __builtin_amdgcn_s_sleep(1);
        if ((++sp & 255u) == 0u) { if (xb_ld(&bar[XB_TMO])) break; if (sp > XB_SPIN_CAP) { (void)xb_add(&bar[XB_TMO], 1u); break; } }
    }
    nloc = mine > 0u ? mine : 1u; nx = cnt > 0u ? cnt : 1u;
}
__device__ __forceinline__ void xcd_barrier(unsigned* bar, unsigned x, unsigned G, volatile LAS unsigned* st, int tid) {
    asm volatile("s_waitcnt vmcnt(0) lgkmcnt(0)" ::: "memory");
    __syncthreads();
    if (tid == 0) {
        unsigned nloc = st[0], nx = st[1];
        if (nloc == 0u) { xcd_barrier_complete(bar, x, G, nloc, nx); st[0] = nloc; st[1] = nx; }
        const unsigned old = xb_add(&bar[XB_XSUB(x)], 1u);
        const unsigned gen = old / nloc;
        if (old + 1u == (gen + 1u) * nloc) {
            __builtin_amdgcn_fence(__ATOMIC_RELEASE, "agent");
            asm volatile("s_waitcnt vmcnt(0)" ::: "memory");
            const unsigned og = xb_add(&bar[XB_TOP], 1u);
            const unsigned tg = og / nx;
            if (og + 1u == (tg + 1u) * nx) (void)xb_add(&bar[XB_TOPGEN], 1u);
            else XB_SPIN(xb_ld(&bar[XB_TOPGEN]) == tg, bar);
            __builtin_amdgcn_fence(__ATOMIC_ACQUIRE, "agent");
            (void)xb_add(&bar[XB_XGEN(x)], 1u);
            asm volatile("s_waitcnt vmcnt(0)" ::: "memory");
        } else {
            XB_SPIN(xb_ld(&bar[XB_XGEN(x)]) == gen, bar);
            __builtin_amdgcn_fence(__ATOMIC_ACQUIRE, "agent");
            asm volatile("s_waitcnt vmcnt(0)" ::: "memory");
        }
    }
    __syncthreads();
}
__device__ __forceinline__ int batch_of_pm(int pm) { return pm < 128 ? (pm >> 6) : 2 + ((pm - 128) >> 4); }

namespace pg8 {
constexpr int BM = 256, BK = 64, HALF = 128, HTB = HALF * BK * 2, STAGE_BYTES = 8 * HTB, NXCD = 8, WGM = 4;
__host__ __device__ __forceinline__ int lds_byte(int r, int c) { const int st = (r >> 4) * 2 + (c >> 5), rr = r & 15, cc = c & 31, ob = rr * 64 + cc * 2; return st * 1024 + (ob ^ (((ob >> 9) & 1) << 5)); }
__host__ __device__ __forceinline__ void stage_rc(int b, int& R, int& C) { const int st = b / 1024, sb = b % 1024, swz = sb ^ (((sb >> 9) & 1) << 5); R = (st >> 1) * 16 + swz / 64; C = (st & 1) * 32 + (swz % 64) / 2; }
__host__ __device__ __forceinline__ int perm32(int rho) { const int n = rho >> 4, i = rho & 15; return 8 * (i >> 2) + 4 * n + (i & 3); }

struct Unit { int pm, pn, z; };

__device__ __forceinline__ void tile_decode(int wgid, int nM, int nN, int& pm, int& pn) {
    const int nwg = nM * nN;
    { const int q = nwg / NXCD, r = nwg % NXCD, xcd = wgid % NXCD, off = wgid / NXCD; wgid = (xcd < r ? xcd * (q + 1) : r * (q + 1) + (xcd - r) * q) + off; }
    const int nig = WGM * nN, gid = wgid / nig, fm = gid * WGM, gsz = (nM - fm) < WGM ? (nM - fm) : WGM;
    pm = fm + ((wgid % nig) % gsz); pn = (wgid % nig) / gsz;
}
struct Sched {
    const char *A0, *B0, *A1, *B1; int nM0, nN0, n0, nM1, n1; size_t tA, tB, bstride; int G, c;
    __device__ __forceinline__ bool next(int i, Unit& u) const {
        int L = i * G + c;
        if (L < n0) { tile_decode(L, nM0, nN0, u.pm, u.pn); u.z = 0; return true; }
        L -= n0; if (L < n1) { u.pm = L % nM1; u.pn = L / nM1; u.z = 1; return true; }
        return false;
    }
    __device__ __forceinline__ const char* abase(const Unit& u) const { return (u.z ? A1 : A0) + (size_t)u.pm * tA; }
    __device__ __forceinline__ const char* bbase(const Unit& u) const { return (u.z ? B1 : B0) + (size_t)u.pn * tB + (bstride ? (size_t)batch_of_pm(u.pm) * bstride : (size_t)0); }
};
struct PreSched {
    const char *Kb, *Vb, *Wmq, *Wmo; int G, c;
    __device__ __forceinline__ bool next(int i, Unit& u) const { const int L = i * G + c; if (L >= 384) return false; u.z = L / 8; const int t = L & 7; if (u.z < 24) { u.pm = 0; u.pn = t; } else { u.pm = t; u.pn = 0; } return true; }
    __device__ __forceinline__ const char* abase(const Unit& u) const { const int zz = u.z % 24, b = zz >> 2, h = zz & 3;
        return u.z < 24 ? Kb + ((size_t)(b * 256) * DM + h * 512) * 2 : Wmo + ((size_t)(u.pm * 256) * DM + h * 512) * 2; }
    __device__ __forceinline__ const char* bbase(const Unit& u) const { const int zz = u.z % 24, b = zz >> 2, h = zz & 3;
        return u.z < 24 ? Wmq + ((size_t)(u.pn * 256) * DM + h * 512) * 2 : Vb + ((size_t)(b * 256) * DM + h * 512) * 2; }
};

template <class Epi, class SchedT, bool ALIGN_EPI, bool SP2>
__device__ __forceinline__ void gemm_phase(LAS unsigned char* lds, const int widk, const int K, const int ld, const SchedT& S, const Epi& E) {
    const int tid = tid_l(widk), wid = __builtin_amdgcn_readfirstlane(tid >> 6), lane = tid & 63, wr = wid >> 2, wc = wid & 3, fr = lane & 15, fq = lane >> 4;
    const int nt = K / BK;
    unsigned voffA[2], voffB[2];
#pragma unroll
    for (int i = 0; i < 2; ++i) { int R, C; stage_rc(tid * 16 + i * 8192, R, C); const int Rb = Epi::PERM ? ((R & ~31) + perm32(R & 31)) : R;
        voffA[i] = (unsigned)(R * ld + C) * 2u; voffB[i] = (unsigned)(Rb * ld + C) * 2u; }
    const size_t kstep = (size_t)(BK * 2);
    const size_t hstep = (size_t)HALF * ld * 2;
    const unsigned ldsw = (unsigned)wid * 1024u;
    const int aoff = lds_byte(wr * 64 + fr, fq * 8), boff = lds_byte(wc * 32 + fr, fq * 8);
#define PG8_SA(b, h) (((b) * 2 + (h)) * HTB)
#define PG8_SB(b, h) ((4 + (b) * 2 + (h)) * HTB)
#define PG8_STAGE(bufoff, gbase, voff) do { _Pragma("unroll") for (int _i = 0; _i < 2; ++_i) \
        __builtin_amdgcn_global_load_lds((const unsigned*)((const char*)(gbase) + (voff)[_i]), (LAS unsigned*)(lds + (bufoff) + ldsw + _i * 8192), 16, 0, 0); } while (0)
#define PG8_LDA(dst, b, h) do { _Pragma("unroll") for (int m = 0; m < 4; ++m) _Pragma("unroll") for (int k = 0; k < 2; ++k) dst[m][k] = *(const LAS bf16x8*)(lds + PG8_SA(b, h) + aoff + m * 2048 + k * 1024); } while (0)
#define PG8_LDB(dst, b, h) do { _Pragma("unroll") for (int n = 0; n < 2; ++n) _Pragma("unroll") for (int k = 0; k < 2; ++k) dst[n][k] = *(const LAS bf16x8*)(lds + PG8_SB(b, h) + boff + n * 2048 + k * 1024); } while (0)
#define PG8_MMA(ai, bj, At, Bt) do { __builtin_amdgcn_s_setprio(1); _Pragma("unroll") for (int m = 0; m < 4; ++m) _Pragma("unroll") for (int n = 0; n < 2; ++n) _Pragma("unroll") for (int k = 0; k < 2; ++k) \
        acc[ai][bj][m][n] = __builtin_amdgcn_mfma_f32_16x16x32_bf16(Bt[n][k], At[m][k], acc[ai][bj][m][n], 0, 0, 0); __builtin_amdgcn_s_setprio(0); } while (0)
#define PG8_WAIT_V(n) asm volatile("s_waitcnt vmcnt(" #n ")" ::: "memory")
#define PG8_WAIT_L(n) asm volatile("s_waitcnt lgkmcnt(" #n ")" ::: "memory")
#define PG8_BAR __builtin_amdgcn_s_barrier()
#define PG8_SCHED __builtin_amdgcn_sched_barrier(0)
    Unit cur, nxt; int ui = 0;
    if (!S.next(0, cur)) return;
    f32x4 acc[2][2][4][2];
#pragma unroll
    for (int a = 0; a < 2; ++a)
#pragma unroll
        for (int b = 0; b < 2; ++b)
#pragma unroll
            for (int m = 0; m < 4; ++m)
#pragma unroll
                for (int n = 0; n < 2; ++n) acc[a][b][m][n] = (f32x4){0.f, 0.f, 0.f, 0.f};
    bf16x8 At[4][2], B0[2][2], B1[2][2];
    const char* cA = S.abase(cur); const char* cB = S.bbase(cur);
    if constexpr (SP2) {
        PG8_STAGE(PG8_SB(0, 0), cB, voffB); PG8_STAGE(PG8_SB(0, 1), cB + hstep, voffB); PG8_STAGE(PG8_SA(0, 0), cA, voffA); PG8_STAGE(PG8_SA(0, 1), cA + hstep, voffA);
        if (wr == 1) PG8_BAR;
        PG8_WAIT_V(2); PG8_BAR;
        PG8_STAGE(PG8_SB(1, 0), cB + kstep, voffB); PG8_STAGE(PG8_SA(1, 0), cA + kstep, voffA); PG8_STAGE(PG8_SB(1, 1), cB + hstep + kstep, voffB);
        PG8_WAIT_V(6); PG8_BAR;
    } else {
        PG8_STAGE(PG8_SB(0, 0), cB, voffB); PG8_STAGE(PG8_SA(0, 0), cA, voffA); PG8_STAGE(PG8_SB(0, 1), cB + hstep, voffB); PG8_STAGE(PG8_SA(0, 1), cA + hstep, voffA);
        if (wr == 1) PG8_BAR;
        PG8_WAIT_V(4); PG8_BAR;
        PG8_STAGE(PG8_SB(1, 0), cB + kstep, voffB); PG8_STAGE(PG8_SA(1, 0), cA + kstep, voffA); PG8_STAGE(PG8_SB(1, 1), cB + hstep + kstep, voffB);
        PG8_WAIT_V(6); PG8_BAR;
    }
    for (;;) {
        const bool has_next = S.next(ui + 1, nxt);
        const char* nA = has_next ? S.abase(nxt) : cA; const char* nB = has_next ? S.bbase(nxt) : cB;
        for (int t = 0; t < nt; t += 2) {
            const bool last = (t == nt - 2);
            const char* a1 = cA + (size_t)(t + 1) * kstep;
            const char* a2 = last ? nA : cA + (size_t)(t + 2) * kstep; const char* b2 = last ? nB : cB + (size_t)(t + 2) * kstep;
            const char* a3 = a2 + kstep; const char* b3 = b2 + kstep;
            if constexpr (SP2) {
            PG8_LDB(B0, 0, 0); PG8_LDB(B1, 0, 1); PG8_SCHED; PG8_LDA(At, 0, 0); PG8_STAGE(PG8_SA(1, 1), a1 + hstep, voffA);
            PG8_WAIT_V(8); PG8_WAIT_L(0); PG8_BAR; PG8_MMA(0, 0, At, B0); PG8_MMA(0, 1, At, B1); PG8_BAR; PG8_SCHED;
            PG8_LDA(At, 0, 1); PG8_STAGE(PG8_SB(0, 0), b2, voffB); PG8_STAGE(PG8_SB(0, 1), b2 + hstep, voffB); PG8_STAGE(PG8_SA(0, 0), a2, voffA);
            PG8_WAIT_V(8); PG8_WAIT_L(0); PG8_BAR; PG8_MMA(1, 0, At, B0); PG8_MMA(1, 1, At, B1); PG8_BAR; PG8_SCHED;
            PG8_LDB(B0, 1, 0); PG8_LDB(B1, 1, 1); PG8_SCHED; PG8_LDA(At, 1, 0); PG8_STAGE(PG8_SA(0, 1), a2 + hstep, voffA);
            PG8_WAIT_V(8); PG8_WAIT_L(0); PG8_BAR; PG8_MMA(0, 0, At, B0); PG8_MMA(0, 1, At, B1); PG8_BAR; PG8_SCHED;
            PG8_LDA(At, 1, 1); PG8_STAGE(PG8_SB(1, 0), b3, voffB); PG8_STAGE(PG8_SB(1, 1), b3 + hstep, voffB); PG8_STAGE(PG8_SA(1, 0), a3, voffA);
            PG8_WAIT_V(8); PG8_WAIT_L(0); PG8_BAR; PG8_MMA(1, 0, At, B0); PG8_MMA(1, 1, At, B1); PG8_BAR; PG8_SCHED;
            } else {
            PG8_LDB(B0, 0, 0); PG8_SCHED; PG8_LDA(At, 0, 0); PG8_STAGE(PG8_SA(1, 1), a1 + hstep, voffA);
            PG8_WAIT_L(8); PG8_BAR; PG8_WAIT_L(0); PG8_MMA(0, 0, At, B0); PG8_BAR; PG8_SCHED;
            PG8_LDB(B1, 0, 1); PG8_STAGE(PG8_SB(0, 0), b2, voffB);
            PG8_BAR; PG8_WAIT_L(0); PG8_MMA(0, 1, At, B1); PG8_BAR;
            PG8_LDA(At, 0, 1); PG8_STAGE(PG8_SA(0, 0), a2, voffA);
            PG8_BAR; PG8_WAIT_L(0); PG8_MMA(1, 0, At, B0); PG8_BAR; PG8_SCHED;
            PG8_STAGE(PG8_SB(0, 1), b2 + hstep, voffB);
            PG8_WAIT_V(6); PG8_BAR; PG8_MMA(1, 1, At, B1); PG8_BAR;
            PG8_LDB(B0, 1, 0); PG8_SCHED; PG8_LDA(At, 1, 0); PG8_STAGE(PG8_SA(0, 1), a2 + hstep, voffA);
            PG8_WAIT_L(8); PG8_BAR; PG8_WAIT_L(0); PG8_MMA(0, 0, At, B0); PG8_BAR; PG8_SCHED;
            PG8_LDB(B1, 1, 1); PG8_STAGE(PG8_SB(1, 0), b3, voffB);
            PG8_BAR; PG8_WAIT_L(0); PG8_MMA(0, 1, At, B1); PG8_BAR;
            PG8_LDA(At, 1, 1); PG8_STAGE(PG8_SA(1, 0), a3, voffA);
            PG8_BAR; PG8_WAIT_L(0); PG8_MMA(1, 0, At, B0); PG8_BAR; PG8_SCHED;
            PG8_STAGE(PG8_SB(1, 1), b3 + hstep, voffB);
            PG8_WAIT_V(6); PG8_BAR; PG8_MMA(1, 1, At, B1); PG8_BAR;
            }
        }
        if constexpr (ALIGN_EPI) { if (wr == 0) PG8_BAR; }
        E(acc, cur, wr, wc, fr, fq);
        if (!has_next) break;
#pragma unroll
        for (int a = 0; a < 2; ++a)
#pragma unroll
            for (int b = 0; b < 2; ++b)
#pragma unroll
                for (int m = 0; m < 4; ++m)
#pragma unroll
                    for (int n = 0; n < 2; ++n) acc[a][b][m][n] = (f32x4){0.f, 0.f, 0.f, 0.f};
        cur = nxt; cA = nA; cB = nB; ++ui;
        if constexpr (ALIGN_EPI) { if (wr == 1) PG8_BAR; }
    }
    PG8_WAIT_V(0);
    if constexpr (!ALIGN_EPI) { if (wr == 0) PG8_BAR; }
    PG8_BAR;
#undef PG8_SA
#undef PG8_SB
#undef PG8_STAGE
#undef PG8_LDA
#undef PG8_LDB
#undef PG8_MMA
#undef PG8_WAIT_V
#undef PG8_WAIT_L
#undef PG8_BAR
#undef PG8_SCHED
}

typedef const f32x4 (&AccRef)[2][2][4][2];

__device__ __forceinline__ float row_rs(const float* ss, int row) {
    const f32x4* p = (const f32x4*)(ss + (size_t)row * 32); float s = 0.f;
#pragma unroll
    for (int i = 0; i < 8; ++i) { const f32x4 v = p[i]; s += (v[0] + v[1]) + (v[2] + v[3]); }
    return __builtin_amdgcn_rsqf(s * (1.0f / DM) + RMS_EPS);
}

struct EpiInProj {
    static constexpr bool PERM = true;
    bf16_t* proj; bf16_t* kb; bf16_t* vb; const float* rs0; const f32x2* rope;
    __device__ __forceinline__ void operator()(AccRef acc, const Unit& u, int wr, int wc, int fr, int fq) const {
        const int row0 = u.pm * BM + wr * 64 + fr;
        if (u.z == 1) {
            bf16_t* base = (u.pn < 8 ? kb : vb) + (u.pn & 7) * BM + wc * 32 + 8 * fq;
#pragma unroll
            for (int ai = 0; ai < 2; ++ai)
#pragma unroll
                for (int m = 0; m < 4; ++m) { bf16_t* rowp = base + (size_t)(row0 + ai * HALF + m * 16) * DM;
#pragma unroll
                    for (int bj = 0; bj < 2; ++bj) { const f32x4 v0 = acc[ai][bj][m][0], v1 = acc[ai][bj][m][1]; u32x4 w;
                        w.x = cvt_pk_bf16(v0[0], v0[1]); w.y = cvt_pk_bf16(v0[2], v0[3]); w.z = cvt_pk_bf16(v1[0], v1[1]); w.w = cvt_pk_bf16(v1[2], v1[3]);
                        *(u32x4*)(rowp + bj * HALF) = w; } }
            return;
        }
        const int pn = u.pn; const bool rp = (pn >= 12 && pn < 20);
        const float sc = pn < 4 ? NA_QS : ((pn >= 12 && pn < 16) ? DF_QS : 1.0f);
        if (!rp) {
            bf16_t* base = proj + pn * BM + wc * 32 + 8 * fq;
#pragma unroll
            for (int ai = 0; ai < 2; ++ai)
#pragma unroll
                for (int m = 0; m < 4; ++m) { const int row = row0 + ai * HALF + m * 16; const float rr = rs0[row] * sc; bf16_t* rowp = base + (size_t)row * INW;
#pragma unroll
                    for (int bj = 0; bj < 2; ++bj) { const f32x4 v0 = acc[ai][bj][m][0] * rr, v1 = acc[ai][bj][m][1] * rr; u32x4 w;
                        w.x = cvt_pk_bf16(v0[0], v0[1]); w.y = cvt_pk_bf16(v0[2], v0[3]); w.z = cvt_pk_bf16(v1[0], v1[1]); w.w = cvt_pk_bf16(v1[2], v1[3]);
                        *(u32x4*)(rowp + bj * HALF) = w; } }
        } else {
            const int dd0 = 16 * (wc & 1) + 4 * fq;
            bf16_t* base = proj + pn * BM + (wc >> 1) * 64 + dd0;
#pragma unroll
            for (int ai = 0; ai < 2; ++ai)
#pragma unroll
                for (int m = 0; m < 4; ++m) { const int row = row0 + ai * HALF + m * 16; const float rr = rs0[row] * sc; bf16_t* rowp = base + (size_t)row * INW;
                    const int t = row < NP ? (row & (TP - 1)) : (row & (TS - 1));
                    const f32x4 cs0 = *(const f32x4*)(rope + (size_t)t * 32 + dd0), cs1 = *(const f32x4*)(rope + (size_t)t * 32 + dd0 + 2);
#pragma unroll
                    for (int bj = 0; bj < 2; ++bj) { const f32x4 x1 = acc[ai][bj][m][0] * rr, x2 = acc[ai][bj][m][1] * rr;
                        const float a0 = x1[0] * cs0[0] - x2[0] * cs0[1], a1 = x1[1] * cs0[2] - x2[1] * cs0[3], a2 = x1[2] * cs1[0] - x2[2] * cs1[1], a3 = x1[3] * cs1[2] - x2[3] * cs1[3];
                        const float b0 = x2[0] * cs0[0] + x1[0] * cs0[1], b1 = x2[1] * cs0[2] + x1[1] * cs0[3], b2 = x2[2] * cs1[0] + x1[2] * cs1[1], b3 = x2[3] * cs1[2] + x1[3] * cs1[3];
                        u32x2 wa, wb; wa.x = cvt_pk_bf16(a0, a1); wa.y = cvt_pk_bf16(a2, a3); wb.x = cvt_pk_bf16(b0, b1); wb.y = cvt_pk_bf16(b2, b3);
                        *(u32x2*)(rowp + bj * HALF) = wa; *(u32x2*)(rowp + bj * HALF + 32) = wb; } }
        }
    }
};
struct EpiPre {
    static constexpr bool PERM = true;
    bf16_t* wqk; bf16_t* wvo;
    __device__ __forceinline__ void operator()(AccRef acc, const Unit& u, int wr, int wc, int fr, int fq) const {
        const int zz = u.z % 24, b = zz >> 2, h = zz & 3; bf16_t* base; int ldc; float sc;
        if (u.z < 24) { base = wqk + ((size_t)(b * 1024 + h * 256)) * DM + u.pn * BM; ldc = DM; sc = MEM_QS; }
        else { base = wvo + ((size_t)(b * 2048 + u.pm * BM)) * NSW + h * 256; ldc = NSW; sc = 1.0f; }
        base += wc * 32 + 8 * fq;
#pragma unroll
        for (int ai = 0; ai < 2; ++ai)
#pragma unroll
            for (int m = 0; m < 4; ++m) { bf16_t* rowp = base + (size_t)(wr * 64 + fr + ai * HALF + m * 16) * ldc;
#pragma unroll
                for (int bj = 0; bj < 2; ++bj) { const f32x4 v0 = acc[ai][bj][m][0] * sc, v1 = acc[ai][bj][m][1] * sc; u32x4 w;
                    w.x = cvt_pk_bf16(v0[0], v0[1]); w.y = cvt_pk_bf16(v0[2], v0[3]); w.z = cvt_pk_bf16(v1[0], v1[1]); w.w = cvt_pk_bf16(v1[2], v1[3]);
                    *(u32x4*)(rowp + bj * HALF) = w; } }
    }
};
__device__ __forceinline__ float row_rs4(const float* ss, int row, int fq) {
    const f32x4* p = (const f32x4*)(ss + (size_t)row * 32 + fq * 8); const f32x4 a = p[0], b = p[1];
    float s = ((a[0] + a[1]) + (a[2] + a[3])) + ((b[0] + b[1]) + (b[2] + b[3]));
    s += __shfl_xor(s, 16); s += __shfl_xor(s, 32);
    return __builtin_amdgcn_rsqf(s * (1.0f / DM) + RMS_EPS);
}
struct EpiResid {
    static constexpr bool PERM = false;
    const float* basef; const bf16_t* baseb; bf16_t* ob; int ldo; float* ss;
    __device__ __forceinline__ void operator()(AccRef acc, const Unit& u, int wr, int wc, int fr, int fq) const {
        const int col0 = u.pn * BM + wc * 32 + 4 * fq;
#pragma unroll
        for (int ai = 0; ai < 2; ++ai)
#pragma unroll
            for (int m = 0; m < 4; ++m) { const int row = u.pm * BM + ai * HALF + wr * 64 + m * 16 + fr; const size_t off = (size_t)row * DM + col0; bf16_t* orow = ob + (size_t)row * ldo + col0; float q = 0.f;
#pragma unroll
                for (int bj = 0; bj < 2; ++bj)
#pragma unroll
                    for (int n = 0; n < 2; ++n) { const int o2 = bj * HALF + n * 16; f32x4 bv;
                        if (baseb) { const u32x2 w = *(const u32x2*)(baseb + off + o2); bv = (f32x4){__uint_as_float(w.x << 16), __uint_as_float(w.x & 0xffff0000u), __uint_as_float(w.y << 16), __uint_as_float(w.y & 0xffff0000u)}; }
                        else bv = *(const f32x4*)(basef + off + o2);
                        const f32x4 o = bv + acc[ai][bj][m][n]; q += (o[0] * o[0] + o[1] * o[1]) + (o[2] * o[2] + o[3] * o[3]);
                        u32x2 w2; w2.x = cvt_pk_bf16(o[0], o[1]); w2.y = cvt_pk_bf16(o[2], o[3]); *(u32x2*)(orow + o2) = w2; }
                q += __shfl_xor(q, 16); q += __shfl_xor(q, 32);
                if (fq == 0) ss[(size_t)row * 32 + u.pn * 4 + wc] = q; }
    }
};
struct EpiX { static constexpr bool PERM = false; const float* xp; const float* xs; bf16_t* ob; float* ss;
    __device__ __forceinline__ void operator()(AccRef acc, const Unit& u, int wr, int wc, int fr, int fq) const {
        const float* base = (u.pm < NP / 256) ? xp : xs - (size_t)NP * DM; EpiResid E{base, nullptr, ob, DM, ss}; E(acc, u, wr, wc, fr, fq); } };
struct EpiSm {
    static constexpr bool PERM = false;
    bf16_t* P; const float* ss; LAS unsigned char* tab;
    __device__ __forceinline__ void operator()(AccRef acc, const Unit& u, int wr, int wc, int fr, int fq) const {
        float rr[2][4];
#pragma unroll
        for (int ai = 0; ai < 2; ++ai)
#pragma unroll
            for (int m = 0; m < 4; ++m) { const int rl = ai * HALF + wr * 64 + m * 16 + fr; const float r_ = row_rs4(ss, u.pm * BM + rl, fq); rr[ai][m] = r_;
                float mx = acc[ai][0][m][0][0];
#pragma unroll
                for (int bj = 0; bj < 2; ++bj)
#pragma unroll
                    for (int n = 0; n < 2; ++n) { const f32x4 v = acc[ai][bj][m][n]; mx = fmaxf(fmaxf(mx, fmaxf(v[0], v[1])), fmaxf(v[2], v[3])); }
                mx *= r_; mx = fmaxf(mx, __shfl_xor(mx, 16)); mx = fmaxf(mx, __shfl_xor(mx, 32));
                float sm = 0.f;
#pragma unroll
                for (int bj = 0; bj < 2; ++bj)
#pragma unroll
                    for (int n = 0; n < 2; ++n) { const f32x4 v = acc[ai][bj][m][n];
                        sm += (__builtin_amdgcn_exp2f(v[0] * r_ - mx) + __builtin_amdgcn_exp2f(v[1] * r_ - mx)) + (__builtin_amdgcn_exp2f(v[2] * r_ - mx) + __builtin_amdgcn_exp2f(v[3] * r_ - mx)); }
                sm += __shfl_xor(sm, 16); sm += __shfl_xor(sm, 32);
                if (fq == 0) *(LAS f32x2*)(tab + (rl * 4 + wc) * 8) = (f32x2){mx, sm}; }
        asm volatile("s_waitcnt lgkmcnt(0)" ::: "memory"); __builtin_amdgcn_s_barrier(); asm volatile("" ::: "memory");
        const int col0 = u.pn * BM + wc * 32 + 4 * fq;
#pragma unroll
        for (int ai = 0; ai < 2; ++ai)
#pragma unroll
            for (int m = 0; m < 4; ++m) { const int rl = ai * HALF + wr * 64 + m * 16 + fr; const float r_ = rr[ai][m];
                const f32x4 t0 = *(const LAS f32x4*)(tab + rl * 32), t1 = *(const LAS f32x4*)(tab + rl * 32 + 16);
                const float M = fmaxf(fmaxf(t0[0], t0[2]), fmaxf(t1[0], t1[2]));
                const float L = (t0[1] * __builtin_amdgcn_exp2f(t0[0] - M) + t0[3] * __builtin_amdgcn_exp2f(t0[2] - M)) + (t1[1] * __builtin_amdgcn_exp2f(t1[0] - M) + t1[3] * __builtin_amdgcn_exp2f(t1[2] - M));
                const float inv = __builtin_amdgcn_rcpf(L);
                bf16_t* rowp = P + (size_t)(u.pm * BM + rl) * NSW + col0;
#pragma unroll
                for (int bj = 0; bj < 2; ++bj)
#pragma unroll
                    for (int n = 0; n < 2; ++n) { const f32x4 v = acc[ai][bj][m][n]; u32x2 w;
                        w.x = cvt_pk_bf16(__builtin_amdgcn_exp2f(v[0] * r_ - M) * inv, __builtin_amdgcn_exp2f(v[1] * r_ - M) * inv);
                        w.y = cvt_pk_bf16(__builtin_amdgcn_exp2f(v[2] * r_ - M) * inv, __builtin_amdgcn_exp2f(v[3] * r_ - M) * inv);
                        *(u32x2*)(rowp + bj * HALF + n * 16) = w; } }
    }
};
struct EpiGU {
    static constexpr bool PERM = true;
    bf16_t* act; const float* ss;
    __device__ __forceinline__ void operator()(AccRef acc, const Unit& u, int wr, int wc, int fr, int fq) const {
        bf16_t* base = act + u.pn * HALF + wc * 32 + 8 * fq;
#pragma unroll
        for (int ai = 0; ai < 2; ++ai)
#pragma unroll
            for (int m = 0; m < 4; ++m) { const int row = u.pm * BM + ai * HALF + wr * 64 + m * 16 + fr; const float rr = row_rs4(ss, row, fq); float o[8];
#pragma unroll
                for (int n = 0; n < 2; ++n)
#pragma unroll
                    for (int e = 0; e < 4; ++e) { const float g = acc[ai][0][m][n][e] * rr, up = acc[ai][1][m][n][e] * rr;
                        o[n * 4 + e] = g * __builtin_amdgcn_rcpf(1.0f + __builtin_amdgcn_exp2f(-g * LOG2E)) * up; }
                u32x4 w; w.x = cvt_pk_bf16(o[0], o[1]); w.y = cvt_pk_bf16(o[2], o[3]); w.z = cvt_pk_bf16(o[4], o[5]); w.w = cvt_pk_bf16(o[6], o[7]);
                *(u32x4*)(base + (size_t)row * DFF) = w; }
    }
};
}

namespace att {
#define SBAR() __builtin_amdgcn_sched_barrier(0)
constexpr float THR = 8.0f;
constexpr int SHM_V = 16384, SHM_K = 16384, OFF_K = 2 * SHM_V, OFF_WS = OFF_K + 2 * SHM_K, OFF_RPB = OFF_WS + 8 * 256, OFF_STG = OFF_RPB + 2048, OFF_END = OFF_STG + 8 * 8192;
constexpr int DF_R = 5, DF_D = 4;
constexpr int DF_K = DF_R * SHM_V, DF_KSZ = 8192, DF_WS = DF_K + DF_R * DF_KSZ, DF_STG = 0  , DF_END = DF_WS + 8 * 256;
static_assert(8 * 8192 <= DF_K, "output stage fits inside the V ring");
static_assert(DF_END <= 147456 && OFF_END <= 147456, "attention LDS maps fit the dynamic LDS allocation");
__device__ __forceinline__ int crow(int r, int hi) { return (r & 3) + 8 * (r >> 2) + 4 * hi; }
#define KSWZ128(row, colB) ((row) * 256 + ((colB) ^ (((row) & 7) << 4)))
#define KSWZ64(row, colB) ((row) * 128 + ((colB) ^ ((((row) >> 1) & 7) << 4)))
__device__ __forceinline__ int v_st(int k, int c) { const int kk = (k & ~0xC) | ((k & 4) << 1) | ((k & 8) >> 1); return ((kk >> 3) * 4 + (c >> 5)) * 512 + ((kk & 7) * 32 + (c & 31)) * 2; }
__device__ __forceinline__ int v_rd_base(int lane) { return ((lane & 3) << 3) | (((lane >> 2) & 3) << 6) | (((lane >> 4) & 1) << 5) | (((lane >> 5) & 1) << 8); }
constexpr int v_rd_off(int d0, int ks, int half) { return d0 * 512 + ks * 4096 + half * 2048; }
template <int OFF> __device__ __forceinline__ s16x4 tr_read(int vb) { s16x4 r; asm volatile("ds_read_b64_tr_b16 %0, %1 offset:%2" : "=&v"(r) : "v"(vb), "i"(OFF) : "memory"); return r; }
template <int D0> __device__ __forceinline__ void pv_one(f32x16& od, int vb, bf16x8 pa0, bf16x8 pa1, bf16x8 pa2, bf16x8 pa3) {
    const s16x4 l0 = tr_read<v_rd_off(D0, 0, 0)>(vb), h0 = tr_read<v_rd_off(D0, 0, 1)>(vb), l1 = tr_read<v_rd_off(D0, 1, 0)>(vb), h1 = tr_read<v_rd_off(D0, 1, 1)>(vb);
    const s16x4 l2 = tr_read<v_rd_off(D0, 2, 0)>(vb), h2 = tr_read<v_rd_off(D0, 2, 1)>(vb), l3 = tr_read<v_rd_off(D0, 3, 0)>(vb), h3 = tr_read<v_rd_off(D0, 3, 1)>(vb);
    asm volatile("s_waitcnt lgkmcnt(0)" ::: "memory"); SBAR();
#define PK(L, H) (bf16x8){L[0], L[1], L[2], L[3], H[0], H[1], H[2], H[3]}
    od = __builtin_amdgcn_mfma_f32_32x32x16_bf16(pa0, PK(l0, h0), od, 0, 0, 0);
    od = __builtin_amdgcn_mfma_f32_32x32x16_bf16(pa1, PK(l1, h1), od, 0, 0, 0);
    od = __builtin_amdgcn_mfma_f32_32x32x16_bf16(pa2, PK(l2, h2), od, 0, 0, 0);
    od = __builtin_amdgcn_mfma_f32_32x32x16_bf16(pa3, PK(l3, h3), od, 0, 0, 0);
#undef PK
}
template <int D0> __device__ __forceinline__ void pv_rd(s16x4 (&L)[4], s16x4 (&H)[4], int vb) {
    L[0] = tr_read<v_rd_off(D0, 0, 0)>(vb); H[0] = tr_read<v_rd_off(D0, 0, 1)>(vb); L[1] = tr_read<v_rd_off(D0, 1, 0)>(vb); H[1] = tr_read<v_rd_off(D0, 1, 1)>(vb);
    L[2] = tr_read<v_rd_off(D0, 2, 0)>(vb); H[2] = tr_read<v_rd_off(D0, 2, 1)>(vb); L[3] = tr_read<v_rd_off(D0, 3, 0)>(vb); H[3] = tr_read<v_rd_off(D0, 3, 1)>(vb);
}
#define PV_PK(L, H) (bf16x8){L[0], L[1], L[2], L[3], H[0], H[1], H[2], H[3]}
#define PV_MMA(od, L, H) do { od = __builtin_amdgcn_mfma_f32_32x32x16_bf16(pa0, PV_PK(L[0], H[0]), od, 0, 0, 0); od = __builtin_amdgcn_mfma_f32_32x32x16_bf16(pa1, PV_PK(L[1], H[1]), od, 0, 0, 0); \
    od = __builtin_amdgcn_mfma_f32_32x32x16_bf16(pa2, PV_PK(L[2], H[2]), od, 0, 0, 0); od = __builtin_amdgcn_mfma_f32_32x32x16_bf16(pa3, PV_PK(L[3], H[3]), od, 0, 0, 0); } while (0)
__device__ __forceinline__ void pv_all_pre(f32x16* o, int vb, bf16x8 pa0, bf16x8 pa1, bf16x8 pa2, bf16x8 pa3) {
    s16x4 L0[4], H0[4], L1[4], H1[4], L2[4], H2[4], L3[4], H3[4];
    pv_rd<0>(L0, H0, vb); pv_rd<1>(L1, H1, vb);
    asm volatile("s_waitcnt lgkmcnt(8)" ::: "memory"); SBAR(); PV_MMA(o[0], L0, H0); SBAR();
    pv_rd<2>(L2, H2, vb);
    asm volatile("s_waitcnt lgkmcnt(8)" ::: "memory"); SBAR(); PV_MMA(o[1], L1, H1); SBAR();
    pv_rd<3>(L3, H3, vb);
    asm volatile("s_waitcnt lgkmcnt(8)" ::: "memory"); SBAR(); PV_MMA(o[2], L2, H2); SBAR();
    asm volatile("s_waitcnt lgkmcnt(0)" ::: "memory"); SBAR(); PV_MMA(o[3], L3, H3); SBAR();
}
__device__ __forceinline__ void pv_all(f32x16* o, int vb, bf16x8 pa0, bf16x8 pa1, bf16x8 pa2, bf16x8 pa3) {
    pv_one<0>(o[0], vb, pa0, pa1, pa2, pa3); pv_one<1>(o[1], vb, pa0, pa1, pa2, pa3); pv_one<2>(o[2], vb, pa0, pa1, pa2, pa3); pv_one<3>(o[3], vb, pa0, pa1, pa2, pa3);
}
__device__ __forceinline__ void softmax_tile(f32x16& p0, f32x16& p1, float& m_reg, float& l_reg, float& alpha, bf16x8& pa0, bf16x8& pa1, bf16x8& pa2, bf16x8& pa3) {
    float pmax = p0[0];
#pragma unroll
    for (int r = 1; r < 16; ++r) pmax = fmaxf(pmax, p0[r]);
#pragma unroll
    for (int r = 0; r < 16; ++r) pmax = fmaxf(pmax, p1[r]);
    { auto rr = __builtin_amdgcn_permlane32_swap(__float_as_uint(pmax), __float_as_uint(pmax), false, false); pmax = fmaxf(__uint_as_float(rr[0]), __uint_as_float(rr[1])); }
    float mn;
    if (__builtin_expect(__all(pmax - m_reg <= THR), 1)) { mn = m_reg; alpha = 1.f; }
    else { mn = fmaxf(m_reg, pmax); alpha = __builtin_amdgcn_exp2f(m_reg - mn); m_reg = mn; }
#pragma unroll
    for (int r = 0; r < 16; ++r) { p0[r] = __builtin_amdgcn_exp2f(p0[r] - mn); p1[r] = __builtin_amdgcn_exp2f(p1[r] - mn); }
    float ps = 0.f;
#pragma unroll
    for (int r = 0; r < 16; ++r) ps += p0[r];
#pragma unroll
    for (int r = 0; r < 16; ++r) ps += p1[r];
    { auto rr = __builtin_amdgcn_permlane32_swap(__float_as_uint(ps), __float_as_uint(ps), false, false); ps = __uint_as_float(rr[0]) + __uint_as_float(rr[1]); }
    l_reg = l_reg * alpha + ps;
#define PK4(P, BASE, OUT) do { unsigned a0 = cvt_pk_bf16(P[BASE + 0], P[BASE + 1]), a1 = cvt_pk_bf16(P[BASE + 2], P[BASE + 3]);   \
    unsigned b0 = cvt_pk_bf16(P[BASE + 4], P[BASE + 5]), b1 = cvt_pk_bf16(P[BASE + 6], P[BASE + 7]);                              \
    auto r0 = __builtin_amdgcn_permlane32_swap(a0, b0, false, false); auto r1 = __builtin_amdgcn_permlane32_swap(a1, b1, false, false); \
    u32x4 w = {r0[0], r1[0], r0[1], r1[1]}; OUT = __builtin_bit_cast(bf16x8, w); } while (0)
    PK4(p0, 0, pa0); PK4(p0, 8, pa1); PK4(p1, 0, pa2); PK4(p1, 8, pa3);
#undef PK4
}
__device__ __forceinline__ void softmax_rel(f32x16& p0, f32x16& p1, float& m_reg, float& l_reg, f32x16& negm, float& alpha, bool first, bf16x8& pa0, bf16x8& pa1, bf16x8& pa2, bf16x8& pa3) {
    float ma = __builtin_fmaxf(__builtin_fmaxf(p0[0], p0[1]), p0[2]), mb = __builtin_fmaxf(__builtin_fmaxf(p0[8], p0[9]), p0[10]);
    float mc = __builtin_fmaxf(__builtin_fmaxf(p1[0], p1[1]), p1[2]), md = __builtin_fmaxf(__builtin_fmaxf(p1[8], p1[9]), p1[10]);
    ma = __builtin_fmaxf(__builtin_fmaxf(ma, p0[3]), p0[4]); mb = __builtin_fmaxf(__builtin_fmaxf(mb, p0[11]), p0[12]); mc = __builtin_fmaxf(__builtin_fmaxf(mc, p1[3]), p1[4]); md = __builtin_fmaxf(__builtin_fmaxf(md, p1[11]), p1[12]);
    ma = __builtin_fmaxf(__builtin_fmaxf(ma, p0[5]), p0[6]); mb = __builtin_fmaxf(__builtin_fmaxf(mb, p0[13]), p0[14]); mc = __builtin_fmaxf(__builtin_fmaxf(mc, p1[5]), p1[6]); md = __builtin_fmaxf(__builtin_fmaxf(md, p1[13]), p1[14]);
    ma = __builtin_fmaxf(__builtin_fmaxf(ma, p0[7]), mb); mc = __builtin_fmaxf(__builtin_fmaxf(mc, p1[7]), md);
    float pmax = __builtin_fmaxf(__builtin_fmaxf(ma, p0[15]), __builtin_fmaxf(mc, p1[15]));
    { auto rr = __builtin_amdgcn_permlane32_swap(__float_as_uint(pmax), __float_as_uint(pmax), false, false); pmax = __builtin_fmaxf(__uint_as_float(rr[0]), __uint_as_float(rr[1])); }
    alpha = 1.f;
    if (__builtin_expect(first || !__all(pmax <= THR), 0)) {
        const float dl = first ? pmax : fmaxf(pmax, 0.f);
        m_reg += dl; alpha = first ? 1.f : __builtin_amdgcn_exp2f(-dl);
#pragma unroll
        for (int r = 0; r < 16; ++r) { p0[r] -= dl; p1[r] -= dl; negm[r] = -m_reg; }
    }
#pragma unroll
    for (int r = 0; r < 16; ++r) { p0[r] = __builtin_amdgcn_exp2f(p0[r]); p1[r] = __builtin_amdgcn_exp2f(p1[r]); }
    float ps0 = p0[0], ps1 = p1[0], ps2 = p0[8], ps3 = p1[8];
#pragma unroll
    for (int r = 1; r < 8; ++r) { ps0 += p0[r]; ps1 += p1[r]; ps2 += p0[8 + r]; ps3 += p1[8 + r]; }
    l_reg = l_reg * alpha + ((ps0 + ps1) + (ps2 + ps3));
#define PK4N(P, BASE, OUT) do { u32x4 w = {cvt_pk_bf16(P[BASE + 0], P[BASE + 1]), cvt_pk_bf16(P[BASE + 2], P[BASE + 3]), cvt_pk_bf16(P[BASE + 4], P[BASE + 5]), cvt_pk_bf16(P[BASE + 6], P[BASE + 7])}; \
    OUT = __builtin_bit_cast(bf16x8, w); } while (0)
    PK4N(p0, 0, pa0); PK4N(p0, 8, pa1); PK4N(p1, 0, pa2); PK4N(p1, 8, pa3);
#undef PK4N
}
#define ATT_RESC2(a) do { if (__any((a) < 1.f)) { if (hi == 0) al_l[r32] = (a); asm volatile("s_waitcnt lgkmcnt(0)" ::: "memory"); \
    _Pragma("unroll") for (int r = 0; r < 16; ++r) { const float f_ = al_l[crow(r, hi)]; o[0][r] *= f_; o[1][r] *= f_; o[2][r] *= f_; o[3][r] *= f_; } } } while (0)
#define ATT_RESC(a) do { if (__any((a) < 1.f)) { if (hi == 0) al_l[r32] = (a); asm volatile("s_waitcnt lgkmcnt(0)" ::: "memory"); \
    _Pragma("unroll") for (int d = 0; d < 4; ++d) _Pragma("unroll") for (int r = 0; r < 16; ++r) o[d][r] *= al_l[crow(r, hi)]; } } while (0)

__device__ __forceinline__ void diff_unit(const bf16_t* __restrict__ proj, bf16_t* __restrict__ mix, float* __restrict__ o1s, const float* __restrict__ g_sub, float lam,
                                          int rowbase, int T, int h, int qb, char* lds, int widk) {
    const int tid = tid_l(widk), wid = tid >> 6, lane = tid & 63, r32 = lane & 31, hi = lane >> 5;
    char* V_lds = lds; char* K_lds = lds + DF_K;
    float* wsf = (float*)(lds + DF_WS) + wid * 64; float* li_l = wsf; float* al_l = wsf + 32;
    LAS unsigned char* ldsl = (LAS unsigned char*)lds; const int widu = __builtin_amdgcn_readfirstlane(wid); const int grp = widu >> 2;
    unsigned kgo, vgo[2];
    { const int X = wid * 1024 + lane * 16, krow = X >> 7, kcolB = (X & 127) ^ (((krow >> 1) & 7) << 4); kgo = (unsigned)(krow * INW * 2 + kcolB); }
#pragma unroll
    for (int i = 0; i < 2; ++i) { const int X = wid * 1024 + lane * 16 + i * 8192, sub = X >> 9, e = (X & 511) >> 1, kk = (sub >> 2) * 8 + (e >> 5), cc = (sub & 3) * 32 + (e & 31);
        vgo[i] = (unsigned)((kk * INW + cc) * 2); }
    const int vb0 = (int)(uintptr_t)V_lds + v_rd_base(lane);
    const int NT = T / 64; const int q0 = qb * 256;
    const bf16_t* Vh = proj + (size_t)rowbase * INW + 5120 + h * 128;
#define BAR() do { asm volatile("" ::: "memory"); __builtin_amdgcn_s_barrier(); asm volatile("" ::: "memory"); } while (0)
#pragma unroll 1
    for (int s = 0; s < 2; ++s) {
        const bf16_t* Kh = proj + (size_t)rowbase * INW + 4096 + h * 128 + s * 64;
        const unsigned qoff = ((unsigned)(rowbase + q0 + wid * 32 + r32) * INW + 3072 + h * 128 + s * 64 + hi * 8) * 2u;
        bf16x8 qr[4];
#pragma unroll
        for (int d0 = 0; d0 < 4; ++d0) qr[d0] = *(const bf16x8*)((const char*)proj + qoff + d0 * 32);
        float m_reg = 0.f, l_reg = 0.f; f32x16 o[4], negm = f32x16{};
#pragma unroll
        for (int d = 0; d < 4; ++d) o[d] = f32x16{};
#define DDMA(j, b) do { const char* kt = (const char*)Kh + (size_t)(j) * (64 * INW * 2); const char* vt = (const char*)Vh + (size_t)(j) * (64 * INW * 2); \
        __builtin_amdgcn_global_load_lds((const unsigned*)(kt + kgo), (LAS unsigned*)(ldsl + DF_K + (b) * DF_KSZ + widu * 1024), 16, 0, 0); \
        __builtin_amdgcn_global_load_lds((const unsigned*)(vt + vgo[0]), (LAS unsigned*)(ldsl + (b) * SHM_V + widu * 1024), 16, 0, 0); \
        __builtin_amdgcn_global_load_lds((const unsigned*)(vt + vgo[1]), (LAS unsigned*)(ldsl + (b) * SHM_V + widu * 1024 + 8192), 16, 0, 0); } while (0)
#pragma unroll
        for (int t = 0; t < DF_D; ++t) DDMA(t, t);
        asm volatile("s_waitcnt vmcnt(%0)" :: "n"(3 * (DF_D - 1)) : "memory"); BAR();
        int ka[4];
#pragma unroll
        for (int d0 = 0; d0 < 4; ++d0) ka[d0] = (int)(uintptr_t)K_lds + KSWZ64(r32, (d0 * 16 + hi * 8) * 2);
#define KRD(dst, addr, OFF) asm volatile("ds_read_b128 %0, %1 offset:" #OFF : "=&v"(dst) : "v"(addr) : "memory")
        if (grp) BAR();
        int bsl = 0;
#pragma unroll 1
        for (int j = 0; j < NT; ++j) {
            BAR();
            f32x16 p0, p1;
            __builtin_amdgcn_s_setprio(1);
            { const int kb = bsl * DF_KSZ; bf16x8 k0, k1, k2, k3, k4, k5, k6, k7; const int a0 = ka[0] + kb, a1 = ka[1] + kb, a2 = ka[2] + kb, a3 = ka[3] + kb;
              KRD(k0, a0, 0); KRD(k1, a0, 4096); KRD(k2, a1, 0); KRD(k3, a1, 4096); KRD(k4, a2, 0); KRD(k5, a2, 4096); KRD(k6, a3, 0); KRD(k7, a3, 4096);
              asm volatile("s_waitcnt lgkmcnt(6)" ::: "memory"); SBAR();
              asm volatile("v_mfma_f32_32x32x16_bf16 %0, %1, %2, %3" : "=&v"(p0) : "v"(k0), "v"(qr[0]), "v"(negm));
              asm volatile("v_mfma_f32_32x32x16_bf16 %0, %1, %2, %3" : "=&v"(p1) : "v"(k1), "v"(qr[0]), "v"(negm)); SBAR();
              asm volatile("s_waitcnt lgkmcnt(4)" ::: "memory"); SBAR();
              p0 = __builtin_amdgcn_mfma_f32_32x32x16_bf16(k2, qr[1], p0, 0, 0, 0); p1 = __builtin_amdgcn_mfma_f32_32x32x16_bf16(k3, qr[1], p1, 0, 0, 0); SBAR();
              asm volatile("s_waitcnt lgkmcnt(2)" ::: "memory"); SBAR();
              p0 = __builtin_amdgcn_mfma_f32_32x32x16_bf16(k4, qr[2], p0, 0, 0, 0); p1 = __builtin_amdgcn_mfma_f32_32x32x16_bf16(k5, qr[2], p1, 0, 0, 0); SBAR();
              asm volatile("s_waitcnt lgkmcnt(0)" ::: "memory"); SBAR();
              p0 = __builtin_amdgcn_mfma_f32_32x32x16_bf16(k6, qr[3], p0, 0, 0, 0); p1 = __builtin_amdgcn_mfma_f32_32x32x16_bf16(k7, qr[3], p1, 0, 0, 0); SBAR(); }
            __builtin_amdgcn_s_setprio(0);
            float alpha; bf16x8 pa0, pa1, pa2, pa3;
            softmax_rel(p0, p1, m_reg, l_reg, negm, alpha, j == 0, pa0, pa1, pa2, pa3);
            ATT_RESC2(alpha);
            if (j + DF_D <= NT) asm volatile("s_waitcnt vmcnt(%0) lgkmcnt(0)" :: "n"(3 * (DF_D - 2)) : "memory"); else asm volatile("s_waitcnt vmcnt(0) lgkmcnt(0)" ::: "memory");
            BAR();
            if (j + DF_D < NT) { const int b2 = bsl >= 1 ? bsl - 1 : DF_R - 1; DDMA(j + DF_D, b2); }
            const int bn = bsl == DF_R - 1 ? 0 : bsl + 1;
            pv_all_pre(o, vb0 + bsl * SHM_V, pa0, pa1, pa2, pa3);
            bsl = bn;
        }
#undef KRD
        asm volatile("s_waitcnt lgkmcnt(0)" ::: "memory");
        if (!grp) BAR();
        BAR();
#undef DDMA
        { auto rr = __builtin_amdgcn_permlane32_swap(__float_as_uint(l_reg), __float_as_uint(l_reg), false, false); l_reg = __uint_as_float(rr[0]) + __uint_as_float(rr[1]); }
        if (hi == 0) li_l[r32] = l_reg;
        asm volatile("s_waitcnt lgkmcnt(0)" ::: "memory");
        float rli[16];
#pragma unroll
        for (int r = 0; r < 16; ++r) rli[r] = __builtin_amdgcn_rcpf(li_l[crow(r, hi)]);
        f32x4* o1v = (f32x4*)((char*)o1s + (unsigned)tid * 256u);
        if (s == 0) {
#pragma unroll
            for (int d = 0; d < 4; ++d)
#pragma unroll
                for (int r = 0; r < 16; r += 4) o1v[d * 4 + (r >> 2)] = (f32x4){o[d][r] * rli[r], o[d][r + 1] * rli[r + 1], o[d][r + 2] * rli[r + 2], o[d][r + 3] * rli[r + 3]};
        } else {
#pragma unroll
            for (int d = 0; d < 4; ++d)
#pragma unroll
                for (int r = 0; r < 16; r += 4) { const f32x4 t = o1v[d * 4 + (r >> 2)];
#pragma unroll
                    for (int e = 0; e < 4; ++e) o[d][r + e] = t[e] - lam * (o[d][r + e] * rli[r + e]); }
            float gs[4];
#pragma unroll
            for (int d = 0; d < 4; ++d) gs[d] = g_sub[d * 32 + r32] * (1.0f - LAM_INIT);
            bf16_t* stg = (bf16_t*)(lds + DF_STG) + wid * 4096;
#pragma unroll
            for (int r = 0; r < 16; ++r) {
                float q = (o[0][r] * o[0][r] + o[1][r] * o[1][r]) + (o[2][r] * o[2][r] + o[3][r] * o[3][r]);
                q += __shfl_xor(q, 1); q += __shfl_xor(q, 2); q += __shfl_xor(q, 4); q += __shfl_xor(q, 8); q += __shfl_xor(q, 16);
                const float rn = __builtin_amdgcn_rsqf(q * (1.0f / 128.0f) + SUBLN_EPS);
#pragma unroll
                for (int d = 0; d < 4; ++d) stg[crow(r, hi) * 128 + d * 32 + r32] = (bf16_t)f2bf(o[d][r] * rn * gs[d]);
            }
            asm volatile("s_waitcnt lgkmcnt(0)" ::: "memory");
            const unsigned goff = ((unsigned)(rowbase + q0 + wid * 32 + (lane >> 4)) * DM + 1024 + h * 128 + (lane & 15) * 8) * 2u;
#pragma unroll
            for (int i = 0; i < 8; ++i) { const u32x4 v = *(const u32x4*)(stg + (i * 4 + (lane >> 4)) * 128 + (lane & 15) * 8); *(u32x4*)((char*)mix + goff + (unsigned)(i * 4 * DM * 2)) = v; }
            asm volatile("s_waitcnt lgkmcnt(0)" ::: "memory"); BAR();
        }
    }
#undef BAR
}

__device__ __forceinline__ void na_unit(const bf16_t* __restrict__ proj, bf16_t* __restrict__ mix, const float* __restrict__ rpb,
                                        int rowbase, int ROWS, int h, int rg, char* lds, int widk) {
    const int tid = tid_l(widk), wid = tid >> 6, lane = tid & 63, r32 = lane & 31, hi = lane >> 5;
    char* V_lds = lds; char* K_lds = lds + OFF_K;
    float* wsf = (float*)(lds + OFF_WS) + wid * 64; float* li_l = wsf; float* al_l = wsf + 32;
    float* rpbL = (float*)(lds + OFF_RPB);
    LAS unsigned char* ldsl = (LAS unsigned char*)lds; const int widu = __builtin_amdgcn_readfirstlane(wid);
    unsigned kgo[2], vgo[2];
#pragma unroll
    for (int i = 0; i < 2; ++i) { const int X = wid * 1024 + lane * 16 + i * 8192;
        { const int krow = X >> 8, kcolB = (X & 255) ^ ((krow & 7) << 4); kgo[i] = (unsigned)(krow * INW * 2 + kcolB); }
        { const int sub = X >> 9, e = (X & 511) >> 1, kk = (sub >> 2) * 8 + (e >> 5), cc = (sub & 3) * 32 + (e & 31); const int k = (kk & ~0xC) | ((kk & 4) << 1) | ((kk & 8) >> 1); vgo[i] = (unsigned)((k * INW + cc) * 2); } }
    const int vb0 = (int)(uintptr_t)V_lds + v_rd_base(lane);
    const int r0 = rg * 4, rq = r0 + (wid >> 1), c = 32 * (wid & 1) + r32;
    const int rsw = min(max(rq - 4, 0), ROWS - 8), cs = min(max(c - 8, 0), 48);
    const int klo = min(max(r0 - 4, 0), ROWS - 8), khi = min(max(r0 + 3 - 4, 0), ROWS - 8) + 8;
    for (int i = tid; i < 465; i += NTHREADS) rpbL[i] = rpb[h * 465 + i] * LOG2E;
    const bf16_t* Kh = proj + (size_t)rowbase * INW + 1024 + h * 128;
    const bf16_t* Vh = proj + (size_t)rowbase * INW + 2048 + h * 128;
    const bf16_t* Qw = proj + (size_t)(rowbase + rq * 64 + c) * INW + h * 128 + hi * 8;
    bf16x8 qr[8];
#pragma unroll
    for (int d0 = 0; d0 < 8; ++d0) qr[d0] = *(const bf16x8*)(Qw + d0 * 16);
    float m_reg = -1e30f, l_reg = 0.f; f32x16 o[4];
#pragma unroll
    for (int d = 0; d < 4; ++d) o[d] = f32x16{};
#define NDMA(kr, b) do { const char* kt = (const char*)Kh + (size_t)(kr) * (64 * INW * 2); const char* vt = (const char*)Vh + (size_t)(kr) * (64 * INW * 2); \
        __builtin_amdgcn_global_load_lds((const unsigned*)(kt + kgo[0]), (LAS unsigned*)(ldsl + OFF_K + (b) * SHM_K + widu * 1024), 16, 0, 0); \
        __builtin_amdgcn_global_load_lds((const unsigned*)(kt + kgo[1]), (LAS unsigned*)(ldsl + OFF_K + (b) * SHM_K + widu * 1024 + 8192), 16, 0, 0); \
        __builtin_amdgcn_global_load_lds((const unsigned*)(vt + vgo[0]), (LAS unsigned*)(ldsl + (b) * SHM_V + widu * 1024), 16, 0, 0); \
        __builtin_amdgcn_global_load_lds((const unsigned*)(vt + vgo[1]), (LAS unsigned*)(ldsl + (b) * SHM_V + widu * 1024 + 8192), 16, 0, 0); } while (0)
    NDMA(klo, 0); asm volatile("s_waitcnt vmcnt(0)" ::: "memory"); __syncthreads();
#pragma unroll 1
    for (int kr = klo; kr < khi; ++kr) {
        const int b = (kr - klo) & 1;
        if (kr + 1 < khi) NDMA(kr + 1, b ^ 1);
        if (kr >= rsw && kr < rsw + 8) {
            f32x16 p0 = f32x16{}, p1 = f32x16{};
            const char* Ks = K_lds + b * SHM_K;
#pragma unroll
            for (int d0 = 0; d0 < 8; ++d0) { const int cb = (d0 * 16 + hi * 8) * 2;
                const bf16x8 b0 = *(const bf16x8*)(Ks + KSWZ128(r32, cb)); const bf16x8 b1 = *(const bf16x8*)(Ks + KSWZ128(32 + r32, cb));
                p0 = __builtin_amdgcn_mfma_f32_32x32x16_bf16(b0, qr[d0], p0, 0, 0, 0); p1 = __builtin_amdgcn_mfma_f32_32x32x16_bf16(b1, qr[d0], p1, 0, 0, 0); }
            const float* brow = rpbL + (kr - rq + 7) * 31;
#pragma unroll
            for (int r = 0; r < 16; ++r) {
                const int kc = crow(r, hi), kc2 = kc + 32;
                const int i0 = min(max(kc - c + 15, 0), 30), i1 = min(max(kc2 - c + 15, 0), 30);
                const float b0 = brow[i0], b1 = brow[i1];
                p0[r] = ((unsigned)(kc - cs) < 16u) ? p0[r] + b0 : -1e30f;
                p1[r] = ((unsigned)(kc2 - cs) < 16u) ? p1[r] + b1 : -1e30f;
            }
            float alpha; bf16x8 pa0, pa1, pa2, pa3;
            softmax_tile(p0, p1, m_reg, l_reg, alpha, pa0, pa1, pa2, pa3);
            ATT_RESC(alpha);
            pv_all(o, vb0 + b * SHM_V, pa0, pa1, pa2, pa3);
        }
        asm volatile("s_waitcnt vmcnt(0)" ::: "memory");
        __syncthreads();
    }
#undef NDMA
    if (hi == 0) li_l[r32] = l_reg;
    asm volatile("s_waitcnt lgkmcnt(0)" ::: "memory");
    bf16_t* stg = (bf16_t*)(lds + OFF_STG) + wid * 4096;
#pragma unroll
    for (int r = 0; r < 16; ++r) { const float rl = __builtin_amdgcn_rcpf(li_l[crow(r, hi)]);
#pragma unroll
        for (int d = 0; d < 4; ++d) stg[crow(r, hi) * 128 + d * 32 + r32] = (bf16_t)f2bf(o[d][r] * rl); }
    asm volatile("s_waitcnt lgkmcnt(0)" ::: "memory");
    bf16_t* gp = mix + (size_t)(rowbase + rq * 64 + 32 * (wid & 1) + (lane >> 4)) * DM + h * 128 + (lane & 15) * 8;
#pragma unroll
    for (int i = 0; i < 8; ++i) { const u32x4 v = *(const u32x4*)(stg + (i * 4 + (lane >> 4)) * 128 + (lane & 15) * 8); *(u32x4*)gp = v; gp += 4 * DM; }
    __syncthreads();
}
#undef SBAR
}

template <int MODE> __device__ __forceinline__ int dest_row(int n) {
    if (MODE == 1) { if (n < 3072 || n >= 5120) return n; const int d = n & 63, blk = n & ~63, nn = d >> 5, dd = d & 31; return blk + 32 * (dd >> 4) + 8 * ((dd >> 2) & 3) + 4 * nn + (dd & 3); }
    if (MODE == 2) { if (n < DFF) return 256 * (n >> 7) + (n & 127); const int n2 = n - DFF; return 256 * (n2 >> 7) + 128 + (n2 & 127); }
    return n;
}
template <int MODE> __device__ __forceinline__ void p0_transpose_item(const float* __restrict__ W, int K, int N, bf16_t* __restrict__ WT, const float* __restrict__ gain, LAS float* scr, int item, int lane) {
    const int nblk = N / 32, kb = item / nblk, nb = item % nblk, k0 = 64 * kb, n0 = 32 * nb;
#pragma unroll 8
    for (int i = 0; i < 32; ++i) { const int kk = 2 * i + (lane >> 5); const float g = gain ? gain[k0 + kk] : 1.0f; scr[kk * 33 + (lane & 31)] = W[(size_t)(k0 + kk) * N + n0 + (lane & 31)] * g; }
    asm volatile("s_waitcnt lgkmcnt(0)" ::: "memory");
    const int c = lane & 7;
#pragma unroll
    for (int j = 0; j < 4; ++j) { const int n = (lane >> 3) + 8 * j; const LAS float* s = scr + (8 * c) * 33 + n;
        u32x4 o; o.x = pk2(s[0 * 33], s[1 * 33]); o.y = pk2(s[2 * 33], s[3 * 33]); o.z = pk2(s[4 * 33], s[5 * 33]); o.w = pk2(s[6 * 33], s[7 * 33]);
        *(u32x4*)(WT + (size_t)dest_row<MODE>(n0 + n) * K + k0 + 8 * c) = o; }
    asm volatile("s_waitcnt lgkmcnt(0)" ::: "memory");
}
__device__ __forceinline__ float row_ssq(const float* xrow, int lane, f32x4 (&v)[8]) {
    const f32x4* xr = (const f32x4*)xrow + lane; float s = 0.f;
#pragma unroll
    for (int j = 0; j < 8; ++j) { v[j] = xr[64 * j]; s += (v[j][0] * v[j][0] + v[j][1] * v[j][1]) + (v[j][2] * v[j][2] + v[j][3] * v[j][3]); }
    return wave_sum(s);
}
__device__ __forceinline__ void sincos_d(double x, double& sn, double& cs) {
    const double k = __builtin_rint(x * 0.6366197723675814); const double r0 = __builtin_fma(-k, 1.5707963267948966, x); const double r = __builtin_fma(-k, 6.123233995736766e-17, r0);
    const double r2 = r * r;
    double s = -1.0 / 1307674368000.0; s = s * r2 + 1.0 / 6227020800.0; s = s * r2 - 1.0 / 39916800.0; s = s * r2 + 1.0 / 362880.0; s = s * r2 - 1.0 / 5040.0; s = s * r2 + 1.0 / 120.0; s = s * r2 - 1.0 / 6.0; s = s * r2 * r + r;
    double c = 1.0 / 20922789888000.0; c = c * r2 - 1.0 / 87178291200.0; c = c * r2 + 1.0 / 479001600.0; c = c * r2 - 1.0 / 3628800.0; c = c * r2 + 1.0 / 40320.0; c = c * r2 - 1.0 / 720.0; c = c * r2 + 1.0 / 24.0; c = c * r2 - 0.5; c = c * r2 + 1.0;
    const int q = ((int)k) & 3;
    sn = (q == 0) ? s : (q == 1) ? c : (q == 2) ? -s : -c;
    cs = (q == 0) ? c : (q == 1) ? -s : (q == 2) ? -c : s;
}

struct Args { const float* in[22]; float* out; unsigned char* ws; int ph_lo, ph_hi; };
constexpr int NPHASE = 10;

__global__ void __launch_bounds__(NTHREADS, 2) fwd_kernel(Args a) {
    extern __shared__ __attribute__((aligned(16))) unsigned char lds[];
    LAS unsigned char* ldsl = (LAS unsigned char*)lds;
    const int widk = __builtin_amdgcn_readfirstlane((int)(threadIdx.x >> 6));
    const int G = gridDim.x, bx = blockIdx.x, vcu = (G % 8 == 0) ? (bx % 8) * (G / 8) + bx / 8 : bx;
#define x_p (ap->in[0])
#define x_s (ap->in[1])
#define mem_p (ap->in[2])
#define mem_s (ap->in[3])
#define g_mix (ap->in[4])
#define w_in (ap->in[5])
#define rpb (ap->in[6])
#define lam_q1 (ap->in[7])
#define lam_k1 (ap->in[8])
#define lam_q2 (ap->in[9])
#define lam_k2 (ap->in[10])
#define g_subln (ap->in[11])
#define w_out (ap->in[12])
#define g_xattn (ap->in[13])
#define g_mem (ap->in[14])
#define w_mq (ap->in[15])
#define w_mkv (ap->in[16])
#define w_mo (ap->in[17])
#define g_ffn (ap->in[18])
#define w_gu (ap->in[19])
#define w_dn (ap->in[20])
#define g_final (ap->in[21])
#define out (ap->out)
#define WSP() const __attribute__((address_space(4))) Args* ap = (const __attribute__((address_space(4))) Args*)__builtin_amdgcn_kernarg_segment_ptr(); asm volatile("" : "+s"(ap)); unsigned char* ws = ap->ws
#define SS ((float*)(ws + WS_SS))
#define RS0 ((float*)(ws + WS_RS0))
#define ROPE ((f32x2*)(ws + WS_ROPE))
#define WIN ((bf16_t*)(ws + WS_WIN))
#define WOUT ((bf16_t*)(ws + WS_WOUT))
#define WMQ ((bf16_t*)(ws + WS_WMQ))
#define WMO ((bf16_t*)(ws + WS_WMO))
#define WMKV ((bf16_t*)(ws + WS_WMKV))
#define WGU ((bf16_t*)(ws + WS_WGU))
#define WDN ((bf16_t*)(ws + WS_WDN))
#define MN ((bf16_t*)(ws + WS_MN))
#define KB ((bf16_t*)(ws + WS_KB))
#define VB ((bf16_t*)(ws + WS_VB))
#define WQK ((bf16_t*)(ws + WS_WQK))
#define WVO ((bf16_t*)(ws + WS_WVO))
#define O1S ((float*)(ws + WS_O1))
#define XB ((bf16_t*)(ws + WS_XB))
#define PROJ ((bf16_t*)(ws + WS_BIG))
#define H1B ((bf16_t*)(ws + WS_H1B))
#define SB ((float*)(ws + WS_S))
#define PB ((bf16_t*)(ws + WS_P))
#define ACT ((bf16_t*)(ws + WS_ACT))
#define MIX XB
#define H2B XB
    const int lo = a.ph_lo, hi_ph = a.ph_hi;
    if (lo < 0) cg::this_grid().sync();
#ifdef ONLY_PHASE
#define IN(k) ((k) == ONLY_PHASE && lo <= (k) && (k) < hi_ph)
#else
#define IN(k) (lo <= (k) && (k) < hi_ph)
#endif
    volatile LAS unsigned* xst = (volatile LAS unsigned*)(ldsl + LDS_BYTES - 64);
    const unsigned xcc = __builtin_amdgcn_readfirstlane((int)xb_xcc_id());
    { const int t0 = tid_l(widk); if (t0 < 2) xst[t0] = 0u;
      if (t0 == 0 && hi_ph - lo > 1) { const __attribute__((address_space(4))) Args* ap0 = (const __attribute__((address_space(4))) Args*)__builtin_amdgcn_kernarg_segment_ptr(); (void)xb_add((unsigned*)(ap0->ws + WS_BAR) + XB_XCNT(xcc), 1u); }
      __syncthreads(); }
#define SEAM(k) do { if (IN(k) && IN((k) + 1)) { WSP(); xcd_barrier((unsigned*)(ws + WS_BAR), xcc, (unsigned)G, xst, tid_l(widk)); } } while (0)
    const int NGW = G * 8;
#define TIDS() const int tid = tid_l(widk), lane = tid & 63, wave = __builtin_amdgcn_readfirstlane(tid >> 6), gw = vcu * 8 + wave; (void)lane; (void)gw

    if (IN(0)) { WSP(); TIDS();
        LAS float* scr = (LAS float*)(ldsl + wave * 16384);
        constexpr int I0 = (DM / 64) * (INW / 32), I1 = (DM / 64) * (DM / 32), I2 = I1, I3 = (DM / 64) * (4096 / 32), I4 = (DM / 64) * (NGU / 32), I5 = (DFF / 64) * (DM / 32);
        constexpr int NIT = I0 + I1 + I2 + I3 + I4 + I5;
        for (int it = gw; it < NIT; it += NGW) {
            int r = it;
            if (r < I0) { p0_transpose_item<1>(w_in, DM, INW, WIN, g_mix, scr, r, lane); continue; } r -= I0;
            if (r < I1) { p0_transpose_item<0>(w_out, DM, DM, WOUT, nullptr, scr, r, lane); continue; } r -= I1;
            if (r < I2) { p0_transpose_item<0>(w_mo, DM, DM, WMO, nullptr, scr, r, lane); continue; } r -= I2;
            if (r < I3) { p0_transpose_item<0>(w_mkv, DM, 4096, WMKV, nullptr, scr, r, lane); continue; } r -= I3;
            if (r < I4) { p0_transpose_item<2>(w_gu, DM, NGU, WGU, g_ffn, scr, r, lane); continue; } r -= I4;
            p0_transpose_item<0>(w_dn, DFF, DM, WDN, nullptr, scr, r, lane);
        }
        for (int k = gw; k < DM; k += NGW) { const float g = g_xattn[k]; const f32x4* src = (const f32x4*)(w_mq + (size_t)k * DM) + lane; u32x2* dst = (u32x2*)(WMQ + (size_t)k * DM) + lane;
#pragma unroll
            for (int j = 0; j < 8; ++j) { const f32x4 v = src[64 * j] * g; u32x2 w; w.x = pk2(v[0], v[1]); w.y = pk2(v[2], v[3]); dst[64 * j] = w; } }
        for (int m = gw; m < MT; m += NGW) { const float* xr = m < NP ? x_p + (size_t)m * DM : x_s + (size_t)(m - NP) * DM; f32x4 v[8];
            const float s = row_ssq(xr, lane, v); if (lane == 0) RS0[m] = 1.0f / sqrtf(s * (1.0f / DM) + RMS_EPS);
            u32x2* dst = (u32x2*)(XB + (size_t)m * DM) + lane;
#pragma unroll
            for (int j = 0; j < 8; ++j) { u32x2 w; w.x = pk2(v[j][0], v[j][1]); w.y = pk2(v[j][2], v[j][3]); dst[64 * j] = w; } }
        for (int m = gw; m < NMEM; m += NGW) { const float* xr = m < 512 ? mem_p + (size_t)m * DM : mem_s + (size_t)(m - 512) * DM; f32x4 v[8];
            const float s = row_ssq(xr, lane, v); const float rr = 1.0f / sqrtf(s * (1.0f / DM) + RMS_EPS);
            u32x2* dst = (u32x2*)(MN + (size_t)m * DM) + lane; const f32x4* gp = (const f32x4*)g_mem + lane;
#pragma unroll
            for (int j = 0; j < 8; ++j) { const f32x4 g = gp[64 * j]; u32x2 w; w.x = pk2(v[j][0] * rr * g[0], v[j][1] * rr * g[1]); w.y = pk2(v[j][2] * rr * g[2], v[j][3] * rr * g[3]); dst[64 * j] = w; } }
        for (int e = vcu * NTHREADS + tid; e < TP * 32; e += G * NTHREADS) { const int t = e >> 5, dd = e & 31;
            double pw = 1.0; for (int i = 0; i < dd; ++i) pw *= 1.333521432163324;
            const float inv = 1.0f / (float)pw; const float ang = (float)t * inv; double sn, cs; sincos_d((double)ang, sn, cs);
            ROPE[e] = (f32x2){(float)cs, (float)sn}; }
    }
    SEAM(0);

    if (IN(1)) { WSP();
        pg8::Sched S{(const char*)XB, (const char*)WIN, (const char*)MN, (const char*)WMKV, MT / 256, INW / 256, (MT / 256) * (INW / 256), NMEM / 256, (NMEM / 256) * 16,
                     (size_t)256 * DM * 2, (size_t)256 * DM * 2, 0, G, bx};
        pg8::EpiInProj E{PROJ, KB, VB, RS0, ROPE};
        pg8::gemm_phase<pg8::EpiInProj, pg8::Sched, true, true>(ldsl, widk, DM, DM, S, E);
    }
    SEAM(1);

    if (IN(2)) { WSP(); TIDS();
#if !defined(P2_PART) || P2_PART == 1
        { pg8::PreSched S{(const char*)KB, (const char*)VB, (const char*)WMQ, (const char*)WMO, G, bx}; pg8::EpiPre E{WQK, WVO};
          pg8::gemm_phase<pg8::EpiPre, pg8::PreSched, true, true>(ldsl, widk, 512, DM, S, E); }
#endif
        __syncthreads();
#if !defined(P2_PART) || P2_PART == 2
        for (int id = vcu; id < 1024 + 512; id += G) {
            const bool pr = id < 1024; const int i2 = pr ? id : id - 1024;
            const int rg = pr ? (i2 & 63) : (i2 & 15), h = pr ? ((i2 >> 6) & 7) : ((i2 >> 4) & 7), b = pr ? (i2 >> 9) : (i2 >> 7);
            att::na_unit(PROJ, MIX, rpb, pr ? b * TP : NP + b * TS, pr ? TP / 64 : TS / 64, h, rg, (char*)lds, widk);
        }
#endif
#if !defined(P2_PART) || P2_PART == 3
        float lam;
        { const float a1 = wave_sum(lam_q1[lane] * lam_k1[lane]), a2 = wave_sum(lam_q2[lane] * lam_k2[lane]); lam = __expf(a1) - __expf(a2) + LAM_INIT; lam = __builtin_bit_cast(float, __builtin_amdgcn_readfirstlane(__builtin_bit_cast(int, lam))); }
        float* o1s = O1S + (size_t)bx * 64 * NTHREADS;
#ifndef DIFF_REPS
#define DIFF_REPS 1
#endif
        for (int rep = 0; rep < DIFF_REPS; ++rep)
        for (int id = vcu; id < 1024 + 512; id += G) {
            const bool pr = id < 1024; const int i2 = pr ? id : id - 1024;
            const int qb = pr ? (i2 & 63) : (i2 & 15), bh = pr ? (i2 >> 6) : (i2 >> 4);
            att::diff_unit(PROJ, MIX, o1s, g_subln, lam, pr ? (bh >> 3) * TP : NP + (bh >> 3) * TS, pr ? TP : TS, bh & 7, qb, (char*)lds, widk);
        }
#endif
    }
    SEAM(2);

    if (IN(3)) { WSP();
        pg8::Sched S{(const char*)MIX, (const char*)WOUT, nullptr, nullptr, MT / 256, DM / 256, (MT / 256) * (DM / 256), 1, 0, (size_t)256 * DM * 2, (size_t)256 * DM * 2, 0, G, bx};
        pg8::EpiX E{x_p, x_s, H1B, SS};
        pg8::gemm_phase<pg8::EpiX, pg8::Sched, true, true>(ldsl, widk, DM, DM, S, E);
    }
    SEAM(3);

    if (IN(4)) { WSP();
        pg8::Sched S{(const char*)H1B, (const char*)WQK, nullptr, nullptr, MT / 256, NSW / 256, (MT / 256) * (NSW / 256), 1, 0, (size_t)256 * DM * 2, (size_t)256 * DM * 2, (size_t)NSW * DM * 2, G, bx};
        pg8::EpiSm E{PB, SS, ldsl + pg8::STAGE_BYTES};
        pg8::gemm_phase<pg8::EpiSm, pg8::Sched, true, true>(ldsl, widk, DM, DM, S, E);
    }
    SEAM(4);


    if (IN(6)) { WSP();
        pg8::Sched S{(const char*)PB, (const char*)WVO, nullptr, nullptr, MT / 256, DM / 256, (MT / 256) * (DM / 256), 1, 0, (size_t)256 * NSW * 2, (size_t)256 * NSW * 2, (size_t)DM * NSW * 2, G, bx};
        pg8::EpiResid E{nullptr, H1B, H2B, DM, SS};
        pg8::gemm_phase<pg8::EpiResid, pg8::Sched, true, true>(ldsl, widk, NSW, NSW, S, E);
    }
    SEAM(6);

    if (IN(7)) { WSP();
        pg8::Sched S{(const char*)H2B, (const char*)WGU, nullptr, nullptr, MT / 256, NGU / 256, (MT / 256) * (NGU / 256), 1, 0, (size_t)256 * DM * 2, (size_t)256 * DM * 2, 0, G, bx};
        pg8::EpiGU E{ACT, SS};
        pg8::gemm_phase<pg8::EpiGU, pg8::Sched, true, true>(ldsl, widk, DM, DM, S, E);
    }
    SEAM(7);

    if (IN(8)) { WSP();
        pg8::Sched S{(const char*)ACT, (const char*)WDN, nullptr, nullptr, MT / 256, DM / 256, (MT / 256) * (DM / 256), 1, 0, (size_t)256 * DFF * 2, (size_t)256 * DFF * 2, 0, G, bx};
        pg8::EpiResid E{nullptr, H2B, (bf16_t*)out + DM, 2 * DM, SS};
        pg8::gemm_phase<pg8::EpiResid, pg8::Sched, true, true>(ldsl, widk, DFF, DFF, S, E);
    }
    SEAM(8);

    if (IN(9)) { WSP(); TIDS();
        for (int m = gw; m < MT; m += NGW) {
            float sq = lane < 32 ? SS[(size_t)m * 32 + lane] : 0.f; sq = wave_sum(sq); const float rr = __builtin_amdgcn_rsqf(sq * (1.0f / DM) + RMS_EPS);
            const u32x2* hp = (const u32x2*)((const bf16_t*)out + (size_t)m * (2 * DM) + DM) + lane;
            u32x2 hv[8];
#pragma unroll
            for (int j = 0; j < 8; ++j) hv[j] = hp[64 * j];
            asm volatile("s_waitcnt vmcnt(0)" ::: "memory");
            f32x4* op = (f32x4*)(out + (size_t)m * DM) + lane; const f32x4* gp = (const f32x4*)g_final + lane;
#pragma unroll
            for (int j = 0; j < 8; ++j) { const f32x4 g = gp[64 * j];
                const f32x4 v = (f32x4){__uint_as_float(hv[j].x << 16), __uint_as_float(hv[j].x & 0xffff0000u), __uint_as_float(hv[j].y << 16), __uint_as_float(hv[j].y & 0xffff0000u)};
                op[64 * j] = v * rr * g; }
        }
    }
#undef IN
#undef SEAM
#undef TIDS
}
#undef x_p
#undef x_s
#undef mem_p
#undef mem_s
#undef g_mix
#undef w_in
#undef rpb
#undef lam_q1
#undef lam_k1
#undef lam_q2
#undef lam_k2
#undef g_subln
#undef w_out
#undef g_xattn
#undef g_mem
#undef w_mq
#undef w_mkv
#undef w_mo
#undef g_ffn
#undef w_gu
#undef w_dn
#undef g_final
#undef out
#undef WSP
#undef SS
#undef RS0
#undef ROPE
#undef WIN
#undef WOUT
#undef WMQ
#undef WMO
#undef WMKV
#undef WGU
#undef WDN
#undef MN
#undef KB
#undef VB
#undef WQK
#undef WVO
#undef O1S
#undef XB
#undef PROJ
#undef H1B
#undef SB
#undef PB
#undef ACT
#undef MIX
#undef H2B


extern "C" void kernel_launch(void* const* d_in, const int* in_sizes, int n_in, void* d_out, int out_size, void* d_ws, size_t ws_size, hipStream_t stream) {
    static int grid = 0;
    if (grid == 0) {
        if (n_in != 22 || out_size != MT * DM || ws_size < WS_END) { fprintf(stderr, "kernel_launch: unexpected shapes (n_in %d, out %d, ws %zu); nothing launched\n", n_in, out_size, ws_size); grid = -1; return; }
        int dev = 0, cus = 0, per_cu = 0;
        (void)hipGetDevice(&dev); (void)hipDeviceGetAttribute(&cus, hipDeviceAttributeMultiprocessorCount, dev);
        if (hipFuncSetAttribute((const void*)fwd_kernel, hipFuncAttributeMaxDynamicSharedMemorySize, LDS_BYTES) != hipSuccess) { fprintf(stderr, "kernel_launch: hipFuncSetAttribute failed\n"); grid = -1; return; }
        if (hipOccupancyMaxActiveBlocksPerMultiprocessor(&per_cu, (const void*)fwd_kernel, NTHREADS, LDS_BYTES) != hipSuccess || per_cu < 1) per_cu = 1;
        (void)hipGetLastError();
        grid = cus * per_cu;
    }
    if (grid < 0) return;
    Args a{};
    for (int i = 0; i < 22; ++i) a.in[i] = (const float*)d_in[i];
    a.out = (float*)d_out; a.ws = (unsigned char*)d_ws;
#if MK_MULTI
    for (int p = 0; p < NPHASE; ++p) { a.ph_lo = p; a.ph_hi = p + 1; hipLaunchKernelGGL(fwd_kernel, dim3(grid), dim3(NTHREADS), LDS_BYTES, stream, a); }
#else
    a.ph_lo = 0; a.ph_hi = NPHASE;
    (void)hipMemsetAsync((char*)d_ws + WS_BAR, 0, 16384, stream);
    void* args[] = {&a};
    hipError_t e = hipLaunchCooperativeKernel((const void*)fwd_kernel, dim3(grid), dim3(NTHREADS), args, LDS_BYTES, stream);
    if (e != hipSuccess) fprintf(stderr, "cooperative launch failed: %s (grid %d)\n", hipGetErrorString(e), grid);
#endif
}
```

```cpp
#include <hip/hip_runtime.h>
#include <hip/hip_cooperative_groups.h>
#include <cstdio>
#include <cstdint>
namespace cg = cooperative_groups;

#ifndef MK_MULTI
#define MK_MULTI 0
#endif

#define LAS __attribute__((address_space(3)))
typedef unsigned short bf16_t;
typedef short bf16x8 __attribute__((ext_vector_type(8)));
typedef short s16x4 __attribute__((ext_vector_type(4)));
typedef float f32x2 __attribute__((ext_vector_type(2)));
typedef float f32x4 __attribute__((ext_vector_type(4)));
typedef float f32x16 __attribute__((ext_vector_type(16)));
typedef unsigned u32x2 __attribute__((ext_vector_type(2)));
typedef unsigned u32x4 __attribute__((ext_vector_type(4)));

constexpr int DM = 2048, TP = 16384, TS = 4096, NP = 2 * TP, NS = 4 * TS, MT = NP + NS;
constexpr int INW = 6144, DFF = 5632, NGU = 2 * DFF, MEMT = 256, NMEM = 6 * MEMT, NSW = 1024;
constexpr float RMS_EPS = 1e-6f, SUBLN_EPS = 1e-5f, LOG2E = 1.4426950408889634f;
constexpr float NA_QS = 0.08838834764831845f * LOG2E, DF_QS = 0.125f * LOG2E, MEM_QS = 0.04419417382415922f * LOG2E;
constexpr float LAM_INIT = 0.2f;

constexpr size_t MiB = 1u << 20;
constexpr size_t WS_SS = 0, WS_RS0 = 6 * MiB, WS_ROPE = 7 * MiB, WS_WIN = 11 * MiB, WS_WOUT = 35 * MiB, WS_WMQ = 43 * MiB, WS_WMO = 51 * MiB,
                 WS_WMKV = 59 * MiB, WS_WGU = 75 * MiB, WS_WDN = 119 * MiB, WS_MN = 141 * MiB, WS_KB = 147 * MiB, WS_VB = 153 * MiB,
                 WS_WQK = 159 * MiB, WS_WVO = 183 * MiB, WS_O1 = 207 * MiB, WS_XB = 239 * MiB, WS_BIG = 431 * MiB, WS_END = 1007 * MiB;
constexpr size_t WS_BAR = 6 * MiB + 512 * 1024;
constexpr size_t WS_H1B = WS_BIG, WS_S = WS_BIG + 192 * MiB, WS_P = WS_BIG + 384 * MiB, WS_ACT = WS_BIG;

constexpr int LDS_BYTES = 147456, NTHREADS = 512;

__device__ __forceinline__ unsigned cvt_pk_bf16(float lo, float hi) { unsigned r; asm volatile("v_cvt_pk_bf16_f32 %0, %1, %2" : "=v"(r) : "v"(lo), "v"(hi)); return r; }
__device__ __forceinline__ unsigned f2bf(float f) { unsigned u = __builtin_bit_cast(unsigned, f); return (u + 0x7fffu + ((u >> 16) & 1u)) >> 16; }
__device__ __forceinline__ unsigned pk2(float lo, float hi) { return f2bf(lo) | (f2bf(hi) << 16); }
__device__ __forceinline__ float wave_sum(float v) {
#pragma unroll
    for (int o = 1; o < 64; o <<= 1) v += __shfl_xor(v, o);
    return v;
}
__device__ __forceinline__ float wave_max(float v) {
#pragma unroll
    for (int o = 1; o < 64; o <<= 1) v = fmaxf(v, __shfl_xor(v, o));
    return v;
}
__device__ __forceinline__ int tid_l(int widk) { int t; asm volatile("v_mbcnt_lo_u32_b32 %0, -1, 0\n\tv_mbcnt_hi_u32_b32 %0, -1, %0\n\tv_or_b32 %0, %1, %0" : "=&v"(t) : "s"(widk << 6)); return t; }
__device__ __forceinline__ void grid_barrier(unsigned* ctr, unsigned target, int tid) {
    asm volatile("s_waitcnt vmcnt(0) lgkmcnt(0)" ::: "memory");
    __syncthreads();
    if (tid == 0) {
        __builtin_amdgcn_fence(__ATOMIC_RELEASE, "agent");
        asm volatile("s_waitcnt vmcnt(0)" ::: "memory");
        (void)__hip_atomic_fetch_add(ctr, 1u, __ATOMIC_RELAXED, __HIP_MEMORY_SCOPE_AGENT);
        unsigned spins = 0;
        while (__hip_atomic_load(ctr, __ATOMIC_RELAXED, __HIP_MEMORY_SCOPE_AGENT) < target && ++spins < (1u << 22)) __builtin_amdgcn_s_sleep(2);
        __builtin_amdgcn_fence(__ATOMIC_ACQUIRE, "agent");
        asm volatile("s_waitcnt vmcnt(0)" ::: "memory");
    }
    __syncthreads();
}
#define XB_TMO      128
#define XB_XCNT(j)  (256  + 64 * (j))
#define XB_XSUB(j)  (1280 + 64 * (j))
#define XB_XGEN(j)  (2304 + 64 * (j))
#define XB_TOP      3328
#define XB_TOPGEN   3392
#define XCD_BAR_WORDS 3456
#define XB_SPIN_CAP (1u << 20)
__device__ __forceinline__ unsigned xb_ld(unsigned* p)              { return __hip_atomic_load(p, __ATOMIC_RELAXED, __HIP_MEMORY_SCOPE_AGENT); }
__device__ __forceinline__ unsigned xb_add(unsigned* p, unsigned v) { return __hip_atomic_fetch_add(p, v, __ATOMIC_RELAXED, __HIP_MEMORY_SCOPE_AGENT); }
__device__ __forceinline__ unsigned xb_xcc_id() { return (unsigned)__builtin_amdgcn_s_getreg((3 << 11) | 20) & 0xFu; }
#define XB_SPIN(cond, bar) do { unsigned _sp = 0; while (cond) { __builtin_amdgcn_s_sleep(1); \
    if ((++_sp & 255u) == 0u) { if (xb_ld(&(bar)[XB_TMO])) break; if (_sp > XB_SPIN_CAP) { (void)xb_add(&(bar)[XB_TMO], 1u); break; } } } } while (0)
__device__ __forceinline__ void xcd_barrier_complete(unsigned* bar, unsigned x, unsigned G, unsigned& nloc, unsigned& nx) {
    unsigned sum, cnt, mine, sp = 0u;
    for (;;) {
        sum = 0u; cnt = 0u; mine = 0u;
#pragma unroll
        for (unsigned j = 0; j < 16; ++j) { const unsigned c = xb_ld(&bar[XB_XCNT(j)]); sum += c; cnt += (c > 0u) ? 1u : 0u; mine = (j == x) ? c : mine; }
        if (sum == G) break;
        __builtin_amdgcn_s_sleep(1);
        if ((++sp & 255u) == 0u) { if (xb_ld(&bar[XB_TMO])) break; if (sp > XB_SPIN_CAP) { (void)xb_add(&bar[XB_TMO], 1u); break; } }
    }
    nloc = mine > 0u ? mine : 1u; nx = cnt > 0u ? cnt : 1u;
}
__device__ __forceinline__ void xcd_barrier(unsigned* bar, unsigned x, unsigned G, volatile LAS unsigned* st, int tid) {
    asm volatile("s_waitcnt vmcnt(0) lgkmcnt(0)" ::: "memory");
    __syncthreads();
    if (tid == 0) {
        unsigned nloc = st[0], nx = st[1];
        if (nloc == 0u) { xcd_barrier_complete(bar, x, G, nloc, nx); st[0] = nloc; st[1] = nx; }
        const unsigned old = xb_add(&bar[XB_XSUB(x)], 1u);
        const unsigned gen = old / nloc;
        if (old + 1u == (gen + 1u) * nloc) {
            __builtin_amdgcn_fence(__ATOMIC_RELEASE, "agent");
            asm volatile("s_waitcnt vmcnt(0)" ::: "memory");
            const unsigned og = xb_add(&bar[XB_TOP], 1u);
            const unsigned tg = og / nx;
            if (og + 1u == (tg + 1u) * nx) (void)xb_add(&bar[XB_TOPGEN], 1u);
            else XB_SPIN(xb_ld(&bar[XB_TOPGEN]) == tg, bar);
            __builtin_amdgcn_fence(__ATOMIC_ACQUIRE, "agent");
            (void)xb_add(&bar[XB_XGEN(x)], 1u);
            asm volatile("s_waitcnt vmcnt(0)" ::: "memory");
        } else {
            XB_SPIN(xb_ld(&bar[XB_XGEN(x)]) == gen, bar);
            __builtin_amdgcn_fence(__ATOMIC_ACQUIRE, "agent");
            asm volatile("s_waitcnt vmcnt(0)" ::: "memory");
        }
    }
    __syncthreads();
}
__device__ __forceinline__ int batch_of_pm(int pm) { return pm < 128 ? (pm >> 6) : 2 + ((pm - 128) >> 4); }

namespace pg8 {
constexpr int BM = 256, BK = 64, HALF = 128, HTB = HALF * BK * 2, STAGE_BYTES = 8 * HTB, NXCD = 8, WGM = 4;
__host__ __device__ __forceinline__ int lds_byte(int r, int c) { const int st = (r >> 4) * 2 + (c >> 5), rr = r & 15, cc = c & 31, ob = rr * 64 + cc * 2; return st * 1024 + (ob ^ (((ob >> 9) & 1) << 5)); }
__host__ __device__ __forceinline__ void stage_rc(int b, int& R, int& C) { const int st = b / 1024, sb = b % 1024, swz = sb ^ (((sb >> 9) & 1) << 5); R = (st >> 1) * 16 + swz / 64; C = (st & 1) * 32 + (swz % 64) / 2; }
__host__ __device__ __forceinline__ int perm32(int rho) { const int n = rho >> 4, i = rho & 15; return 8 * (i >> 2) + 4 * n + (i & 3); }

struct Unit { int pm, pn, z; };

__device__ __forceinline__ void tile_decode(int wgid, int nM, int nN, int& pm, int& pn) {
    const int nwg = nM * nN;
    { const int q = nwg / NXCD, r = nwg % NXCD, xcd = wgid % NXCD, off = wgid / NXCD; wgid = (xcd < r ? xcd * (q + 1) : r * (q + 1) + (xcd - r) * q) + off; }
    const int nig = WGM * nN, gid = wgid / nig, fm = gid * WGM, gsz = (nM - fm) < WGM ? (nM - fm) : WGM;
    pm = fm + ((wgid % nig) % gsz); pn = (wgid % nig) / gsz;
}
struct Sched {
    const char *A0, *B0, *A1, *B1; int nM0, nN0, n0, nM1, n1; size_t tA, tB, bstride; int G, c;
    __device__ __forceinline__ bool next(int i, Unit& u) const {
        int L = i * G + c;
        if (L < n0) { tile_decode(L, nM0, nN0, u.pm, u.pn); u.z = 0; return true; }
        L -= n0; if (L < n1) { u.pm = L % nM1; u.pn = L / nM1; u.z = 1; return true; }
        return false;
    }
    __device__ __forceinline__ const char* abase(const Unit& u) const { return (u.z ? A1 : A0) + (size_t)u.pm * tA; }
    __device__ __forceinline__ const char* bbase(const Unit& u) const { return (u.z ? B1 : B0) + (size_t)u.pn * tB + (bstride ? (size_t)batch_of_pm(u.pm) * bstride : (size_t)0); }
};
struct PreSched {
    const char *Kb, *Vb, *Wmq, *Wmo; int G, c;
    __device__ __forceinline__ bool next(int i, Unit& u) const { const int L = i * G + c; if (L >= 384) return false; u.z = L / 8; const int t = L & 7; if (u.z < 24) { u.pm = 0; u.pn = t; } else { u.pm = t; u.pn = 0; } return true; }
    __device__ __forceinline__ const char* abase(const Unit& u) const { const int zz = u.z % 24, b = zz >> 2, h = zz & 3;
        return u.z < 24 ? Kb + ((size_t)(b * 256) * DM + h * 512) * 2 : Wmo + ((size_t)(u.pm * 256) * DM + h * 512) * 2; }
    __device__ __forceinline__ const char* bbase(const Unit& u) const { const int zz = u.z % 24, b = zz >> 2, h = zz & 3;
        return u.z < 24 ? Wmq + ((size_t)(u.pn * 256) * DM + h * 512) * 2 : Vb + ((size_t)(b * 256) * DM + h * 512) * 2; }
};

template <class Epi, class SchedT, bool ALIGN_EPI, bool SP2>
__device__ __forceinline__ void gemm_phase(LAS unsigned char* lds, const int widk, const int K, const int ld, const SchedT& S, const Epi& E) {
    const int tid = tid_l(widk), wid = __builtin_amdgcn_readfirstlane(tid >> 6), lane = tid & 63, wr = wid >> 2, wc = wid & 3, fr = lane & 15, fq = lane >> 4;
    const int nt = K / BK;
    unsigned voffA[2], voffB[2];
#pragma unroll
    for (int i = 0; i < 2; ++i) { int R, C; stage_rc(tid * 16 + i * 8192, R, C); const int Rb = Epi::PERM ? ((R & ~31) + perm32(R & 31)) : R;
        voffA[i] = (unsigned)(R * ld + C) * 2u; voffB[i] = (unsigned)(Rb * ld + C) * 2u; }
    const size_t kstep = (size_t)(BK * 2);
    const size_t hstep = (size_t)HALF * ld * 2;
    const unsigned ldsw = (unsigned)wid * 1024u;
    const int aoff = lds_byte(wr * 64 + fr, fq * 8), boff = lds_byte(wc * 32 + fr, fq * 8);
#define PG8_SA(b, h) (((b) * 2 + (h)) * HTB)
#define PG8_SB(b, h) ((4 + (b) * 2 + (h)) * HTB)
#define PG8_STAGE(bufoff, gbase, voff) do { _Pragma("unroll") for (int _i = 0; _i < 2; ++_i) \
        __builtin_amdgcn_global_load_lds((const unsigned*)((const char*)(gbase) + (voff)[_i]), (LAS unsigned*)(lds + (bufoff) + ldsw + _i * 8192), 16, 0, 0); } while (0)
#define PG8_LDA(dst, b, h) do { _Pragma("unroll") for (int m = 0; m < 4; ++m) _Pragma("unroll") for (int k = 0; k < 2; ++k) dst[m][k] = *(const LAS bf16x8*)(lds + PG8_SA(b, h) + aoff + m * 2048 + k * 1024); } while (0)
#define PG8_LDB(dst, b, h) do { _Pragma("unroll") for (int n = 0; n < 2; ++n) _Pragma("unroll") for (int k = 0; k < 2; ++k) dst[n][k] = *(const LAS bf16x8*)(lds + PG8_SB(b, h) + boff + n * 2048 + k * 1024); } while (0)
#define PG8_MMA(ai, bj, At, Bt) do { __builtin_amdgcn_s_setprio(1); _Pragma("unroll") for (int m = 0; m < 4; ++m) _Pragma("unroll") for (int n = 0; n < 2; ++n) _Pragma("unroll") for (int k = 0; k < 2; ++k) \
        acc[ai][bj][m][n] = __builtin_amdgcn_mfma_f32_16x16x32_bf16(Bt[n][k], At[m][k], acc[ai][bj][m][n], 0, 0, 0); __builtin_amdgcn_s_setprio(0); } while (0)
#define PG8_WAIT_V(n) asm volatile("s_waitcnt vmcnt(" #n ")" ::: "memory")
#define PG8_WAIT_L(n) asm volatile("s_waitcnt lgkmcnt(" #n ")" ::: "memory")
#define PG8_BAR __builtin_amdgcn_s_barrier()
#define PG8_SCHED __builtin_amdgcn_sched_barrier(0)
    Unit cur, nxt; int ui = 0;
    if (!S.next(0, cur)) return;
    f32x4 acc[2][2][4][2];
#pragma unroll
    for (int a = 0; a < 2; ++a)
#pragma unroll
        for (int b = 0; b < 2; ++b)
#pragma unroll
            for (int m = 0; m < 4; ++m)
#pragma unroll
                for (int n = 0; n < 2; ++n) acc[a][b][m][n] = (f32x4){0.f, 0.f, 0.f, 0.f};
    bf16x8 At[4][2], B0[2][2], B1[2][2];
    const char* cA = S.abase(cur); const char* cB = S.bbase(cur);
    if constexpr (SP2) {
        PG8_STAGE(PG8_SB(0, 0), cB, voffB); PG8_STAGE(PG8_SB(0, 1), cB + hstep, voffB); PG8_STAGE(PG8_SA(0, 0), cA, voffA); PG8_STAGE(PG8_SA(0, 1), cA + hstep, voffA);
        if (wr == 1) PG8_BAR;
        PG8_WAIT_V(2); PG8_BAR;
        PG8_STAGE(PG8_SB(1, 0), cB + kstep, voffB); PG8_STAGE(PG8_SA(1, 0), cA + kstep, voffA); PG8_STAGE(PG8_SB(1, 1), cB + hstep + kstep, voffB);
        PG8_WAIT_V(6); PG8_BAR;
    } else {
        PG8_STAGE(PG8_SB(0, 0), cB, voffB); PG8_STAGE(PG8_SA(0, 0), cA, voffA); PG8_STAGE(PG8_SB(0, 1), cB + hstep, voffB); PG8_STAGE(PG8_SA(0, 1), cA + hstep, voffA);
        if (wr == 1) PG8_BAR;
        PG8_WAIT_V(4); PG8_BAR;
        PG8_STAGE(PG8_SB(1, 0), cB + kstep, voffB); PG8_STAGE(PG8_SA(1, 0), cA + kstep, voffA); PG8_STAGE(PG8_SB(1, 1), cB + hstep + kstep, voffB);
        PG8_WAIT_V(6); PG8_BAR;
    }
    for (;;) {
        const bool has_next = S.next(ui + 1, nxt);
        const char* nA = has_next ? S.abase(nxt) : cA; const char* nB = has_next ? S.bbase(nxt) : cB;
        for (int t = 0; t < nt; t += 2) {
            const bool last = (t == nt - 2);
            const char* a1 = cA + (size_t)(t + 1) * kstep;
            const char* a2 = last ? nA : cA + (size_t)(t + 2) * kstep; const char* b2 = last ? nB : cB + (size_t)(t + 2) * kstep;
            const char* a3 = a2 + kstep; const char* b3 = b2 + kstep;
            if constexpr (SP2) {
            PG8_LDB(B0, 0, 0); PG8_LDB(B1, 0, 1); PG8_SCHED; PG8_LDA(At, 0, 0); PG8_STAGE(PG8_SA(1, 1), a1 + hstep, voffA);
            PG8_WAIT_V(8); PG8_WAIT_L(0); PG8_BAR; PG8_MMA(0, 0, At, B0); PG8_MMA(0, 1, At, B1); PG8_BAR; PG8_SCHED;
            PG8_LDA(At, 0, 1); PG8_STAGE(PG8_SB(0, 0), b2, voffB); PG8_STAGE(PG8_SB(0, 1), b2 + hstep, voffB); PG8_STAGE(PG8_SA(0, 0), a2, voffA);
            PG8_WAIT_V(8); PG8_WAIT_L(0); PG8_BAR; PG8_MMA(1, 0, At, B0); PG8_MMA(1, 1, At, B1); PG8_BAR; PG8_SCHED;
            PG8_LDB(B0, 1, 0); PG8_LDB(B1, 1, 1); PG8_SCHED; PG8_LDA(At, 1, 0); PG8_STAGE(PG8_SA(0, 1), a2 + hstep, voffA);
            PG8_WAIT_V(8); PG8_WAIT_L(0); PG8_BAR; PG8_MMA(0, 0, At, B0); PG8_MMA(0, 1, At, B1); PG8_BAR; PG8_SCHED;
            PG8_LDA(At, 1, 1); PG8_STAGE(PG8_SB(1, 0), b3, voffB); PG8_STAGE(PG8_SB(1, 1), b3 + hstep, voffB); PG8_STAGE(PG8_SA(1, 0), a3, voffA);
            PG8_WAIT_V(8); PG8_WAIT_L(0); PG8_BAR; PG8_MMA(1, 0, At, B0); PG8_MMA(1, 1, At, B1); PG8_BAR; PG8_SCHED;
            } else {
            PG8_LDB(B0, 0, 0); PG8_SCHED; PG8_LDA(At, 0, 0); PG8_STAGE(PG8_SA(1, 1), a1 + hstep, voffA);
            PG8_WAIT_L(8); PG8_BAR; PG8_WAIT_L(0); PG8_MMA(0, 0, At, B0); PG8_BAR; PG8_SCHED;
            PG8_LDB(B1, 0, 1); PG8_STAGE(PG8_SB(0, 0), b2, voffB);
            PG8_BAR; PG8_WAIT_L(0); PG8_MMA(0, 1, At, B1); PG8_BAR;
            PG8_LDA(At, 0, 1); PG8_STAGE(PG8_SA(0, 0), a2, voffA);
            PG8_BAR; PG8_WAIT_L(0); PG8_MMA(1, 0, At, B0); PG8_BAR; PG8_SCHED;
            PG8_STAGE(PG8_SB(0, 1), b2 + hstep, voffB);
            PG8_WAIT_V(6); PG8_BAR; PG8_MMA(1, 1, At, B1); PG8_BAR;
            PG8_LDB(B0, 1, 0); PG8_SCHED; PG8_LDA(At, 1, 0); PG8_STAGE(PG8_SA(0, 1), a2 + hstep, voffA);
            PG8_WAIT_L(8); PG8_BAR; PG8_WAIT_L(0); PG8_MMA(0, 0, At, B0); PG8_BAR; PG8_SCHED;
            PG8_LDB(B1, 1, 1); PG8_STAGE(PG8_SB(1, 0), b3, voffB);
            PG8_BAR; PG8_WAIT_L(0); PG8_MMA(0, 1, At, B1); PG8_BAR;
            PG8_LDA(At, 1, 1); PG8_STAGE(PG8_SA(1, 0), a3, voffA);
            PG8_BAR; PG8_WAIT_L(0); PG8_MMA(1, 0, At, B0); PG8_BAR; PG8_SCHED;
            PG8_STAGE(PG8_SB(1, 1), b3 + hstep, voffB);
            PG8_WAIT_V(6); PG8_BAR; PG8_MMA(1, 1, At, B1); PG8_BAR;
            }
        }
        if constexpr (ALIGN_EPI) { if (wr == 0) PG8_BAR; }
        E(acc, cur, wr, wc, fr, fq);
        if (!has_next) break;
#pragma unroll
        for (int a = 0; a < 2; ++a)
#pragma unroll
            for (int b = 0; b < 2; ++b)
#pragma unroll
                for (int m = 0; m < 4; ++m)
#pragma unroll
                    for (int n = 0; n < 2; ++n) acc[a][b][m][n] = (f32x4){0.f, 0.f, 0.f, 0.f};
        cur = nxt; cA = nA; cB = nB; ++ui;
        if constexpr (ALIGN_EPI) { if (wr == 1) PG8_BAR; }
    }
    PG8_WAIT_V(0);
    if constexpr (!ALIGN_EPI) { if (wr == 0) PG8_BAR; }
    PG8_BAR;
#undef PG8_SA
#undef PG8_SB
#undef PG8_STAGE
#undef PG8_LDA
#undef PG8_LDB
#undef PG8_MMA
#undef PG8_WAIT_V
#undef PG8_WAIT_L
#undef PG8_BAR
#undef PG8_SCHED
}

typedef const f32x4 (&AccRef)[2][2][4][2];

__device__ __forceinline__ float row_rs(const float* ss, int row) {
    const f32x4* p = (const f32x4*)(ss + (size_t)row * 32); float s = 0.f;
#pragma unroll
    for (int i = 0; i < 8; ++i) { const f32x4 v = p[i]; s += (v[0] + v[1]) + (v[2] + v[3]); }
    return __builtin_amdgcn_rsqf(s * (1.0f / DM) + RMS_EPS);
}

struct EpiInProj {
    static constexpr bool PERM = true;
    bf16_t* proj; bf16_t* kb; bf16_t* vb; const float* rs0; const f32x2* rope;
    __device__ __forceinline__ void operator()(AccRef acc, const Unit& u, int wr, int wc, int fr, int fq) const {
        const int row0 = u.pm * BM + wr * 64 + fr;
        if (u.z == 1) {
            bf16_t* base = (u.pn < 8 ? kb : vb) + (u.pn & 7) * BM + wc * 32 + 8 * fq;
#pragma unroll
            for (int ai = 0; ai < 2; ++ai)
#pragma unroll
                for (int m = 0; m < 4; ++m) { bf16_t* rowp = base + (size_t)(row0 + ai * HALF + m * 16) * DM;
#pragma unroll
                    for (int bj = 0; bj < 2; ++bj) { const f32x4 v0 = acc[ai][bj][m][0], v1 = acc[ai][bj][m][1]; u32x4 w;
                        w.x = cvt_pk_bf16(v0[0], v0[1]); w.y = cvt_pk_bf16(v0[2], v0[3]); w.z = cvt_pk_bf16(v1[0], v1[1]); w.w = cvt_pk_bf16(v1[2], v1[3]);
                        *(u32x4*)(rowp + bj * HALF) = w; } }
            return;
        }
        const int pn = u.pn; const bool rp = (pn >= 12 && pn < 20);
        const float sc = pn < 4 ? NA_QS : ((pn >= 12 && pn < 16) ? DF_QS : 1.0f);
        if (!rp) {
            bf16_t* base = proj + pn * BM + wc * 32 + 8 * fq;
#pragma unroll
            for (int ai = 0; ai < 2; ++ai)
#pragma unroll
                for (int m = 0; m < 4; ++m) { const int row = row0 + ai * HALF + m * 16; const float rr = rs0[row] * sc; bf16_t* rowp = base + (size_t)row * INW;
#pragma unroll
                    for (int bj = 0; bj < 2; ++bj) { const f32x4 v0 = acc[ai][bj][m][0] * rr, v1 = acc[ai][bj][m][1] * rr; u32x4 w;
                        w.x = cvt_pk_bf16(v0[0], v0[1]); w.y = cvt_pk_bf16(v0[2], v0[3]); w.z = cvt_pk_bf16(v1[0], v1[1]); w.w = cvt_pk_bf16(v1[2], v1[3]);
                        *(u32x4*)(rowp + bj * HALF) = w; } }
        } else {
            const int dd0 = 16 * (wc & 1) + 4 * fq;
            bf16_t* base = proj + pn * BM + (wc >> 1) * 64 + dd0;
#pragma unroll
            for (int ai = 0; ai < 2; ++ai)
#pragma unroll
                for (int m = 0; m < 4; ++m) { const int row = row0 + ai * HALF + m * 16; const float rr = rs0[row] * sc; bf16_t* rowp = base + (size_t)row * INW;
                    const int t = row < NP ? (row & (TP - 1)) : (row & (TS - 1));
                    const f32x4 cs0 = *(const f32x4*)(rope + (size_t)t * 32 + dd0), cs1 = *(const f32x4*)(rope + (size_t)t * 32 + dd0 + 2);
#pragma unroll
                    for (int bj = 0; bj < 2; ++bj) { const f32x4 x1 = acc[ai][bj][m][0] * rr, x2 = acc[ai][bj][m][1] * rr;
                        const float a0 = x1[0] * cs0[0] - x2[0] * cs0[1], a1 = x1[1] * cs0[2] - x2[1] * cs0[3], a2 = x1[2] * cs1[0] - x2[2] * cs1[1], a3 = x1[3] * cs1[2] - x2[3] * cs1[3];
                        const float b0 = x2[0] * cs0[0] + x1[0] * cs0[1], b1 = x2[1] * cs0[2] + x1[1] * cs0[3], b2 = x2[2] * cs1[0] + x1[2] * cs1[1], b3 = x2[3] * cs1[2] + x1[3] * cs1[3];
                        u32x2 wa, wb; wa.x = cvt_pk_bf16(a0, a1); wa.y = cvt_pk_bf16(a2, a3); wb.x = cvt_pk_bf16(b0, b1); wb.y = cvt_pk_bf16(b2, b3);
                        *(u32x2*)(rowp + bj * HALF) = wa; *(u32x2*)(rowp + bj * HALF + 32) = wb; } }
        }
    }
};
struct EpiPre {
    static constexpr bool PERM = true;
    bf16_t* wqk; bf16_t* wvo;
    __device__ __forceinline__ void operator()(AccRef acc, const Unit& u, int wr, int wc, int fr, int fq) const {
        const int zz = u.z % 24, b = zz >> 2, h = zz & 3; bf16_t* base; int ldc; float sc;
        if (u.z < 24) { base = wqk + ((size_t)(b * 1024 + h * 256)) * DM + u.pn * BM; ldc = DM; sc = MEM_QS; }
        else { base = wvo + ((size_t)(b * 2048 + u.pm * BM)) * NSW + h * 256; ldc = NSW; sc = 1.0f; }
        base += wc * 32 + 8 * fq;
#pragma unroll
        for (int ai = 0; ai < 2; ++ai)
#pragma unroll
            for (int m = 0; m < 4; ++m) { bf16_t* rowp = base + (size_t)(wr * 64 + fr + ai * HALF + m * 16) * ldc;
#pragma unroll
                for (int bj = 0; bj < 2; ++bj) { const f32x4 v0 = acc[ai][bj][m][0] * sc, v1 = acc[ai][bj][m][1] * sc; u32x4 w;
                    w.x = cvt_pk_bf16(v0[0], v0[1]); w.y = cvt_pk_bf16(v0[2], v0[3]); w.z = cvt_pk_bf16(v1[0], v1[1]); w.w = cvt_pk_bf16(v1[2], v1[3]);
                    *(u32x4*)(rowp + bj * HALF) = w; } }
    }
};
__device__ __forceinline__ float row_rs4(const float* ss, int row, int fq) {
    const f32x4* p = (const f32x4*)(ss + (size_t)row * 32 + fq * 8); const f32x4 a = p[0], b = p[1];
    float s = ((a[0] + a[1]) + (a[2] + a[3])) + ((b[0] + b[1]) + (b[2] + b[3]));
    s += __shfl_xor(s, 16); s += __shfl_xor(s, 32);
    return __builtin_amdgcn_rsqf(s * (1.0f / DM) + RMS_EPS);
}
struct EpiResid {
    static constexpr bool PERM = false;
    const float* basef; const bf16_t* baseb; bf16_t* ob; int ldo; float* ss;
    __device__ __forceinline__ void operator()(AccRef acc, const Unit& u, int wr, int wc, int fr, int fq) const {
        const int col0 = u.pn * BM + wc * 32 + 4 * fq;
#pragma unroll
        for (int ai = 0; ai < 2; ++ai)
#pragma unroll
            for (int m = 0; m < 4; ++m) { const int row = u.pm * BM + ai * HALF + wr * 64 + m * 16 + fr; const size_t off = (size_t)row * DM + col0; bf16_t* orow = ob + (size_t)row * ldo + col0; float q = 0.f;
#pragma unroll
                for (int bj = 0; bj < 2; ++bj)
#pragma unroll
                    for (int n = 0; n < 2; ++n) { const int o2 = bj * HALF + n * 16; f32x4 bv;
                        if (baseb) { const u32x2 w = *(const u32x2*)(baseb + off + o2); bv = (f32x4){__uint_as_float(w.x << 16), __uint_as_float(w.x & 0xffff0000u), __uint_as_float(w.y << 16), __uint_as_float(w.y & 0xffff0000u)}; }
                        else bv = *(const f32x4*)(basef + off + o2);
                        const f32x4 o = bv + acc[ai][bj][m][n]; q += (o[0] * o[0] + o[1] * o[1]) + (o[2] * o[2] + o[3] * o[3]);
                        u32x2 w2; w2.x = cvt_pk_bf16(o[0], o[1]); w2.y = cvt_pk_bf16(o[2], o[3]); *(u32x2*)(orow + o2) = w2; }
                q += __shfl_xor(q, 16); q += __shfl_xor(q, 32);
                if (fq == 0) ss[(size_t)row * 32 + u.pn * 4 + wc] = q; }
    }
};
struct EpiX { static constexpr bool PERM = false; const float* xp; const float* xs; bf16_t* ob; float* ss;
    __device__ __forceinline__ void operator()(AccRef acc, const Unit& u, int wr, int wc, int fr, int fq) const {
        const float* base = (u.pm < NP / 256) ? xp : xs - (size_t)NP * DM; EpiResid E{base, nullptr, ob, DM, ss}; E(acc, u, wr, wc, fr, fq); } };
struct EpiSm {
    static constexpr bool PERM = false;
    bf16_t* P; const float* ss; LAS unsigned char* tab;
    __device__ __forceinline__ void operator()(AccRef acc, const Unit& u, int wr, int wc, int fr, int fq) const {
        float rr[2][4];
#pragma unroll
        for (int ai = 0; ai < 2; ++ai)
#pragma unroll
            for (int m = 0; m < 4; ++m) { const int rl = ai * HALF + wr * 64 + m * 16 + fr; const float r_ = row_rs4(ss, u.pm * BM + rl, fq); rr[ai][m] = r_;
                float mx = acc[ai][0][m][0][0];
#pragma unroll
                for (int bj = 0; bj < 2; ++bj)
#pragma unroll
                    for (int n = 0; n < 2; ++n) { const f32x4 v = acc[ai][bj][m][n]; mx = fmaxf(fmaxf(mx, fmaxf(v[0], v[1])), fmaxf(v[2], v[3])); }
                mx *= r_; mx = fmaxf(mx, __shfl_xor(mx, 16)); mx = fmaxf(mx, __shfl_xor(mx, 32));
                float sm = 0.f;
#pragma unroll
                for (int bj = 0; bj < 2; ++bj)
#pragma unroll
                    for (int n = 0; n < 2; ++n) { const f32x4 v = acc[ai][bj][m][n];
                        sm += (__builtin_amdgcn_exp2f(v[0] * r_ - mx) + __builtin_amdgcn_exp2f(v[1] * r_ - mx)) + (__builtin_amdgcn_exp2f(v[2] * r_ - mx) + __builtin_amdgcn_exp2f(v[3] * r_ - mx)); }
                sm += __shfl_xor(sm, 16); sm += __shfl_xor(sm, 32);
                if (fq == 0) *(LAS f32x2*)(tab + (rl * 4 + wc) * 8) = (f32x2){mx, sm}; }
        asm volatile("s_waitcnt lgkmcnt(0)" ::: "memory"); __builtin_amdgcn_s_barrier(); asm volatile("" ::: "memory");
        const int col0 = u.pn * BM + wc * 32 + 4 * fq;
#pragma unroll
        for (int ai = 0; ai < 2; ++ai)
#pragma unroll
            for (int m = 0; m < 4; ++m) { const int rl = ai * HALF + wr * 64 + m * 16 + fr; const float r_ = rr[ai][m];
                const f32x4 t0 = *(const LAS f32x4*)(tab + rl * 32), t1 = *(const LAS f32x4*)(tab + rl * 32 + 16);
                const float M = fmaxf(fmaxf(t0[0], t0[2]), fmaxf(t1[0], t1[2]));
                const float L = (t0[1] * __builtin_amdgcn_exp2f(t0[0] - M) + t0[3] * __builtin_amdgcn_exp2f(t0[2] - M)) + (t1[1] * __builtin_amdgcn_exp2f(t1[0] - M) + t1[3] * __builtin_amdgcn_exp2f(t1[2] - M));
                const float inv = __builtin_amdgcn_rcpf(L);
                bf16_t* rowp = P + (size_t)(u.pm * BM + rl) * NSW + col0;
#pragma unroll
                for (int bj = 0; bj < 2; ++bj)
#pragma unroll
                    for (int n = 0; n < 2; ++n) { const f32x4 v = acc[ai][bj][m][n]; u32x2 w;
                        w.x = cvt_pk_bf16(__builtin_amdgcn_exp2f(v[0] * r_ - M) * inv, __builtin_amdgcn_exp2f(v[1] * r_ - M) * inv);
                        w.y = cvt_pk_bf16(__builtin_amdgcn_exp2f(v[2] * r_ - M) * inv, __builtin_amdgcn_exp2f(v[3] * r_ - M) * inv);
                        *(u32x2*)(rowp + bj * HALF + n * 16) = w; } }
    }
};
struct EpiGU {
    static constexpr bool PERM = true;
    bf16_t* act; const float* ss;
    __device__ __forceinline__ void operator()(AccRef acc, const Unit& u, int wr, int wc, int fr, int fq) const {
        bf16_t* base = act + u.pn * HALF + wc * 32 + 8 * fq;
#pragma unroll
        for (int ai = 0; ai < 2; ++ai)
#pragma unroll
            for (int m = 0; m < 4; ++m) { const int row = u.pm * BM + ai * HALF + wr * 64 + m * 16 + fr; const float rr = row_rs4(ss, row, fq); float o[8];
#pragma unroll
                for (int n = 0; n < 2; ++n)
#pragma unroll
                    for (int e = 0; e < 4; ++e) { const float g = acc[ai][0][m][n][e] * rr, up = acc[ai][1][m][n][e] * rr;
                        o[n * 4 + e] = g * __builtin_amdgcn_rcpf(1.0f + __builtin_amdgcn_exp2f(-g * LOG2E)) * up; }
                u32x4 w; w.x = cvt_pk_bf16(o[0], o[1]); w.y = cvt_pk_bf16(o[2], o[3]); w.z = cvt_pk_bf16(o[4], o[5]); w.w = cvt_pk_bf16(o[6], o[7]);
                *(u32x4*)(base + (size_t)row * DFF) = w; }
    }
};
}

namespace att {
#define SBAR() __builtin_amdgcn_sched_barrier(0)
constexpr float THR = 8.0f;
constexpr int SHM_V = 16384, SHM_K = 16384, OFF_K = 2 * SHM_V, OFF_WS = OFF_K + 2 * SHM_K, OFF_RPB = OFF_WS + 8 * 256, OFF_STG = OFF_RPB + 2048, OFF_END = OFF_STG + 8 * 8192;
constexpr int DF_R = 5, DF_D = 4;
constexpr int DF_K = DF_R * SHM_V, DF_KSZ = 8192, DF_WS = DF_K + DF_R * DF_KSZ, DF_STG = 0  , DF_END = DF_WS + 8 * 256;
static_assert(8 * 8192 <= DF_K, "output stage fits inside the V ring");
static_assert(DF_END <= 147456 && OFF_END <= 147456, "attention LDS maps fit the dynamic LDS allocation");
__device__ __forceinline__ int crow(int r, int hi) { return (r & 3) + 8 * (r >> 2) + 4 * hi; }
#define KSWZ128(row, colB) ((row) * 256 + ((colB) ^ (((row) & 7) << 4)))
#define KSWZ64(row, colB) ((row) * 128 + ((colB) ^ ((((row) >> 1) & 7) << 4)))
__device__ __forceinline__ int v_st(int k, int c) { const int kk = (k & ~0xC) | ((k & 4) << 1) | ((k & 8) >> 1); return ((kk >> 3) * 4 + (c >> 5)) * 512 + ((kk & 7) * 32 + (c & 31)) * 2; }
__device__ __forceinline__ int v_rd_base(int lane) { return ((lane & 3) << 3) | (((lane >> 2) & 3) << 6) | (((lane >> 4) & 1) << 5) | (((lane >> 5) & 1) << 8); }
constexpr int v_rd_off(int d0, int ks, int half) { return d0 * 512 + ks * 4096 + half * 2048; }
template <int OFF> __device__ __forceinline__ s16x4 tr_read(int vb) { s16x4 r; asm volatile("ds_read_b64_tr_b16 %0, %1 offset:%2" : "=&v"(r) : "v"(vb), "i"(OFF) : "memory"); return r; }
template <int D0> __device__ __forceinline__ void pv_one(f32x16& od, int vb, bf16x8 pa0, bf16x8 pa1, bf16x8 pa2, bf16x8 pa3) {
    const s16x4 l0 = tr_read<v_rd_off(D0, 0, 0)>(vb), h0 = tr_read<v_rd_off(D0, 0, 1)>(vb), l1 = tr_read<v_rd_off(D0, 1, 0)>(vb), h1 = tr_read<v_rd_off(D0, 1, 1)>(vb);
    const s16x4 l2 = tr_read<v_rd_off(D0, 2, 0)>(vb), h2 = tr_read<v_rd_off(D0, 2, 1)>(vb), l3 = tr_read<v_rd_off(D0, 3, 0)>(vb), h3 = tr_read<v_rd_off(D0, 3, 1)>(vb);
    asm volatile("s_waitcnt lgkmcnt(0)" ::: "memory"); SBAR();
#define PK(L, H) (bf16x8){L[0], L[1], L[2], L[3], H[0], H[1], H[2], H[3]}
    od = __builtin_amdgcn_mfma_f32_32x32x16_bf16(pa0, PK(l0, h0), od, 0, 0, 0);
    od = __builtin_amdgcn_mfma_f32_32x32x16_bf16(pa1, PK(l1, h1), od, 0, 0, 0);
    od = __builtin_amdgcn_mfma_f32_32x32x16_bf16(pa2, PK(l2, h2), od, 0, 0, 0);
    od = __builtin_amdgcn_mfma_f32_32x32x16_bf16(pa3, PK(l3, h3), od, 0, 0, 0);
#undef PK
}
template <int D0> __device__ __forceinline__ void pv_rd(s16x4 (&L)[4], s16x4 (&H)[4], int vb) {
    L[0] = tr_read<v_rd_off(D0, 0, 0)>(vb); H[0] = tr_read<v_rd_off(D0, 0, 1)>(vb); L[1] = tr_read<v_rd_off(D0, 1, 0)>(vb); H[1] = tr_read<v_rd_off(D0, 1, 1)>(vb);
    L[2] = tr_read<v_rd_off(D0, 2, 0)>(vb); H[2] = tr_read<v_rd_off(D0, 2, 1)>(vb); L[3] = tr_read<v_rd_off(D0, 3, 0)>(vb); H[3] = tr_read<v_rd_off(D0, 3, 1)>(vb);
}
#define PV_PK(L, H) (bf16x8){L[0], L[1], L[2], L[3], H[0], H[1], H[2], H[3]}
#define PV_MMA(od, L, H) do { od = __builtin_amdgcn_mfma_f32_32x32x16_bf16(pa0, PV_PK(L[0], H[0]), od, 0, 0, 0); od = __builtin_amdgcn_mfma_f32_32x32x16_bf16(pa1, PV_PK(L[1], H[1]), od, 0, 0, 0); \
    od = __builtin_amdgcn_mfma_f32_32x32x16_bf16(pa2, PV_PK(L[2], H[2]), od, 0, 0, 0); od = __builtin_amdgcn_mfma_f32_32x32x16_bf16(pa3, PV_PK(L[3], H[3]), od, 0, 0, 0); } while (0)
__device__ __forceinline__ void pv_all_pre(f32x16* o, int vb, bf16x8 pa0, bf16x8 pa1, bf16x8 pa2, bf16x8 pa3) {
    s16x4 L0[4], H0[4], L1[4], H1[4], L2[4], H2[4], L3[4], H3[4];
    pv_rd<0>(L0, H0, vb); pv_rd<1>(L1, H1, vb);
    asm volatile("s_waitcnt lgkmcnt(8)" ::: "memory"); SBAR(); PV_MMA(o[0], L0, H0); SBAR();
    pv_rd<2>(L2, H2, vb);
    asm volatile("s_waitcnt lgkmcnt(8)" ::: "memory"); SBAR(); PV_MMA(o[1], L1, H1); SBAR();
    pv_rd<3>(L3, H3, vb);
    asm volatile("s_waitcnt lgkmcnt(8)" ::: "memory"); SBAR(); PV_MMA(o[2], L2, H2); SBAR();
    asm volatile("s_waitcnt lgkmcnt(0)" ::: "memory"); SBAR(); PV_MMA(o[3], L3, H3); SBAR();
}
__device__ __forceinline__ void pv_all(f32x16* o, int vb, bf16x8 pa0, bf16x8 pa1, bf16x8 pa2, bf16x8 pa3) {
    pv_one<0>(o[0], vb, pa0, pa1, pa2, pa3); pv_one<1>(o[1], vb, pa0, pa1, pa2, pa3); pv_one<2>(o[2], vb, pa0, pa1, pa2, pa3); pv_one<3>(o[3], vb, pa0, pa1, pa2, pa3);
}
__device__ __forceinline__ void softmax_tile(f32x16& p0, f32x16& p1, float& m_reg, float& l_reg, float& alpha, bf16x8& pa0, bf16x8& pa1, bf16x8& pa2, bf16x8& pa3) {
    float pmax = p0[0];
#pragma unroll
    for (int r = 1; r < 16; ++r) pmax = fmaxf(pmax, p0[r]);
#pragma unroll
    for (int r = 0; r < 16; ++r) pmax = fmaxf(pmax, p1[r]);
    { auto rr = __builtin_amdgcn_permlane32_swap(__float_as_uint(pmax), __float_as_uint(pmax), false, false); pmax = fmaxf(__uint_as_float(rr[0]), __uint_as_float(rr[1])); }
    float mn;
    if (__builtin_expect(__all(pmax - m_reg <= THR), 1)) { mn = m_reg; alpha = 1.f; }
    else { mn = fmaxf(m_reg, pmax); alpha = __builtin_amdgcn_exp2f(m_reg - mn); m_reg = mn; }
#pragma unroll
    for (int r = 0; r < 16; ++r) { p0[r] = __builtin_amdgcn_exp2f(p0[r] - mn); p1[r] = __builtin_amdgcn_exp2f(p1[r] - mn); }
    float ps = 0.f;
#pragma unroll
    for (int r = 0; r < 16; ++r) ps += p0[r];
#pragma unroll
    for (int r = 0; r < 16; ++r) ps += p1[r];
    { auto rr = __builtin_amdgcn_permlane32_swap(__float_as_uint(ps), __float_as_uint(ps), false, false); ps = __uint_as_float(rr[0]) + __uint_as_float(rr[1]); }
    l_reg = l_reg * alpha + ps;
#define PK4(P, BASE, OUT) do { unsigned a0 = cvt_pk_bf16(P[BASE + 0], P[BASE + 1]), a1 = cvt_pk_bf16(P[BASE + 2], P[BASE + 3]);   \
    unsigned b0 = cvt_pk_bf16(P[BASE + 4], P[BASE + 5]), b1 = cvt_pk_bf16(P[BASE + 6], P[BASE + 7]);                              \
    auto r0 = __builtin_amdgcn_permlane32_swap(a0, b0, false, false); auto r1 = __builtin_amdgcn_permlane32_swap(a1, b1, false, false); \
    u32x4 w = {r0[0], r1[0], r0[1], r1[1]}; OUT = __builtin_bit_cast(bf16x8, w); } while (0)
    PK4(p0, 0, pa0); PK4(p0, 8, pa1); PK4(p1, 0, pa2); PK4(p1, 8, pa3);
#undef PK4
}
__device__ __forceinline__ void softmax_rel(f32x16& p0, f32x16& p1, float& m_reg, float& l_reg, f32x16& negm, float& alpha, bool first, bf16x8& pa0, bf16x8& pa1, bf16x8& pa2, bf16x8& pa3) {
    float ma = __builtin_fmaxf(__builtin_fmaxf(p0[0], p0[1]), p0[2]), mb = __builtin_fmaxf(__builtin_fmaxf(p0[8], p0[9]), p0[10]);
    float mc = __builtin_fmaxf(__builtin_fmaxf(p1[0], p1[1]), p1[2]), md = __builtin_fmaxf(__builtin_fmaxf(p1[8], p1[9]), p1[10]);
    ma = __builtin_fmaxf(__builtin_fmaxf(ma, p0[3]), p0[4]); mb = __builtin_fmaxf(__builtin_fmaxf(mb, p0[11]), p0[12]); mc = __builtin_fmaxf(__builtin_fmaxf(mc, p1[3]), p1[4]); md = __builtin_fmaxf(__builtin_fmaxf(md, p1[11]), p1[12]);
    ma = __builtin_fmaxf(__builtin_fmaxf(ma, p0[5]), p0[6]); mb = __builtin_fmaxf(__builtin_fmaxf(mb, p0[13]), p0[14]); mc = __builtin_fmaxf(__builtin_fmaxf(mc, p1[5]), p1[6]); md = __builtin_fmaxf(__builtin_fmaxf(md, p1[13]), p1[14]);
    ma = __builtin_fmaxf(__builtin_fmaxf(ma, p0[7]), mb); mc = __builtin_fmaxf(__builtin_fmaxf(mc, p1[7]), md);
    float pmax = __builtin_fmaxf(__builtin_fmaxf(ma, p0[15]), __builtin_fmaxf(mc, p1[15]));
    { auto rr = __builtin_amdgcn_permlane32_swap(__float_as_uint(pmax), __float_as_uint(pmax), false, false); pmax = __builtin_fmaxf(__uint_as_float(rr[0]), __uint_as_float(rr[1])); }
    alpha = 1.f;
    if (__builtin_expect(first || !__all(pmax <= THR), 0)) {
        const float dl = first ? pmax : fmaxf(pmax, 0.f);
        m_reg += dl; alpha = first ? 1.f : __builtin_amdgcn_exp2f(-dl);
#pragma unroll
        for (int r = 0; r < 16; ++r) { p0[r] -= dl; p1[r] -= dl; negm[r] = -m_reg; }
    }
#pragma unroll
    for (int r = 0; r < 16; ++r) { p0[r] = __builtin_amdgcn_exp2f(p0[r]); p1[r] = __builtin_amdgcn_exp2f(p1[r]); }
    float ps0 = p0[0], ps1 = p1[0], ps2 = p0[8], ps3 = p1[8];
#pragma unroll
    for (int r = 1; r < 8; ++r) { ps0 += p0[r]; ps1 += p1[r]; ps2 += p0[8 + r]; ps3 += p1[8 + r]; }
    l_reg = l_reg * alpha + ((ps0 + ps1) + (ps2 + ps3));
#define PK4N(P, BASE, OUT) do { u32x4 w = {cvt_pk_bf16(P[BASE + 0], P[BASE + 1]), cvt_pk_bf16(P[BASE + 2], P[BASE + 3]), cvt_pk_bf16(P[BASE + 4], P[BASE + 5]), cvt_pk_bf16(P[BASE + 6], P[BASE + 7])}; \
    OUT = __builtin_bit_cast(bf16x8, w); } while (0)
    PK4N(p0, 0, pa0); PK4N(p0, 8, pa1); PK4N(p1, 0, pa2); PK4N(p1, 8, pa3);
#undef PK4N
}
#define ATT_RESC2(a) do { if (__any((a) < 1.f)) { if (hi == 0) al_l[r32] = (a); asm volatile("s_waitcnt lgkmcnt(0)" ::: "memory"); \
    _Pragma("unroll") for (int r = 0; r < 16; ++r) { const float f_ = al_l[crow(r, hi)]; o[0][r] *= f_; o[1][r] *= f_; o[2][r] *= f_; o[3][r] *= f_; } } } while (0)
#define ATT_RESC(a) do { if (__any((a) < 1.f)) { if (hi == 0) al_l[r32] = (a); asm volatile("s_waitcnt lgkmcnt(0)" ::: "memory"); \
    _Pragma("unroll") for (int d = 0; d < 4; ++d) _Pragma("unroll") for (int r = 0; r < 16; ++r) o[d][r] *= al_l[crow(r, hi)]; } } while (0)

__device__ __forceinline__ void diff_unit(const bf16_t* __restrict__ proj, bf16_t* __restrict__ mix, float* __restrict__ o1s, const float* __restrict__ g_sub, float lam,
                                          int rowbase, int T, int h, int qb, char* lds, int widk) {
    const int tid = tid_l(widk), wid = tid >> 6, lane = tid & 63, r32 = lane & 31, hi = lane >> 5;
    char* V_lds = lds; char* K_lds = lds + DF_K;
    float* wsf = (float*)(lds + DF_WS) + wid * 64; float* li_l = wsf; float* al_l = wsf + 32;
    LAS unsigned char* ldsl = (LAS unsigned char*)lds; const int widu = __builtin_amdgcn_readfirstlane(wid); const int grp = widu >> 2;
    unsigned kgo, vgo[2];
    { const int X = wid * 1024 + lane * 16, krow = X >> 7, kcolB = (X & 127) ^ (((krow >> 1) & 7) << 4); kgo = (unsigned)(krow * INW * 2 + kcolB); }
#pragma unroll
    for (int i = 0; i < 2; ++i) { const int X = wid * 1024 + lane * 16 + i * 8192, sub = X >> 9, e = (X & 511) >> 1, kk = (sub >> 2) * 8 + (e >> 5), cc = (sub & 3) * 32 + (e & 31);
        vgo[i] = (unsigned)((kk * INW + cc) * 2); }
    const int vb0 = (int)(uintptr_t)V_lds + v_rd_base(lane);
    const int NT = T / 64; const int q0 = qb * 256;
    const bf16_t* Vh = proj + (size_t)rowbase * INW + 5120 + h * 128;
#define BAR() do { asm volatile("" ::: "memory"); __builtin_amdgcn_s_barrier(); asm volatile("" ::: "memory"); } while (0)
#pragma unroll 1
    for (int s = 0; s < 2; ++s) {
        const bf16_t* Kh = proj + (size_t)rowbase * INW + 4096 + h * 128 + s * 64;
        const unsigned qoff = ((unsigned)(rowbase + q0 + wid * 32 + r32) * INW + 3072 + h * 128 + s * 64 + hi * 8) * 2u;
        bf16x8 qr[4];
#pragma unroll
        for (int d0 = 0; d0 < 4; ++d0) qr[d0] = *(const bf16x8*)((const char*)proj + qoff + d0 * 32);
        float m_reg = 0.f, l_reg = 0.f; f32x16 o[4], negm = f32x16{};
#pragma unroll
        for (int d = 0; d < 4; ++d) o[d] = f32x16{};
#define DDMA(j, b) do { const char* kt = (const char*)Kh + (size_t)(j) * (64 * INW * 2); const char* vt = (const char*)Vh + (size_t)(j) * (64 * INW * 2); \
        __builtin_amdgcn_global_load_lds((const unsigned*)(kt + kgo), (LAS unsigned*)(ldsl + DF_K + (b) * DF_KSZ + widu * 1024), 16, 0, 0); \
        __builtin_amdgcn_global_load_lds((const unsigned*)(vt + vgo[0]), (LAS unsigned*)(ldsl + (b) * SHM_V + widu * 1024), 16, 0, 0); \
        __builtin_amdgcn_global_load_lds((const unsigned*)(vt + vgo[1]), (LAS unsigned*)(ldsl + (b) * SHM_V + widu * 1024 + 8192), 16, 0, 0); } while (0)
#pragma unroll
        for (int t = 0; t < DF_D; ++t) DDMA(t, t);
        asm volatile("s_waitcnt vmcnt(%0)" :: "n"(3 * (DF_D - 1)) : "memory"); BAR();
        int ka[4];
#pragma unroll
        for (int d0 = 0; d0 < 4; ++d0) ka[d0] = (int)(uintptr_t)K_lds + KSWZ64(r32, (d0 * 16 + hi * 8) * 2);
#define KRD(dst, addr, OFF) asm volatile("ds_read_b128 %0, %1 offset:" #OFF : "=&v"(dst) : "v"(addr) : "memory")
        if (grp) BAR();
        int bsl = 0;
#pragma unroll 1
        for (int j = 0; j < NT; ++j) {
            BAR();
            f32x16 p0, p1;
            __builtin_amdgcn_s_setprio(1);
            { const int kb = bsl * DF_KSZ; bf16x8 k0, k1, k2, k3, k4, k5, k6, k7; const int a0 = ka[0] + kb, a1 = ka[1] + kb, a2 = ka[2] + kb, a3 = ka[3] + kb;
              KRD(k0, a0, 0); KRD(k1, a0, 4096); KRD(k2, a1, 0); KRD(k3, a1, 4096); KRD(k4, a2, 0); KRD(k5, a2, 4096); KRD(k6, a3, 0); KRD(k7, a3, 4096);
              asm volatile("s_waitcnt lgkmcnt(6)" ::: "memory"); SBAR();
              asm volatile("v_mfma_f32_32x32x16_bf16 %0, %1, %2, %3" : "=&v"(p0) : "v"(k0), "v"(qr[0]), "v"(negm));
              asm volatile("v_mfma_f32_32x32x16_bf16 %0, %1, %2, %3" : "=&v"(p1) : "v"(k1), "v"(qr[0]), "v"(negm)); SBAR();
              asm volatile("s_waitcnt lgkmcnt(4)" ::: "memory"); SBAR();
              p0 = __builtin_amdgcn_mfma_f32_32x32x16_bf16(k2, qr[1], p0, 0, 0, 0); p1 = __builtin_amdgcn_mfma_f32_32x32x16_bf16(k3, qr[1], p1, 0, 0, 0); SBAR();
              asm volatile("s_waitcnt lgkmcnt(2)" ::: "memory"); SBAR();
              p0 = __builtin_amdgcn_mfma_f32_32x32x16_bf16(k4, qr[2], p0, 0, 0, 0); p1 = __builtin_amdgcn_mfma_f32_32x32x16_bf16(k5, qr[2], p1, 0, 0, 0); SBAR();
              asm volatile("s_waitcnt lgkmcnt(0)" ::: "memory"); SBAR();
              p0 = __builtin_amdgcn_mfma_f32_32x32x16_bf16(k6, qr[3], p0, 0, 0, 0); p1 = __builtin_amdgcn_mfma_f32_32x32x16_bf16(k7, qr[3], p1, 0, 0, 0); SBAR(); }
            __builtin_amdgcn_s_setprio(0);
            float alpha; bf16x8 pa0, pa1, pa2, pa3;
            softmax_rel(p0, p1, m_reg, l_reg, negm, alpha, j == 0, pa0, pa1, pa2, pa3);
            ATT_RESC2(alpha);
            if (j + DF_D <= NT) asm volatile("s_waitcnt vmcnt(%0) lgkmcnt(0)" :: "n"(3 * (DF_D - 2)) : "memory"); else asm volatile("s_waitcnt vmcnt(0) lgkmcnt(0)" ::: "memory");
            BAR();
            if (j + DF_D < NT) { const int b2 = bsl >= 1 ? bsl - 1 : DF_R - 1; DDMA(j + DF_D, b2); }
            const int bn = bsl == DF_R - 1 ? 0 : bsl + 1;
            pv_all_pre(o, vb0 + bsl * SHM_V, pa0, pa1, pa2, pa3);
            bsl = bn;
        }
#undef KRD
        asm volatile("s_waitcnt lgkmcnt(0)" ::: "memory");
        if (!grp) BAR();
        BAR();
#undef DDMA
        { auto rr = __builtin_amdgcn_permlane32_swap(__float_as_uint(l_reg), __float_as_uint(l_reg), false, false); l_reg = __uint_as_float(rr[0]) + __uint_as_float(rr[1]); }
        if (hi == 0) li_l[r32] = l_reg;
        asm volatile("s_waitcnt lgkmcnt(0)" ::: "memory");
        float rli[16];
#pragma unroll
        for (int r = 0; r < 16; ++r) rli[r] = __builtin_amdgcn_rcpf(li_l[crow(r, hi)]);
        f32x4* o1v = (f32x4*)((char*)o1s + (unsigned)tid * 256u);
        if (s == 0) {
#pragma unroll
            for (int d = 0; d < 4; ++d)
#pragma unroll
                for (int r = 0; r < 16; r += 4) o1v[d * 4 + (r >> 2)] = (f32x4){o[d][r] * rli[r], o[d][r + 1] * rli[r + 1], o[d][r + 2] * rli[r + 2], o[d][r + 3] * rli[r + 3]};
        } else {
#pragma unroll
            for (int d = 0; d < 4; ++d)
#pragma unroll
                for (int r = 0; r < 16; r += 4) { const f32x4 t = o1v[d * 4 + (r >> 2)];
#pragma unroll
                    for (int e = 0; e < 4; ++e) o[d][r + e] = t[e] - lam * (o[d][r + e] * rli[r + e]); }
            float gs[4];
#pragma unroll
            for (int d = 0; d < 4; ++d) gs[d] = g_sub[d * 32 + r32] * (1.0f - LAM_INIT);
            bf16_t* stg = (bf16_t*)(lds + DF_STG) + wid * 4096;
#pragma unroll
            for (int r = 0; r < 16; ++r) {
                float q = (o[0][r] * o[0][r] + o[1][r] * o[1][r]) + (o[2][r] * o[2][r] + o[3][r] * o[3][r]);
                q += __shfl_xor(q, 1); q += __shfl_xor(q, 2); q += __shfl_xor(q, 4); q += __shfl_xor(q, 8); q += __shfl_xor(q, 16);
                const float rn = __builtin_amdgcn_rsqf(q * (1.0f / 128.0f) + SUBLN_EPS);
#pragma unroll
                for (int d = 0; d < 4; ++d) stg[crow(r, hi) * 128 + d * 32 + r32] = (bf16_t)f2bf(o[d][r] * rn * gs[d]);
            }
            asm volatile("s_waitcnt lgkmcnt(0)" ::: "memory");
            const unsigned goff = ((unsigned)(rowbase + q0 + wid * 32 + (lane >> 4)) * DM + 1024 + h * 128 + (lane & 15) * 8) * 2u;
#pragma unroll
            for (int i = 0; i < 8; ++i) { const u32x4 v = *(const u32x4*)(stg + (i * 4 + (lane >> 4)) * 128 + (lane & 15) * 8); *(u32x4*)((char*)mix + goff + (unsigned)(i * 4 * DM * 2)) = v; }
            asm volatile("s_waitcnt lgkmcnt(0)" ::: "memory"); BAR();
        }
    }
#undef BAR
}

__device__ __forceinline__ void na_unit(const bf16_t* __restrict__ proj, bf16_t* __restrict__ mix, const float* __restrict__ rpb,
                                        int rowbase, int ROWS, int h, int rg, char* lds, int widk) {
    const int tid = tid_l(widk), wid = tid >> 6, lane = tid & 63, r32 = lane & 31, hi = lane >> 5;
    char* V_lds = lds; char* K_lds = lds + OFF_K;
    float* wsf = (float*)(lds + OFF_WS) + wid * 64; float* li_l = wsf; float* al_l = wsf + 32;
    float* rpbL = (float*)(lds + OFF_RPB);
    LAS unsigned char* ldsl = (LAS unsigned char*)lds; const int widu = __builtin_amdgcn_readfirstlane(wid);
    unsigned kgo[2], vgo[2];
#pragma unroll
    for (int i = 0; i < 2; ++i) { const int X = wid * 1024 + lane * 16 + i * 8192;
        { const int krow = X >> 8, kcolB = (X & 255) ^ ((krow & 7) << 4); kgo[i] = (unsigned)(krow * INW * 2 + kcolB); }
        { const int sub = X >> 9, e = (X & 511) >> 1, kk = (sub >> 2) * 8 + (e >> 5), cc = (sub & 3) * 32 + (e & 31); const int k = (kk & ~0xC) | ((kk & 4) << 1) | ((kk & 8) >> 1); vgo[i] = (unsigned)((k * INW + cc) * 2); } }
    const int vb0 = (int)(uintptr_t)V_lds + v_rd_base(lane);
    const int r0 = rg * 4, rq = r0 + (wid >> 1), c = 32 * (wid & 1) + r32;
    const int rsw = min(max(rq - 4, 0), ROWS - 8), cs = min(max(c - 8, 0), 48);
    const int klo = min(max(r0 - 4, 0), ROWS - 8), khi = min(max(r0 + 3 - 4, 0), ROWS - 8) + 8;
    for (int i = tid; i < 465; i += NTHREADS) rpbL[i] = rpb[h * 465 + i] * LOG2E;
    const bf16_t* Kh = proj + (size_t)rowbase * INW + 1024 + h * 128;
    const bf16_t* Vh = proj + (size_t)rowbase * INW + 2048 + h * 128;
    const bf16_t* Qw = proj + (size_t)(rowbase + rq * 64 + c) * INW + h * 128 + hi * 8;
    bf16x8 qr[8];
#pragma unroll
    for (int d0 = 0; d0 < 8; ++d0) qr[d0] = *(const bf16x8*)(Qw + d0 * 16);
    float m_reg = -1e30f, l_reg = 0.f; f32x16 o[4];
#pragma unroll
    for (int d = 0; d < 4; ++d) o[d] = f32x16{};
#define NDMA(kr, b) do { const char* kt = (const char*)Kh + (size_t)(kr) * (64 * INW * 2); const char* vt = (const char*)Vh + (size_t)(kr) * (64 * INW * 2); \
        __builtin_amdgcn_global_load_lds((const unsigned*)(kt + kgo[0]), (LAS unsigned*)(ldsl + OFF_K + (b) * SHM_K + widu * 1024), 16, 0, 0); \
        __builtin_amdgcn_global_load_lds((const unsigned*)(kt + kgo[1]), (LAS unsigned*)(ldsl + OFF_K + (b) * SHM_K + widu * 1024 + 8192), 16, 0, 0); \
        __builtin_amdgcn_global_load_lds((const unsigned*)(vt + vgo[0]), (LAS unsigned*)(ldsl + (b) * SHM_V + widu * 1024), 16, 0, 0); \
        __builtin_amdgcn_global_load_lds((const unsigned*)(vt + vgo[1]), (LAS unsigned*)(ldsl + (b) * SHM_V + widu * 1024 + 8192), 16, 0, 0); } while (0)
    NDMA(klo, 0); asm volatile("s_waitcnt vmcnt(0)" ::: "memory"); __syncthreads();
#pragma unroll 1
    for (int kr = klo; kr < khi; ++kr) {
        const int b = (kr - klo) & 1;
        if (kr + 1 < khi) NDMA(kr + 1, b ^ 1);
        if (kr >= rsw && kr < rsw + 8) {
            f32x16 p0 = f32x16{}, p1 = f32x16{};
            const char* Ks = K_lds + b * SHM_K;
#pragma unroll
            for (int d0 = 0; d0 < 8; ++d0) { const int cb = (d0 * 16 + hi * 8) * 2;
                const bf16x8 b0 = *(const bf16x8*)(Ks + KSWZ128(r32, cb)); const bf16x8 b1 = *(const bf16x8*)(Ks + KSWZ128(32 + r32, cb));
                p0 = __builtin_amdgcn_mfma_f32_32x32x16_bf16(b0, qr[d0], p0, 0, 0, 0); p1 = __builtin_amdgcn_mfma_f32_32x32x16_bf16(b1, qr[d0], p1, 0, 0, 0); }
            const float* brow = rpbL + (kr - rq + 7) * 31;
#pragma unroll
            for (int r = 0; r < 16; ++r) {
                const int kc = crow(r, hi), kc2 = kc + 32;
                const int i0 = min(max(kc - c + 15, 0), 30), i1 = min(max(kc2 - c + 15, 0), 30);
                const float b0 = brow[i0], b1 = brow[i1];
                p0[r] = ((unsigned)(kc - cs) < 16u) ? p0[r] + b0 : -1e30f;
                p1[r] = ((unsigned)(kc2 - cs) < 16u) ? p1[r] + b1 : -1e30f;
            }
            float alpha; bf16x8 pa0, pa1, pa2, pa3;
            softmax_tile(p0, p1, m_reg, l_reg, alpha, pa0, pa1, pa2, pa3);
            ATT_RESC(alpha);
            pv_all(o, vb0 + b * SHM_V, pa0, pa1, pa2, pa3);
        }
        asm volatile("s_waitcnt vmcnt(0)" ::: "memory");
        __syncthreads();
    }
#undef NDMA
    if (hi == 0) li_l[r32] = l_reg;
    asm volatile("s_waitcnt lgkmcnt(0)" ::: "memory");
    bf16_t* stg = (bf16_t*)(lds + OFF_STG) + wid * 4096;
#pragma unroll
    for (int r = 0; r < 16; ++r) { const float rl = __builtin_amdgcn_rcpf(li_l[crow(r, hi)]);
#pragma unroll
        for (int d = 0; d < 4; ++d) stg[crow(r, hi) * 128 + d * 32 + r32] = (bf16_t)f2bf(o[d][r] * rl); }
    asm volatile("s_waitcnt lgkmcnt(0)" ::: "memory");
    bf16_t* gp = mix + (size_t)(rowbase + rq * 64 + 32 * (wid & 1) + (lane >> 4)) * DM + h * 128 + (lane & 15) * 8;
#pragma unroll
    for (int i = 0; i < 8; ++i) { const u32x4 v = *(const u32x4*)(stg + (i * 4 + (lane >> 4)) * 128 + (lane & 15) * 8); *(u32x4*)gp = v; gp += 4 * DM; }
    __syncthreads();
}
#undef SBAR
}

template <int MODE> __device__ __forceinline__ int dest_row(int n) {
    if (MODE == 1) { if (n < 3072 || n >= 5120) return n; const int d = n & 63, blk = n & ~63, nn = d >> 5, dd = d & 31; return blk + 32 * (dd >> 4) + 8 * ((dd >> 2) & 3) + 4 * nn + (dd & 3); }
    if (MODE == 2) { if (n < DFF) return 256 * (n >> 7) + (n & 127); const int n2 = n - DFF; return 256 * (n2 >> 7) + 128 + (n2 & 127); }
    return n;
}
template <int MODE> __device__ __forceinline__ void p0_transpose_item(const float* __restrict__ W, int K, int N, bf16_t* __restrict__ WT, const float* __restrict__ gain, LAS float* scr, int item, int lane) {
    const int nblk = N / 32, kb = item / nblk, nb = item % nblk, k0 = 64 * kb, n0 = 32 * nb;
#pragma unroll
    for (int i = 0; i < 8; ++i) { const int kk = 8 * i + (lane >> 3), c4 = (lane & 7) * 4; const float g = gain ? gain[k0 + kk] : 1.0f;
        const f32x4 v = *(const f32x4*)(W + (size_t)(k0 + kk) * N + n0 + c4); LAS float* d = scr + kk * 33 + c4; d[0] = v[0] * g; d[1] = v[1] * g; d[2] = v[2] * g; d[3] = v[3] * g; }
    asm volatile("s_waitcnt lgkmcnt(0)" ::: "memory");
    const int c = lane & 7;
#pragma unroll
    for (int j = 0; j < 4; ++j) { const int n = (lane >> 3) + 8 * j; const LAS float* s = scr + (8 * c) * 33 + n;
        u32x4 o; o.x = pk2(s[0 * 33], s[1 * 33]); o.y = pk2(s[2 * 33], s[3 * 33]); o.z = pk2(s[4 * 33], s[5 * 33]); o.w = pk2(s[6 * 33], s[7 * 33]);
        *(u32x4*)(WT + (size_t)dest_row<MODE>(n0 + n) * K + k0 + 8 * c) = o; }
    asm volatile("s_waitcnt lgkmcnt(0)" ::: "memory");
}
__device__ __forceinline__ float row_ssq(const float* xrow, int lane, f32x4 (&v)[8]) {
    const f32x4* xr = (const f32x4*)xrow + lane; float s = 0.f;
#pragma unroll
    for (int j = 0; j < 8; ++j) { v[j] = xr[64 * j]; s += (v[j][0] * v[j][0] + v[j][1] * v[j][1]) + (v[j][2] * v[j][2] + v[j][3] * v[j][3]); }
    return wave_sum(s);
}
__device__ __forceinline__ void sincos_d(double x, double& sn, double& cs) {
    const double k = __builtin_rint(x * 0.6366197723675814); const double r0 = __builtin_fma(-k, 1.5707963267948966, x); const double r = __builtin_fma(-k, 6.123233995736766e-17, r0);
    const double r2 = r * r;
    double s = -1.0 / 1307674368000.0; s = s * r2 + 1.0 / 6227020800.0; s = s * r2 - 1.0 / 39916800.0; s = s * r2 + 1.0 / 362880.0; s = s * r2 - 1.0 / 5040.0; s = s * r2 + 1.0 / 120.0; s = s * r2 - 1.0 / 6.0; s = s * r2 * r + r;
    double c = 1.0 / 20922789888000.0; c = c * r2 - 1.0 / 87178291200.0; c = c * r2 + 1.0 / 479001600.0; c = c * r2 - 1.0 / 3628800.0; c = c * r2 + 1.0 / 40320.0; c = c * r2 - 1.0 / 720.0; c = c * r2 + 1.0 / 24.0; c = c * r2 - 0.5; c = c * r2 + 1.0;
    const int q = ((int)k) & 3;
    sn = (q == 0) ? s : (q == 1) ? c : (q == 2) ? -s : -c;
    cs = (q == 0) ? c : (q == 1) ? -s : (q == 2) ? -c : s;
}

struct Args { const float* in[22]; float* out; unsigned char* ws; int ph_lo, ph_hi; };
constexpr int NPHASE = 10;

__global__ void __launch_bounds__(NTHREADS, 2) fwd_kernel(Args a) {
    extern __shared__ __attribute__((aligned(16))) unsigned char lds[];
    LAS unsigned char* ldsl = (LAS unsigned char*)lds;
    const int widk = __builtin_amdgcn_readfirstlane((int)(threadIdx.x >> 6));
    const int G = gridDim.x, bx = blockIdx.x, vcu = (G % 8 == 0) ? (bx % 8) * (G / 8) + bx / 8 : bx;
#define x_p (ap->in[0])
#define x_s (ap->in[1])
#define mem_p (ap->in[2])
#define mem_s (ap->in[3])
#define g_mix (ap->in[4])
#define w_in (ap->in[5])
#define rpb (ap->in[6])
#define lam_q1 (ap->in[7])
#define lam_k1 (ap->in[8])
#define lam_q2 (ap->in[9])
#define lam_k2 (ap->in[10])
#define g_subln (ap->in[11])
#define w_out (ap->in[12])
#define g_xattn (ap->in[13])
#define g_mem (ap->in[14])
#define w_mq (ap->in[15])
#define w_mkv (ap->in[16])
#define w_mo (ap->in[17])
#define g_ffn (ap->in[18])
#define w_gu (ap->in[19])
#define w_dn (ap->in[20])
#define g_final (ap->in[21])
#define out (ap->out)
#define WSP() const __attribute__((address_space(4))) Args* ap = (const __attribute__((address_space(4))) Args*)__builtin_amdgcn_kernarg_segment_ptr(); asm volatile("" : "+s"(ap)); unsigned char* ws = ap->ws
#define SS ((float*)(ws + WS_SS))
#define RS0 ((float*)(ws + WS_RS0))
#define ROPE ((f32x2*)(ws + WS_ROPE))
#define WIN ((bf16_t*)(ws + WS_WIN))
#define WOUT ((bf16_t*)(ws + WS_WOUT))
#define WMQ ((bf16_t*)(ws + WS_WMQ))
#define WMO ((bf16_t*)(ws + WS_WMO))
#define WMKV ((bf16_t*)(ws + WS_WMKV))
#define WGU ((bf16_t*)(ws + WS_WGU))
#define WDN ((bf16_t*)(ws + WS_WDN))
#define MN ((bf16_t*)(ws + WS_MN))
#define KB ((bf16_t*)(ws + WS_KB))
#define VB ((bf16_t*)(ws + WS_VB))
#define WQK ((bf16_t*)(ws + WS_WQK))
#define WVO ((bf16_t*)(ws + WS_WVO))
#define O1S ((float*)(ws + WS_O1))
#define XB ((bf16_t*)(ws + WS_XB))
#define PROJ ((bf16_t*)(ws + WS_BIG))
#define H1B ((bf16_t*)(ws + WS_H1B))
#define SB ((float*)(ws + WS_S))
#define PB ((bf16_t*)(ws + WS_P))
#define ACT ((bf16_t*)(ws + WS_ACT))
#define MIX XB
#define H2B XB
    const int lo = a.ph_lo, hi_ph = a.ph_hi;
    if (lo < 0) cg::this_grid().sync();
#ifdef ONLY_PHASE
#define IN(k) ((k) == ONLY_PHASE && lo <= (k) && (k) < hi_ph)
#else
#define IN(k) (lo <= (k) && (k) < hi_ph)
#endif
    volatile LAS unsigned* xst = (volatile LAS unsigned*)(ldsl + LDS_BYTES - 64);
    const unsigned xcc = __builtin_amdgcn_readfirstlane((int)xb_xcc_id());
    { const int t0 = tid_l(widk); if (t0 < 2) xst[t0] = 0u;
      if (t0 == 0 && hi_ph - lo > 1) { const __attribute__((address_space(4))) Args* ap0 = (const __attribute__((address_space(4))) Args*)__builtin_amdgcn_kernarg_segment_ptr(); (void)xb_add((unsigned*)(ap0->ws + WS_BAR) + XB_XCNT(xcc), 1u); }
      __syncthreads(); }
#define SEAM(k) do { if (IN(k) && IN((k) + 1)) { WSP(); xcd_barrier((unsigned*)(ws + WS_BAR), xcc, (unsigned)G, xst, tid_l(widk)); } } while (0)
    const int NGW = G * 8;
#define TIDS() const int tid = tid_l(widk), lane = tid & 63, wave = __builtin_amdgcn_readfirstlane(tid >> 6), gw = vcu * 8 + wave; (void)lane; (void)gw

    if (IN(0)) { WSP(); TIDS();
        LAS float* scr = (LAS float*)(ldsl + wave * 16384);
        constexpr int I0 = (DM / 64) * (INW / 32), I1 = (DM / 64) * (DM / 32), I2 = I1, I3 = (DM / 64) * (4096 / 32), I4 = (DM / 64) * (NGU / 32), I5 = (DFF / 64) * (DM / 32);
        constexpr int NIT = I0 + I1 + I2 + I3 + I4 + I5;
        for (int it = gw; it < NIT; it += NGW) {
            int r = it;
            if (r < I0) { p0_transpose_item<1>(w_in, DM, INW, WIN, g_mix, scr, r, lane); continue; } r -= I0;
            if (r < I1) { p0_transpose_item<0>(w_out, DM, DM, WOUT, nullptr, scr, r, lane); continue; } r -= I1;
            if (r < I2) { p0_transpose_item<0>(w_mo, DM, DM, WMO, nullptr, scr, r, lane); continue; } r -= I2;
            if (r < I3) { p0_transpose_item<0>(w_mkv, DM, 4096, WMKV, nullptr, scr, r, lane); continue; } r -= I3;
            if (r < I4) { p0_transpose_item<2>(w_gu, DM, NGU, WGU, g_ffn, scr, r, lane); continue; } r -= I4;
            p0_transpose_item<0>(w_dn, DFF, DM, WDN, nullptr, scr, r, lane);
        }
        for (int k = gw; k < DM; k += NGW) { const float g = g_xattn[k]; const f32x4* src = (const f32x4*)(w_mq + (size_t)k * DM) + lane; u32x2* dst = (u32x2*)(WMQ + (size_t)k * DM) + lane;
#pragma unroll
            for (int j = 0; j < 8; ++j) { const f32x4 v = src[64 * j] * g; u32x2 w; w.x = pk2(v[0], v[1]); w.y = pk2(v[2], v[3]); dst[64 * j] = w; } }
        for (int m = gw; m < MT; m += NGW) { const float* xr = m < NP ? x_p + (size_t)m * DM : x_s + (size_t)(m - NP) * DM; f32x4 v[8];
            const float s = row_ssq(xr, lane, v); if (lane == 0) RS0[m] = 1.0f / sqrtf(s * (1.0f / DM) + RMS_EPS);
            u32x2* dst = (u32x2*)(XB + (size_t)m * DM) + lane;
#pragma unroll
            for (int j = 0; j < 8; ++j) { u32x2 w; w.x = pk2(v[j][0], v[j][1]); w.y = pk2(v[j][2], v[j][3]); dst[64 * j] = w; } }
        for (int m = gw; m < NMEM; m += NGW) { const float* xr = m < 512 ? mem_p + (size_t)m * DM : mem_s + (size_t)(m - 512) * DM; f32x4 v[8];
            const float s = row_ssq(xr, lane, v); const float rr = 1.0f / sqrtf(s * (1.0f / DM) + RMS_EPS);
            u32x2* dst = (u32x2*)(MN + (size_t)m * DM) + lane; const f32x4* gp = (const f32x4*)g_mem + lane;
#pragma unroll
            for (int j = 0; j < 8; ++j) { const f32x4 g = gp[64 * j]; u32x2 w; w.x = pk2(v[j][0] * rr * g[0], v[j][1] * rr * g[1]); w.y = pk2(v[j][2] * rr * g[2], v[j][3] * rr * g[3]); dst[64 * j] = w; } }
        for (int e = vcu * NTHREADS + tid; e < TP * 32; e += G * NTHREADS) { const int t = e >> 5, dd = e & 31;
            double pw = 1.0; for (int i = 0; i < dd; ++i) pw *= 1.333521432163324;
            const float inv = 1.0f / (float)pw; const float ang = (float)t * inv; double sn, cs; sincos_d((double)ang, sn, cs);
            ROPE[e] = (f32x2){(float)cs, (float)sn}; }
    }
    SEAM(0);

    if (IN(1)) { WSP();
        pg8::Sched S{(const char*)XB, (const char*)WIN, (const char*)MN, (const char*)WMKV, MT / 256, INW / 256, (MT / 256) * (INW / 256), NMEM / 256, (NMEM / 256) * 16,
                     (size_t)256 * DM * 2, (size_t)256 * DM * 2, 0, G, bx};
        pg8::EpiInProj E{PROJ, KB, VB, RS0, ROPE};
        pg8::gemm_phase<pg8::EpiInProj, pg8::Sched, true, true>(ldsl, widk, DM, DM, S, E);
    }
    SEAM(1);

    if (IN(2)) { WSP(); TIDS();
#if !defined(P2_PART) || P2_PART == 1
        { pg8::PreSched S{(const char*)KB, (const char*)VB, (const char*)WMQ, (const char*)WMO, G, bx}; pg8::EpiPre E{WQK, WVO};
          pg8::gemm_phase<pg8::EpiPre, pg8::PreSched, true, true>(ldsl, widk, 512, DM, S, E); }
#endif
        __syncthreads();
#if !defined(P2_PART) || P2_PART == 2
        for (int id = vcu; id < 1024 + 512; id += G) {
            const bool pr = id < 1024; const int i2 = pr ? id : id - 1024;
            const int rg = pr ? (i2 & 63) : (i2 & 15), h = pr ? ((i2 >> 6) & 7) : ((i2 >> 4) & 7), b = pr ? (i2 >> 9) : (i2 >> 7);
            att::na_unit(PROJ, MIX, rpb, pr ? b * TP : NP + b * TS, pr ? TP / 64 : TS / 64, h, rg, (char*)lds, widk);
        }
#endif
#if !defined(P2_PART) || P2_PART == 3
        float lam;
        { const float a1 = wave_sum(lam_q1[lane] * lam_k1[lane]), a2 = wave_sum(lam_q2[lane] * lam_k2[lane]); lam = __expf(a1) - __expf(a2) + LAM_INIT; lam = __builtin_bit_cast(float, __builtin_amdgcn_readfirstlane(__builtin_bit_cast(int, lam))); }
        float* o1s = O1S + (size_t)bx * 64 * NTHREADS;
#ifndef DIFF_REPS
#define DIFF_REPS 1
#endif
        for (int rep = 0; rep < DIFF_REPS; ++rep)
        for (int id = vcu; id < 1024 + 512; id += G) {
            const bool pr = id < 1024; const int i2 = pr ? id : id - 1024;
            const int qb = pr ? (i2 & 63) : (i2 & 15), bh = pr ? (i2 >> 6) : (i2 >> 4);
            att::diff_unit(PROJ, MIX, o1s, g_subln, lam, pr ? (bh >> 3) * TP : NP + (bh >> 3) * TS, pr ? TP : TS, bh & 7, qb, (char*)lds, widk);
        }
#endif
    }
    SEAM(2);

    if (IN(3)) { WSP();
        pg8::Sched S{(const char*)MIX, (const char*)WOUT, nullptr, nullptr, MT / 256, DM / 256, (MT / 256) * (DM / 256), 1, 0, (size_t)256 * DM * 2, (size_t)256 * DM * 2, 0, G, bx};
        pg8::EpiX E{x_p, x_s, H1B, SS};
        pg8::gemm_phase<pg8::EpiX, pg8::Sched, true, true>(ldsl, widk, DM, DM, S, E);
    }
    SEAM(3);

    if (IN(4)) { WSP();
        pg8::Sched S{(const char*)H1B, (const char*)WQK, nullptr, nullptr, MT / 256, NSW / 256, (MT / 256) * (NSW / 256), 1, 0, (size_t)256 * DM * 2, (size_t)256 * DM * 2, (size_t)NSW * DM * 2, G, bx};
        pg8::EpiSm E{PB, SS, ldsl + pg8::STAGE_BYTES};
        pg8::gemm_phase<pg8::EpiSm, pg8::Sched, true, true>(ldsl, widk, DM, DM, S, E);
    }
    SEAM(4);


    if (IN(6)) { WSP();
        pg8::Sched S{(const char*)PB, (const char*)WVO, nullptr, nullptr, MT / 256, DM / 256, (MT / 256) * (DM / 256), 1, 0, (size_t)256 * NSW * 2, (size_t)256 * NSW * 2, (size_t)DM * NSW * 2, G, bx};
        pg8::EpiResid E{nullptr, H1B, H2B, DM, SS};
        pg8::gemm_phase<pg8::EpiResid, pg8::Sched, true, true>(ldsl, widk, NSW, NSW, S, E);
    }
    SEAM(6);

    if (IN(7)) { WSP();
        pg8::Sched S{(const char*)H2B, (const char*)WGU, nullptr, nullptr, MT / 256, NGU / 256, (MT / 256) * (NGU / 256), 1, 0, (size_t)256 * DM * 2, (size_t)256 * DM * 2, 0, G, bx};
        pg8::EpiGU E{ACT, SS};
        pg8::gemm_phase<pg8::EpiGU, pg8::Sched, true, true>(ldsl, widk, DM, DM, S, E);
    }
    SEAM(7);

    if (IN(8)) { WSP();
        pg8::Sched S{(const char*)ACT, (const char*)WDN, nullptr, nullptr, MT / 256, DM / 256, (MT / 256) * (DM / 256), 1, 0, (size_t)256 * DFF * 2, (size_t)256 * DFF * 2, 0, G, bx};
        pg8::EpiResid E{nullptr, H2B, (bf16_t*)out + DM, 2 * DM, SS};
        pg8::gemm_phase<pg8::EpiResid, pg8::Sched, true, true>(ldsl, widk, DFF, DFF, S, E);
    }
    SEAM(8);

    if (IN(9)) { WSP(); TIDS();
        for (int m = gw; m < MT; m += NGW) {
            float sq = lane < 32 ? SS[(size_t)m * 32 + lane] : 0.f; sq = wave_sum(sq); const float rr = __builtin_amdgcn_rsqf(sq * (1.0f / DM) + RMS_EPS);
            const u32x2* hp = (const u32x2*)((const bf16_t*)out + (size_t)m * (2 * DM) + DM) + lane;
            u32x2 hv[8];
#pragma unroll
            for (int j = 0; j < 8; ++j) hv[j] = hp[64 * j];
            asm volatile("s_waitcnt vmcnt(0)" ::: "memory");
            f32x4* op = (f32x4*)(out + (size_t)m * DM) + lane; const f32x4* gp = (const f32x4*)g_final + lane;
#pragma unroll
            for (int j = 0; j < 8; ++j) { const f32x4 g = gp[64 * j];
                const f32x4 v = (f32x4){__uint_as_float(hv[j].x << 16), __uint_as_float(hv[j].x & 0xffff0000u), __uint_as_float(hv[j].y << 16), __uint_as_float(hv[j].y & 0xffff0000u)};
                op[64 * j] = v * rr * g; }
        }
    }
#undef IN
#undef SEAM
#undef TIDS
}
#undef x_p
#undef x_s
#undef mem_p
#undef mem_s
#undef g_mix
#undef w_in
#undef rpb
#undef lam_q1
#undef lam_k1
#undef lam_q2
#undef lam_k2
#undef g_subln
#undef w_out
#undef g_xattn
#undef g_mem
#undef w_mq
#undef w_mkv
#undef w_mo
#undef g_ffn
#undef w_gu
#undef w_dn
#undef g_final
#undef out
#undef WSP
#undef SS
#undef RS0
#undef ROPE
#undef WIN
#undef WOUT
#undef WMQ
#undef WMO
#undef WMKV
#undef WGU
#undef WDN
#undef MN
#undef KB
#undef VB
#undef WQK
#undef WVO
#undef O1S
#undef XB
#undef PROJ
#undef H1B
#undef SB
#undef PB
#undef ACT
#undef MIX
#undef H2B


extern "C" void kernel_launch(void* const* d_in, const int* in_sizes, int n_in, void* d_out, int out_size, void* d_ws, size_t ws_size, hipStream_t stream) {
    static int grid = 0;
    if (grid == 0) {
        if (n_in != 22 || out_size != MT * DM || ws_size < WS_END) { fprintf(stderr, "kernel_launch: unexpected shapes (n_in %d, out %d, ws %zu); nothing launched\n", n_in, out_size, ws_size); grid = -1; return; }
        int dev = 0, cus = 0, per_cu = 0;
        (void)hipGetDevice(&dev); (void)hipDeviceGetAttribute(&cus, hipDeviceAttributeMultiprocessorCount, dev);
        if (hipFuncSetAttribute((const void*)fwd_kernel, hipFuncAttributeMaxDynamicSharedMemorySize, LDS_BYTES) != hipSuccess) { fprintf(stderr, "kernel_launch: hipFuncSetAttribute failed\n"); grid = -1; return; }
        if (hipOccupancyMaxActiveBlocksPerMultiprocessor(&per_cu, (const void*)fwd_kernel, NTHREADS, LDS_BYTES) != hipSuccess || per_cu < 1) per_cu = 1;
        (void)hipGetLastError();
        grid = cus * per_cu;
    }
    if (grid < 0) return;
    Args a{};
    for (int i = 0; i < 22; ++i) a.in[i] = (const float*)d_in[i];
    a.out = (float*)d_out; a.ws = (unsigned char*)d_ws;
#if MK_MULTI
    for (int p = 0; p < NPHASE; ++p) { a.ph_lo = p; a.ph_hi = p + 1; hipLaunchKernelGGL(fwd_kernel, dim3(grid), dim3(NTHREADS), LDS_BYTES, stream, a); }
#else
    a.ph_lo = 0; a.ph_hi = NPHASE;
    (void)hipMemsetAsync((char*)d_ws + WS_BAR, 0, 16384, stream);
    void* args[] = {&a};
    hipError_t e = hipLaunchCooperativeKernel((const void*)fwd_kernel, dim3(grid), dim3(NTHREADS), args, LDS_BYTES, stream);
    if (e != hipSuccess) fprintf(stderr, "cooperative launch failed: %s (grid %d)\n", hipGetErrorString(e), grid);
#endif
}
```
